# Optimizing an MI355X kernel written in HIP

```python
import jax, jax.numpy as jnp
from jax import lax
import numpy as np

D_MODEL = 1024
BATCH = 32
SEQ = 2048
DEPTH = 1

CHUNK = 64
N_HEADS = 8
HEAD_DIM = 64
ATTN_WIDTH = N_HEADS * HEAD_DIM
N_IDX_HEADS = 4
IDX_DIM = 64
TOPK_MAX = 256
Q_BLOCK = 128
POOL_WINDOWS = (2, 4, 8, 16)
N_POOL_GROUPS = 4
POOL_WIDTH = 512
POOL_GROUP = POOL_WIDTH // N_POOL_GROUPS
N_BRANCHES = 2
PEER_HEADS = 8
PEER_QDIM = 128
PEER_HALF = PEER_QDIM // 2
N_KEYS = 128
N_EXPERTS = N_KEYS * N_KEYS
PEER_TOPK = 16
TOKEN_BLOCK = 128
EPS = 1e-6
IN_SIZES = (ATTN_WIDTH, HEAD_DIM, HEAD_DIM, N_IDX_HEADS * IDX_DIM, IDX_DIM, N_IDX_HEADS, POOL_WIDTH, N_BRANCHES * D_MODEL)
IN_WIDTH = sum(IN_SIZES)

kernel_name = 'chunk_causal_dsa_pool_peer_hybrid'


def rms_norm(x, g):
    x32 = x.astype(jnp.float32)
    y = x32 * lax.rsqrt(jnp.mean(x32 * x32, axis=-1, keepdims=True) + EPS)
    return (y * g.astype(jnp.float32)).astype(x.dtype)


def dsa_attention(q, k, v, iq, ik, iw):
    B, S = q.shape[0], q.shape[1]
    n_sel = min(TOPK_MAX, S // 4)
    n_blk = S // Q_BLOCK
    key_chunk = jnp.arange(S) // CHUNK
    idx_scale = IDX_DIM ** -0.5
    w_scale = N_IDX_HEADS ** -0.5
    attn_scale = HEAD_DIM ** -0.5

    def to_blocks(a):
        return jnp.swapaxes(a.reshape((B, n_blk, Q_BLOCK) + a.shape[2:]), 0, 1)

    def gather_rows(table, idx):
        return jax.vmap(lambda tb, ib: tb[ib])(table, idx)

    def one_block(args):
        qb, iqb, iwb, blk = args
        q_chunk = (blk * Q_BLOCK + jnp.arange(Q_BLOCK)) // CHUNK
        admissible = key_chunk[None, :] <= q_chunk[:, None]
        rel = jax.nn.relu(jnp.einsum('bqhd,bsd->bqhs', iqb, ik) * idx_scale)
        score = jnp.einsum('bqhs,bqh->bqs', rel, iwb * w_scale).astype(jnp.float32)
        score = jnp.where(admissible[None], score, -jnp.inf)
        _, sel = lax.top_k(score, n_sel)
        k_sel = gather_rows(k, sel)
        v_sel = gather_rows(v, sel)
        ok = key_chunk[sel] <= q_chunk[None, :, None]
        logits = jnp.einsum('bqhd,bqkd->bqhk', qb, k_sel).astype(jnp.float32) * attn_scale
        logits = jnp.where(ok[:, :, None, :], logits, -jnp.inf)
        p = jax.nn.softmax(logits, axis=-1).astype(v.dtype)
        return jnp.einsum('bqhk,bqkd->bqhd', p, v_sel)

    out = lax.map(one_block, (to_blocks(q), to_blocks(iq), to_blocks(iw), jnp.arange(n_blk)))
    return jnp.swapaxes(out, 0, 1).reshape(B, S, ATTN_WIDTH)


def pool_mixer(p, w_grp, s_pool):
    B, S = p.shape[0], p.shape[1]
    pg = p.reshape(B, S, N_POOL_GROUPS, POOL_GROUP).astype(jnp.float32)
    cs = jnp.pad(jnp.cumsum(pg, axis=1), ((0, 0), (1, 0), (0, 0), (0, 0)))
    t = jnp.arange(S)
    outs = []
    for g, w in enumerate(POOL_WINDOWS):
        cs_g = cs[:, :, g, :]
        lo = jnp.maximum(t + 1 - w, 0)
        cnt = (t + 1 - lo).astype(jnp.float32)
        mean = (cs_g[:, t + 1] - cs_g[:, lo]) / cnt[None, :, None]
        outs.append(mean - pg[:, :, g, :])
    mixed = jnp.stack(outs, axis=2).astype(p.dtype)
    mixed = jnp.einsum('bsgc,gcd->bsgd', mixed, w_grp) * s_pool
    return mixed.reshape(B, S, POOL_WIDTH)


def peer_ffn(h, w_q, sub_keys, u, v):
    B, S, D = h.shape
    n_blk = (B * S) // TOKEN_BLOCK
    hb = h.reshape(n_blk, TOKEN_BLOCK, D)

    def one_block(hx):
        q = (hx @ w_q).reshape(TOKEN_BLOCK, PEER_HEADS, 2, PEER_HALF)
        s = jnp.einsum('nhpd,hpkd->nhpk', q, sub_keys).astype(jnp.float32)
        top_s, top_i = lax.top_k(s, PEER_TOPK)
        cand = top_s[:, :, 0, :, None] + top_s[:, :, 1, None, :]
        best_s, best_p = lax.top_k(cand.reshape(TOKEN_BLOCK, PEER_HEADS, PEER_TOPK * PEER_TOPK), PEER_TOPK)
        i1 = jnp.take_along_axis(top_i[:, :, 0], best_p // PEER_TOPK, axis=-1)
        i2 = jnp.take_along_axis(top_i[:, :, 1], best_p % PEER_TOPK, axis=-1)
        expert = (i1 * N_KEYS + i2).reshape(TOKEN_BLOCK, PEER_HEADS * PEER_TOPK)
        gate = jax.nn.softmax(best_s, axis=-1).reshape(TOKEN_BLOCK, PEER_HEADS * PEER_TOPK).astype(hx.dtype)
        u_sel = u[expert]
        v_sel = v[expert]
        act = jax.nn.gelu(jnp.einsum('nd,ned->ne', hx, u_sel), approximate=False)
        return jnp.einsum('ne,ned->nd', gate * act, v_sel)

    return lax.map(one_block, hb).reshape(B, S, D)


def setup_inputs(seed: int = 0) -> dict:
    key = jax.random.key(seed)
    ks = jax.random.split(key, 20)
    f32 = jnp.float32
    D = D_MODEL

    def nrm(k, shape, scale):
        return jax.random.normal(k, shape, f32) * scale

    return {
        'x': nrm(ks[0], (BATCH, SEQ, D), 1.0),
        'c': nrm(ks[1], (BATCH, D), 1.0),
        'w_ada': nrm(ks[2], (DEPTH, D, 6 * D), 0.5 * D ** -0.5),
        'b_ada': nrm(ks[3], (DEPTH, 6 * D), 0.02),
        'g_norm1': 1.0 + nrm(ks[4], (DEPTH, D), 0.02),
        'w_in': nrm(ks[5], (DEPTH, D, IN_WIDTH), D ** -0.5),
        'g_q': 1.0 + nrm(ks[6], (DEPTH, HEAD_DIM), 0.02),
        'g_k': 1.0 + nrm(ks[7], (DEPTH, HEAD_DIM), 0.02),
        'g_ik': 1.0 + nrm(ks[8], (DEPTH, IDX_DIM), 0.02),
        'w_pool_grp': nrm(ks[9], (DEPTH, N_POOL_GROUPS, POOL_GROUP, POOL_GROUP), POOL_GROUP ** -0.5),
        's_pool': 1.0 + nrm(ks[10], (DEPTH, N_POOL_GROUPS, POOL_GROUP), 0.1),
        'w_up_attn': nrm(ks[11], (DEPTH, ATTN_WIDTH, D), ATTN_WIDTH ** -0.5),
        'w_up_pool': nrm(ks[12], (DEPTH, POOL_WIDTH, D), POOL_WIDTH ** -0.5),
        'w_out': nrm(ks[13], (DEPTH, D, D), D ** -0.5),
        'g_norm2': 1.0 + nrm(ks[14], (DEPTH, D), 0.02),
        'w_peer_q': nrm(ks[15], (DEPTH, D, PEER_HEADS * PEER_QDIM), D ** -0.5),
        'peer_subkeys': nrm(ks[16], (DEPTH, PEER_HEADS, 2, N_KEYS, PEER_HALF), PEER_HALF ** -0.5),
        'peer_u': nrm(ks[17], (DEPTH, N_EXPERTS, D), D ** -0.5),
        'peer_v': nrm(ks[18], (DEPTH, N_EXPERTS, D), 0.5),
    }


def reference(x, c, w_ada, b_ada, g_norm1, w_in, g_q, g_k, g_ik, w_pool_grp, s_pool,
              w_up_attn, w_up_pool, w_out, g_norm2, w_peer_q, peer_subkeys, peer_u, peer_v):
    B, S, D = x.shape
    cuts = [int(v) for v in np.cumsum(IN_SIZES)[:-1]]
    for layer in range(DEPTH):
        ada = c @ w_ada[layer] + b_ada[layer]
        shift1, scale1, gate1, shift2, scale2, gate2 = [a[:, None, :] for a in jnp.split(ada, 6, axis=-1)]

        h = rms_norm(x, g_norm1[layer]) * (1.0 + scale1) + shift1
        z = h @ w_in[layer]
        zq, zk, zv, ziq, zik, ziw, zp, zg = jnp.split(z, cuts, axis=-1)
        q = rms_norm(zq.reshape(B, S, N_HEADS, HEAD_DIM), g_q[layer])
        k = rms_norm(zk, g_k[layer])
        iq = ziq.reshape(B, S, N_IDX_HEADS, IDX_DIM)
        ik = rms_norm(zik, g_ik[layer])
        y_attn = dsa_attention(q, k, zv, iq, ik, ziw) @ w_up_attn[layer]
        y_pool = pool_mixer(zp, w_pool_grp[layer], s_pool[layer]) @ w_up_pool[layer]
        g_attn, g_pool = jnp.split(jax.nn.sigmoid(zg), 2, axis=-1)
        mixed = (g_attn * y_attn + g_pool * y_pool) @ w_out[layer]
        x = x + gate1 * mixed

        h2 = rms_norm(x, g_norm2[layer]) * (1.0 + scale2) + shift2
        x = x + gate2 * peer_ffn(h2, w_peer_q[layer], peer_subkeys[layer], peer_u[layer], peer_v[layer])
    return x
```

```cpp
#define GATE_FP8 1
#define MIN_FP8 1
#define ZP_FP8 1
#define X1_BF16 1
#define QN_DSA 1
#define ADA_SPREAD 1
#define QUANT2 1
#define EIDX16 1
#include <hip/hip_runtime.h>
#include <hip/hip_bf16.h>
#include <cstdio>
#include <cstdint>
__device__ __forceinline__ int opaque_tid() { int t = threadIdx.x; asm volatile("" : "+v"(t)); return t; }
namespace pg8 {
#define PG8_LAS __attribute__((address_space(3)))
typedef unsigned short bf16_t;
typedef short bf16x8 __attribute__((ext_vector_type(8)));
typedef float f32x4 __attribute__((ext_vector_type(4)));
typedef unsigned u32x4 __attribute__((ext_vector_type(4)));
constexpr int BM = 256, BK = 64, HALF = 128, HTB = HALF * BK * 2  , STAGE_BYTES = 8 * HTB, NXCD = 8, WGM = 8;

__host__ __device__ __forceinline__ int lds_byte(int r, int c) { const int st = (r >> 4) * 2 + (c >> 5), rr = r & 15, cc = c & 31, ob = rr * 64 + cc * 2; return st * 1024 + (ob ^ (((ob >> 9) & 1) << 5)); }
__host__ __device__ __forceinline__ void stage_rc(int b, int& R, int& C) { const int st = b / 1024, sb = b % 1024, swz = sb ^ (((sb >> 9) & 1) << 5); R = (st >> 1) * 16 + swz / 64; C = (st & 1) * 32 + (swz % 64) / 2; }
__host__ __device__ __forceinline__ int perm32(int rho) { const int n = rho >> 4, i = rho & 15; return 8 * (i >> 2) + 4 * n + (i & 3); }

struct Unit { int pm, pn; };
struct Gemm { const bf16_t* A; const bf16_t* Bt; int M, N, K; };

struct StaticOrder {
    int nM, nN, nwg, G, c;
    __host__ __device__ void init(int M, int N, int G_, int c_) { nM = M / BM; nN = N / BM; nwg = nM * nN; G = G_; c = c_; }
    __host__ __device__ bool next(int i, Unit& u) const {
        const long L = (long)i * G + c; if (L >= nwg) return false;
        int wgid = (int)L; { const int q = nwg / NXCD, r = nwg % NXCD, xcd = wgid % NXCD, off = wgid / NXCD; wgid = (xcd < r ? xcd * (q + 1) : r * (q + 1) + (xcd - r) * q) + off; }
        const int nig = WGM * nN, gid = wgid / nig, fm = gid * WGM, gsz = (nM - fm) < WGM ? (nM - fm) : WGM;
        u.pm = fm + ((wgid % nig) % gsz); u.pn = (wgid % nig) / gsz; return true;
    }
    __device__ __forceinline__ void a_ready(const Unit&) const {}
    __device__ __forceinline__ void done(const Unit&) const {}
};

__device__ __forceinline__ unsigned cvt_pk_bf16(float lo, float hi) { unsigned r; asm volatile("v_cvt_pk_bf16_f32 %0, %1, %2" : "=v"(r) : "v"(lo), "v"(hi)); return r; }
typedef float f32x2 __attribute__((ext_vector_type(2)));
__device__ __forceinline__ f32x2 gelu_pk(f32x2 v) {
    const f32x2 av = __builtin_elementwise_abs(v), d = av * 0.2316418882f + 1.0f;
    f32x2 t; t.x = __builtin_amdgcn_rcpf(d.x); t.y = __builtin_amdgcn_rcpf(d.y);
    f32x2 q = t * 0.5307027145f + (-0.7265760135f); q = q * t + 0.7107068705f; q = q * t + (-0.142248368f); q = q * t + 0.127414796f; q = q * t;
    const f32x2 s = (v * v) * (-0.72134752044f);
    f32x2 e; e.x = __builtin_amdgcn_exp2f(s.x); e.y = __builtin_amdgcn_exp2f(s.y);
    const f32x2 m = v * (q * e), r = v - m;
    f32x2 o; o.x = v.x < 0.f ? m.x : r.x; o.y = v.y < 0.f ? m.y : r.y; return o;
}

template <int ACT  > struct EpiBf16 {
    static constexpr bool PERM = true, AFTER_DRAIN = false; static_assert(ACT == 0 || ACT == 1, "EpiBf16: ACT is 0 (none) or 1 (gelu_pk)");
    bf16_t* O; int ldc; const float* bias; int split_cols; size_t split_stride; float scale0;
    __device__ __forceinline__ void operator()(const f32x4 (&acc)[2][2][4][2], const Unit& u, int wr, int wc, int fr, int fq) const {
        const int row0 = u.pm * BM + wr * 64 + fr; int colt = u.pn * BM; bf16_t* base = O;
        float sc = 1.f; if (split_cols) { const int t = colt / split_cols; base += (size_t)t * split_stride; colt -= t * split_cols; if (t == 0) sc = scale0; }
        const int col0 = colt + wc * 32 + 8 * fq, bcol0 = u.pn * BM + wc * 32 + 8 * fq;
        f32x4 bv[2][2];
#pragma unroll
        for (int bj = 0; bj < 2; ++bj)
#pragma unroll
            for (int n = 0; n < 2; ++n) bv[bj][n] = bias ? *(const f32x4*)(bias + bcol0 + bj * HALF + 4 * n) : (f32x4){0.f, 0.f, 0.f, 0.f};
#pragma unroll
        for (int ai = 0; ai < 2; ++ai)
#pragma unroll
            for (int m = 0; m < 4; ++m) { bf16_t* rowp = base + (size_t)(row0 + ai * HALF + m * 16) * ldc + col0;
#pragma unroll
                for (int bj = 0; bj < 2; ++bj) { f32x4 v0 = acc[ai][bj][m][0] + bv[bj][0], v1 = acc[ai][bj][m][1] + bv[bj][1];
                    if (ACT == 1) { f32x2 a = gelu_pk((f32x2){v0[0], v0[1]}), b = gelu_pk((f32x2){v0[2], v0[3]}), c = gelu_pk((f32x2){v1[0], v1[1]}), d = gelu_pk((f32x2){v1[2], v1[3]});
                        v0 = (f32x4){a.x, a.y, b.x, b.y}; v1 = (f32x4){c.x, c.y, d.x, d.y}; }
                    v0 = v0 * sc; v1 = v1 * sc; u32x4 w; w.x = cvt_pk_bf16(v0[0], v0[1]); w.y = cvt_pk_bf16(v0[2], v0[3]); w.z = cvt_pk_bf16(v1[0], v1[1]); w.w = cvt_pk_bf16(v1[2], v1[3]);
                    *(u32x4*)(rowp + bj * HALF) = w; } }
    }
};
template <class Epi, class Sched, bool ALIGN_EPI = false, bool SP2 = false>
__device__ __forceinline__ void gemm_phase(PG8_LAS unsigned char* lds, const Gemm g, const Sched& S, const Epi& E) {
    const int tid = opaque_tid(), wid = __builtin_amdgcn_readfirstlane(tid >> 6), lane = tid & 63, wr = wid >> 2, wc = wid & 3, fr = lane & 15, fq = lane >> 4;
    const int K = g.K, nt = K / BK;
    unsigned voffA[2], voffB[2];
#pragma unroll
    for (int i = 0; i < 2; ++i) { int R, C; stage_rc(tid * 16 + i * 8192, R, C); const int Rb = Epi::PERM ? ((R & ~31) + perm32(R & 31)) : R;
        voffA[i] = (unsigned)(R * K + C) * 2u; voffB[i] = (unsigned)(Rb * K + C) * 2u; }
    const size_t kstep = (size_t)(BK * 2);
    const size_t hstep = (size_t)HALF * K * 2;
    const size_t tstep = 2 * hstep;
    const unsigned ldsw = (unsigned)wid * 1024u;
    const int aoff = lds_byte(wr * 64 + fr, fq * 8), boff = lds_byte(wc * 32 + fr, fq * 8);
#define PG8_SA(b, h) (((b) * 2 + (h)) * HTB)
#define PG8_SB(b, h) ((4 + (b) * 2 + (h)) * HTB)
#define PG8_STAGE(bufoff, gbase, voff) do { _Pragma("unroll") for (int _i = 0; _i < 2; ++_i) \
        __builtin_amdgcn_global_load_lds((const unsigned*)((const char*)(gbase) + (voff)[_i]), (PG8_LAS unsigned*)(lds + (bufoff) + ldsw + _i * 8192), 16, 0, 0); } while (0)
#define PG8_LDA(dst, b, h) do { _Pragma("unroll") for (int m = 0; m < 4; ++m) _Pragma("unroll") for (int k = 0; k < 2; ++k) dst[m][k] = *(const PG8_LAS bf16x8*)(lds + PG8_SA(b, h) + aoff + m * 2048 + k * 1024); } while (0)
#define PG8_LDB(dst, b, h) do { _Pragma("unroll") for (int n = 0; n < 2; ++n) _Pragma("unroll") for (int k = 0; k < 2; ++k) dst[n][k] = *(const PG8_LAS bf16x8*)(lds + PG8_SB(b, h) + boff + n * 2048 + k * 1024); } while (0)
#define PG8_MMA(ai, bj, At, Bt) do { __builtin_amdgcn_s_setprio(1); _Pragma("unroll") for (int m = 0; m < 4; ++m) _Pragma("unroll") for (int n = 0; n < 2; ++n) _Pragma("unroll") for (int k = 0; k < 2; ++k) \
        acc[ai][bj][m][n] = __builtin_amdgcn_mfma_f32_16x16x32_bf16(Bt[n][k], At[m][k], acc[ai][bj][m][n], 0, 0, 0); __builtin_amdgcn_s_setprio(0); } while (0)
#define PG8_WAIT_V(n) asm volatile("s_waitcnt vmcnt(" #n ")" ::: "memory")
#define PG8_WAIT_L(n) asm volatile("s_waitcnt lgkmcnt(" #n ")" ::: "memory")
#define PG8_BAR __builtin_amdgcn_s_barrier()
#define PG8_SCHED __builtin_amdgcn_sched_barrier(0)
    Unit cur, nxt; int ui = 0;
    if (!S.next(0, cur)) return;
    f32x4 acc[2][2][4][2];
#pragma unroll
    for (int a = 0; a < 2; ++a)
#pragma unroll
        for (int b = 0; b < 2; ++b)
#pragma unroll
            for (int m = 0; m < 4; ++m)
#pragma unroll
                for (int n = 0; n < 2; ++n) acc[a][b][m][n] = (f32x4){0.f, 0.f, 0.f, 0.f};
    bf16x8 At[4][2], B0[2][2], B1[2][2];
    const char* cA = (const char*)g.A + (size_t)cur.pm * tstep; const char* cB = (const char*)g.Bt + (size_t)cur.pn * tstep;
    S.a_ready(cur);
    if constexpr (SP2) {
        PG8_STAGE(PG8_SB(0, 0), cB, voffB); PG8_STAGE(PG8_SB(0, 1), cB + hstep, voffB); PG8_STAGE(PG8_SA(0, 0), cA, voffA); PG8_STAGE(PG8_SA(0, 1), cA + hstep, voffA);
        if (wr == 1) PG8_BAR;
        PG8_WAIT_V(2); PG8_BAR;
        PG8_STAGE(PG8_SB(1, 0), cB + kstep, voffB); PG8_STAGE(PG8_SA(1, 0), cA + kstep, voffA); PG8_STAGE(PG8_SB(1, 1), cB + hstep + kstep, voffB);
        PG8_WAIT_V(6); PG8_BAR;
    } else {
        PG8_STAGE(PG8_SB(0, 0), cB, voffB); PG8_STAGE(PG8_SA(0, 0), cA, voffA); PG8_STAGE(PG8_SB(0, 1), cB + hstep, voffB); PG8_STAGE(PG8_SA(0, 1), cA + hstep, voffA);
        if (wr == 1) PG8_BAR;
        PG8_WAIT_V(4); PG8_BAR;
        PG8_STAGE(PG8_SB(1, 0), cB + kstep, voffB); PG8_STAGE(PG8_SA(1, 0), cA + kstep, voffA); PG8_STAGE(PG8_SB(1, 1), cB + hstep + kstep, voffB);
        PG8_WAIT_V(6); PG8_BAR;
    }
    for (;;) {
        const bool has_next = S.next(ui + 1, nxt);
        const char* nA = has_next ? (const char*)g.A + (size_t)nxt.pm * tstep : cA; const char* nB = has_next ? (const char*)g.Bt + (size_t)nxt.pn * tstep : cB;
        for (int t = 0; t < nt; t += 2) {
            const bool last = (t == nt - 2);
            const char* a1 = cA + (size_t)(t + 1) * kstep;
            const char* a2 = last ? nA : cA + (size_t)(t + 2) * kstep; const char* b2 = last ? nB : cB + (size_t)(t + 2) * kstep;
            const char* a3 = a2 + kstep; const char* b3 = b2 + kstep;
            if (last && has_next) S.a_ready(nxt);
            if constexpr (SP2) {
            PG8_LDB(B0, 0, 0); PG8_LDB(B1, 0, 1); PG8_SCHED; PG8_LDA(At, 0, 0); PG8_STAGE(PG8_SA(1, 1), a1 + hstep, voffA);
            PG8_WAIT_V(8); PG8_WAIT_L(0); PG8_BAR; PG8_MMA(0, 0, At, B0); PG8_MMA(0, 1, At, B1); PG8_BAR; PG8_SCHED;
            PG8_LDA(At, 0, 1); PG8_STAGE(PG8_SB(0, 0), b2, voffB); PG8_STAGE(PG8_SB(0, 1), b2 + hstep, voffB); PG8_STAGE(PG8_SA(0, 0), a2, voffA);
            PG8_WAIT_V(8); PG8_WAIT_L(0); PG8_BAR; PG8_MMA(1, 0, At, B0); PG8_MMA(1, 1, At, B1); PG8_BAR; PG8_SCHED;
            PG8_LDB(B0, 1, 0); PG8_LDB(B1, 1, 1); PG8_SCHED; PG8_LDA(At, 1, 0); PG8_STAGE(PG8_SA(0, 1), a2 + hstep, voffA);
            PG8_WAIT_V(8); PG8_WAIT_L(0); PG8_BAR; PG8_MMA(0, 0, At, B0); PG8_MMA(0, 1, At, B1); PG8_BAR; PG8_SCHED;
            PG8_LDA(At, 1, 1); PG8_STAGE(PG8_SB(1, 0), b3, voffB); PG8_STAGE(PG8_SB(1, 1), b3 + hstep, voffB); PG8_STAGE(PG8_SA(1, 0), a3, voffA);
            PG8_WAIT_V(8); PG8_WAIT_L(0); PG8_BAR; PG8_MMA(1, 0, At, B0); PG8_MMA(1, 1, At, B1); PG8_BAR; PG8_SCHED;
            } else {
            PG8_LDB(B0, 0, 0); PG8_SCHED; PG8_LDA(At, 0, 0); PG8_STAGE(PG8_SA(1, 1), a1 + hstep, voffA);
            PG8_WAIT_L(8); PG8_BAR; PG8_WAIT_L(0); PG8_MMA(0, 0, At, B0); PG8_BAR; PG8_SCHED;
            PG8_LDB(B1, 0, 1); PG8_STAGE(PG8_SB(0, 0), b2, voffB);
            PG8_BAR; PG8_WAIT_L(0); PG8_MMA(0, 1, At, B1); PG8_BAR;
            PG8_LDA(At, 0, 1); PG8_STAGE(PG8_SA(0, 0), a2, voffA);
            PG8_BAR; PG8_WAIT_L(0); PG8_MMA(1, 0, At, B0); PG8_BAR; PG8_SCHED;
            PG8_STAGE(PG8_SB(0, 1), b2 + hstep, voffB);
            PG8_WAIT_V(6); PG8_BAR; PG8_MMA(1, 1, At, B1); PG8_BAR;
            PG8_LDB(B0, 1, 0); PG8_SCHED; PG8_LDA(At, 1, 0); PG8_STAGE(PG8_SA(0, 1), a2 + hstep, voffA);
            PG8_WAIT_L(8); PG8_BAR; PG8_WAIT_L(0); PG8_MMA(0, 0, At, B0); PG8_BAR; PG8_SCHED;
            PG8_LDB(B1, 1, 1); PG8_STAGE(PG8_SB(1, 0), b3, voffB);
            PG8_BAR; PG8_WAIT_L(0); PG8_MMA(0, 1, At, B1); PG8_BAR;
            PG8_LDA(At, 1, 1); PG8_STAGE(PG8_SA(1, 0), a3, voffA);
            PG8_BAR; PG8_WAIT_L(0); PG8_MMA(1, 0, At, B0); PG8_BAR; PG8_SCHED;
            PG8_STAGE(PG8_SB(1, 1), b3 + hstep, voffB);
            PG8_WAIT_V(6); PG8_BAR; PG8_MMA(1, 1, At, B1); PG8_BAR;
            }
        }
        if constexpr (ALIGN_EPI) { if (wr == 0) PG8_BAR; }
        if constexpr (!Epi::AFTER_DRAIN) { E(acc, cur, wr, wc, fr, fq); S.done(cur); }
        if (!has_next) break;
#pragma unroll
        for (int a = 0; a < 2; ++a)
#pragma unroll
            for (int b = 0; b < 2; ++b)
#pragma unroll
                for (int m = 0; m < 4; ++m)
#pragma unroll
                    for (int n = 0; n < 2; ++n) acc[a][b][m][n] = (f32x4){0.f, 0.f, 0.f, 0.f};
        cur = nxt; cA = nA; cB = nB; ++ui;
        if constexpr (ALIGN_EPI) { if (wr == 1) PG8_BAR; }
    }
    PG8_WAIT_V(0);
    if constexpr (!ALIGN_EPI) { if (wr == 0) PG8_BAR; }
    PG8_BAR;
    if constexpr (Epi::AFTER_DRAIN) { E.fused(acc, cur, wr, wc, fr, fq, lds, wid, lane); S.done(cur); }
#undef PG8_SA
#undef PG8_SB
#undef PG8_STAGE
#undef PG8_LDA
#undef PG8_LDB
#undef PG8_MMA
#undef PG8_WAIT_V
#undef PG8_WAIT_L
#undef PG8_BAR
#undef PG8_SCHED
}
}

#define GAS __attribute__((address_space(1)))
#define LAS __attribute__((address_space(3)))
typedef unsigned short bf16;
typedef unsigned v4u __attribute__((ext_vector_type(4)));
typedef unsigned v2u __attribute__((ext_vector_type(2)));
typedef float f32x4 __attribute__((ext_vector_type(4)));
typedef float f32x16 __attribute__((ext_vector_type(16)));
typedef short bf16x8 __attribute__((ext_vector_type(8)));
typedef __bf16 bf16x2_t __attribute__((ext_vector_type(2)));

constexpr int NWAVES = 8, NTHR = 512;
constexpr int NB = 32, SEQ = 2048, T = NB * SEQ, D = 1024, ZW = 3584, INW = 3524;
constexpr int ZC_Q = 0, ZC_K = 512, ZC_V = 576, ZC_IK = 640, ZC_IW = 704, ZC_IQ = 768, ZC_ZP = 1024, ZC_GA = 1536, ZC_GP = 2560;
constexpr float EPS = 1e-6f;
constexpr float QSCALE = 0.125f * 1.4426950408889634f;

constexpr size_t MiB = 1u << 20;
constexpr size_t WS_CTL = 0, CTL_ZERO_BYTES = 65536;
constexpr size_t WS_ADA = 1 * MiB, WS_IW = 2 * MiB, WS_SK = 3 * MiB, WS_WGRP = 4 * MiB, WS_WUA = 5 * MiB, WS_WUP = 6 * MiB, WS_WOUT = 7 * MiB, WS_WPQ = 9 * MiB, WS_WIN = 11 * MiB;
constexpr size_t WS_IKX = 18 * MiB, WS_KX = 26 * MiB, WS_VX = 34 * MiB;
constexpr size_t WS_U = 64 * MiB, WS_V = 96 * MiB, WS_Z = 128 * MiB, WS_H = 576 * MiB, WS_POOLED = 576 * MiB, WS_PM = 640 * MiB;
constexpr size_t WS_ATT = 704 * MiB, WS_PQ = 704 * MiB, WS_MIN = 832 * MiB, WS_EIDX = 832 * MiB, WS_EGATE = 864 * MiB, WS_END = 960 * MiB;
constexpr int CW_BAR = 4096;
constexpr size_t WS_SU = 512 * 1024, WS_SV = 576 * 1024, WS_SH2 = 640 * 1024;
constexpr size_t WS_X1 = 128 * MiB;
constexpr size_t WS_H2HI = 384 * MiB, WS_H2LO = 416 * MiB;
constexpr size_t WS_H2F8 = 384 * MiB;

constexpr int RING_BYTES = 131072, LDS_BYTES = 163840, LDSCTL_OFF = LDS_BYTES - 1024, MISC_OFF = LDSCTL_OFF + 320;

__device__ __forceinline__ unsigned f2bf(float f) { unsigned u = __builtin_bit_cast(unsigned, f); return (u + 0x7fffu + ((u >> 16) & 1u)) >> 16; }
__device__ __forceinline__ unsigned pk2(float lo, float hi) { typedef float f32x2_ __attribute__((ext_vector_type(2))); typedef __bf16 bf16x2_ __attribute__((ext_vector_type(2))); const f32x2_ v = {lo, hi}; return __builtin_bit_cast(unsigned, __builtin_convertvector(v, bf16x2_)); }
__device__ __forceinline__ float bflo(unsigned w) { return __builtin_bit_cast(float, w << 16); }
__device__ __forceinline__ float bfhi(unsigned w) { return __builtin_bit_cast(float, w & 0xffff0000u); }
__device__ __forceinline__ float bf2f(bf16 h) { return __builtin_bit_cast(float, (unsigned)h << 16); }
#define LDS_WAIT() asm volatile("s_waitcnt lgkmcnt(0)" ::: "memory")
#define VM_WAIT() asm volatile("s_waitcnt vmcnt(0)" ::: "memory")

#define XB_TMO      128
#define XB_XCNT(j)  (256  + 64 * (j))
#define XB_XSUB(j)  (1280 + 64 * (j))
#define XB_XGEN(j)  (2304 + 64 * (j))
#define XB_TOP      3328
#define XB_TOPGEN   3392
#define XCD_BAR_WORDS 3456
#define XB_SPIN_CAP (1u << 26)

__device__ __forceinline__ unsigned xb_ld(unsigned* p)              { return __hip_atomic_load(p, __ATOMIC_RELAXED, __HIP_MEMORY_SCOPE_AGENT); }
__device__ __forceinline__ unsigned xb_add(unsigned* p, unsigned v) { return __hip_atomic_fetch_add(p, v, __ATOMIC_RELAXED, __HIP_MEMORY_SCOPE_AGENT); }
__device__ __forceinline__ unsigned xb_xcc_id() { return (unsigned)__builtin_amdgcn_s_getreg((3 << 11) | 20) & 0xFu; }
#define XB_SPIN(cond, bar) do { unsigned _sp = 0; while (cond) { __builtin_amdgcn_s_sleep(1); \
    if ((++_sp & 255u) == 0u) { if (xb_ld(&(bar)[XB_TMO])) break; if (_sp > XB_SPIN_CAP) { atomicAdd(&(bar)[XB_TMO], 1u); break; } } } } while (0)

struct XcdBarrier {
    unsigned* bar; unsigned x;
    volatile LAS unsigned* st;
};

__device__ __forceinline__ XcdBarrier xcd_barrier_post(unsigned* bar, volatile LAS unsigned* st) {
    XcdBarrier b; b.bar = bar; b.x = xb_xcc_id(); b.st = st;
    if (threadIdx.x == 0) (void)xb_add(&bar[XB_XCNT(b.x)], 1u);
    return b;
}
__device__ __forceinline__ void xcd_barrier_complete(unsigned* bar, unsigned x, unsigned& nloc, unsigned& nx) {
    const unsigned G = gridDim.x * gridDim.y * gridDim.z;
    unsigned sum, cnt, mine, sp = 0u;
    for (;;) {
        sum = 0u; cnt = 0u; mine = 0u;
#pragma unroll
        for (unsigned j = 0; j < 16; ++j) { const unsigned c = xb_ld(&bar[XB_XCNT(j)]); sum += c; cnt += (c > 0u) ? 1u : 0u; mine = (j == x) ? c : mine; }
        if (sum == G) break;
        __builtin_amdgcn_s_sleep(1);
        if ((++sp & 255u) == 0u) { if (xb_ld(&bar[XB_TMO])) break; if (sp > XB_SPIN_CAP) { atomicAdd(&bar[XB_TMO], 1u); break; } }
    }
    nloc = mine > 0u ? mine : 1u; nx = cnt > 0u ? cnt : 1u;
}

__device__ __forceinline__ void xcd_barrier(const XcdBarrier& b) {
    asm volatile("s_waitcnt vmcnt(0)" ::: "memory");
    __syncthreads();
    if (threadIdx.x == 0) {
        unsigned* bar = b.bar;
        __builtin_amdgcn_s_waitcnt(0);
        unsigned nloc = b.st[0], nx = b.st[1];
        if (nloc == 0u) { xcd_barrier_complete(bar, b.x, nloc, nx); b.st[0] = nloc; b.st[1] = nx; }
        const unsigned old = xb_add(&bar[XB_XSUB(b.x)], 1u);
        const unsigned gen = old / nloc;
        if (old + 1u == (gen + 1u) * nloc) {
            __builtin_amdgcn_fence(__ATOMIC_RELEASE, "agent");
            asm volatile("s_waitcnt vmcnt(0)" ::: "memory");
            const unsigned og = xb_add(&bar[XB_TOP], 1u);
            const unsigned tg = og / nx;
            if (og + 1u == (tg + 1u) * nx) xb_add(&bar[XB_TOPGEN], 1u);
            else XB_SPIN(xb_ld(&bar[XB_TOPGEN]) == tg, bar);
            __builtin_amdgcn_fence(__ATOMIC_ACQUIRE, "agent");
            xb_add(&bar[XB_XGEN(b.x)], 1u);
            asm volatile("s_waitcnt vmcnt(0)" ::: "memory");
        } else {
            XB_SPIN(xb_ld(&bar[XB_XGEN(b.x)]) == gen, bar);
            __builtin_amdgcn_fence(__ATOMIC_ACQUIRE, "agent");
            asm volatile("s_waitcnt vmcnt(0)" ::: "memory");
        }
    }
    __syncthreads();
}


struct Args {
    const float *x, *c, *w_ada, *b_ada, *g1, *w_in, *g_q, *g_k, *g_ik, *w_grp, *s_pool, *w_ua, *w_up, *w_out, *g2, *w_pq, *sk, *pu, *pv;
    float* out; unsigned char* ws;
};

struct Frame {
    LAS unsigned char* lds;
    int tid, lane, wave, vcu, G, gw, NGW;
};

__device__ __forceinline__ float wave_sum(float v) {
#pragma unroll
    for (int o = 1; o < 64; o <<= 1) v += __shfl_xor(v, o);
    return v;
}
__device__ __forceinline__ float xhalf_max(float m) { auto rr = __builtin_amdgcn_permlane32_swap(__float_as_uint(m), __float_as_uint(m), false, false); return fmaxf(__uint_as_float(rr[0]), __uint_as_float(rr[1])); }
__device__ __forceinline__ float xhalf_sum(float m) { auto rr = __builtin_amdgcn_permlane32_swap(__float_as_uint(m), __float_as_uint(m), false, false); return __uint_as_float(rr[0]) + __uint_as_float(rr[1]); }
__device__ __forceinline__ unsigned ordf(float f) { unsigned b = __float_as_uint(f); return b ^ ((b >> 31) ? 0xFFFFFFFFu : 0x80000000u); }
__device__ __forceinline__ float unordf(unsigned u) { unsigned b = u ^ ((u >> 31) ? 0x80000000u : 0xFFFFFFFFu); return __uint_as_float(b); }

__device__ __forceinline__ void transpose_item(const float* W, int ldw, int src_k0, int src_col0, int valid, bf16* WT, int ldwt, int dst_row0, int dst_k0, LAS float* scr, int lane) {
#pragma unroll 8
    for (int i = 0; i < 32; ++i) { const int kk = 2 * i + (lane >> 5), n = lane & 31; scr[kk * 33 + n] = (n < valid) ? W[(size_t)(src_k0 + kk) * ldw + src_col0 + n] : 0.f; }
    LDS_WAIT(); asm volatile("" ::: "memory");
    const int c = lane & 7;
#pragma unroll
    for (int j = 0; j < 4; ++j) { const int n = (lane >> 3) + 8 * j; const LAS float* s = scr + (8 * c) * 33 + n;
        v4u o; o.x = pk2(s[0 * 33], s[1 * 33]); o.y = pk2(s[2 * 33], s[3 * 33]); o.z = pk2(s[4 * 33], s[5 * 33]); o.w = pk2(s[6 * 33], s[7 * 33]);
        *(GAS v4u*)(WT + (size_t)(dst_row0 + n) * ldwt + dst_k0 + 8 * c) = o; }
    LDS_WAIT(); asm volatile("" ::: "memory");
}
__device__ __forceinline__ void zcol_src(int nb, int& src, int& valid) {
    const int n0 = nb * 32; valid = 32;
    if (n0 < 640) src = n0;
    else if (n0 < 704) src = 896 + (n0 - 640);
    else if (n0 < 736) { src = 960; valid = 4; }
    else if (n0 < 768) { src = 0; valid = 0; }
    else if (n0 < 1024) src = 640 + (n0 - 768);
    else if (n0 < 1536) src = 964 + (n0 - 1024);
    else src = 1476 + (n0 - 1536);
}
__device__ __forceinline__ void cvt_stream(const float* src, bf16* dst, size_t n8, int gtid, int gthreads) {
    for (size_t i = gtid; i < n8; i += gthreads) {
        const f32x4 a = ((const GAS f32x4*)src)[2 * i], b = ((const GAS f32x4*)src)[2 * i + 1];
        v4u o; o.x = pk2(a.x, a.y); o.y = pk2(a.z, a.w); o.z = pk2(b.x, b.y); o.w = pk2(b.z, b.w);
        ((GAS v4u*)dst)[i] = o;
    }
}
__device__ __forceinline__ void p0_prologue(Frame& F, const Args& A) {
    unsigned char* ws = A.ws;
    float* ADA = (float*)(ws + WS_ADA);
#ifdef ADA_SPREAD
    if (F.vcu * NWAVES < 1536) {
        LAS float* cT = (LAS float*)F.lds;
        LAS float* part = (LAS float*)(F.lds + 131072);
        for (int idx = F.tid; idx < NB * D; idx += NTHR) cT[(idx & (D - 1)) * NB + (idx >> 10)] = A.c[idx];
        __syncthreads();
      for (int item = F.gw; item < 1536; item += F.NGW) {
        const int task = item >> 2, quarter = item & 3;
        {
            const int col = task * 16 + (F.lane & 15), ks = F.lane >> 4;
            float acc[NB];
#pragma unroll
            for (int b = 0; b < NB; ++b) acc[b] = 0.f;
#pragma unroll 4
            for (int i = 0; i < 64; ++i) {
                const int k = quarter * 256 + 4 * i + ks;
                const float w = A.w_ada[(size_t)k * 6144 + col];
                const LAS f32x4* cr = (const LAS f32x4*)(cT + k * NB);
#pragma unroll
                for (int b4 = 0; b4 < 8; ++b4) { const f32x4 cv = cr[b4]; acc[4 * b4] = fmaf(cv.x, w, acc[4 * b4]); acc[4 * b4 + 1] = fmaf(cv.y, w, acc[4 * b4 + 1]); acc[4 * b4 + 2] = fmaf(cv.z, w, acc[4 * b4 + 2]); acc[4 * b4 + 3] = fmaf(cv.w, w, acc[4 * b4 + 3]); }
            }
#pragma unroll
            for (int b = 0; b < NB; ++b) { float v = acc[b]; v += __shfl_xor(v, 16); v += __shfl_xor(v, 32); acc[b] = v; }
            if (ks == 0) {
                LAS f32x4* pp = (LAS f32x4*)(part + (F.wave * 16 + (F.lane & 15)) * NB);
#pragma unroll
                for (int b4 = 0; b4 < 8; ++b4) pp[b4] = (f32x4){acc[4 * b4], acc[4 * b4 + 1], acc[4 * b4 + 2], acc[4 * b4 + 3]};
            }
        }
        __syncthreads();
        if (quarter == 0) {
#pragma unroll
            for (int j = 0; j < 8; ++j) {
                const int o = F.lane * 8 + j, cc = o >> 5, bb = o & 31;
                const float v = part[((F.wave + 0) * 16 + cc) * NB + bb] + part[((F.wave + 1) * 16 + cc) * NB + bb] + part[((F.wave + 2) * 16 + cc) * NB + bb] + part[((F.wave + 3) * 16 + cc) * NB + bb];
                ADA[bb * 6144 + task * 16 + cc] = v + A.b_ada[task * 16 + cc];
            }
        }
        __syncthreads();
      }
    }
#else
    if (F.vcu * NWAVES < 384) {
        LAS float* cT = (LAS float*)F.lds;
        for (int idx = F.tid; idx < NB * D; idx += NTHR) cT[(idx & (D - 1)) * NB + (idx >> 10)] = A.c[idx];
        __syncthreads();
        for (int task = F.gw; task < 384; task += F.NGW) {
            const int col = task * 16 + (F.lane & 15), ks = F.lane >> 4;
            float acc[NB];
#pragma unroll
            for (int b = 0; b < NB; ++b) acc[b] = 0.f;
#pragma unroll 4
            for (int i = 0; i < 256; ++i) {
                const int k = 4 * i + ks;
                const float w = A.w_ada[(size_t)k * 6144 + col];
                const LAS f32x4* cr = (const LAS f32x4*)(cT + k * NB);
#pragma unroll
                for (int b4 = 0; b4 < 8; ++b4) { const f32x4 cv = cr[b4]; acc[4 * b4] = fmaf(cv.x, w, acc[4 * b4]); acc[4 * b4 + 1] = fmaf(cv.y, w, acc[4 * b4 + 1]); acc[4 * b4 + 2] = fmaf(cv.z, w, acc[4 * b4 + 2]); acc[4 * b4 + 3] = fmaf(cv.w, w, acc[4 * b4 + 3]); }
            }
#pragma unroll
            for (int b = 0; b < NB; ++b) { float v = acc[b]; v += __shfl_xor(v, 16); v += __shfl_xor(v, 32); acc[b] = v; }
            if (ks == 0) {
                const float bb = A.b_ada[col];
#pragma unroll
                for (int b = 0; b < NB; ++b) ADA[b * 6144 + col] = acc[b] + bb;
            }
        }
        __syncthreads();
    }
#endif
    LAS float* scr = (LAS float*)(F.lds + F.wave * 16384);
    bf16* WIN = (bf16*)(ws + WS_WIN); bf16* WUA = (bf16*)(ws + WS_WUA); bf16* WUP = (bf16*)(ws + WS_WUP); bf16* WOUT = (bf16*)(ws + WS_WOUT); bf16* WPQ = (bf16*)(ws + WS_WPQ); bf16* WGRP = (bf16*)(ws + WS_WGRP);
    constexpr int I_IN = 16 * 112, I_UA = 8 * 32, I_UP = 8 * 32, I_OUT = 16 * 32, I_PQ = 16 * 32;
    constexpr int NITEMS = I_IN + I_UA + I_UP + I_OUT + I_PQ;
    for (int it = F.gw; it < NITEMS; it += F.NGW) {
        int r = it;
        if (r < I_IN) { const int kb = r / 112, nb = r % 112; int src, valid; zcol_src(nb, src, valid); transpose_item(A.w_in, INW, kb * 64, src, valid, WIN, 1024, nb * 32, kb * 64, scr, F.lane); continue; } r -= I_IN;
        if (r < I_UA) { const int kb = r / 32, nb = r % 32; transpose_item(A.w_ua, 1024, kb * 64, nb * 32, 32, WUA, 512, nb * 32, kb * 64, scr, F.lane); continue; } r -= I_UA;
        if (r < I_UP) { continue; } r -= I_UP;
        if (r < I_OUT) { const int kb = r / 32, nb = r % 32; transpose_item(A.w_out, 1024, kb * 64, nb * 32, 32, WOUT, 1024, nb * 32, kb * 64, scr, F.lane); continue; } r -= I_OUT;
        if (r < I_PQ) { const int kb = r / 32, nb = r % 32; transpose_item(A.w_pq, 1024, kb * 64, nb * 32, 32, WPQ, 1024, nb * 32, kb * 64, scr, F.lane); continue; } r -= I_PQ;
        (void)WGRP;
    }
    const int gtid = F.gw * 64 + F.lane, gthreads = F.NGW * 64;
    for (int it = F.gw; it < 512 * 4; it += F.NGW) {
        const int k = it >> 2, n = (it & 3) * 256 + F.lane, g = k >> 7;
        const float* wg = A.w_grp + (size_t)k * 128; const float* sp = A.s_pool + g * 128; const float* wu = A.w_up + (size_t)g * 128 * 1024 + n;
        float a0 = 0.f, a1 = 0.f, a2 = 0.f, a3 = 0.f;
#pragma unroll 8
        for (int d = 0; d < 128; ++d) { const float ws_ = wg[d] * sp[d]; const float* wr = wu + (size_t)d * 1024;
            a0 = fmaf(ws_, wr[0], a0); a1 = fmaf(ws_, wr[64], a1); a2 = fmaf(ws_, wr[128], a2); a3 = fmaf(ws_, wr[192], a3); }
        WUP[(size_t)n * 512 + k] = (bf16)f2bf(a0); WUP[(size_t)(n + 64) * 512 + k] = (bf16)f2bf(a1); WUP[(size_t)(n + 128) * 512 + k] = (bf16)f2bf(a2); WUP[(size_t)(n + 192) * 512 + k] = (bf16)f2bf(a3);
    }
    cvt_stream(A.sk, (bf16*)(ws + WS_SK), (size_t)16 * 128 * 64 / 8, gtid, gthreads);
#ifdef QUANT2
#ifndef QUANT_R
#define QUANT_R 2
#endif
    for (int row = F.gw; row < 2 * 16384; row += QUANT_R * F.NGW) {
        f32x4 av[QUANT_R][4]; float m[QUANT_R];
#pragma unroll
        for (int q = 0; q < QUANT_R; ++q) { int rq = row + q * F.NGW; rq = rq < 2 * 16384 ? rq : row; const bool isv = rq >= 16384; const int r = isv ? rq - 16384 : rq; const float* src = (isv ? A.pv : A.pu) + (size_t)r * 1024 + 16 * F.lane;
#pragma unroll
            for (int j = 0; j < 4; ++j) av[q][j] = *(const GAS f32x4*)(src + 4 * j); }
#pragma unroll
        for (int q = 0; q < QUANT_R; ++q) { float t = 0.f;
#pragma unroll
            for (int j = 0; j < 4; ++j) t = fmaxf(t, fmaxf(fmaxf(fabsf(av[q][j].x), fabsf(av[q][j].y)), fmaxf(fabsf(av[q][j].z), fabsf(av[q][j].w))));
            m[q] = t; }
#pragma unroll
        for (int o = 1; o < 64; o <<= 1) {
#pragma unroll
            for (int q = 0; q < QUANT_R; ++q) m[q] = fmaxf(m[q], __shfl_xor(m[q], o)); }
#pragma unroll
        for (int q = 0; q < QUANT_R; ++q) {
            int rq = row + q * F.NGW; rq = rq < 2 * 16384 ? rq : row; const bool isv = rq >= 16384; const int r = isv ? rq - 16384 : rq;
            const float sc = m[q] > 0.f ? (isv ? 6.0f / m[q] : 10.0f / m[q]) : 1.0f;
            unsigned w[2] = {0u, 0u};
#pragma unroll
            for (int j = 0; j < 4; ++j)
#pragma unroll
                for (int k = 0; k < 4; ++k) {
                    const float x = av[q][j][k], a = fabsf(x) * sc;
                    const unsigned c = (a >= 0.25f) + (a >= 0.75f) + (a >= 1.25f) + (a >= 1.75f) + (a >= 2.5f) + (a >= 3.5f) + (a >= 5.0f);
                    unsigned nib = c | (x < 0.f ? 8u : 0u);
                    if (!isv) { int qi = (int)rintf(x * sc); qi = qi < -8 ? -8 : (qi > 7 ? 7 : qi); nib = (unsigned)qi & 15u; }
                    const int el = 4 * j + k;
                    w[el >> 3] |= nib << (4 * (el & 7));
                }
            *(GAS v2u*)(ws + (isv ? WS_V : WS_U) + (size_t)(F.lane >> 4) * (16384 * 128) + (size_t)r * 128 + 8 * (F.lane & 15)) = (v2u){w[0], w[1]};
            if (F.lane == 0) ((float*)(ws + (isv ? WS_SV : WS_SU)))[r] = m[q] > 0.f ? (isv ? m[q] * (1.0f / 6.0f) : m[q] * 0.1f) : 1.0f;
        }
    }
}
#else
    for (int row = F.gw; row < 2 * 16384; row += F.NGW) {
        const bool isv = row >= 16384; const int r = isv ? row - 16384 : row;
        const float* src = (isv ? A.pv : A.pu) + (size_t)r * 1024 + 16 * F.lane;
        f32x4 av[4];
#pragma unroll
        for (int j = 0; j < 4; ++j) av[j] = *(const GAS f32x4*)(src + 4 * j);
        float m = 0.f;
#pragma unroll
        for (int j = 0; j < 4; ++j) m = fmaxf(m, fmaxf(fmaxf(fabsf(av[j].x), fabsf(av[j].y)), fmaxf(fabsf(av[j].z), fabsf(av[j].w))));
#pragma unroll
        for (int o = 1; o < 64; o <<= 1) m = fmaxf(m, __shfl_xor(m, o));
        const float sc = m > 0.f ? (isv ? 6.0f / m : 10.0f / m) : 1.0f;
        unsigned w[2] = {0u, 0u};
#pragma unroll
        for (int j = 0; j < 4; ++j)
#pragma unroll
            for (int k = 0; k < 4; ++k) {
                const float x = av[j][k], a = fabsf(x) * sc;
                const unsigned c = (a >= 0.25f) + (a >= 0.75f) + (a >= 1.25f) + (a >= 1.75f) + (a >= 2.5f) + (a >= 3.5f) + (a >= 5.0f);
                unsigned nib = c | (x < 0.f ? 8u : 0u);
                if (!isv) { int qi = (int)rintf(x * sc); qi = qi < -8 ? -8 : (qi > 7 ? 7 : qi); nib = (unsigned)qi & 15u; }
                const int el = 4 * j + k;
#if defined(U4_SWAP) && !defined(OLD_GATHER)
                w[el >> 3] |= nib << (4 * (isv ? (el & 7) : ((el & 7) ^ 1)));
#else
                w[el >> 3] |= nib << (4 * (el & 7));
#endif
            }
#ifdef OLD_GATHER
        *(GAS v2u*)(ws + (isv ? WS_V : WS_U) + (size_t)r * 512 + 8 * F.lane) = (v2u){w[0], w[1]};
#else
        *(GAS v2u*)(ws + (isv ? WS_V : WS_U) + (size_t)(F.lane >> 4) * (16384 * 128) + (size_t)r * 128 + 8 * (F.lane & 15)) = (v2u){w[0], w[1]};
#endif
        if (F.lane == 0) ((float*)(ws + (isv ? WS_SV : WS_SU)))[r] = m > 0.f ? (isv ? m * (1.0f / 6.0f) : m * 0.1f) : 1.0f;
    }
}
#endif

__device__ __forceinline__ void norm_rows(Frame& F, const float* X, const float* g, const float* ADA, int shift_off, int scale_off, bf16* O, unsigned char* O8, float* S8, const bf16* XB = nullptr) {
    const int rpw = T / F.NGW, m_begin = F.gw * rpw, b = m_begin >> 11;
    f32x4 cg[4], sh[4];
#pragma unroll
    for (int j = 0; j < 4; ++j) { const int col = 4 * F.lane + 256 * j;
        const f32x4 gg = *(const GAS f32x4*)(g + col), sc = *(const GAS f32x4*)(ADA + b * 6144 + scale_off + col);
        cg[j] = gg * (sc + 1.0f); sh[j] = *(const GAS f32x4*)(ADA + b * 6144 + shift_off + col); }
    for (int m0 = m_begin; m0 < m_begin + rpw; m0 += 4) {
        f32x4 v[4][4]; float s[4];
#pragma unroll
        for (int r = 0; r < 4; ++r) {
            if (XB) {
                const GAS v2u* ar = (const GAS v2u*)(XB + (size_t)(m0 + r) * D) + F.lane;
#pragma unroll
                for (int j = 0; j < 4; ++j) { const v2u a = ar[64 * j]; v[r][j] = (f32x4){__uint_as_float(a.x << 16), __uint_as_float(a.x & 0xffff0000u), __uint_as_float(a.y << 16), __uint_as_float(a.y & 0xffff0000u)}; }
            } else {
                const GAS f32x4* xr = (const GAS f32x4*)(X + (size_t)(m0 + r) * D) + F.lane;
#pragma unroll
                for (int j = 0; j < 4; ++j) v[r][j] = xr[64 * j];
            } }
#pragma unroll
        for (int r = 0; r < 4; ++r) { float t = 0.f;
#pragma unroll
            for (int j = 0; j < 4; ++j) t += (v[r][j].x * v[r][j].x + v[r][j].y * v[r][j].y) + (v[r][j].z * v[r][j].z + v[r][j].w * v[r][j].w);
            s[r] = t; }
#pragma unroll
        for (int o = 1; o < 64; o <<= 1) {
#pragma unroll
            for (int r = 0; r < 4; ++r) s[r] += __shfl_xor(s[r], o);
        }
#pragma unroll
        for (int r = 0; r < 4; ++r) {
            const float rstd = 1.0f / sqrtf(s[r] * (1.f / D) + EPS);
            GAS unsigned long long* o8 = (GAS unsigned long long*)(O + (size_t)(m0 + r) * D) + F.lane;
#pragma unroll
            for (int j = 0; j < 4; ++j) { const f32x4 y = (v[r][j] * rstd) * cg[j] + sh[j]; o8[64 * j] = (unsigned long long)pk2(y.x, y.y) | ((unsigned long long)pk2(y.z, y.w) << 32); v[r][j] = y; }
        }
        if (O8) {
            float am[4];
#pragma unroll
            for (int r = 0; r < 4; ++r) { float t = 0.f;
#pragma unroll
                for (int j = 0; j < 4; ++j) t = fmaxf(t, fmaxf(fmaxf(fabsf(v[r][j].x), fabsf(v[r][j].y)), fmaxf(fabsf(v[r][j].z), fabsf(v[r][j].w))));
                am[r] = t; }
#pragma unroll
            for (int o = 1; o < 64; o <<= 1) {
#pragma unroll
                for (int r = 0; r < 4; ++r) am[r] = fmaxf(am[r], __shfl_xor(am[r], o));
            }
#pragma unroll
            for (int r = 0; r < 4; ++r) {
                const float q = am[r] > 0.f ? 119.0f / am[r] : 1.0f;
                GAS unsigned* hi = (GAS unsigned*)(O8 + (size_t)(m0 + r) * 512); GAS unsigned* lo = (GAS unsigned*)(O8 + (WS_H2LO - WS_H2HI) + (size_t)(m0 + r) * 512);
#pragma unroll
                for (int j = 0; j < 4; ++j) {
                    unsigned h16 = 0u, l16 = 0u;
#pragma unroll
                    for (int k = 0; k < 4; ++k) { const int x = (int)rintf(v[r][j][k] * q); const int l4 = ((x + 8) & 15) - 8; const int h4 = (x - l4) >> 4; h16 |= ((unsigned)h4 & 15u) << (4 * k); l16 |= ((unsigned)l4 & 15u) << (4 * k); }
                    const unsigned ph = (unsigned)__shfl_xor((int)h16, 1), pl = (unsigned)__shfl_xor((int)l16, 1);
                    if (!(F.lane & 1)) { hi[32 * j + (F.lane >> 1)] = h16 | (ph << 16); lo[32 * j + (F.lane >> 1)] = l16 | (pl << 16); }
                }
                if (F.lane == 0) S8[m0 + r] = am[r] > 0.f ? am[r] * (1.0f / 119.0f) : 1.0f;
            }
        }
    }
}

namespace pg8 {
__device__ __forceinline__ float sigm(float v) { return __builtin_amdgcn_rcpf(1.0f + __builtin_amdgcn_exp2f(-1.4426950408889634f * v)); }
template <int MODE> struct EpiB {
    static constexpr bool PERM = true, AFTER_DRAIN = false;
    bf16_t* O; int ldc; int sig_from; const float* colscale; const bf16_t* G; int ldg; int gcol0; int zp8_from;
    __device__ __forceinline__ void operator()(const f32x4 (&acc)[2][2][4][2], const Unit& u, int wr, int wc, int fr, int fq) const {
        const int row0 = u.pm * BM + wr * 64 + fr, col0 = u.pn * BM + wc * 32 + 8 * fq;
        const bool sg = (MODE == 0) && (u.pn >= sig_from);
        f32x4 cs[2][2];
        if (MODE == 1) {
#pragma unroll
            for (int bj = 0; bj < 2; ++bj)
#pragma unroll
                for (int n = 0; n < 2; ++n) cs[bj][n] = *(const f32x4*)(colscale + col0 + bj * HALF + 4 * n);
        }
#pragma unroll
        for (int ai = 0; ai < 2; ++ai)
#pragma unroll
            for (int m = 0; m < 4; ++m) { const size_t row = (size_t)(row0 + ai * HALF + m * 16); bf16_t* rowp = O + row * ldc + col0;
#pragma unroll
                for (int bj = 0; bj < 2; ++bj) { f32x4 v0 = acc[ai][bj][m][0], v1 = acc[ai][bj][m][1];
                    if (MODE == 0) { if (sg) { v0 = (f32x4){sigm(v0[0]), sigm(v0[1]), sigm(v0[2]), sigm(v0[3])}; v1 = (f32x4){sigm(v1[0]), sigm(v1[1]), sigm(v1[2]), sigm(v1[3])}; } }
                    if (MODE == 1) { v0 = v0 * cs[bj][0]; v1 = v1 * cs[bj][1]; }
#ifdef GATE_FP8
                    if (MODE == 2 || MODE == 3) {
                        typedef float f32x2g __attribute__((ext_vector_type(2)));
                        const unsigned long long g8 = *(const unsigned long long*)((const unsigned char*)G + row * (size_t)(ldg * 2) + 3072 + (gcol0 - 1536 + col0 + bj * HALF));
                        const unsigned glo = (unsigned)g8, ghi = (unsigned)(g8 >> 32);
                        const f32x2g a0 = __builtin_amdgcn_cvt_pk_f32_fp8(glo, false), a1 = __builtin_amdgcn_cvt_pk_f32_fp8(glo, true), a2 = __builtin_amdgcn_cvt_pk_f32_fp8(ghi, false), a3 = __builtin_amdgcn_cvt_pk_f32_fp8(ghi, true);
                        v0 = v0 * (f32x4){a0.x, a0.y, a1.x, a1.y}; v1 = v1 * (f32x4){a2.x, a2.y, a3.x, a3.y};
                    }
#else
                    if (MODE == 2 || MODE == 3) {
                        const u32x4 gw = *(const u32x4*)(G + row * ldg + gcol0 + col0 + bj * HALF);
                        v0 = v0 * (f32x4){__builtin_bit_cast(float, gw.x << 16), __builtin_bit_cast(float, gw.x & 0xffff0000u), __builtin_bit_cast(float, gw.y << 16), __builtin_bit_cast(float, gw.y & 0xffff0000u)};
                        v1 = v1 * (f32x4){__builtin_bit_cast(float, gw.z << 16), __builtin_bit_cast(float, gw.z & 0xffff0000u), __builtin_bit_cast(float, gw.w << 16), __builtin_bit_cast(float, gw.w & 0xffff0000u)};
                    }
#endif
#ifdef MIN_FP8
                    if (MODE == 3) {
                        typedef float f32x2g __attribute__((ext_vector_type(2)));
                        const unsigned long long o8 = *(const unsigned long long*)((const unsigned char*)G + row * (size_t)(ldg * 2) + 5120 + (col0 + bj * HALF));
                        const unsigned olo = (unsigned)o8, ohi = (unsigned)(o8 >> 32);
                        const f32x2g a0 = __builtin_amdgcn_cvt_pk_f32_fp8(olo, false), a1 = __builtin_amdgcn_cvt_pk_f32_fp8(olo, true), a2 = __builtin_amdgcn_cvt_pk_f32_fp8(ohi, false), a3 = __builtin_amdgcn_cvt_pk_f32_fp8(ohi, true);
                        v0 = v0 + (f32x4){a0.x, a0.y, a1.x, a1.y}; v1 = v1 + (f32x4){a2.x, a2.y, a3.x, a3.y};
                    }
                    if (MODE == 2) {
                        int lo = 0, hi = 0;
                        lo = __builtin_amdgcn_cvt_pk_fp8_f32(v0[0], v0[1], lo, false); lo = __builtin_amdgcn_cvt_pk_fp8_f32(v0[2], v0[3], lo, true);
                        hi = __builtin_amdgcn_cvt_pk_fp8_f32(v1[0], v1[1], hi, false); hi = __builtin_amdgcn_cvt_pk_fp8_f32(v1[2], v1[3], hi, true);
                        *(unsigned long long*)((unsigned char*)G + row * (size_t)(ldg * 2) + 5120 + (col0 + bj * HALF)) = (unsigned long long)(unsigned)lo | ((unsigned long long)(unsigned)hi << 32);
                        continue;
                    }
#else
                    if (MODE == 3) {
                        const u32x4 ow = *(const u32x4*)(rowp + bj * HALF);
                        v0 = v0 + (f32x4){__builtin_bit_cast(float, ow.x << 16), __builtin_bit_cast(float, ow.x & 0xffff0000u), __builtin_bit_cast(float, ow.y << 16), __builtin_bit_cast(float, ow.y & 0xffff0000u)};
                        v1 = v1 + (f32x4){__builtin_bit_cast(float, ow.z << 16), __builtin_bit_cast(float, ow.z & 0xffff0000u), __builtin_bit_cast(float, ow.w << 16), __builtin_bit_cast(float, ow.w & 0xffff0000u)};
                    }
#endif
#ifdef ZP_FP8
                    if (MODE == 0 && zp8_from > 0 && u.pn >= zp8_from && u.pn < sig_from) {
                        int lo = 0, hi = 0;
                        lo = __builtin_amdgcn_cvt_pk_fp8_f32(v0[0], v0[1], lo, false); lo = __builtin_amdgcn_cvt_pk_fp8_f32(v0[2], v0[3], lo, true);
                        hi = __builtin_amdgcn_cvt_pk_fp8_f32(v1[0], v1[1], hi, false); hi = __builtin_amdgcn_cvt_pk_fp8_f32(v1[2], v1[3], hi, true);
                        *(unsigned long long*)((unsigned char*)O + row * (size_t)(ldc * 2) + 6144 + (col0 - 256 * zp8_from + bj * HALF)) = (unsigned long long)(unsigned)lo | ((unsigned long long)(unsigned)hi << 32);
                        continue;
                    }
#endif
#ifdef GATE_FP8
                    if (MODE == 0 && sg) {
                        int lo = 0, hi = 0;
                        lo = __builtin_amdgcn_cvt_pk_fp8_f32(v0[0], v0[1], lo, false); lo = __builtin_amdgcn_cvt_pk_fp8_f32(v0[2], v0[3], lo, true);
                        hi = __builtin_amdgcn_cvt_pk_fp8_f32(v1[0], v1[1], hi, false); hi = __builtin_amdgcn_cvt_pk_fp8_f32(v1[2], v1[3], hi, true);
                        *(unsigned long long*)((unsigned char*)O + row * (size_t)(ldc * 2) + 3072 + (col0 - 1536 + bj * HALF)) = (unsigned long long)(unsigned)lo | ((unsigned long long)(unsigned)hi << 32);
                        continue;
                    }
#endif
                    u32x4 w; w.x = cvt_pk_bf16(v0[0], v0[1]); w.y = cvt_pk_bf16(v0[2], v0[3]); w.z = cvt_pk_bf16(v1[0], v1[1]); w.w = cvt_pk_bf16(v1[2], v1[3]);
                    *(u32x4*)(rowp + bj * HALF) = w; } }
    }
};
struct EpiRes {
    static constexpr bool PERM = false, AFTER_DRAIN = false;
    const float* X; float* C; const float* gate;
    __device__ __forceinline__ void operator()(const f32x4 (&acc)[2][2][4][2], const Unit& u, int wr, int wc, int fr, int fq) const {
        const int row0 = u.pm * BM + wr * 64 + fr, col0 = u.pn * BM + wc * 32 + 4 * fq;
        const int b = (u.pm * BM) >> 11;
        f32x4 gv[2][2];
#pragma unroll
        for (int bj = 0; bj < 2; ++bj)
#pragma unroll
            for (int n = 0; n < 2; ++n) gv[bj][n] = *(const f32x4*)(gate + b * 6144 + col0 + bj * HALF + n * 16);
#pragma unroll
        for (int ai = 0; ai < 2; ++ai)
#pragma unroll
            for (int m = 0; m < 4; ++m) { const size_t off = (size_t)(row0 + ai * HALF + m * 16) * 1024 + col0;
#pragma unroll
                for (int bj = 0; bj < 2; ++bj)
#pragma unroll
                    for (int n = 0; n < 2; ++n) { const f32x4 xv = *(const f32x4*)(X + off + bj * HALF + n * 16); *(f32x4*)(C + off + bj * HALF + n * 16) = xv + gv[bj][n] * acc[ai][bj][m][n]; } }
    }
};
struct EpiX1 {
    static constexpr bool PERM = true, AFTER_DRAIN = false;
    const float* X; bf16_t* O; const float* gate;
    __device__ __forceinline__ void operator()(const f32x4 (&acc)[2][2][4][2], const Unit& u, int wr, int wc, int fr, int fq) const {
        const int row0 = u.pm * BM + wr * 64 + fr, col0 = u.pn * BM + wc * 32 + 8 * fq;
        const int b = (u.pm * BM) >> 11;
        f32x4 gv[2][2];
#pragma unroll
        for (int bj = 0; bj < 2; ++bj)
#pragma unroll
            for (int n = 0; n < 2; ++n) gv[bj][n] = *(const f32x4*)(gate + b * 6144 + col0 + bj * HALF + 4 * n);
#pragma unroll
        for (int ai = 0; ai < 2; ++ai)
#pragma unroll
            for (int m = 0; m < 4; ++m) { const size_t off = (size_t)(row0 + ai * HALF + m * 16) * 1024 + col0;
#pragma unroll
                for (int bj = 0; bj < 2; ++bj) {
                    const f32x4 v0 = *(const f32x4*)(X + off + bj * HALF) + gv[bj][0] * acc[ai][bj][m][0], v1 = *(const f32x4*)(X + off + bj * HALF + 4) + gv[bj][1] * acc[ai][bj][m][1];
                    u32x4 w; w.x = cvt_pk_bf16(v0[0], v0[1]); w.y = cvt_pk_bf16(v0[2], v0[3]); w.z = cvt_pk_bf16(v1[0], v1[1]); w.w = cvt_pk_bf16(v1[2], v1[3]);
                    *(u32x4*)(O + off + bj * HALF) = w; } }
    }
};
}

__device__ __forceinline__ void p3_fixup(Frame& F, const Args& A) {
    unsigned char* ws = A.ws;
    bf16* Z = (bf16*)(ws + WS_Z); bf16* IKX = (bf16*)(ws + WS_IKX); bf16* KX = (bf16*)(ws + WS_KX); bf16* VX = (bf16*)(ws + WS_VX); float* IW = (float*)(ws + WS_IW); bf16* POOLED = (bf16*)(ws + WS_POOLED);
    const int lane = F.lane;
    const int rpw = T / F.NGW, m_begin = F.gw * rpw;
    for (int m0 = m_begin; m0 < m_begin + rpw; m0 += 2) {
        const int g = lane >> 4, w = 2 << g;
#ifdef ZP_FP8
        typedef float f32x2z __attribute__((ext_vector_type(2)));
        float sum[2][8], self[2][8]; int cnt[2];
#pragma unroll
        for (int r = 0; r < 2; ++r) {
            const int m = m0 + r, s = m & (SEQ - 1);
            const int lo = (s + 1 - w) > 0 ? (s + 1 - w) : 0; cnt[r] = s + 1 - lo;
            const unsigned char* zp8 = (const unsigned char*)Z + (size_t)m * (ZW * 2) + 6144 + 8 * lane;
#pragma unroll
            for (int j = 0; j < 8; ++j) { sum[r][j] = 0.f; self[r][j] = 0.f; }
#pragma unroll
            for (int i = 0; i < 16; ++i) {
                if (i < cnt[r]) { const v2u q = *(const GAS v2u*)(zp8 - (size_t)i * (ZW * 2));
                    const f32x2z a0 = __builtin_amdgcn_cvt_pk_f32_fp8(q.x, false), a1 = __builtin_amdgcn_cvt_pk_f32_fp8(q.x, true), a2 = __builtin_amdgcn_cvt_pk_f32_fp8(q.y, false), a3 = __builtin_amdgcn_cvt_pk_f32_fp8(q.y, true);
                    const float fv[8] = {a0.x, a0.y, a1.x, a1.y, a2.x, a2.y, a3.x, a3.y};
#pragma unroll
                    for (int j = 0; j < 8; ++j) { sum[r][j] += fv[j]; if (i == 0) self[r][j] = fv[j]; } }
            }
        }
#pragma unroll
        for (int r = 0; r < 2; ++r) {
            const float inv = 1.0f / (float)cnt[r];
            v4u o; o.x = pk2(sum[r][0] * inv - self[r][0], sum[r][1] * inv - self[r][1]); o.y = pk2(sum[r][2] * inv - self[r][2], sum[r][3] * inv - self[r][3]);
            o.z = pk2(sum[r][4] * inv - self[r][4], sum[r][5] * inv - self[r][5]); o.w = pk2(sum[r][6] * inv - self[r][6], sum[r][7] * inv - self[r][7]);
            *(GAS v4u*)(POOLED + (size_t)(m0 + r) * 512 + 8 * lane) = o;
        }
    }
#else
        float sum[2][8]; v4u self[2]; int cnt[2];
#pragma unroll
        for (int r = 0; r < 2; ++r) {
            const int m = m0 + r, s = m & (SEQ - 1);
            const int lo = (s + 1 - w) > 0 ? (s + 1 - w) : 0; cnt[r] = s + 1 - lo;
            const bf16* zp = Z + (size_t)m * ZW + ZC_ZP + 8 * lane;
#pragma unroll
            for (int j = 0; j < 8; ++j) sum[r][j] = 0.f;
            self[r] = (v4u){0u, 0u, 0u, 0u};
#pragma unroll
            for (int i = 0; i < 16; ++i) {
                if (i < cnt[r]) { const v4u q = *(const GAS v4u*)(zp - (size_t)i * ZW); if (i == 0) self[r] = q;
                    sum[r][0] += bflo(q.x); sum[r][1] += bfhi(q.x); sum[r][2] += bflo(q.y); sum[r][3] += bfhi(q.y); sum[r][4] += bflo(q.z); sum[r][5] += bfhi(q.z); sum[r][6] += bflo(q.w); sum[r][7] += bfhi(q.w); }
            }
        }
#pragma unroll
        for (int r = 0; r < 2; ++r) {
            const float inv = 1.0f / (float)cnt[r];
            v4u o; o.x = pk2(sum[r][0] * inv - bflo(self[r].x), sum[r][1] * inv - bfhi(self[r].x)); o.y = pk2(sum[r][2] * inv - bflo(self[r].y), sum[r][3] * inv - bfhi(self[r].y));
            o.z = pk2(sum[r][4] * inv - bflo(self[r].z), sum[r][5] * inv - bfhi(self[r].z)); o.w = pk2(sum[r][6] * inv - bflo(self[r].w), sum[r][7] * inv - bfhi(self[r].w));
            *(GAS v4u*)(POOLED + (size_t)(m0 + r) * 512 + 8 * lane) = o;
        }
    }
#endif
    for (int tile = F.gw; tile < T / 32; tile += F.NGW) {
        const bf16* vsrc = Z + (size_t)tile * 32 * ZW + ZC_V;
        bf16* vdst = VX + (size_t)tile * 2048;
#pragma unroll
        for (int i = 0; i < 4; ++i) {
            const int pi = lane + 64 * i, h = pi & 1, d = (pi >> 1) & 31, s = (pi >> 6) & 1, rt = pi >> 7;
            unsigned e[8];
#pragma unroll
            for (int j = 0; j < 8; ++j) { const int key = 16 * s + 8 * (j >> 2) + 4 * h + (j & 3); e[j] = vsrc[(size_t)key * ZW + d + 32 * rt]; }
            v4u o; o.x = e[0] | (e[1] << 16); o.y = e[2] | (e[3] << 16); o.z = e[4] | (e[5] << 16); o.w = e[6] | (e[7] << 16);
            *(GAS v4u*)(vdst + pi * 8) = o;
        }
    }
    float gqv[8];
#pragma unroll
    for (int j = 0; j < 8; ++j) gqv[j] = A.g_q[8 * (lane & 7) + j];
    const float gkv = A.g_k[lane], gikv = A.g_ik[lane];
    for (int m0 = m_begin; m0 < m_begin + rpw; m0 += 4) {
        v4u qr[4]; float kv[4], ikv[4], iwr[4];
#pragma unroll
        for (int r = 0; r < 4; ++r) { bf16* zr = Z + (size_t)(m0 + r) * ZW;
#ifndef QN_DSA
            qr[r] = *(GAS v4u*)(zr + 8 * lane);
#endif
            kv[r] = bf2f(zr[ZC_K + lane]); ikv[r] = bf2f(zr[ZC_IK + lane]); iwr[r] = bf2f(zr[ZC_IW + (lane & 3)]); }
        float sk[4], sik[4];
#pragma unroll
        for (int r = 0; r < 4; ++r) { sk[r] = kv[r] * kv[r]; sik[r] = ikv[r] * ikv[r]; }
#pragma unroll
        for (int o = 1; o < 64; o <<= 1) {
#pragma unroll
            for (int r = 0; r < 4; ++r) { sk[r] += __shfl_xor(sk[r], o); sik[r] += __shfl_xor(sik[r], o); }
        }
#pragma unroll
        for (int r = 0; r < 4; ++r) {
            const int m = m0 + r, b = m >> 11, s = m & (SEQ - 1);
            bf16* zr = Z + (size_t)m * ZW;
#ifndef QN_DSA
            float q[8] = {bflo(qr[r].x), bfhi(qr[r].x), bflo(qr[r].y), bfhi(qr[r].y), bflo(qr[r].z), bfhi(qr[r].z), bflo(qr[r].w), bfhi(qr[r].w)};
            float ss = 0.f;
#pragma unroll
            for (int j = 0; j < 8; ++j) ss += q[j] * q[j];
            ss += __shfl_xor(ss, 1); ss += __shfl_xor(ss, 2); ss += __shfl_xor(ss, 4);
            const float rstd = QSCALE / sqrtf(ss * (1.f / 64.f) + EPS);
#pragma unroll
            for (int j = 0; j < 8; ++j) q[j] = q[j] * rstd * gqv[j];
            v4u o; o.x = pk2(q[0], q[1]); o.y = pk2(q[2], q[3]); o.z = pk2(q[4], q[5]); o.w = pk2(q[6], q[7]);
            *(GAS v4u*)(zr + 8 * lane) = o;
#else
            (void)zr; (void)gqv;
#endif
            const float rk = 1.0f / sqrtf(sk[r] * (1.f / 64.f) + EPS), rik = 0.125f / sqrtf(sik[r] * (1.f / 64.f) + EPS);
            const size_t xo = ((((size_t)b * 64 + (s >> 5)) * 4 + (lane >> 4)) * 32 + (s & 31)) * 16 + (lane & 15);
            KX[xo] = (bf16)f2bf(kv[r] * rk * gkv);
            IKX[xo] = (bf16)f2bf(ikv[r] * rik * gikv);
            if (lane < 4) IW[(size_t)m * 4 + lane] = 0.5f * iwr[r];
        }
    }
}


__device__ __forceinline__ void p4_naive(Frame& F, const Args& A) {
    const bf16* POOLED = (const bf16*)(A.ws + WS_POOLED); bf16* PM = (bf16*)(A.ws + WS_PM);
    const int lane = F.lane, g = lane >> 4, d0 = 8 * (lane & 15);
    for (int m = F.gw; m < T; m += F.NGW) {
        float acc[8];
#pragma unroll
        for (int j = 0; j < 8; ++j) acc[j] = 0.f;
        for (int c = 0; c < 128; ++c) {
            const float p = bf2f(POOLED[(size_t)m * 512 + g * 128 + c]);
            const float* w = A.w_grp + ((size_t)g * 128 + c) * 128 + d0;
#pragma unroll
            for (int j = 0; j < 8; ++j) acc[j] = fmaf(p, w[j], acc[j]);
        }
        const float* sp = A.s_pool + g * 128 + d0;
        v4u o; o.x = pk2(acc[0] * sp[0], acc[1] * sp[1]); o.y = pk2(acc[2] * sp[2], acc[3] * sp[3]); o.z = pk2(acc[4] * sp[4], acc[5] * sp[5]); o.w = pk2(acc[6] * sp[6], acc[7] * sp[7]);
        *(GAS v4u*)(PM + (size_t)m * 512 + 8 * lane) = o;
    }
}


__device__ __forceinline__ void dbg_pool_check(Frame& F, const Args& A) {
    if (blockIdx.x != 0) return;
    unsigned char* ws = A.ws;
    const bf16* Z = (const bf16*)(ws + WS_Z); const bf16* POOLED = (const bf16*)(ws + WS_POOLED); const bf16* PM = (const bf16*)(ws + WS_PM); const bf16* MIN = (const bf16*)(ws + WS_MIN); const bf16* WUP = (const bf16*)(ws + WS_WUP);
    unsigned* flag = (unsigned*)(ws + WS_CTL) + 64;
    const int t = F.tid;
    const int r = (int)(((long long)t * 2579 + 17) % T), c = (t * 131 + 5) % 1024;
    unsigned f = 0u;
    { const int k = (t * 7) % 512; if (WUP[(size_t)c * 512 + k] != (bf16)f2bf(A.w_up[(size_t)k * 1024 + c])) f |= 8u; }
    const int n = c % 512, g = n >> 7, w = 2 << g, s = r & (SEQ - 1);
    { const int lo = (s + 1 - w) > 0 ? (s + 1 - w) : 0, cnt = s + 1 - lo; float sum = 0.f;
      for (int i = 0; i < cnt; ++i) sum += bf2f(Z[(size_t)(r - i) * ZW + ZC_ZP + n]);
      const float e = sum / (float)cnt - bf2f(Z[(size_t)r * ZW + ZC_ZP + n]), got = bf2f(POOLED[(size_t)r * 512 + n]);
      if (fabsf(got - e) > 0.02f * fabsf(e) + 0.02f) f |= 1u; }
    { float acc = 0.f; for (int cc = 0; cc < 128; ++cc) acc += bf2f(POOLED[(size_t)r * 512 + g * 128 + cc]) * A.w_grp[((size_t)g * 128 + cc) * 128 + (n & 127)];
      const float e = acc * A.s_pool[n], got = bf2f(PM[(size_t)r * 512 + n]);
      if (fabsf(got - e) > 0.02f * fabsf(e) + 0.02f) f |= 2u; }
    { float acc = 0.f; for (int k = 0; k < 512; ++k) acc += bf2f(PM[(size_t)r * 512 + k]) * A.w_up[(size_t)k * 1024 + c];
      const float e = acc * bf2f(Z[(size_t)r * ZW + ZC_GP + c]), got = bf2f(MIN[(size_t)r * 1024 + c]);
      if (fabsf(got - e) > 0.02f * fabsf(e) + 0.02f) f |= 4u; }
    if (f) atomicOr(flag, f);
}
__device__ __forceinline__ void dbg_min_check(Frame& F, const Args& A) {
    if (blockIdx.x != 0) return;
    unsigned char* ws = A.ws;
    const bf16* Z = (const bf16*)(ws + WS_Z); const bf16* PM = (const bf16*)(ws + WS_PM); const bf16* MIN = (const bf16*)(ws + WS_MIN); const bf16* ATT = (const bf16*)(ws + WS_ATT);
    unsigned* flag = (unsigned*)(ws + WS_CTL) + 64;
    const int t = F.tid;
    const int r = (int)(((long long)t * 2579 + 17) % T), c = (t * 131 + 5) % 1024;
    float a1 = 0.f, a2 = 0.f;
    for (int k = 0; k < 512; ++k) { a1 += bf2f(PM[(size_t)r * 512 + k]) * A.w_up[(size_t)k * 1024 + c]; a2 += bf2f(ATT[(size_t)r * 512 + k]) * A.w_ua[(size_t)k * 1024 + c]; }
    const float e = a1 * bf2f(Z[(size_t)r * ZW + ZC_GP + c]) + a2 * bf2f(Z[(size_t)r * ZW + ZC_GA + c]), got = bf2f(MIN[(size_t)r * 1024 + c]);
    if (fabsf(got - e) > 0.03f * fabsf(e) + 0.03f) atomicOr(flag, 32u);
}
__device__ __forceinline__ void dbg_report(const Args& A) {
    if (blockIdx.x == 0 && threadIdx.x == 0) {
        const unsigned f = *((volatile unsigned*)(A.ws + WS_CTL) + 64);
        float add = 0.f; if (f & 1u) add += 1e4f; if (f & 2u) add += 1e5f; if (f & 4u) add += 1e6f; if (f & 8u) add += 1e7f; if (f & 16u) add += 3e3f; if (f & 32u) add += 1e8f;
        A.out[0] += add;
    }
}

constexpr int DSA_HS = 288;
constexpr int DSA_HIST = 0, DSA_STG = 73728, DSA_STGB = 32768, DSA_MASK = DSA_STG + 65536, DSA_PRE = DSA_MASK + 16384, DSA_KREM = DSA_PRE + 256;
static_assert(64 * DSA_HS * 4 <= DSA_STG, "DSA histogram rows");
static_assert(DSA_KREM + 256 <= LDSCTL_OFF, "DSA LDS map");

__device__ __forceinline__ unsigned umax(unsigned a, unsigned b) { return a > b ? a : b; }
__device__ __forceinline__ unsigned umin(unsigned a, unsigned b) { return a < b ? a : b; }
#define GLDS16(gsrc, ldst) __builtin_amdgcn_global_load_lds((const unsigned*)(gsrc), (LAS unsigned*)(ldst), 16, 0, 0)
__device__ __forceinline__ void idx_scores(const LAS unsigned char* ikt, const bf16x8 (&aiq)[4], const f32x4 (&iwv)[4], int lane, unsigned (&u)[4]) {
    f32x16 acc;
#pragma unroll
    for (int r = 0; r < 16; ++r) acc[r] = 0.f;
    const LAS unsigned char* p = ikt + (lane & 31) * 32 + (lane >> 5) * 16;
#pragma unroll
    for (int ks = 0; ks < 4; ++ks) { const bf16x8 bik = *(const LAS bf16x8*)(p + ks * 1024); acc = __builtin_amdgcn_mfma_f32_32x32x16_bf16(aiq[ks], bik, acc, 0, 0, 0); }
#pragma unroll
    for (int j = 0; j < 4; ++j) {
        float s = fmaxf(acc[4 * j + 0], 0.f) * iwv[j][0];
        s = __builtin_fmaf(fmaxf(acc[4 * j + 1], 0.f), iwv[j][1], s);
        s = __builtin_fmaf(fmaxf(acc[4 * j + 2], 0.f), iwv[j][2], s);
        s = __builtin_fmaf(fmaxf(acc[4 * j + 3], 0.f), iwv[j][3], s);
        u[j] = (s == 0.f) ? 0x80000000u : ordf(s);
    }
}

__device__ __forceinline__ bool hist_scan(LAS unsigned* HIST, LAS unsigned* PRE, LAS unsigned* KREM, int wave, int lane) {
    bool exact = true;
    for (int i = 0; i < 8; ++i) {
        const int q = 8 * wave + i;
        const v4u c4 = *(const LAS v4u*)(HIST + q * DSA_HS + 252 - 4 * lane);
        const unsigned c0 = c4.w, c1 = c4.z, c2 = c4.y, c3 = c4.x, ssum = c0 + c1 + c2 + c3;
        unsigned incl = ssum;
#pragma unroll
        for (int o = 1; o < 64; o <<= 1) { const unsigned t = __shfl_up(incl, o); if (lane >= o) incl += t; }
        const unsigned k = KREM[q], pold = PRE[q];
        const unsigned long long bal = __ballot(incl >= k);
        const int L = bal ? (__ffsll((long long)bal) - 1) : 63;
        unsigned a = __shfl(incl - ssum, L);
        const unsigned d0 = __shfl(c0, L), d1 = __shfl(c1, L), d2 = __shfl(c2, L), d3 = __shfl(c3, L);
        int bin; unsigned dsel;
        if (a + d0 >= k) { bin = 255 - 4 * L; dsel = d0; }
        else { a += d0; if (a + d1 >= k) { bin = 254 - 4 * L; dsel = d1; } else { a += d1; if (a + d2 >= k) { bin = 253 - 4 * L; dsel = d2; } else { a += d2; bin = 252 - 4 * L; dsel = d3; } } }
        const unsigned pnew = (pold << 8) | (unsigned)bin;
        exact = exact && (dsel == k - a) && (pnew != 0u);
        if (lane == 0) { PRE[q] = pnew; KREM[q] = k - a; }
    }
    return __builtin_amdgcn_readfirstlane((int)exact) != 0;
}

template <int VAR> __device__ __forceinline__ void dsa_attend(const bf16* Z, const unsigned char* KX, const unsigned char* VX, bf16* ATT, LAS unsigned char* STG, LAS unsigned* MASKW,
                                                          int tq, size_t kblk0, int nsteps, int c, int lane, int wave, int tid, const float* GQ) {
        const int half = lane >> 5, l31 = lane & 31;
#ifdef NO_PRIO_DSA
        if (wave >> 2) __builtin_amdgcn_s_setprio(2);
#endif
        bf16x8 bq[2][4];
#pragma unroll
        for (int ct = 0; ct < 2; ++ct) { const bf16* qp = Z + (size_t)(tq + 4 * ct + (l31 >> 3)) * ZW + ZC_Q + (l31 & 7) * 64 + half * 8;
#pragma unroll
            for (int ks = 0; ks < 4; ++ks) bq[ct][ks] = *(const GAS bf16x8*)(qp + 16 * ks); }
#ifdef QN_DSA
#pragma unroll
        for (int ct = 0; ct < 2; ++ct) {
            float qf[4][8]; float ss = 0.f;
#pragma unroll
            for (int ks = 0; ks < 4; ++ks) { const v4u w = __builtin_bit_cast(v4u, bq[ct][ks]);
                qf[ks][0] = bflo(w.x); qf[ks][1] = bfhi(w.x); qf[ks][2] = bflo(w.y); qf[ks][3] = bfhi(w.y); qf[ks][4] = bflo(w.z); qf[ks][5] = bfhi(w.z); qf[ks][6] = bflo(w.w); qf[ks][7] = bfhi(w.w);
#pragma unroll
                for (int jj = 0; jj < 8; ++jj) ss += qf[ks][jj] * qf[ks][jj]; }
            ss = xhalf_sum(ss);
            const float rstd = QSCALE / sqrtf(ss * (1.f / 64.f) + EPS);
#pragma unroll
            for (int ks = 0; ks < 4; ++ks) { const f32x4 g0 = *(const GAS f32x4*)(GQ + 16 * ks + 8 * half), g1 = *(const GAS f32x4*)(GQ + 16 * ks + 8 * half + 4);
                v4u o; o.x = pk2(qf[ks][0] * rstd * g0.x, qf[ks][1] * rstd * g0.y); o.y = pk2(qf[ks][2] * rstd * g0.z, qf[ks][3] * rstd * g0.w);
                o.z = pk2(qf[ks][4] * rstd * g1.x, qf[ks][5] * rstd * g1.y); o.w = pk2(qf[ks][6] * rstd * g1.z, qf[ks][7] * rstd * g1.w);
                bq[ct][ks] = __builtin_bit_cast(bf16x8, o); }
        }
#endif
        f32x16 O[2][2];
#pragma unroll
        for (int ct = 0; ct < 2; ++ct)
#pragma unroll
            for (int rt = 0; rt < 2; ++rt)
#pragma unroll
                for (int r = 0; r < 16; ++r) O[ct][rt][r] = 0.f;
        float m_run[2] = {-1e30f, -1e30f}, l_run[2] = {0.f, 0.f};
        const int qsel = (lane >> 3) & 3;
        const bool all_on = (c < 4);
#ifdef ATT_BIG8
        constexpr int AB = 4; LAS unsigned char* const ABASE = STG - DSA_STG; constexpr int ABUFB = 65536;
        __syncthreads();
#else
#ifndef ATT_AB
#define ATT_AB 2
#endif
        constexpr int AB = ATT_AB; LAS unsigned char* const ABASE = STG; constexpr int ABUFB = DSA_STGB;
#endif
        constexpr int AVOFF = AB * 8192;
        const int nbig2 = (nsteps + AB - 1) / AB;
        { const int ns0 = nsteps < AB ? nsteps : AB;
#pragma unroll
          for (int k = 0; k < AB; ++k) if (k < ns0) { GLDS16(KX + kblk0 + (size_t)k * 8192 + (size_t)tid * 16, ABASE + k * 8192 + wave * 1024); GLDS16(VX + kblk0 + (size_t)k * 8192 + (size_t)tid * 16, ABASE + AVOFF + k * 8192 + wave * 1024); } }
        __syncthreads();
        for (int bs = 0; bs < nbig2; ++bs) {
            const int nsub = (nsteps - AB * bs) < AB ? (nsteps - AB * bs) : AB;
            const int nnext = (bs + 1 < nbig2) ? ((nsteps - AB * (bs + 1)) < AB ? (nsteps - AB * (bs + 1)) : AB) : 0;
#pragma unroll
            for (int k = 0; k < AB; ++k) if (VAR != 5 && k < nnext) { const size_t o = kblk0 + (size_t)(AB * (bs + 1) + k) * 8192 + (size_t)tid * 16; LAS unsigned char* nb = ABASE + ((bs + 1) & 1) * ABUFB + k * 8192 + wave * 1024; GLDS16(KX + o, nb); GLDS16(VX + o, nb + AVOFF); }
            const LAS unsigned char* buf = ABASE + (bs & 1) * ABUFB;
#pragma unroll 1
            for (int tl = 0; tl < 2 * nsub; ++tl) {
                const LAS unsigned char* kp = buf + (VAR == 4 ? 0 : tl) * 4096 + l31 * 32 + half * 16;
                bf16x8 kf[4];
#pragma unroll
                for (int ks = 0; ks < 4; ++ks) kf[ks] = *(const LAS bf16x8*)(kp + ks * 1024);
                const LAS unsigned char* vp = buf + AVOFF + (VAR == 4 ? 0 : tl) * 4096 + l31 * 32 + half * 16;
                bf16x8 vf[2][2];
#pragma unroll
                for (int rt = 0; rt < 2; ++rt)
#pragma unroll
                    for (int s = 0; s < 2; ++s) vf[rt][s] = *(const LAS bf16x8*)(vp + (rt * 2 + s) * 1024);
#ifdef ATT_S2
                f32x16 sacc2[2];
#pragma unroll
                for (int ct = 0; ct < 2; ++ct) {
#pragma unroll
                    for (int r = 0; r < 16; ++r) sacc2[ct][r] = 0.f;
#pragma unroll
                    for (int ks = 0; ks < 4; ++ks) sacc2[ct] = __builtin_amdgcn_mfma_f32_32x32x16_bf16(kf[ks], bq[ct][ks], sacc2[ct], 0, 0, 0);
                }
#endif
#pragma unroll
                for (int ct = 0; ct < 2; ++ct) {
#ifdef ATT_S2
                    const f32x16 sacc = sacc2[ct];
#else
                    f32x16 sacc;
#pragma unroll
                    for (int r = 0; r < 16; ++r) sacc[r] = 0.f;
#pragma unroll
                    for (int ks = 0; ks < (VAR == 2 ? 1 : 4); ++ks) sacc = __builtin_amdgcn_mfma_f32_32x32x16_bf16(kf[ks], bq[ct][ks], sacc, 0, 0, 0);
#endif
                    const unsigned Wq = all_on ? 0xFFFFFFFFu : MASKW[(8 * wave + 4 * ct + qsel) * 64 + 2 * AB * bs + tl];
                    const unsigned Wh = Wq >> (4 * half);
                    float mx = fmaxf(fmaxf(sacc[0], sacc[1]), sacc[2]);
#pragma unroll
                    for (int r = 3; r < 15; r += 2) mx = fmaxf(fmaxf(mx, sacc[r]), sacc[r + 1]);
                    mx = fmaxf(mx, sacc[15]);
                    mx = xhalf_max(mx);
                    const float m_new = fmaxf(m_run[ct], mx);
                    const float alpha = __builtin_amdgcn_exp2f(m_run[ct] - m_new);
                    m_run[ct] = m_new;
                    unsigned pw[8]; float psum = 0.f;
#pragma unroll
                    for (int i = 0; i < 8; ++i) {
                        const int r0 = 2 * i, b0 = (r0 & 3) + 8 * (r0 >> 2);
                        const unsigned k0 = (unsigned)__builtin_amdgcn_sbfe((int)Wh, b0, 1), k1 = (unsigned)__builtin_amdgcn_sbfe((int)Wh, b0 + 1, 1);
                        const unsigned keep = __builtin_amdgcn_perm(k1, k0, 0x05040100u);
                        const unsigned pk = (VAR == 1 ? pk2(sacc[r0] - m_new, sacc[r0 + 1] - m_new) : pk2(__builtin_amdgcn_exp2f(sacc[r0] - m_new), __builtin_amdgcn_exp2f(sacc[r0 + 1] - m_new))) & keep;
                        pw[i] = pk;
                        psum = __builtin_amdgcn_fdot2_f32_bf16(__builtin_bit_cast(bf16x2_t, pk), __builtin_bit_cast(bf16x2_t, 0x3F803F80u), psum, false);
                    }
                    l_run[ct] = l_run[ct] * alpha + psum;
                    if (__any(alpha != 1.0f)) {
#pragma unroll
                        for (int rt = 0; rt < 2; ++rt)
#pragma unroll
                            for (int r = 0; r < 16; ++r) O[ct][rt][r] *= alpha;
                    }
                    bf16x8 pb[2];
#pragma unroll
                    for (int s = 0; s < 2; ++s) pb[s] = __builtin_bit_cast(bf16x8, (v4u){pw[4 * s], pw[4 * s + 1], pw[4 * s + 2], pw[4 * s + 3]});
#pragma unroll
                    for (int rt = 0; rt < (VAR == 3 ? 1 : 2); ++rt)
#pragma unroll
                        for (int s = 0; s < (VAR == 3 ? 1 : 2); ++s) O[ct][rt] = __builtin_amdgcn_mfma_f32_32x32x16_bf16(vf[rt][s], pb[s], O[ct][rt], 0, 0, 0);
                }
            }
            if (VAR != 5) __syncthreads();
        }
        if (VAR == 5) __syncthreads();
#pragma unroll
        for (int ct = 0; ct < 2; ++ct) {
            const float inv = 1.0f / xhalf_sum(l_run[ct]);
            bf16* op = ATT + (size_t)(tq + 4 * ct + (l31 >> 3)) * 512 + (l31 & 7) * 64 + 4 * half;
#pragma unroll
            for (int rt = 0; rt < 2; ++rt)
#pragma unroll
                for (int g = 0; g < 4; ++g) {
                    v2u w; w.x = pk2(O[ct][rt][4 * g] * inv, O[ct][rt][4 * g + 1] * inv); w.y = pk2(O[ct][rt][4 * g + 2] * inv, O[ct][rt][4 * g + 3] * inv);
                    *(GAS v2u*)(op + 32 * rt + 8 * g) = w;
                }
        }
#ifdef NO_PRIO_DSA
        __builtin_amdgcn_s_setprio(0);
#endif
}

__device__ __forceinline__ void dsa_phase(Frame& F, const Args& A) {
    unsigned char* ws = A.ws;
    const bf16* Z = (const bf16*)(ws + WS_Z); const unsigned char* IKX = ws + WS_IKX; const unsigned char* KX = ws + WS_KX; const unsigned char* VX = ws + WS_VX;
    const float* IW = (const float*)(ws + WS_IW); bf16* ATT = (bf16*)(ws + WS_ATT);
    const int lane = F.lane, wave = F.wave, tid = F.tid, half = lane >> 5, l31 = lane & 31;
    LAS unsigned* HIST = (LAS unsigned*)(F.lds + DSA_HIST);
    LAS unsigned* PRE = (LAS unsigned*)(F.lds + DSA_PRE);
    LAS unsigned* KREM = (LAS unsigned*)(F.lds + DSA_KREM);
    LAS unsigned* MASKW = (LAS unsigned*)(F.lds + DSA_MASK);
    LAS unsigned char* STG = F.lds + DSA_STG;

    for (int P = F.vcu; P < 512; P += F.G) {
      for (int side = 0; side < 2; ++side) {
        const int b = P >> 4, c = side ? 31 - (P & 15) : (P & 15);
        const int nsteps = c + 1;
        const int tq = b * SEQ + 64 * c + 8 * wave;
        const size_t kblk0 = (size_t)b * 64 * 4096;
#ifndef DSA_REP_SEL
#define DSA_REP_SEL 1
#endif
#ifndef DSA_REP_ATT
#define DSA_REP_ATT 1
#endif
        for (int rs_ = 0; rs_ < DSA_REP_SEL; ++rs_)
        if (c >= 4) {
            const int v_ = F.vcu;
            const size_t scb = v_ < 128 ? WS_PM + (size_t)v_ * (512 * 1024) : v_ < 172 ? 42 * MiB + (size_t)(v_ - 128) * (512 * 1024) : v_ < 220 ? 72 * MiB + (size_t)(v_ - 172) * (512 * 1024) : 104 * MiB + (size_t)(v_ - 220) * (512 * 1024);
            unsigned* SC = (unsigned*)(ws + scb) + (size_t)(wave * 64 + lane) * 4;
            if (lane < 8) { PRE[8 * wave + lane] = 0u; KREM[8 * wave + lane] = 256u; }
#ifndef DSA_REP_P0
#define DSA_REP_P0 1
#endif
            for (int rp0_ = 0; rp0_ < DSA_REP_P0; ++rp0_) {
#pragma unroll
            for (int i = 0; i < 8; ++i) *(LAS v4u*)(HIST + (wave * 8 + i) * DSA_HS + lane * 4) = (v4u){0u, 0u, 0u, 0u};
            {
                bf16x8 aiq[4];
                { const bf16* zq = Z + (size_t)(tq + (l31 >> 2)) * ZW + ZC_IQ + (l31 & 3) * 64 + half * 8;
#pragma unroll
                  for (int ks = 0; ks < 4; ++ks) aiq[ks] = *(const GAS bf16x8*)(zq + 16 * ks); }
                f32x4 iwv[4];
#pragma unroll
                for (int j = 0; j < 4; ++j) iwv[j] = *(const GAS f32x4*)(IW + (size_t)(tq + 2 * j + half) * 4);
                const int nbig = (nsteps + 3) >> 2;
                { const int ns0 = nsteps < 4 ? nsteps : 4;
#pragma unroll
                  for (int k = 0; k < 4; ++k) if (k < ns0) GLDS16(IKX + kblk0 + (size_t)k * 8192 + (size_t)tid * 16, STG + k * 8192 + wave * 1024); }
                __syncthreads();
                unsigned WB = 0u; unsigned long long pkc[4] = {0ull, 0ull, 0ull, 0ull};
                for (int bs = 0; bs < nbig; ++bs) {
                    const int nsub = (nsteps - 4 * bs) < 4 ? (nsteps - 4 * bs) : 4;
                    const int nnext = (bs + 1 < nbig) ? ((nsteps - 4 * (bs + 1)) < 4 ? (nsteps - 4 * (bs + 1)) : 4) : 0;
#pragma unroll
                    for (int k = 0; k < 4; ++k) if (k < nnext) GLDS16(IKX + kblk0 + (size_t)(4 * (bs + 1) + k) * 8192 + (size_t)tid * 16, STG + ((bs + 1) & 1) * DSA_STGB + k * 8192 + wave * 1024);
                    const LAS unsigned char* buf = STG + (bs & 1) * DSA_STGB;
                    for (int sb = 0; sb < nsub; ++sb) {
                        unsigned uu[2][4];
                        idx_scores(buf + sb * 8192, aiq, iwv, lane, uu[0]);
                        idx_scores(buf + sb * 8192 + 4096, aiq, iwv, lane, uu[1]);
                        if (bs == 0 && sb == 0) {
                            unsigned fm = 0u;
#pragma unroll
                            for (int t2 = 0; t2 < 2; ++t2)
#pragma unroll
                                for (int j = 0; j < 4; ++j) { const unsigned u = uu[t2][j]; fm = umax(fm, umax(u >> 24, (~u) >> 24)); }
#pragma unroll
                            for (int o = 1; o < 64; o <<= 1) fm = umax(fm, (unsigned)__shfl_xor((int)fm, o));
                            WB = (unsigned)__builtin_amdgcn_readfirstlane((int)fm) - 3u;
                        }
#pragma unroll
                        for (int t2 = 0; t2 < 2; ++t2) {
                            const int tile = 8 * bs + 2 * sb + t2;
                            *(GAS v4u*)(SC + (size_t)tile * 2048) = (v4u){uu[t2][0], uu[t2][1], uu[t2][2], uu[t2][3]};
#pragma unroll
                            for (int j = 0; j < 4; ++j) {
                                const unsigned u = uu[t2][j], bin = u >> 24, nb = (~u) >> 24, slot = umax(bin, nb) - WB;
                                if (slot < 4u) pkc[j] += 1ull << (8u * slot + ((nb >> 7) << 5));
                                else __hip_atomic_fetch_add(HIST + (8 * wave + 2 * j + half) * DSA_HS + bin, 1u, __ATOMIC_RELAXED, __HIP_MEMORY_SCOPE_WORKGROUP);
                            }
                        }
                    }
                    __syncthreads();
                }
#pragma unroll
                for (int j = 0; j < 4; ++j) {
                    const unsigned lo = (unsigned)pkc[j], hi = (unsigned)(pkc[j] >> 32);
                    unsigned f[4] = {lo & 0x00FF00FFu, (lo >> 8) & 0x00FF00FFu, hi & 0x00FF00FFu, (hi >> 8) & 0x00FF00FFu};
#pragma unroll
                    for (int o = 1; o < 32; o <<= 1)
#pragma unroll
                        for (int i = 0; i < 4; ++i) f[i] += (unsigned)__shfl_xor((int)f[i], o);
                    const unsigned sc8[8] = {f[0] & 0xFFFFu, f[1] & 0xFFFFu, f[0] >> 16, f[1] >> 16, f[2] & 0xFFFFu, f[3] & 0xFFFFu, f[2] >> 16, f[3] >> 16};
                    unsigned mine = 0u;
#pragma unroll
                    for (int s8 = 0; s8 < 8; ++s8) mine = (l31 == s8) ? sc8[s8] : mine;
                    const unsigned fbv = WB + (unsigned)(l31 & 3), bin = (l31 & 4) ? (255u - fbv) : fbv;
                    if (l31 < 8 && mine != 0u) __hip_atomic_fetch_add(HIST + (8 * wave + 2 * j + half) * DSA_HS + (bin & 255u), mine, __ATOMIC_RELAXED, __HIP_MEMORY_SCOPE_WORKGROUP);
                }
            }
            }
            bool exact = hist_scan(HIST, PRE, KREM, wave, lane);
            for (int pass = 1; pass < 5; ++pass) {
                if (pass < 4 && exact) {
                    if (lane < 8) { const int q = 8 * wave + lane; PRE[q] = (PRE[q] << (8 * (4 - pass))) - 1u; KREM[q] = 0u; }
                    pass = 4;
                }
                unsigned pre[4], krem[4], eqrun[4];
#pragma unroll
                for (int j = 0; j < 4; ++j) { pre[j] = PRE[8 * wave + 2 * j + half]; krem[j] = KREM[8 * wave + 2 * j + half]; eqrun[j] = 0u; }
                if (pass < 4) {
#pragma unroll
                    for (int i = 0; i < 8; ++i) *(LAS v4u*)(HIST + (wave * 8 + i) * DSA_HS + lane * 4) = (v4u){0u, 0u, 0u, 0u};
                }
                const int sh_hi = 32 - 8 * pass, sh_lo = 24 - 8 * pass;
                const unsigned lmask = (1u << l31) - 1u;
                {
                    const int ntiles = 2 * nsteps;
                    v4u nx[4];
#pragma unroll
                    for (int k = 0; k < 4; ++k) { nx[k] = (v4u){0u, 0u, 0u, 0u}; if (k < ntiles) nx[k] = *(const GAS v4u*)(SC + (size_t)k * 2048); }
                    for (int t0 = 0; t0 < ntiles; t0 += 4) {
                        v4u cur[4];
#pragma unroll
                        for (int k = 0; k < 4; ++k) { cur[k] = nx[k]; if (t0 + 4 + k < ntiles) nx[k] = *(const GAS v4u*)(SC + (size_t)(t0 + 4 + k) * 2048); }
#pragma unroll
                        for (int k = 0; k < 4; ++k) {
                            const int tile = t0 + k;
                            if (tile < ntiles) {
                                const unsigned u4[4] = {cur[k].x, cur[k].y, cur[k].z, cur[k].w};
                                if (pass < 4) {
#pragma unroll
                                    for (int j = 0; j < 4; ++j) {
                                        const unsigned u = u4[j];
                                        if ((u >> sh_hi) == pre[j]) __hip_atomic_fetch_add(HIST + (8 * wave + 2 * j + half) * DSA_HS + ((u >> sh_lo) & 255u), 1u, __ATOMIC_RELAXED, __HIP_MEMORY_SCOPE_WORKGROUP);
                                    }
                                } else {
#pragma unroll
                                    for (int j = 0; j < 4; ++j) {
                                        const unsigned u = u4[j];
                                        const bool e = (u == pre[j]);
                                        const unsigned long long em = __ballot(e);
                                        const unsigned mine = half ? (unsigned)(em >> 32) : (unsigned)em;
                                        const unsigned rank = eqrun[j] + __popc(mine & lmask);
                                        eqrun[j] += __popc(mine);
                                        const bool sel = (u > pre[j]) || (e && rank < krem[j]);
                                        const unsigned long long sm = __ballot(sel);
                                        if (lane == 0) { MASKW[(8 * wave + 2 * j) * 64 + tile] = (unsigned)sm; MASKW[(8 * wave + 2 * j + 1) * 64 + tile] = (unsigned)(sm >> 32); }
                                    }
                                }
                            }
                        }
                    }
                }
                if (pass < 4) exact = hist_scan(HIST, PRE, KREM, wave, lane);
            }
#ifdef DBG_SEL
            for (int i = 0; i < 8; ++i) {
                unsigned v = (lane < 2 * nsteps) ? (unsigned)__popc(MASKW[(8 * wave + i) * 64 + lane]) : 0u;
#pragma unroll
                for (int o = 1; o < 64; o <<= 1) v += (unsigned)__shfl_xor((int)v, o);
                if (lane == 0 && v != 256u) atomicOr((unsigned*)(ws + WS_CTL) + 64, 1u);
            }
#endif
        }

#if DSA_REP_ATT == 2
        dsa_attend<ATT_VARIANT>(Z, KX, VX, ATT, STG, MASKW, tq, kblk0, nsteps, c, lane, wave, tid, A.g_q);
#endif
        dsa_attend<0>(Z, KX, VX, ATT, STG, MASKW, tq, kblk0, nsteps, c, lane, wave, tid, A.g_q);
      }
    }
}

template <int BASE, int N> __device__ __forceinline__ void sort16(float (&v)[N]) {
    constexpr int NCE = 60;
    constexpr unsigned char CI[NCE] = {0,1,2,3,4,5,7,9, 0,1,2,3,6,8,10,11, 0,2,4,6,7,10,12,14, 0,1,4,5,6,8,12,13, 1,3,4,5,8,9,13, 1,2,5,7,9,11, 2,3,9,11, 3,6,7,10, 3,5,7,9,11, 6,8};
    constexpr unsigned char CJ[NCE] = {13,12,15,14,8,6,11,10, 5,7,9,4,13,14,15,12, 1,3,5,8,9,11,13,15, 2,3,10,11,7,9,14,15, 2,12,6,7,10,11,14, 4,6,8,10,13,14, 4,6,12,13, 5,8,9,12, 4,6,8,10,12, 7,9};
#pragma unroll
    for (int c = 0; c < NCE; ++c) { const float x = v[BASE + CI[c]], y = v[BASE + CJ[c]]; v[BASE + CI[c]] = fmaxf(x, y); v[BASE + CJ[c]] = fminf(x, y); }
}
template <int A0, int B0, int N> __device__ __forceinline__ void merge16(float (&v)[N]) {
#pragma unroll
    for (int i = 0; i < 16; ++i) v[A0 + i] = fmaxf(v[A0 + i], v[B0 + 15 - i]);
#pragma unroll
    for (int j = 8; j > 0; j >>= 1)
#pragma unroll
        for (int i = 0; i < 16; ++i) { const int l = i ^ j; if (l > i) { const float x = v[A0 + i], y = v[A0 + l]; v[A0 + i] = fmaxf(x, y); v[A0 + l] = fminf(x, y); } }
}
__device__ __forceinline__ void top16_of64(float (&v)[64]) {
    sort16<0, 64>(v); sort16<16, 64>(v); sort16<32, 64>(v); sort16<48, 64>(v);
    merge16<0, 16, 64>(v); merge16<32, 48, 64>(v); merge16<0, 32, 64>(v);
}
__device__ __forceinline__ void peer_half(const bf16x8 (&bqf)[4], const LAS unsigned char* skl, int p, int lane, float (&lst)[16]) {
    const int half = lane >> 5, l31 = lane & 31;
    float v[64];
    const LAS unsigned char* ap = skl + p * 16384 + l31 * 32 + half * 16;
#pragma unroll
    for (int rt = 0; rt < 4; ++rt) {
        f32x16 acc;
#pragma unroll
        for (int r = 0; r < 16; ++r) acc[r] = 0.f;
#pragma unroll
        for (int ks = 0; ks < 4; ++ks) { const bf16x8 af = *(const LAS bf16x8*)(ap + (rt * 4 + ks) * 1024); acc = __builtin_amdgcn_mfma_f32_32x32x16_bf16(af, bqf[ks], acc, 0, 0, 0); }
#pragma unroll
        for (int r = 0; r < 16; ++r) { const unsigned kidx = rt * 32 + (r & 3) + 8 * (r >> 2) + 4 * half; v[rt * 16 + r] = __uint_as_float((__float_as_uint(acc[r]) & ~127u) | (127u - kidx)); }
    }
    top16_of64(v);
    float both[32];
#pragma unroll
    for (int i = 0; i < 16; ++i) { both[i] = v[i]; both[16 + i] = __shfl_xor(v[i], 32); }
    merge16<0, 16, 32>(both);
#pragma unroll
    for (int i = 0; i < 16; ++i) lst[i] = both[i];
}
__device__ __forceinline__ void peer_route(Frame& F, const Args& A) {
    unsigned char* ws = A.ws;
    const bf16* PQ = (const bf16*)(ws + WS_PQ); const bf16* SK = (const bf16*)(ws + WS_SK); int* EIDX = (int*)(ws + WS_EIDX); float* EGATE = (float*)(ws + WS_EGATE);
    const int lane = F.lane;
    LAS unsigned* KL = (LAS unsigned*)(F.lds + F.wave * 8192);
    LAS unsigned char* SKL = F.lds + 65536;
    for (int hp = 0; hp < 4; ++hp) {
        __syncthreads();
#pragma unroll
        for (int i = 0; i < 8; ++i) {
            const int ch = F.tid + 512 * i, c8 = ch & 7, key = (ch >> 3) & 127, p = (ch >> 10) & 1, hh = ch >> 11;
            const v4u r = *(const GAS v4u*)(SK + ((size_t)((2 * hp + hh) * 2 + p) * 128 + key) * 64 + 8 * c8);
            *(LAS v4u*)(SKL + hh * 32768 + ((p * 4 + (key >> 5)) * 4 + (c8 >> 1)) * 1024 + (key & 31) * 32 + (c8 & 1) * 16) = r;
        }
        __syncthreads();
      for (int tt = F.gw * (T / 32 / F.NGW); tt < (F.gw + 1) * (T / 32 / F.NGW); ++tt) {
        const int token = tt * 32 + (lane & 31);
        float l0[16], l1[16];
        {
            const bool hi = lane >= 32;
            const bf16* qa = PQ + (size_t)token * 1024 + (2 * hp) * 128 + (lane >> 5) * 8; const bf16* qb = qa + 128;
            bf16x8 bq[4]; float t[16];
#pragma unroll
            for (int ks = 0; ks < 4; ++ks) bq[ks] = *(const GAS bf16x8*)(qa + 16 * ks);
            peer_half(bq, SKL, 0, lane, l0);
#pragma unroll
            for (int ks = 0; ks < 4; ++ks) bq[ks] = *(const GAS bf16x8*)(qb + 16 * ks);
            peer_half(bq, SKL + 32768, 0, lane, t);
#pragma unroll
            for (int i = 0; i < 16; ++i) l0[i] = hi ? t[i] : l0[i];
#pragma unroll
            for (int ks = 0; ks < 4; ++ks) bq[ks] = *(const GAS bf16x8*)(qa + 64 + 16 * ks);
            peer_half(bq, SKL, 1, lane, l1);
#pragma unroll
            for (int ks = 0; ks < 4; ++ks) bq[ks] = *(const GAS bf16x8*)(qb + 64 + 16 * ks);
            peer_half(bq, SKL + 32768, 1, lane, t);
#pragma unroll
            for (int i = 0; i < 16; ++i) l1[i] = hi ? t[i] : l1[i];
        }
        const int h = 2 * hp + (lane >> 5);
        float s0[16], s1[16];
#pragma unroll
        for (int i = 0; i < 16; ++i) { const unsigned b0 = __float_as_uint(l0[i]), b1 = __float_as_uint(l1[i]); s0[i] = __uint_as_float(b0 & ~127u); s1[i] = __uint_as_float(b1 & ~127u); KL[i * 64 + lane] = 127u - (b0 & 127u); KL[(16 + i) * 64 + lane] = 127u - (b1 & 127u); }
        float cs[64]; int nc = 0;
#pragma unroll
        for (int r = 0; r < 64; ++r) cs[r] = -3.0e38f;
#pragma unroll
        for (int i = 0; i < 16; ++i)
#pragma unroll
            for (int j = 0; j < 16; ++j)
                if ((i + 1) * (j + 1) <= 16) { cs[nc] = __uint_as_float((__float_as_uint(s0[i] + s1[j]) & ~255u) | (255u - (unsigned)(i * 16 + j))); ++nc; }
        top16_of64(cs);
        float ev[16]; unsigned be[16]; float sum = 0.f; const float mx = __uint_as_float(__float_as_uint(cs[0]) & ~255u);
#pragma unroll
        for (int i = 0; i < 16; ++i) {
            const unsigned cb = __float_as_uint(cs[i]); ev[i] = __expf(__uint_as_float(cb & ~255u) - mx); sum += ev[i];
            const unsigned fi = 255u - (cb & 255u);
            be[i] = KL[(fi >> 4) * 64 + lane] * 128u + KL[(16 + (fi & 15u)) * 64 + lane];
        }
        const float inv = 1.0f / sum;
        {
            int* ep = EIDX + (size_t)token * 128 + h * 16; float* gp = EGATE + (size_t)token * 128 + h * 16;
#pragma unroll
            for (int i = 0; i < 4; ++i) {
#ifndef EIDX16
                *(GAS v4u*)(ep + 4 * i) = (v4u){be[4 * i], be[4 * i + 1], be[4 * i + 2], be[4 * i + 3]};
#endif
                *(GAS f32x4*)(gp + 4 * i) = (f32x4){ev[4 * i] * inv, ev[4 * i + 1] * inv, ev[4 * i + 2] * inv, ev[4 * i + 3] * inv};
            }
#ifdef EIDX16
            {
                GAS v4u* e16 = (GAS v4u*)((unsigned short*)EIDX + (size_t)token * 128 + h * 16);
                e16[0] = (v4u){(unsigned)be[0] | ((unsigned)be[1] << 16), (unsigned)be[2] | ((unsigned)be[3] << 16), (unsigned)be[4] | ((unsigned)be[5] << 16), (unsigned)be[6] | ((unsigned)be[7] << 16)};
                e16[1] = (v4u){(unsigned)be[8] | ((unsigned)be[9] << 16), (unsigned)be[10] | ((unsigned)be[11] << 16), (unsigned)be[12] | ((unsigned)be[13] << 16), (unsigned)be[14] | ((unsigned)be[15] << 16)};
            }
#endif
        }
        LDS_WAIT(); asm volatile("" ::: "memory");
      }
    }
}

__device__ __forceinline__ float dot2bf(unsigned w, unsigned x, float acc) { return __builtin_amdgcn_fdot2_f32_bf16(__builtin_bit_cast(bf16x2_t, w), __builtin_bit_cast(bf16x2_t, x), acc, false); }
__device__ __forceinline__ float dot8(v4u a, v4u b, float acc) {
    const unsigned a0 = a.x, a1 = a.y, a2 = a.z, a3 = a.w, b0 = b.x, b1 = b.y, b2 = b.z, b3 = b.w;
    return dot2bf(a3, b3, dot2bf(a2, b2, dot2bf(a1, b1, dot2bf(a0, b0, acc))));
}
__device__ __forceinline__ float dot8f4(unsigned q, v4u h, float acc) {
    const unsigned h0 = h.x, h1 = h.y, h2 = h.z, h3 = h.w;
    acc = __builtin_amdgcn_fdot2_f32_bf16(__builtin_amdgcn_cvt_scalef32_pk_bf16_fp4(q, 1.0f, 0), __builtin_bit_cast(bf16x2_t, h0), acc, false);
    acc = __builtin_amdgcn_fdot2_f32_bf16(__builtin_amdgcn_cvt_scalef32_pk_bf16_fp4(q, 1.0f, 1), __builtin_bit_cast(bf16x2_t, h1), acc, false);
    acc = __builtin_amdgcn_fdot2_f32_bf16(__builtin_amdgcn_cvt_scalef32_pk_bf16_fp4(q, 1.0f, 2), __builtin_bit_cast(bf16x2_t, h2), acc, false);
    acc = __builtin_amdgcn_fdot2_f32_bf16(__builtin_amdgcn_cvt_scalef32_pk_bf16_fp4(q, 1.0f, 3), __builtin_bit_cast(bf16x2_t, h3), acc, false);
    return acc;
}
typedef float f32x2v __attribute__((ext_vector_type(2)));
__device__ __forceinline__ void peer_gather(Frame& F, const Args& A, const bool dummy) {
    unsigned char* ws = A.ws;
    const bf16* H2 = (const bf16*)(ws + WS_H); const unsigned char* U4 = ws + WS_U; const unsigned char* V4 = ws + WS_V;
    const float* SU = (const float*)(ws + WS_SU); const float* SV = (const float*)(ws + WS_SV);
    const int* EIDX = (const int*)(ws + WS_EIDX); const float* EGATE = (const float*)(ws + WS_EGATE); const float* ADA = (const float*)(ws + WS_ADA);
    const int lane = F.lane, grp = lane >> 3, i8 = lane & 7;
    LAS unsigned* WSM = (LAS unsigned*)(F.lds + F.wave * 1024);
    for (int n = F.gw; n < T; n += F.NGW) {
        const int b = n >> 11;
        v4u hh[4][4];
        { const bf16* hp = H2 + (size_t)n * 1024 + 32 * i8;
#pragma unroll
          for (int t = 0; t < 4; ++t)
#pragma unroll
              for (int k = 0; k < 4; ++k) hh[t][k] = *(const GAS v4u*)(hp + 256 * t + 8 * k); }
#pragma unroll 4
        for (int bb = 0; bb < 16; ++bb) {
            const int slot = bb * 8 + grp;
            const int eid = EIDX[(size_t)n * 128 + slot]; const float gt = EGATE[(size_t)n * 128 + slot];
            const unsigned char* up = U4 + (size_t)eid * 512 + 16 * i8;
            v4u q[4];
#pragma unroll
            for (int t = 0; t < 4; ++t) q[t] = *(const GAS v4u*)(up + 128 * t);
            const float su = SU[eid], sv = SV[eid];
            float d0 = 0.f, d1 = 0.f;
#pragma unroll
            for (int t = 0; t < 4; ++t) {
                const unsigned q0 = q[t].x, q1 = q[t].y, q2 = q[t].z, q3 = q[t].w;
                d0 = dot8f4(q0, hh[t][0], d0); d1 = dot8f4(q1, hh[t][1], d1); d0 = dot8f4(q2, hh[t][2], d0); d1 = dot8f4(q3, hh[t][3], d1);
            }
#ifdef GATHER_DUP_U
            { float e0 = 0.f, e1 = 0.f;
#pragma unroll
              for (int t = 0; t < 4; ++t) { const unsigned q0 = q[t].x ^ 0x88888888u, q1 = q[t].y ^ 0x88888888u, q2 = q[t].z ^ 0x88888888u, q3 = q[t].w ^ 0x88888888u;
                e0 = dot8f4(q0, hh[t][0], e0); e1 = dot8f4(q1, hh[t][1], e1); e0 = dot8f4(q2, hh[t][2], e0); e1 = dot8f4(q3, hh[t][3], e1); }
              d0 = 0.5f * (d0 - e0); d1 = 0.5f * (d1 - e1); }
#endif
            float dot = d0 + d1;
            dot += __shfl_xor(dot, 1); dot += __shfl_xor(dot, 2); dot += __shfl_xor(dot, 4);
            dot *= su;
            const float act = 0.5f * dot * (1.0f + erff(dot * 0.70710678118654752f));
            if (i8 == 0) { WSM[2 * slot] = (unsigned)eid; WSM[2 * slot + 1] = __float_as_uint(gt * act * sv); }
        }
        LDS_WAIT(); asm volatile("" ::: "memory");
        f32x2v acc[8];
#pragma unroll
        for (int j = 0; j < 8; ++j) acc[j] = (f32x2v){0.f, 0.f};
#pragma unroll 2
        for (int e0 = 0; e0 < 128; e0 += 16) {
            v2u vv[16]; float ww[16];
#pragma unroll
            for (int j = 0; j < 16; ++j) {
                const v2u ew = *(const LAS v2u*)(WSM + 2 * (e0 + j));
                const int eid = __builtin_amdgcn_readfirstlane((int)ew.x); ww[j] = __uint_as_float(__builtin_amdgcn_readfirstlane((int)ew.y));
                vv[j] = *(const GAS v2u*)(V4 + (size_t)eid * 512 + 8 * lane);
            }
#pragma unroll
            for (int j = 0; j < 16; ++j) {
                const unsigned v0 = vv[j].x, v1 = vv[j].y; const f32x2v w2 = (f32x2v){ww[j], ww[j]};
                acc[0] += w2 * __builtin_amdgcn_cvt_scalef32_pk_f32_fp4(v0, 1.0f, 0); acc[1] += w2 * __builtin_amdgcn_cvt_scalef32_pk_f32_fp4(v0, 1.0f, 1);
                acc[2] += w2 * __builtin_amdgcn_cvt_scalef32_pk_f32_fp4(v0, 1.0f, 2); acc[3] += w2 * __builtin_amdgcn_cvt_scalef32_pk_f32_fp4(v0, 1.0f, 3);
                acc[4] += w2 * __builtin_amdgcn_cvt_scalef32_pk_f32_fp4(v1, 1.0f, 0); acc[5] += w2 * __builtin_amdgcn_cvt_scalef32_pk_f32_fp4(v1, 1.0f, 1);
                acc[6] += w2 * __builtin_amdgcn_cvt_scalef32_pk_f32_fp4(v1, 1.0f, 2); acc[7] += w2 * __builtin_amdgcn_cvt_scalef32_pk_f32_fp4(v1, 1.0f, 3);
            }
        }
        LDS_WAIT(); asm volatile("" ::: "memory");
        const float* ip = A.out + (size_t)n * 1024 + 16 * lane; float* op = dummy ? (float*)(ws + WS_Z) + (size_t)n * 1024 + 16 * lane : A.out + (size_t)n * 1024 + 16 * lane; const float* g2p = ADA + b * 6144 + 5 * 1024 + 16 * lane;
#pragma unroll
        for (int q4 = 0; q4 < 4; ++q4) {
            const f32x4 xv = *(const GAS f32x4*)(ip + 4 * q4), gv = *(const GAS f32x4*)(g2p + 4 * q4);
            const f32x4 av = (f32x4){acc[2 * q4].x, acc[2 * q4].y, acc[2 * q4 + 1].x, acc[2 * q4 + 1].y};
            *(GAS f32x4*)(op + 4 * q4) = xv + gv * av;
        }
    }
}


constexpr int CW_Q1 = 8192, CW_Q3 = 8192 + 8 * 64;
__device__ __forceinline__ float quad_sum(float v) {
    v += __builtin_bit_cast(float, __builtin_amdgcn_update_dpp(0, __builtin_bit_cast(int, v), 0xB1, 0xF, 0xF, true));
    v += __builtin_bit_cast(float, __builtin_amdgcn_update_dpp(0, __builtin_bit_cast(int, v), 0x4E, 0xF, 0xF, true));
    return v;
}
__device__ __forceinline__ int next_item(Frame& F, unsigned* q) {
    LAS int* sh = (LAS int*)(F.lds);
    if (F.tid == 0) sh[0] = (int)__hip_atomic_fetch_add(q, 1u, __ATOMIC_RELAXED, __HIP_MEMORY_SCOPE_AGENT);
    __syncthreads(); const int it = sh[0]; __syncthreads();
    return it;
}
__device__ __forceinline__ void peer_g1(Frame& F, const Args& A) {
    unsigned char* ws = A.ws;
    const bf16* H2 = (const bf16*)(ws + WS_H); const unsigned char* U4 = ws + WS_U; const int* EIDX = (const int*)(ws + WS_EIDX); float* PD = (float*)(ws + WS_Z);
    unsigned* Q = (unsigned*)(ws + WS_CTL) + CW_Q1;
    const int lane = F.lane, tk = lane >> 3, c4 = lane & 7;
    const int s0 = (int)(xb_xcc_id() & 3u);
    for (int so = 0; so < 4; ++so) {
        const int s = (s0 + so) & 3;
        for (;;) {
            const int item = next_item(F, Q + 64 * s);
            if (item >= T / 128) break;
          for (int sub = 0; sub < 2; ++sub) {
            const int n = item * 128 + F.wave * 16 + sub * 8 + tk;
            v4u h2s[4];
            { const bf16* hp = H2 + (size_t)n * 1024 + 256 * s + 32 * c4;
#pragma unroll
              for (int k = 0; k < 4; ++k) h2s[k] = *(const GAS v4u*)(hp + 8 * k); }
            const unsigned char* ub = U4 + (size_t)s * (16384 * 128) + 16 * c4;
            float* pd = PD + ((size_t)s * T + n) * 128;
            const int* ep = EIDX + (size_t)n * 128;
            v4u idb[2], idc[2], rows[8], rnx[8];
            { const v4u i0 = *(const GAS v4u*)(ep), i1 = *(const GAS v4u*)(ep + 4); idb[0] = *(const GAS v4u*)(ep + 8); idb[1] = *(const GAS v4u*)(ep + 12);
              const unsigned a0 = i0.x, a1 = i0.y, a2 = i0.z, a3 = i0.w, a4 = i1.x, a5 = i1.y, a6 = i1.z, a7 = i1.w;
              rows[0] = *(const GAS v4u*)(ub + (size_t)a0 * 128); rows[1] = *(const GAS v4u*)(ub + (size_t)a1 * 128); rows[2] = *(const GAS v4u*)(ub + (size_t)a2 * 128); rows[3] = *(const GAS v4u*)(ub + (size_t)a3 * 128);
              rows[4] = *(const GAS v4u*)(ub + (size_t)a4 * 128); rows[5] = *(const GAS v4u*)(ub + (size_t)a5 * 128); rows[6] = *(const GAS v4u*)(ub + (size_t)a6 * 128); rows[7] = *(const GAS v4u*)(ub + (size_t)a7 * 128); }
            for (int g = 0; g < 16; ++g) {
                if (g + 2 < 16) { idc[0] = *(const GAS v4u*)(ep + 8 * (g + 2)); idc[1] = *(const GAS v4u*)(ep + 8 * (g + 2) + 4); }
                if (g + 1 < 16) {
                    const unsigned a0 = idb[0].x, a1 = idb[0].y, a2 = idb[0].z, a3 = idb[0].w, a4 = idb[1].x, a5 = idb[1].y, a6 = idb[1].z, a7 = idb[1].w;
                    rnx[0] = *(const GAS v4u*)(ub + (size_t)a0 * 128); rnx[1] = *(const GAS v4u*)(ub + (size_t)a1 * 128); rnx[2] = *(const GAS v4u*)(ub + (size_t)a2 * 128); rnx[3] = *(const GAS v4u*)(ub + (size_t)a3 * 128);
                    rnx[4] = *(const GAS v4u*)(ub + (size_t)a4 * 128); rnx[5] = *(const GAS v4u*)(ub + (size_t)a5 * 128); rnx[6] = *(const GAS v4u*)(ub + (size_t)a6 * 128); rnx[7] = *(const GAS v4u*)(ub + (size_t)a7 * 128);
                }
                float p[8];
#pragma unroll
                for (int k = 0; k < 8; ++k) { const unsigned x0 = rows[k].x, x1 = rows[k].y, x2 = rows[k].z, x3 = rows[k].w; float pp = quad_sum(dot8f4(x3, h2s[3], dot8f4(x2, h2s[2], dot8f4(x1, h2s[1], dot8f4(x0, h2s[0], 0.f))))); pp += __shfl_xor(pp, 4); p[k] = pp; }
                if (c4 == 0) { *(GAS f32x4*)(pd + 8 * g) = (f32x4){p[0], p[1], p[2], p[3]}; *(GAS f32x4*)(pd + 8 * g + 4) = (f32x4){p[4], p[5], p[6], p[7]}; }
#pragma unroll
                for (int k = 0; k < 8; ++k) rows[k] = rnx[k];
                idb[0] = idc[0]; idb[1] = idc[1];
            }
          }
        }
    }
}
__device__ __forceinline__ void peer_g2(Frame& F, const Args& A) {
    unsigned char* ws = A.ws;
    const int* EIDX = (const int*)(ws + WS_EIDX); float* EGATE = (float*)(ws + WS_EGATE); const float* PD = (const float*)(ws + WS_Z);
    const float* SU = (const float*)(ws + WS_SU); const float* SV = (const float*)(ws + WS_SV); const float* SH2 = (const float*)(ws + WS_SH2);
    const size_t gtid = (size_t)F.gw * 64 + F.lane, gthreads = (size_t)F.NGW * 64;
    for (size_t idx = gtid; idx < (size_t)T * 128; idx += gthreads) {
        float d = 0.f;
#pragma unroll
        for (int s = 0; s < 4; ++s) d += PD[(size_t)s * T * 128 + idx];
        const int eid = EIDX[idx];
        d *= SU[eid];
        const float act = 0.5f * d * (1.0f + erff(d * 0.70710678118654752f));
        EGATE[idx] = EGATE[idx] * act * SV[eid];
    }
}
__device__ __forceinline__ void peer_g3(Frame& F, const Args& A) {
    unsigned char* ws = A.ws;
    const unsigned char* V4 = ws + WS_V; const int* EIDX = (const int*)(ws + WS_EIDX); const float* W = (const float*)(ws + WS_EGATE); const float* ADA = (const float*)(ws + WS_ADA);
    unsigned* Q = (unsigned*)(ws + WS_CTL) + CW_Q3;
    const int lane = F.lane, tk = lane >> 3, c4 = lane & 7;
#ifdef G3_DUPLOAD
    const size_t zoff = (size_t)*((volatile unsigned*)(ws + WS_CTL) + 80);
#endif
    const int s0 = (int)(xb_xcc_id() & 3u);
    for (int so = 0; so < 4; ++so) {
        const int s = (s0 + so) & 3;
        for (;;) {
            const int item = next_item(F, Q + 64 * s);
            if (item >= T / 128) break;
          for (int sub = 0; sub < 2; ++sub) {
            const int n = item * 128 + F.wave * 16 + sub * 8 + tk;
            const unsigned char* vb = V4 + (size_t)s * (16384 * 128) + 16 * c4;
            f32x2v acc[16];
#pragma unroll
            for (int j = 0; j < 16; ++j) acc[j] = (f32x2v){0.f, 0.f};
            const int* ep = EIDX + (size_t)n * 128; const float* wp = W + (size_t)n * 128;
            v4u idb[2], idc[2], rows[8], rnx[8]; f32x4 wc[2], wb[2], wn[2];
            { const v4u i0 = *(const GAS v4u*)(ep), i1 = *(const GAS v4u*)(ep + 4); idb[0] = *(const GAS v4u*)(ep + 8); idb[1] = *(const GAS v4u*)(ep + 12);
              wc[0] = *(const GAS f32x4*)(wp); wc[1] = *(const GAS f32x4*)(wp + 4); wb[0] = *(const GAS f32x4*)(wp + 8); wb[1] = *(const GAS f32x4*)(wp + 12);
              const unsigned a0 = i0.x, a1 = i0.y, a2 = i0.z, a3 = i0.w, a4 = i1.x, a5 = i1.y, a6 = i1.z, a7 = i1.w;
              rows[0] = *(const GAS v4u*)(vb + (size_t)a0 * 128); rows[1] = *(const GAS v4u*)(vb + (size_t)a1 * 128); rows[2] = *(const GAS v4u*)(vb + (size_t)a2 * 128); rows[3] = *(const GAS v4u*)(vb + (size_t)a3 * 128);
              rows[4] = *(const GAS v4u*)(vb + (size_t)a4 * 128); rows[5] = *(const GAS v4u*)(vb + (size_t)a5 * 128); rows[6] = *(const GAS v4u*)(vb + (size_t)a6 * 128); rows[7] = *(const GAS v4u*)(vb + (size_t)a7 * 128); }
            for (int g = 0; g < 16; ++g) {
                if (g + 2 < 16) { idc[0] = *(const GAS v4u*)(ep + 8 * (g + 2)); idc[1] = *(const GAS v4u*)(ep + 8 * (g + 2) + 4); wn[0] = *(const GAS f32x4*)(wp + 8 * (g + 2)); wn[1] = *(const GAS f32x4*)(wp + 8 * (g + 2) + 4); }
                if (g + 1 < 16) {
                    const unsigned a0 = idb[0].x, a1 = idb[0].y, a2 = idb[0].z, a3 = idb[0].w, a4 = idb[1].x, a5 = idb[1].y, a6 = idb[1].z, a7 = idb[1].w;
                    rnx[0] = *(const GAS v4u*)(vb + (size_t)a0 * 128); rnx[1] = *(const GAS v4u*)(vb + (size_t)a1 * 128); rnx[2] = *(const GAS v4u*)(vb + (size_t)a2 * 128); rnx[3] = *(const GAS v4u*)(vb + (size_t)a3 * 128);
                    rnx[4] = *(const GAS v4u*)(vb + (size_t)a4 * 128); rnx[5] = *(const GAS v4u*)(vb + (size_t)a5 * 128); rnx[6] = *(const GAS v4u*)(vb + (size_t)a6 * 128); rnx[7] = *(const GAS v4u*)(vb + (size_t)a7 * 128);
                }
#ifdef G3_DUPLOAD
                v4u r2[8];
                if (g + 1 < 16) {
                    const unsigned a0 = idb[0].x, a1 = idb[0].y, a2 = idb[0].z, a3 = idb[0].w, a4 = idb[1].x, a5 = idb[1].y, a6 = idb[1].z, a7 = idb[1].w;
                    r2[0] = *(const GAS v4u*)(vb + zoff + (size_t)a0 * 128); r2[1] = *(const GAS v4u*)(vb + zoff + (size_t)a1 * 128); r2[2] = *(const GAS v4u*)(vb + zoff + (size_t)a2 * 128); r2[3] = *(const GAS v4u*)(vb + zoff + (size_t)a3 * 128);
                    r2[4] = *(const GAS v4u*)(vb + zoff + (size_t)a4 * 128); r2[5] = *(const GAS v4u*)(vb + zoff + (size_t)a5 * 128); r2[6] = *(const GAS v4u*)(vb + zoff + (size_t)a6 * 128); r2[7] = *(const GAS v4u*)(vb + zoff + (size_t)a7 * 128);
#pragma unroll
                    for (int k = 0; k < 8; ++k) { rnx[k].y = r2[k].y; rnx[k].w = r2[k].w; }
                }
#endif
#pragma unroll
                for (int k = 0; k < 8; ++k) {
                    const float wk = wc[k >> 2][k & 3]; const f32x2v w2 = (f32x2v){wk, wk};
                    const unsigned x0 = rows[k].x, x1 = rows[k].y, x2 = rows[k].z, x3 = rows[k].w;
                    acc[0] += w2 * __builtin_amdgcn_cvt_scalef32_pk_f32_fp4(x0, 1.0f, 0); acc[1] += w2 * __builtin_amdgcn_cvt_scalef32_pk_f32_fp4(x0, 1.0f, 1);
                    acc[2] += w2 * __builtin_amdgcn_cvt_scalef32_pk_f32_fp4(x0, 1.0f, 2); acc[3] += w2 * __builtin_amdgcn_cvt_scalef32_pk_f32_fp4(x0, 1.0f, 3);
                    acc[4] += w2 * __builtin_amdgcn_cvt_scalef32_pk_f32_fp4(x1, 1.0f, 0); acc[5] += w2 * __builtin_amdgcn_cvt_scalef32_pk_f32_fp4(x1, 1.0f, 1);
                    acc[6] += w2 * __builtin_amdgcn_cvt_scalef32_pk_f32_fp4(x1, 1.0f, 2); acc[7] += w2 * __builtin_amdgcn_cvt_scalef32_pk_f32_fp4(x1, 1.0f, 3);
                    acc[8] += w2 * __builtin_amdgcn_cvt_scalef32_pk_f32_fp4(x2, 1.0f, 0); acc[9] += w2 * __builtin_amdgcn_cvt_scalef32_pk_f32_fp4(x2, 1.0f, 1);
                    acc[10] += w2 * __builtin_amdgcn_cvt_scalef32_pk_f32_fp4(x2, 1.0f, 2); acc[11] += w2 * __builtin_amdgcn_cvt_scalef32_pk_f32_fp4(x2, 1.0f, 3);
                    acc[12] += w2 * __builtin_amdgcn_cvt_scalef32_pk_f32_fp4(x3, 1.0f, 0); acc[13] += w2 * __builtin_amdgcn_cvt_scalef32_pk_f32_fp4(x3, 1.0f, 1);
                    acc[14] += w2 * __builtin_amdgcn_cvt_scalef32_pk_f32_fp4(x3, 1.0f, 2); acc[15] += w2 * __builtin_amdgcn_cvt_scalef32_pk_f32_fp4(x3, 1.0f, 3);
                }
#pragma unroll
                for (int k = 0; k < 8; ++k) rows[k] = rnx[k];
                idb[0] = idc[0]; idb[1] = idc[1]; wc[0] = wb[0]; wc[1] = wb[1]; wb[0] = wn[0]; wb[1] = wn[1];
            }
            float* op = A.out + (size_t)n * 1024 + 256 * s + 32 * c4; const float* g2p = ADA + (n >> 11) * 6144 + 5 * 1024 + 256 * s + 32 * c4;
#pragma unroll
            for (int q4 = 0; q4 < 8; ++q4) {
                const f32x4 xv = *(const GAS f32x4*)(op + 4 * q4), gv = *(const GAS f32x4*)(g2p + 4 * q4);
                const f32x4 av = (f32x4){acc[2 * q4].x, acc[2 * q4].y, acc[2 * q4 + 1].x, acc[2 * q4 + 1].y};
                *(GAS f32x4*)(op + 4 * q4) = xv + gv * av;
            }
          }
        }
    }
}


__device__ __forceinline__ void peer_local(Frame& F, const Args& A, const XcdBarrier& xb) {
    unsigned char* ws = A.ws;
    const bf16* H2 = (const bf16*)(ws + WS_H); const unsigned char* U4 = ws + WS_U; const unsigned char* V4 = ws + WS_V;
    const int* EIDX = (const int*)(ws + WS_EIDX); const float* EGATE = (const float*)(ws + WS_EGATE); const float* ADA = (const float*)(ws + WS_ADA);
    const float* SU = (const float*)(ws + WS_SU); const float* SV = (const float*)(ws + WS_SV); const float* SH2 = (const float*)(ws + WS_SH2);
    const int lane = F.lane, tk = lane >> 3, c4 = lane & 7;
    const int tpw = T / F.NGW;
    LAS float* PDL = (LAS float*)F.lds + (size_t)F.wave * tpw * 128;
    const int nbase = F.gw * tpw;
    for (int i = lane; i < tpw * 128; i += 64) PDL[i] = 0.f;
    LDS_WAIT(); asm volatile("" ::: "memory");
    const unsigned char* HHI = ws + WS_H2HI; const unsigned char* HLO = ws + WS_H2LO;
    for (int s = 0; s < 4; ++s) {
#ifdef SLICE_BAR
        if (s) xcd_barrier(xb);
#endif
        const unsigned char* ub = U4 + (size_t)s * (16384 * 128) + 16 * c4;
        for (int sub = 0; sub < tpw; sub += 8) {
            const int n = nbase + sub + tk;
            const v4u hh = *(const GAS v4u*)(HHI + (size_t)n * 512 + 128 * s + 16 * c4), hl = *(const GAS v4u*)(HLO + (size_t)n * 512 + 128 * s + 16 * c4);
            const int h0 = (int)hh.x, h1 = (int)hh.y, h2_ = (int)hh.z, h3 = (int)hh.w, l0 = (int)hl.x, l1 = (int)hl.y, l2 = (int)hl.z, l3 = (int)hl.w;
            LAS float* pd = PDL + (sub + tk) * 128;
            const int* ep = EIDX + (size_t)n * 128;
            v4u idb[2], idc[2], rows[8], rnx[8];
#ifdef EIDX16
            const unsigned short* ep16 = (const unsigned short*)EIDX + (size_t)n * 128;
            { const v4u i0 = *(const GAS v4u*)(ep16); idb[0] = *(const GAS v4u*)(ep16 + 8); idb[1] = idb[0]; (void)ep;
              const unsigned a0 = i0.x & 0xFFFFu, a1 = i0.x >> 16, a2 = i0.y & 0xFFFFu, a3 = i0.y >> 16, a4 = i0.z & 0xFFFFu, a5 = i0.z >> 16, a6 = i0.w & 0xFFFFu, a7 = i0.w >> 16;
#else
            { const v4u i0 = *(const GAS v4u*)(ep), i1 = *(const GAS v4u*)(ep + 4); idb[0] = *(const GAS v4u*)(ep + 8); idb[1] = *(const GAS v4u*)(ep + 12);
              const unsigned a0 = i0.x, a1 = i0.y, a2 = i0.z, a3 = i0.w, a4 = i1.x, a5 = i1.y, a6 = i1.z, a7 = i1.w;
#endif
              rows[0] = *(const GAS v4u*)(ub + (size_t)a0 * 128); rows[1] = *(const GAS v4u*)(ub + (size_t)a1 * 128); rows[2] = *(const GAS v4u*)(ub + (size_t)a2 * 128); rows[3] = *(const GAS v4u*)(ub + (size_t)a3 * 128);
              rows[4] = *(const GAS v4u*)(ub + (size_t)a4 * 128); rows[5] = *(const GAS v4u*)(ub + (size_t)a5 * 128); rows[6] = *(const GAS v4u*)(ub + (size_t)a6 * 128); rows[7] = *(const GAS v4u*)(ub + (size_t)a7 * 128); }
            for (int g = 0; g < 16; ++g) {
#ifdef EIDX16
                if (g + 2 < 16) { idc[0] = *(const GAS v4u*)(ep16 + 8 * (g + 2)); idc[1] = idc[0]; }
                if (g + 1 < 16) {
                    const unsigned a0 = idb[0].x & 0xFFFFu, a1 = idb[0].x >> 16, a2 = idb[0].y & 0xFFFFu, a3 = idb[0].y >> 16, a4 = idb[0].z & 0xFFFFu, a5 = idb[0].z >> 16, a6 = idb[0].w & 0xFFFFu, a7 = idb[0].w >> 16;
#else
                if (g + 2 < 16) { idc[0] = *(const GAS v4u*)(ep + 8 * (g + 2)); idc[1] = *(const GAS v4u*)(ep + 8 * (g + 2) + 4); }
                if (g + 1 < 16) {
                    const unsigned a0 = idb[0].x, a1 = idb[0].y, a2 = idb[0].z, a3 = idb[0].w, a4 = idb[1].x, a5 = idb[1].y, a6 = idb[1].z, a7 = idb[1].w;
#endif
                    rnx[0] = *(const GAS v4u*)(ub + (size_t)a0 * 128); rnx[1] = *(const GAS v4u*)(ub + (size_t)a1 * 128); rnx[2] = *(const GAS v4u*)(ub + (size_t)a2 * 128); rnx[3] = *(const GAS v4u*)(ub + (size_t)a3 * 128);
                    rnx[4] = *(const GAS v4u*)(ub + (size_t)a4 * 128); rnx[5] = *(const GAS v4u*)(ub + (size_t)a5 * 128); rnx[6] = *(const GAS v4u*)(ub + (size_t)a6 * 128); rnx[7] = *(const GAS v4u*)(ub + (size_t)a7 * 128);
                }
                float p[8];
#pragma unroll
                for (int k = 0; k < 8; ++k) {
                    const int x0 = (int)rows[k].x, x1 = (int)rows[k].y, x2 = (int)rows[k].z, x3 = (int)rows[k].w;
                    const int ah = __builtin_amdgcn_sdot8(x3, h3, __builtin_amdgcn_sdot8(x2, h2_, __builtin_amdgcn_sdot8(x1, h1, __builtin_amdgcn_sdot8(x0, h0, 0, false), false), false), false);
                    const int al = __builtin_amdgcn_sdot8(x3, l3, __builtin_amdgcn_sdot8(x2, l2, __builtin_amdgcn_sdot8(x1, l1, __builtin_amdgcn_sdot8(x0, l0, 0, false), false), false), false);
                    int t = 16 * ah + al;
                    t += __builtin_amdgcn_update_dpp(0, t, 0xB1, 0xF, 0xF, true); t += __builtin_amdgcn_update_dpp(0, t, 0x4E, 0xF, 0xF, true); t += __shfl_xor(t, 4);
                    p[k] = (float)t;
                }
                if (c4 == 0) {
                    const f32x4 o0 = *(const LAS f32x4*)(pd + 8 * g), o1 = *(const LAS f32x4*)(pd + 8 * g + 4);
                    *(LAS f32x4*)(pd + 8 * g) = o0 + (f32x4){p[0], p[1], p[2], p[3]}; *(LAS f32x4*)(pd + 8 * g + 4) = o1 + (f32x4){p[4], p[5], p[6], p[7]};
                }
#pragma unroll
                for (int k = 0; k < 8; ++k) rows[k] = rnx[k];
                idb[0] = idc[0]; idb[1] = idc[1];
            }
        }
    }
    LDS_WAIT(); asm volatile("" ::: "memory");
    for (int i = lane; i < tpw * 128; i += 64) {
        const size_t gi = (size_t)nbase * 128 + i;
#ifdef EIDX16
        const int eid = ((const unsigned short*)EIDX)[gi];
#else
        const int eid = EIDX[gi];
#endif
        const float d = PDL[i] * SU[eid] * SH2[nbase + (i >> 7)];
        const float act = 0.5f * d * (1.0f + erff(d * 0.70710678118654752f));
        PDL[i] = EGATE[gi] * act * SV[eid];
    }
    LDS_WAIT(); asm volatile("" ::: "memory");
    for (int s = 0; s < 4; ++s) {
#ifdef SLICE_BAR
        xcd_barrier(xb);
#endif
        const unsigned char* vb = V4 + (size_t)s * (16384 * 128) + 16 * c4;
        for (int sub = 0; sub < tpw; sub += 8) {
            const int n = nbase + sub + tk;
            const LAS float* wl = PDL + (sub + tk) * 128;
            f32x2v acc[16];
#pragma unroll
            for (int j = 0; j < 16; ++j) acc[j] = (f32x2v){0.f, 0.f};
#ifdef P12_PREF
            f32x4 xpre[8];
            { const float* op0 = A.out + (size_t)n * 1024 + 256 * s + 32 * c4;
#pragma unroll
              for (int q4 = 0; q4 < 8; ++q4) xpre[q4] = *(const GAS f32x4*)(op0 + 4 * q4); }
#endif
            const int* ep = EIDX + (size_t)n * 128;
            v4u idb[2], idc[2], rows[8], rnx[8];
#ifdef EIDX16
            const unsigned short* ep16 = (const unsigned short*)EIDX + (size_t)n * 128;
            { const v4u i0 = *(const GAS v4u*)(ep16); idb[0] = *(const GAS v4u*)(ep16 + 8); idb[1] = idb[0]; (void)ep;
              const unsigned a0 = i0.x & 0xFFFFu, a1 = i0.x >> 16, a2 = i0.y & 0xFFFFu, a3 = i0.y >> 16, a4 = i0.z & 0xFFFFu, a5 = i0.z >> 16, a6 = i0.w & 0xFFFFu, a7 = i0.w >> 16;
#else
            { const v4u i0 = *(const GAS v4u*)(ep), i1 = *(const GAS v4u*)(ep + 4); idb[0] = *(const GAS v4u*)(ep + 8); idb[1] = *(const GAS v4u*)(ep + 12);
              const unsigned a0 = i0.x, a1 = i0.y, a2 = i0.z, a3 = i0.w, a4 = i1.x, a5 = i1.y, a6 = i1.z, a7 = i1.w;
#endif
              rows[0] = *(const GAS v4u*)(vb + (size_t)a0 * 128); rows[1] = *(const GAS v4u*)(vb + (size_t)a1 * 128); rows[2] = *(const GAS v4u*)(vb + (size_t)a2 * 128); rows[3] = *(const GAS v4u*)(vb + (size_t)a3 * 128);
              rows[4] = *(const GAS v4u*)(vb + (size_t)a4 * 128); rows[5] = *(const GAS v4u*)(vb + (size_t)a5 * 128); rows[6] = *(const GAS v4u*)(vb + (size_t)a6 * 128); rows[7] = *(const GAS v4u*)(vb + (size_t)a7 * 128); }
            for (int g = 0; g < 16; ++g) {
#ifdef EIDX16
                if (g + 2 < 16) { idc[0] = *(const GAS v4u*)(ep16 + 8 * (g + 2)); idc[1] = idc[0]; }
                if (g + 1 < 16) {
                    const unsigned a0 = idb[0].x & 0xFFFFu, a1 = idb[0].x >> 16, a2 = idb[0].y & 0xFFFFu, a3 = idb[0].y >> 16, a4 = idb[0].z & 0xFFFFu, a5 = idb[0].z >> 16, a6 = idb[0].w & 0xFFFFu, a7 = idb[0].w >> 16;
#else
                if (g + 2 < 16) { idc[0] = *(const GAS v4u*)(ep + 8 * (g + 2)); idc[1] = *(const GAS v4u*)(ep + 8 * (g + 2) + 4); }
                if (g + 1 < 16) {
                    const unsigned a0 = idb[0].x, a1 = idb[0].y, a2 = idb[0].z, a3 = idb[0].w, a4 = idb[1].x, a5 = idb[1].y, a6 = idb[1].z, a7 = idb[1].w;
#endif
                    rnx[0] = *(const GAS v4u*)(vb + (size_t)a0 * 128); rnx[1] = *(const GAS v4u*)(vb + (size_t)a1 * 128); rnx[2] = *(const GAS v4u*)(vb + (size_t)a2 * 128); rnx[3] = *(const GAS v4u*)(vb + (size_t)a3 * 128);
                    rnx[4] = *(const GAS v4u*)(vb + (size_t)a4 * 128); rnx[5] = *(const GAS v4u*)(vb + (size_t)a5 * 128); rnx[6] = *(const GAS v4u*)(vb + (size_t)a6 * 128); rnx[7] = *(const GAS v4u*)(vb + (size_t)a7 * 128);
                }
                const f32x4 w0 = *(const LAS f32x4*)(wl + 8 * g), w1 = *(const LAS f32x4*)(wl + 8 * g + 4);
#pragma unroll
                for (int k = 0; k < 8; ++k) {
                    const float wk = (k < 4) ? w0[k & 3] : w1[k & 3]; const f32x2v w2 = (f32x2v){wk, wk};
                    const unsigned x0 = rows[k].x, x1 = rows[k].y, x2 = rows[k].z, x3 = rows[k].w;
                    acc[0] += w2 * __builtin_amdgcn_cvt_scalef32_pk_f32_fp4(x0, 1.0f, 0); acc[1] += w2 * __builtin_amdgcn_cvt_scalef32_pk_f32_fp4(x0, 1.0f, 1);
                    acc[2] += w2 * __builtin_amdgcn_cvt_scalef32_pk_f32_fp4(x0, 1.0f, 2); acc[3] += w2 * __builtin_amdgcn_cvt_scalef32_pk_f32_fp4(x0, 1.0f, 3);
                    acc[4] += w2 * __builtin_amdgcn_cvt_scalef32_pk_f32_fp4(x1, 1.0f, 0); acc[5] += w2 * __builtin_amdgcn_cvt_scalef32_pk_f32_fp4(x1, 1.0f, 1);
                    acc[6] += w2 * __builtin_amdgcn_cvt_scalef32_pk_f32_fp4(x1, 1.0f, 2); acc[7] += w2 * __builtin_amdgcn_cvt_scalef32_pk_f32_fp4(x1, 1.0f, 3);
                    acc[8] += w2 * __builtin_amdgcn_cvt_scalef32_pk_f32_fp4(x2, 1.0f, 0); acc[9] += w2 * __builtin_amdgcn_cvt_scalef32_pk_f32_fp4(x2, 1.0f, 1);
                    acc[10] += w2 * __builtin_amdgcn_cvt_scalef32_pk_f32_fp4(x2, 1.0f, 2); acc[11] += w2 * __builtin_amdgcn_cvt_scalef32_pk_f32_fp4(x2, 1.0f, 3);
                    acc[12] += w2 * __builtin_amdgcn_cvt_scalef32_pk_f32_fp4(x3, 1.0f, 0); acc[13] += w2 * __builtin_amdgcn_cvt_scalef32_pk_f32_fp4(x3, 1.0f, 1);
                    acc[14] += w2 * __builtin_amdgcn_cvt_scalef32_pk_f32_fp4(x3, 1.0f, 2); acc[15] += w2 * __builtin_amdgcn_cvt_scalef32_pk_f32_fp4(x3, 1.0f, 3);
                }
#pragma unroll
                for (int k = 0; k < 8; ++k) rows[k] = rnx[k];
                idb[0] = idc[0]; idb[1] = idc[1];
            }
            float* op = A.out + (size_t)n * 1024 + 256 * s + 32 * c4; const float* g2p = ADA + (n >> 11) * 6144 + 5 * 1024 + 256 * s + 32 * c4;
#pragma unroll
            for (int q4 = 0; q4 < 8; ++q4) {
#if defined(X1_BF16)
#ifdef P12_NT
                const f32x4 gv = *(const GAS f32x4*)(g2p + 4 * q4); const v2u a_ = __builtin_nontemporal_load((const GAS v2u*)((const bf16*)(ws + WS_X1) + (size_t)n * 1024 + 256 * s + 32 * c4 + 4 * q4));
#else
                const f32x4 gv = *(const GAS f32x4*)(g2p + 4 * q4); const v2u a_ = *(const GAS v2u*)((const bf16*)(ws + WS_X1) + (size_t)n * 1024 + 256 * s + 32 * c4 + 4 * q4);
#endif
                const f32x4 xv = (f32x4){__uint_as_float(a_.x << 16), __uint_as_float(a_.x & 0xffff0000u), __uint_as_float(a_.y << 16), __uint_as_float(a_.y & 0xffff0000u)};
#elif defined(P12_PREF)
                const f32x4 xv = xpre[q4], gv = *(const GAS f32x4*)(g2p + 4 * q4);
#else
                const f32x4 xv = *(const GAS f32x4*)(op + 4 * q4), gv = *(const GAS f32x4*)(g2p + 4 * q4);
#endif
                const f32x4 av = (f32x4){acc[2 * q4].x, acc[2 * q4].y, acc[2 * q4 + 1].x, acc[2 * q4 + 1].y};
#ifdef P12_NT
                __builtin_nontemporal_store(xv + gv * av, (GAS f32x4*)(op + 4 * q4));
#else
                *(GAS f32x4*)(op + 4 * q4) = xv + gv * av;
#endif
            }
        }
    }
}

__device__ __forceinline__ void dbg_peer_check1(Frame& F, const Args& A) {
    if (blockIdx.x != 0) return;
    unsigned char* ws = A.ws;
    const bf16* H2 = (const bf16*)(ws + WS_H); const bf16* PQ = (const bf16*)(ws + WS_PQ); const bf16* SK = (const bf16*)(ws + WS_SK);
    const int* EIDX = (const int*)(ws + WS_EIDX); const float* EGATE = (const float*)(ws + WS_EGATE); float* DBG = (float*)(ws + 48 * MiB);
    unsigned* flag = (unsigned*)(ws + WS_CTL) + 64;
    const int t = F.tid;
    const int r = (int)(((long long)t * 2579 + 17) % T), c = (t * 131 + 5) % 1024;
    unsigned f = 0u;
    { float acc = 0.f; for (int k = 0; k < 1024; ++k) acc += bf2f(H2[(size_t)r * 1024 + k]) * A.w_pq[(size_t)k * 1024 + c];
      const float got = bf2f(PQ[(size_t)r * 1024 + c]); if (fabsf(got - acc) > 0.02f * fabsf(acc) + 0.02f) f |= 1u; }
    { const int h = t & 7; float s[2][128];
      float* sc = DBG + 4096 + (size_t)t * 256;
      for (int p = 0; p < 2; ++p) for (int k = 0; k < 128; ++k) { float acc = 0.f; for (int d = 0; d < 64; ++d) acc += bf2f(PQ[(size_t)r * 1024 + h * 128 + p * 64 + d]) * bf2f(SK[((size_t)(h * 2 + p) * 128 + k) * 64 + d]); sc[p * 128 + k] = acc; }
      (void)s;
      float t0v[16], t1v[16];
      for (int p = 0; p < 2; ++p) { float last = 3.0e38f; int lasti = -1; for (int i = 0; i < 16; ++i) { float best = -3.0e38f; int bi = -1; for (int k = 0; k < 128; ++k) { const float v = sc[p * 128 + k]; if ((v < last || (v == last && k > lasti)) && v > best) { best = v; bi = k; } } last = best; lasti = bi; if (p == 0) t0v[i] = best; else t1v[i] = best; } }
      float last = 3.0e38f; int cnt_ge = 0; float kth = 0.f;
      for (int it = 0; it < 16; ++it) { float best = -3.0e38f; for (int i = 0; i < 16; ++i) for (int j = 0; j < 16; ++j) { const float v = t0v[i] + t1v[j]; if (v < last && v > best) best = v; } last = best; kth = best; }
      (void)cnt_ge;
      float gs = 0.f; int badn = 0;
      for (int i = 0; i < 16; ++i) { const int e = EIDX[(size_t)r * 128 + h * 16 + i]; const float g = EGATE[(size_t)r * 128 + h * 16 + i]; gs += g;
          if (e < 0 || e >= 16384) { badn += 100; continue; }
          const float sm = sc[e >> 7] + sc[128 + (e & 127)]; if (sm < kth - 0.02f * fabsf(kth) - 0.02f) ++badn; }
      if (badn > 1) f |= 2u;
      if (fabsf(gs - 1.0f) > 0.01f) f |= 4u; }
    { float acc = 0.f;
      for (int e = 0; e < 128; ++e) { const int id = EIDX[(size_t)r * 128 + e]; const float g = EGATE[(size_t)r * 128 + e]; if (id < 0 || id >= 16384) continue;
          float d = 0.f; for (int k = 0; k < 1024; ++k) d += bf2f(H2[(size_t)r * 1024 + k]) * A.pu[(size_t)id * 1024 + k];
          const float act = 0.5f * d * (1.0f + erff(d * 0.70710678f)); acc += g * act * A.pv[(size_t)id * 1024 + c]; }
      DBG[t] = acc; DBG[512 + t] = A.out[(size_t)r * 1024 + c]; }
    if (f) atomicOr(flag, f);
}
__device__ __forceinline__ void dbg_peer_check2(Frame& F, const Args& A) {
    if (blockIdx.x != 0) return;
    unsigned char* ws = A.ws; const float* DBG = (const float*)(ws + 48 * MiB); const float* ADA = (const float*)(ws + WS_ADA);
    unsigned* flag = (unsigned*)(ws + WS_CTL) + 64;
    const int t = F.tid;
    const int r = (int)(((long long)t * 2579 + 17) % T), c = (t * 131 + 5) % 1024;
    const float e = DBG[512 + t] + ADA[(r >> 11) * 6144 + 5120 + c] * DBG[t], got = A.out[(size_t)r * 1024 + c];
    if (fabsf(got - e) > 0.03f * fabsf(DBG[t]) + 0.02f) atomicOr(flag, 8u);
}

__device__ __forceinline__ Args fresh_args() {
    const __attribute__((address_space(4))) Args* p = (const __attribute__((address_space(4))) Args*)__builtin_amdgcn_kernarg_segment_ptr();
    asm volatile("" : "+s"(p));
    return *(const Args*)p;
}
__global__ void __launch_bounds__(NTHR, 2) fwd_megakernel(Args args_byval) {
    extern __shared__ __attribute__((aligned(16))) unsigned char lds_raw[];
#define MAKE_FRAME() Frame F; F.lds = (LAS unsigned char*)lds_raw; F.tid = opaque_tid(); F.lane = F.tid & 63; F.wave = __builtin_amdgcn_readfirstlane(F.tid >> 6); \
    F.G = gridDim.x; { const int bx_ = blockIdx.x; F.vcu = (F.G % 8 == 0) ? (bx_ % 8) * (F.G / 8) + bx_ / 8 : bx_; } F.gw = F.vcu * NWAVES + F.wave; F.NGW = F.G * NWAVES;
    LAS unsigned char* const lds0 = (LAS unsigned char*)lds_raw;
    for (int u = threadIdx.x; u < (LDS_BYTES - LDSCTL_OFF) / 4; u += NTHR) ((LAS unsigned*)(lds0 + LDSCTL_OFF))[u] = 0u;
    __syncthreads();
    XcdBarrier bar = xcd_barrier_post((unsigned*)(fresh_args().ws + WS_CTL) + CW_BAR, (volatile LAS unsigned*)(lds0 + MISC_OFF) + 8);
#define GRID_BAR() xcd_barrier(bar)
    const int bx = (int)blockIdx.x;

    using pg8::Gemm; using pg8::StaticOrder; using pg8::EpiB; using pg8::EpiRes; using pg8::EpiX1;
#ifndef REP_P0
#define REP_P0 1
#endif
    for (int rep_ = 0; rep_ < REP_P0; ++rep_) {

#ifndef NO_PH_P0
    { const Args args = fresh_args(); MAKE_FRAME(); p0_prologue(F, args); }
#endif
    GRID_BAR();
    }

#ifndef REP_P1
#define REP_P1 1
#endif
    for (int rep_ = 0; rep_ < REP_P1; ++rep_) {

#ifndef NO_PH_NORM
    { const Args args = fresh_args(); MAKE_FRAME(); norm_rows(F, args.x, args.g1, ((const float*)(args.ws + WS_ADA)), 0, 1024, ((bf16*)(args.ws + WS_H)), nullptr, nullptr); }
#endif
    GRID_BAR();
    }

#ifndef REP_P2
#define REP_P2 1
#endif
    for (int rep_ = 0; rep_ < REP_P2; ++rep_) {
#ifndef NO_PH_GEMM
    { const Args args = fresh_args(); MAKE_FRAME(); Gemm g{((bf16*)(args.ws + WS_H)), ((bf16*)(args.ws + WS_WIN)), T, ZW, 1024}; StaticOrder S; S.init(T, ZW, F.G, bx); EpiB<0> E{((bf16*)(args.ws + WS_Z)), ZW, 6, nullptr, nullptr, 0, 0, 4};
      pg8::gemm_phase<EpiB<0>, StaticOrder, true, true>(F.lds, g, S, E); }
#endif
    GRID_BAR();
    }


#ifndef NO_PH_P3
    { const Args args = fresh_args(); MAKE_FRAME();
#ifdef PRIO_P3
      if (F.wave >> 2) __builtin_amdgcn_s_setprio(2);
#endif
      p3_fixup(F, args);
#ifdef PRIO_P3
      __builtin_amdgcn_s_setprio(0);
#endif
     }
#endif
    GRID_BAR();
#ifndef NO_PH_GEMM
    { const Args args = fresh_args(); MAKE_FRAME(); Gemm g{((bf16*)(args.ws + WS_POOLED)), ((bf16*)(args.ws + WS_WUP)), T, 1024, 512}; StaticOrder S; S.init(T, 1024, F.G, bx);
#ifdef P5_NOGATE
      EpiB<0> E{((bf16*)(args.ws + WS_MIN)), 1024, 1000, nullptr, nullptr, 0, 0};
      pg8::gemm_phase<EpiB<0>, StaticOrder, true, true>(F.lds, g, S, E); }
#else
      EpiB<2> E{((bf16*)(args.ws + WS_MIN)), 1024, 0, nullptr, ((bf16*)(args.ws + WS_Z)), ZW, ZC_GP};
      pg8::gemm_phase<EpiB<2>, StaticOrder, true, true>(F.lds, g, S, E); }
#endif
#endif
#ifdef DBG_POOL
    GRID_BAR();
    { const Args args = fresh_args(); MAKE_FRAME(); dbg_pool_check(F, args); }
#endif
#ifdef P5P6_BAR
    GRID_BAR();
#endif
#ifndef REP_DSA
#define REP_DSA 1
#endif
    for (int rep_ = 0; rep_ < REP_DSA; ++rep_) {

#ifndef NO_PH_DSA
    { const Args args = fresh_args(); MAKE_FRAME();
#ifndef NO_PRIO_DSA
      if (F.wave >> 2) __builtin_amdgcn_s_setprio(2);
#endif
      dsa_phase(F, args);
#ifndef NO_PRIO_DSA
      __builtin_amdgcn_s_setprio(0);
#endif
     }
#endif
    GRID_BAR();
    }

#if !defined(NO_PH_GEMM) && !defined(NO_P7)
    { const Args args = fresh_args(); MAKE_FRAME(); Gemm g{((bf16*)(args.ws + WS_ATT)), ((bf16*)(args.ws + WS_WUA)), T, 1024, 512}; StaticOrder S; S.init(T, 1024, F.G, bx); EpiB<3> E{((bf16*)(args.ws + WS_MIN)), 1024, 0, nullptr, ((bf16*)(args.ws + WS_Z)), ZW, ZC_GA};
      pg8::gemm_phase<EpiB<3>, StaticOrder, true, true>(F.lds, g, S, E); }
#endif
    GRID_BAR();
#ifdef DBG_POOL
    { const Args args = fresh_args(); MAKE_FRAME(); dbg_min_check(F, args); }
    GRID_BAR();
#endif
#ifndef REP_P8
#define REP_P8 1
#endif
    for (int rep_ = 0; rep_ < REP_P8; ++rep_) {
#ifndef NO_PH_GEMM
    { const Args args = fresh_args(); MAKE_FRAME(); Gemm g{((bf16*)(args.ws + WS_MIN)), ((bf16*)(args.ws + WS_WOUT)), T, 1024, 1024}; StaticOrder S; S.init(T, 1024, F.G, bx);
#ifdef X1_BF16
      EpiX1 E{args.x, ((bf16*)(args.ws + WS_X1)), ((const float*)(args.ws + WS_ADA)) + 2048};
      pg8::gemm_phase<EpiX1, StaticOrder, true, true>(F.lds, g, S, E); }
#else
      EpiRes E{args.x, args.out, ((const float*)(args.ws + WS_ADA)) + 2048};
      pg8::gemm_phase<EpiRes, StaticOrder, true, true>(F.lds, g, S, E); }
#endif
#endif
    GRID_BAR();
    }

#ifndef REP_P9
#define REP_P9 1
#endif
    for (int rep_ = 0; rep_ < REP_P9; ++rep_) {

#ifndef NO_PH_NORM
    { const Args args = fresh_args(); MAKE_FRAME();
#ifdef X1_BF16
      norm_rows(F, nullptr, args.g2, ((const float*)(args.ws + WS_ADA)), 3072, 4096, ((bf16*)(args.ws + WS_H)), args.ws + WS_H2HI, (float*)(args.ws + WS_SH2), (const bf16*)(args.ws + WS_X1)); }
#else
      norm_rows(F, args.out, args.g2, ((const float*)(args.ws + WS_ADA)), 3072, 4096, ((bf16*)(args.ws + WS_H)), args.ws + WS_H2HI, (float*)(args.ws + WS_SH2)); }
#endif
#endif
    GRID_BAR();
    }

#ifndef REP_P10
#define REP_P10 1
#endif
    for (int rep_ = 0; rep_ < REP_P10; ++rep_) {
#ifndef NO_PH_GEMM
    { const Args args = fresh_args(); MAKE_FRAME(); Gemm g{((bf16*)(args.ws + WS_H)), ((bf16*)(args.ws + WS_WPQ)), T, 1024, 1024}; StaticOrder S; S.init(T, 1024, F.G, bx); EpiB<0> E{((bf16*)(args.ws + WS_PQ)), 1024, 1000, nullptr, nullptr, 0, 0};
      pg8::gemm_phase<EpiB<0>, StaticOrder, true, true>(F.lds, g, S, E); }
#endif
    GRID_BAR();
    }

#ifndef REP_P11
#define REP_P11 1
#endif
    for (int rep_ = 0; rep_ < REP_P11; ++rep_) {

#ifndef NO_PH_ROUTE
    { const Args args = fresh_args(); MAKE_FRAME();
#ifdef PRIO_ROUTE
      if (F.wave >> 2) __builtin_amdgcn_s_setprio(2);
#endif
      peer_route(F, args);
#ifdef PRIO_ROUTE
      __builtin_amdgcn_s_setprio(0);
#endif
     }
#endif
#ifdef PEER_QUEUED
    GRID_BAR();
#else
    VM_WAIT();
    __builtin_amdgcn_fence(__ATOMIC_ACQUIRE, "agent"); VM_WAIT();
    __syncthreads();
#endif
#ifdef DBG_PEER
    { const Args args = fresh_args(); MAKE_FRAME(); dbg_peer_check1(F, args); }
    GRID_BAR();
#endif
    }

#ifndef REP_GATHER
#define REP_GATHER 1
#endif
    for (int rep_ = 1; rep_ < REP_GATHER; ++rep_) { { const Args args = fresh_args(); MAKE_FRAME(); peer_gather(F, args, true); } GRID_BAR(); }

#ifdef OLD_GATHER
    { const Args args = fresh_args(); MAKE_FRAME(); peer_gather(F, args, false); }
#else
#ifdef PEER_QUEUED
    { const Args args = fresh_args(); MAKE_FRAME(); peer_g1(F, args); } GRID_BAR();
    { const Args args = fresh_args(); MAKE_FRAME(); peer_g2(F, args); } GRID_BAR();
    { const Args args = fresh_args(); MAKE_FRAME(); peer_g3(F, args); }
#else
    { const Args args = fresh_args(); MAKE_FRAME();
#ifdef PRIO_LOCAL
      if (F.wave >> 2) __builtin_amdgcn_s_setprio(2);
#endif
      peer_local(F, args, bar);
#ifdef PRIO_LOCAL
      __builtin_amdgcn_s_setprio(0);
#endif
     }
#endif
#endif

#ifdef DBG_PEER
    GRID_BAR();
    { const Args args = fresh_args(); MAKE_FRAME(); dbg_peer_check2(F, args); }
#endif
#if defined(DBG_POOL) || defined(DBG_PEER) || defined(DBG_SEL)
    GRID_BAR();
    { const Args args = fresh_args(); dbg_report(args); }
#endif
#ifdef DBG_FP4
    GRID_BAR();
    if (blockIdx.x == 0 && threadIdx.x == 0) {
        const Args args = fresh_args();
        volatile unsigned* src = (volatile unsigned*)(args.ws + WS_CTL) + 80;
        const unsigned x = 0x00007521u + *src; const float one = 1.0f + (float)*src, three = 3.0f + (float)*src;
        typedef float f32x2q __attribute__((ext_vector_type(2)));
        const f32x2q f0 = __builtin_amdgcn_cvt_scalef32_pk_f32_fp4(x, one, 0), f1 = __builtin_amdgcn_cvt_scalef32_pk_f32_fp4(x, one, 1), f3 = __builtin_amdgcn_cvt_scalef32_pk_f32_fp4(x, three, 0);
        const unsigned b0 = __builtin_bit_cast(unsigned, __builtin_amdgcn_cvt_scalef32_pk_bf16_fp4(x, one, 0));
        const bool A = (f0.x == 0.5f && f0.y == 1.0f && f1.x == 3.0f && f1.y == 6.0f && b0 == 0x3F803F00u);
        const bool Bf = (f3.x == 1.5f && f3.y == 3.0f), Cf = (f3.x == 1.0f && f3.y == 2.0f);
        const int code = (A ? 1 : 0) + (Bf ? 2 : 0) + (Cf ? 4 : 0);
        args.out[0] += 1000.0f * (float)(1 + code);
    }
#endif
#ifndef DBG_SCALE
#define DBG_SCALE 1000.0f
#endif
#ifdef DBG_MFMA8
    GRID_BAR();
    {
        const Args args = fresh_args();
        volatile unsigned* src = (volatile unsigned*)(args.ws + WS_CTL) + 80;
        const int z = (int)*src;
        const int lane_ = threadIdx.x & 63;
        typedef int v8i_ __attribute__((ext_vector_type(8)));
        v8i_ a = (v8i_){0x22222222 + z, 0x22222222, 0x22222222, 0x22222222, 0, 0, 0, 0};
        v8i_ bb = (v8i_){0x38383838 + z, 0x38383838, 0x38383838, 0x38383838, 0x38383838, 0x38383838, 0x38383838, 0x38383838};
#if DBG_MFMA8 == 2
        a = (v8i_){(lane_ < 32) ? (0x00200000 + z) : z, 0, 0, 0, 0, 0, 0, 0};
        { const unsigned sgn = (lane_ >= 32) ? 0x80808080u : 0u;
          const unsigned w0 = 0x48444038u | sgn, w1 = 0x504E4C4Au | sgn, w2 = 0x54535251u | sgn, w3 = 0x58575655u | sgn;
          bb = (v8i_){(int)w0 + z, (int)w1, (int)w2, (int)w3, (int)w0, (int)w1, (int)w2, (int)w3}; }
#endif
        f32x16 c;
#pragma unroll
        for (int i = 0; i < 16; ++i) c[i] = 0.f;
#if DBG_MFMA8 == 3
        a = bb;
        c = __builtin_amdgcn_mfma_scale_f32_32x32x64_f8f6f4(a, bb, c, 0, 0, 0, 127 + z, 0, 127 + z);
#else
        c = __builtin_amdgcn_mfma_scale_f32_32x32x64_f8f6f4(a, bb, c, 4, 0, 0, 127 + z, 0, 127 + z);
#endif
        if (blockIdx.x == 0 && threadIdx.x == 0) { const float v = c[0]; float code = (v != v) ? 2.0f : (fabsf(v) > 1.0e6f) ? 3.0f : (fminf(fmaxf(v, -28.0f), 100.0f) * 0.25f + 12.0f); args.out[0] += DBG_SCALE * code; }
    }
#endif
#ifdef DBG_MFMA16
    GRID_BAR();
    {
        const Args args = fresh_args();
        volatile unsigned* src = (volatile unsigned*)(args.ws + WS_CTL) + 80;
        const int z = (int)*src;
        const int lane_ = threadIdx.x & 63, q_ = lane_ >> 4;
        typedef int v8i_ __attribute__((ext_vector_type(8)));
        constexpr int PQ = DBG_MFMA16 / 100, PJ = DBG_MFMA16 % 100;
        unsigned aw[4] = {0u, 0u, 0u, 0u};
        if (q_ == PQ) aw[PJ >> 3] = 2u << (4 * (PJ & 7));
        v8i_ a = (v8i_){(int)aw[0] + z, (int)aw[1], (int)aw[2], (int)aw[3], 0, 0, 0, 0};
        const unsigned sgn = (q_ >= 2) ? 0x80808080u : 0u;
        const unsigned lo0 = 0x48444038u, lo1 = 0x504E4C4Au, hi0 = 0x54535251u, hi1 = 0x58575655u;
        const unsigned w0 = ((q_ & 1) ? hi0 : lo0) | sgn, w1 = ((q_ & 1) ? hi1 : lo1) | sgn;
        v8i_ bb = (v8i_){(int)w0 + z, (int)w1, (int)w0, (int)w1, (int)w0, (int)w1, (int)w0, (int)w1};
        pg8::f32x4 c = (pg8::f32x4){0.f, 0.f, 0.f, 0.f};
        c = __builtin_amdgcn_mfma_scale_f32_16x16x128_f8f6f4(a, bb, c, 4, 0, 0, 127 + z, 0, 127 + z);
        if (blockIdx.x == 0 && threadIdx.x == 0) { const float v = c[0]; float code = (v != v) ? 2.0f : (fabsf(v) > 1.0e6f) ? 3.0f : (fminf(fmaxf(v, -28.0f), 100.0f) * 0.25f + 12.0f); args.out[0] += DBG_SCALE * code; }
    }
#endif

}

extern "C" void kernel_launch(void* const* d_in, const int* in_sizes, int n_in, void* d_out, int out_size, void* d_ws, size_t ws_size, hipStream_t stream) {
    static int grid = 0;
    if (grid == 0) {
        if (n_in != 19 || in_sizes[0] != T * D || out_size != T * D || ws_size < WS_END) { fprintf(stderr, "kernel_launch: unexpected shapes (n_in %d, in0 %d, out %d, ws %zu < %zu); nothing launched\n", n_in, n_in > 0 ? in_sizes[0] : -1, out_size, ws_size, (size_t)WS_END); grid = -1; return; }
        int dev = 0, cus = 0, per_cu = 0;
        if (hipGetDevice(&dev) != hipSuccess || hipDeviceGetAttribute(&cus, hipDeviceAttributeMultiprocessorCount, dev) != hipSuccess) { grid = -1; return; }
        if (hipFuncSetAttribute((const void*)fwd_megakernel, hipFuncAttributeMaxDynamicSharedMemorySize, LDS_BYTES) != hipSuccess) { fprintf(stderr, "kernel_launch: hipFuncSetAttribute failed\n"); grid = -1; return; }
        if (hipOccupancyMaxActiveBlocksPerMultiprocessor(&per_cu, (const void*)fwd_megakernel, NTHR, LDS_BYTES) != hipSuccess || per_cu < 1) { fprintf(stderr, "kernel_launch: occupancy query says %d blocks per CU; nothing launched\n", per_cu); (void)hipGetLastError(); grid = -1; return; }
        grid = 256; while (grid > cus) grid >>= 1;
        if (grid < 8) { fprintf(stderr, "kernel_launch: only %d CUs; nothing launched\n", cus); grid = -1; return; }
    }
    if (grid < 0) return;
    if (hipMemsetAsync((char*)d_ws + WS_CTL, 0, CTL_ZERO_BYTES, stream) != hipSuccess) { fprintf(stderr, "kernel_launch: memset failed\n"); return; }
    Args a{};
    const float** ap = (const float**)&a;
    for (int i = 0; i < 19; ++i) ap[i] = (const float*)d_in[i];
    a.out = (float*)d_out; a.ws = (unsigned char*)d_ws;
    void* kargs[] = {&a};
    hipError_t e = hipLaunchCooperativeKernel((const void*)fwd_megakernel, dim3(grid), dim3(NTHR), kargs, LDS_BYTES, stream);
    if (e != hipSuccess) fprintf(stderr, "kernel_launch: cooperative launch failed: %s (grid %d)\n", hipGetErrorString(e), grid);
}
```

```cpp
#define GATE_FP8 1
#define MIN_FP8 1
#define ZP_FP8 1
#define X1_BF16 1
#define QN_DSA 1
#define ADA_SPREAD 1
#define QUANT2 1
#define EIDX16 1
#include <hip/hip_runtime.h>
#include <hip/hip_bf16.h>
#include <cstdio>
#include <cstdint>
__device__ __forceinline__ int opaque_tid() { int t = threadIdx.x; asm volatile("" : "+v"(t)); return t; }
namespace pg8 {
#define PG8_LAS __attribute__((address_space(3)))
typedef unsigned short bf16_t;
typedef short bf16x8 __attribute__((ext_vector_type(8)));
typedef float f32x4 __attribute__((ext_vector_type(4)));
typedef unsigned u32x4 __attribute__((ext_vector_type(4)));
constexpr int BM = 256, BK = 64, HALF = 128, HTB = HALF * BK * 2  , STAGE_BYTES = 8 * HTB, NXCD = 8, WGM = 8;

__host__ __device__ __forceinline__ int lds_byte(int r, int c) { const int st = (r >> 4) * 2 + (c >> 5), rr = r & 15, cc = c & 31, ob = rr * 64 + cc * 2; return st * 1024 + (ob ^ (((ob >> 9) & 1) << 5)); }
__host__ __device__ __forceinline__ void stage_rc(int b, int& R, int& C) { const int st = b / 1024, sb = b % 1024, swz = sb ^ (((sb >> 9) & 1) << 5); R = (st >> 1) * 16 + swz / 64; C = (st & 1) * 32 + (swz % 64) / 2; }
__host__ __device__ __forceinline__ int perm32(int rho) { const int n = rho >> 4, i = rho & 15; return 8 * (i >> 2) + 4 * n + (i & 3); }

struct Unit { int pm, pn; };
struct Gemm { const bf16_t* A; const bf16_t* Bt; int M, N, K; };

struct StaticOrder {
    int nM, nN, nwg, G, c;
    __host__ __device__ void init(int M, int N, int G_, int c_) { nM = M / BM; nN = N / BM; nwg = nM * nN; G = G_; c = c_; }
    __host__ __device__ bool next(int i, Unit& u) const {
        const long L = (long)i * G + c; if (L >= nwg) return false;
        int wgid = (int)L; { const int q = nwg / NXCD, r = nwg % NXCD, xcd = wgid % NXCD, off = wgid / NXCD; wgid = (xcd < r ? xcd * (q + 1) : r * (q + 1) + (xcd - r) * q) + off; }
        const int nig = WGM * nN, gid = wgid / nig, fm = gid * WGM, gsz = (nM - fm) < WGM ? (nM - fm) : WGM;
        u.pm = fm + ((wgid % nig) % gsz); u.pn = (wgid % nig) / gsz; return true;
    }
    __device__ __forceinline__ void a_ready(const Unit&) const {}
    __device__ __forceinline__ void done(const Unit&) const {}
};

__device__ __forceinline__ unsigned cvt_pk_bf16(float lo, float hi) { unsigned r; asm volatile("v_cvt_pk_bf16_f32 %0, %1, %2" : "=v"(r) : "v"(lo), "v"(hi)); return r; }
typedef float f32x2 __attribute__((ext_vector_type(2)));
__device__ __forceinline__ f32x2 gelu_pk(f32x2 v) {
    const f32x2 av = __builtin_elementwise_abs(v), d = av * 0.2316418882f + 1.0f;
    f32x2 t; t.x = __builtin_amdgcn_rcpf(d.x); t.y = __builtin_amdgcn_rcpf(d.y);
    f32x2 q = t * 0.5307027145f + (-0.7265760135f); q = q * t + 0.7107068705f; q = q * t + (-0.142248368f); q = q * t + 0.127414796f; q = q * t;
    const f32x2 s = (v * v) * (-0.72134752044f);
    f32x2 e; e.x = __builtin_amdgcn_exp2f(s.x); e.y = __builtin_amdgcn_exp2f(s.y);
    const f32x2 m = v * (q * e), r = v - m;
    f32x2 o; o.x = v.x < 0.f ? m.x : r.x; o.y = v.y < 0.f ? m.y : r.y; return o;
}

template <int ACT  > struct EpiBf16 {
    static constexpr bool PERM = true, AFTER_DRAIN = false; static_assert(ACT == 0 || ACT == 1, "EpiBf16: ACT is 0 (none) or 1 (gelu_pk)");
    bf16_t* O; int ldc; const float* bias; int split_cols; size_t split_stride; float scale0;
    __device__ __forceinline__ void operator()(const f32x4 (&acc)[2][2][4][2], const Unit& u, int wr, int wc, int fr, int fq) const {
        const int row0 = u.pm * BM + wr * 64 + fr; int colt = u.pn * BM; bf16_t* base = O;
        float sc = 1.f; if (split_cols) { const int t = colt / split_cols; base += (size_t)t * split_stride; colt -= t * split_cols; if (t == 0) sc = scale0; }
        const int col0 = colt + wc * 32 + 8 * fq, bcol0 = u.pn * BM + wc * 32 + 8 * fq;
        f32x4 bv[2][2];
#pragma unroll
        for (int bj = 0; bj < 2; ++bj)
#pragma unroll
            for (int n = 0; n < 2; ++n) bv[bj][n] = bias ? *(const f32x4*)(bias + bcol0 + bj * HALF + 4 * n) : (f32x4){0.f, 0.f, 0.f, 0.f};
#pragma unroll
        for (int ai = 0; ai < 2; ++ai)
#pragma unroll
            for (int m = 0; m < 4; ++m) { bf16_t* rowp = base + (size_t)(row0 + ai * HALF + m * 16) * ldc + col0;
#pragma unroll
                for (int bj = 0; bj < 2; ++bj) { f32x4 v0 = acc[ai][bj][m][0] + bv[bj][0], v1 = acc[ai][bj][m][1] + bv[bj][1];
                    if (ACT == 1) { f32x2 a = gelu_pk((f32x2){v0[0], v0[1]}), b = gelu_pk((f32x2){v0[2], v0[3]}), c = gelu_pk((f32x2){v1[0], v1[1]}), d = gelu_pk((f32x2){v1[2], v1[3]});
                        v0 = (f32x4){a.x, a.y, b.x, b.y}; v1 = (f32x4){c.x, c.y, d.x, d.y}; }
                    v0 = v0 * sc; v1 = v1 * sc; u32x4 w; w.x = cvt_pk_bf16(v0[0], v0[1]); w.y = cvt_pk_bf16(v0[2], v0[3]); w.z = cvt_pk_bf16(v1[0], v1[1]); w.w = cvt_pk_bf16(v1[2], v1[3]);
                    *(u32x4*)(rowp + bj * HALF) = w; } }
    }
};
template <class Epi, class Sched, bool ALIGN_EPI = false, bool SP2 = false>
__device__ __forceinline__ void gemm_phase(PG8_LAS unsigned char* lds, const Gemm g, const Sched& S, const Epi& E) {
    const int tid = opaque_tid(), wid = __builtin_amdgcn_readfirstlane(tid >> 6), lane = tid & 63, wr = wid >> 2, wc = wid & 3, fr = lane & 15, fq = lane >> 4;
    const int K = g.K, nt = K / BK;
    unsigned voffA[2], voffB[2];
#pragma unroll
    for (int i = 0; i < 2; ++i) { int R, C; stage_rc(tid * 16 + i * 8192, R, C); const int Rb = Epi::PERM ? ((R & ~31) + perm32(R & 31)) : R;
        voffA[i] = (unsigned)(R * K + C) * 2u; voffB[i] = (unsigned)(Rb * K + C) * 2u; }
    const size_t kstep = (size_t)(BK * 2);
    const size_t hstep = (size_t)HALF * K * 2;
    const size_t tstep = 2 * hstep;
    const unsigned ldsw = (unsigned)wid * 1024u;
    const int aoff = lds_byte(wr * 64 + fr, fq * 8), boff = lds_byte(wc * 32 + fr, fq * 8);
#define PG8_SA(b, h) (((b) * 2 + (h)) * HTB)
#define PG8_SB(b, h) ((4 + (b) * 2 + (h)) * HTB)
#define PG8_STAGE(bufoff, gbase, voff) do { _Pragma("unroll") for (int _i = 0; _i < 2; ++_i) \
        __builtin_amdgcn_global_load_lds((const unsigned*)((const char*)(gbase) + (voff)[_i]), (PG8_LAS unsigned*)(lds + (bufoff) + ldsw + _i * 8192), 16, 0, 0); } while (0)
#define PG8_LDA(dst, b, h) do { _Pragma("unroll") for (int m = 0; m < 4; ++m) _Pragma("unroll") for (int k = 0; k < 2; ++k) dst[m][k] = *(const PG8_LAS bf16x8*)(lds + PG8_SA(b, h) + aoff + m * 2048 + k * 1024); } while (0)
#define PG8_LDB(dst, b, h) do { _Pragma("unroll") for (int n = 0; n < 2; ++n) _Pragma("unroll") for (int k = 0; k < 2; ++k) dst[n][k] = *(const PG8_LAS bf16x8*)(lds + PG8_SB(b, h) + boff + n * 2048 + k * 1024); } while (0)
#define PG8_MMA(ai, bj, At, Bt) do { __builtin_amdgcn_s_setprio(1); _Pragma("unroll") for (int m = 0; m < 4; ++m) _Pragma("unroll") for (int n = 0; n < 2; ++n) _Pragma("unroll") for (int k = 0; k < 2; ++k) \
        acc[ai][bj][m][n] = __builtin_amdgcn_mfma_f32_16x16x32_bf16(Bt[n][k], At[m][k], acc[ai][bj][m][n], 0, 0, 0); __builtin_amdgcn_s_setprio(0); } while (0)
#define PG8_WAIT_V(n) asm volatile("s_waitcnt vmcnt(" #n ")" ::: "memory")
#define PG8_WAIT_L(n) asm volatile("s_waitcnt lgkmcnt(" #n ")" ::: "memory")
#define PG8_BAR __builtin_amdgcn_s_barrier()
#define PG8_SCHED __builtin_amdgcn_sched_barrier(0)
    Unit cur, nxt; int ui = 0;
    if (!S.next(0, cur)) return;
    f32x4 acc[2][2][4][2];
#pragma unroll
    for (int a = 0; a < 2; ++a)
#pragma unroll
        for (int b = 0; b < 2; ++b)
#pragma unroll
            for (int m = 0; m < 4; ++m)
#pragma unroll
                for (int n = 0; n < 2; ++n) acc[a][b][m][n] = (f32x4){0.f, 0.f, 0.f, 0.f};
    bf16x8 At[4][2], B0[2][2], B1[2][2];
    const char* cA = (const char*)g.A + (size_t)cur.pm * tstep; const char* cB = (const char*)g.Bt + (size_t)cur.pn * tstep;
    S.a_ready(cur);
    if constexpr (SP2) {
        PG8_STAGE(PG8_SB(0, 0), cB, voffB); PG8_STAGE(PG8_SB(0, 1), cB + hstep, voffB); PG8_STAGE(PG8_SA(0, 0), cA, voffA); PG8_STAGE(PG8_SA(0, 1), cA + hstep, voffA);
        if (wr == 1) PG8_BAR;
        PG8_WAIT_V(2); PG8_BAR;
        PG8_STAGE(PG8_SB(1, 0), cB + kstep, voffB); PG8_STAGE(PG8_SA(1, 0), cA + kstep, voffA); PG8_STAGE(PG8_SB(1, 1), cB + hstep + kstep, voffB);
        PG8_WAIT_V(6); PG8_BAR;
    } else {
        PG8_STAGE(PG8_SB(0, 0), cB, voffB); PG8_STAGE(PG8_SA(0, 0), cA, voffA); PG8_STAGE(PG8_SB(0, 1), cB + hstep, voffB); PG8_STAGE(PG8_SA(0, 1), cA + hstep, voffA);
        if (wr == 1) PG8_BAR;
        PG8_WAIT_V(4); PG8_BAR;
        PG8_STAGE(PG8_SB(1, 0), cB + kstep, voffB); PG8_STAGE(PG8_SA(1, 0), cA + kstep, voffA); PG8_STAGE(PG8_SB(1, 1), cB + hstep + kstep, voffB);
        PG8_WAIT_V(6); PG8_BAR;
    }
    for (;;) {
        const bool has_next = S.next(ui + 1, nxt);
        const char* nA = has_next ? (const char*)g.A + (size_t)nxt.pm * tstep : cA; const char* nB = has_next ? (const char*)g.Bt + (size_t)nxt.pn * tstep : cB;
        for (int t = 0; t < nt; t += 2) {
            const bool last = (t == nt - 2);
            const char* a1 = cA + (size_t)(t + 1) * kstep;
            const char* a2 = last ? nA : cA + (size_t)(t + 2) * kstep; const char* b2 = last ? nB : cB + (size_t)(t + 2) * kstep;
            const char* a3 = a2 + kstep; const char* b3 = b2 + kstep;
            if (last && has_next) S.a_ready(nxt);
            if constexpr (SP2) {
            PG8_LDB(B0, 0, 0); PG8_LDB(B1, 0, 1); PG8_SCHED; PG8_LDA(At, 0, 0); PG8_STAGE(PG8_SA(1, 1), a1 + hstep, voffA);
            PG8_WAIT_V(8); PG8_WAIT_L(0); PG8_BAR; PG8_MMA(0, 0, At, B0); PG8_MMA(0, 1, At, B1); PG8_BAR; PG8_SCHED;
            PG8_LDA(At, 0, 1); PG8_STAGE(PG8_SB(0, 0), b2, voffB); PG8_STAGE(PG8_SB(0, 1), b2 + hstep, voffB); PG8_STAGE(PG8_SA(0, 0), a2, voffA);
            PG8_WAIT_V(8); PG8_WAIT_L(0); PG8_BAR; PG8_MMA(1, 0, At, B0); PG8_MMA(1, 1, At, B1); PG8_BAR; PG8_SCHED;
            PG8_LDB(B0, 1, 0); PG8_LDB(B1, 1, 1); PG8_SCHED; PG8_LDA(At, 1, 0); PG8_STAGE(PG8_SA(0, 1), a2 + hstep, voffA);
            PG8_WAIT_V(8); PG8_WAIT_L(0); PG8_BAR; PG8_MMA(0, 0, At, B0); PG8_MMA(0, 1, At, B1); PG8_BAR; PG8_SCHED;
            PG8_LDA(At, 1, 1); PG8_STAGE(PG8_SB(1, 0), b3, voffB); PG8_STAGE(PG8_SB(1, 1), b3 + hstep, voffB); PG8_STAGE(PG8_SA(1, 0), a3, voffA);
            PG8_WAIT_V(8); PG8_WAIT_L(0); PG8_BAR; PG8_MMA(1, 0, At, B0); PG8_MMA(1, 1, At, B1); PG8_BAR; PG8_SCHED;
            } else {
            PG8_LDB(B0, 0, 0); PG8_SCHED; PG8_LDA(At, 0, 0); PG8_STAGE(PG8_SA(1, 1), a1 + hstep, voffA);
            PG8_WAIT_L(8); PG8_BAR; PG8_WAIT_L(0); PG8_MMA(0, 0, At, B0); PG8_BAR; PG8_SCHED;
            PG8_LDB(B1, 0, 1); PG8_STAGE(PG8_SB(0, 0), b2, voffB);
            PG8_BAR; PG8_WAIT_L(0); PG8_MMA(0, 1, At, B1); PG8_BAR;
            PG8_LDA(At, 0, 1); PG8_STAGE(PG8_SA(0, 0), a2, voffA);
            PG8_BAR; PG8_WAIT_L(0); PG8_MMA(1, 0, At, B0); PG8_BAR; PG8_SCHED;
            PG8_STAGE(PG8_SB(0, 1), b2 + hstep, voffB);
            PG8_WAIT_V(6); PG8_BAR; PG8_MMA(1, 1, At, B1); PG8_BAR;
            PG8_LDB(B0, 1, 0); PG8_SCHED; PG8_LDA(At, 1, 0); PG8_STAGE(PG8_SA(0, 1), a2 + hstep, voffA);
            PG8_WAIT_L(8); PG8_BAR; PG8_WAIT_L(0); PG8_MMA(0, 0, At, B0); PG8_BAR; PG8_SCHED;
            PG8_LDB(B1, 1, 1); PG8_STAGE(PG8_SB(1, 0), b3, voffB);
            PG8_BAR; PG8_WAIT_L(0); PG8_MMA(0, 1, At, B1); PG8_BAR;
            PG8_LDA(At, 1, 1); PG8_STAGE(PG8_SA(1, 0), a3, voffA);
            PG8_BAR; PG8_WAIT_L(0); PG8_MMA(1, 0, At, B0); PG8_BAR; PG8_SCHED;
            PG8_STAGE(PG8_SB(1, 1), b3 + hstep, voffB);
            PG8_WAIT_V(6); PG8_BAR; PG8_MMA(1, 1, At, B1); PG8_BAR;
            }
        }
        if constexpr (ALIGN_EPI) { if (wr == 0) PG8_BAR; }
        if constexpr (!Epi::AFTER_DRAIN) { E(acc, cur, wr, wc, fr, fq); S.done(cur); }
        if (!has_next) break;
#pragma unroll
        for (int a = 0; a < 2; ++a)
#pragma unroll
            for (int b = 0; b < 2; ++b)
#pragma unroll
                for (int m = 0; m < 4; ++m)
#pragma unroll
                    for (int n = 0; n < 2; ++n) acc[a][b][m][n] = (f32x4){0.f, 0.f, 0.f, 0.f};
        cur = nxt; cA = nA; cB = nB; ++ui;
        if constexpr (ALIGN_EPI) { if (wr == 1) PG8_BAR; }
    }
    PG8_WAIT_V(0);
    if constexpr (!ALIGN_EPI) { if (wr == 0) PG8_BAR; }
    PG8_BAR;
    if constexpr (Epi::AFTER_DRAIN) { E.fused(acc, cur, wr, wc, fr, fq, lds, wid, lane); S.done(cur); }
#undef PG8_SA
#undef PG8_SB
#undef PG8_STAGE
#undef PG8_LDA
#undef PG8_LDB
#undef PG8_MMA
#undef PG8_WAIT_V
#undef PG8_WAIT_L
#undef PG8_BAR
#undef PG8_SCHED
}
}

#define GAS __attribute__((address_space(1)))
#define LAS __attribute__((address_space(3)))
typedef unsigned short bf16;
typedef unsigned v4u __attribute__((ext_vector_type(4)));
typedef unsigned v2u __attribute__((ext_vector_type(2)));
typedef float f32x4 __attribute__((ext_vector_type(4)));
typedef float f32x16 __attribute__((ext_vector_type(16)));
typedef short bf16x8 __attribute__((ext_vector_type(8)));
typedef __bf16 bf16x2_t __attribute__((ext_vector_type(2)));

constexpr int NWAVES = 8, NTHR = 512;
constexpr int NB = 32, SEQ = 2048, T = NB * SEQ, D = 1024, ZW = 3584, INW = 3524;
constexpr int ZC_Q = 0, ZC_K = 512, ZC_V = 576, ZC_IK = 640, ZC_IW = 704, ZC_IQ = 768, ZC_ZP = 1024, ZC_GA = 1536, ZC_GP = 2560;
constexpr float EPS = 1e-6f;
constexpr float QSCALE = 0.125f * 1.4426950408889634f;

constexpr size_t MiB = 1u << 20;
constexpr size_t WS_CTL = 0, CTL_ZERO_BYTES = 65536;
constexpr size_t WS_ADA = 1 * MiB, WS_IW = 2 * MiB, WS_SK = 3 * MiB, WS_WGRP = 4 * MiB, WS_WUA = 5 * MiB, WS_WUP = 6 * MiB, WS_WOUT = 7 * MiB, WS_WPQ = 9 * MiB, WS_WIN = 11 * MiB;
constexpr size_t WS_IKX = 18 * MiB, WS_KX = 26 * MiB, WS_VX = 34 * MiB;
constexpr size_t WS_U = 64 * MiB, WS_V = 96 * MiB, WS_Z = 128 * MiB, WS_H = 576 * MiB, WS_POOLED = 576 * MiB, WS_PM = 640 * MiB;
constexpr size_t WS_ATT = 704 * MiB, WS_PQ = 704 * MiB, WS_MIN = 832 * MiB, WS_EIDX = 832 * MiB, WS_EGATE = 864 * MiB, WS_END = 960 * MiB;
constexpr int CW_BAR = 4096;
constexpr size_t WS_SU = 512 * 1024, WS_SV = 576 * 1024, WS_SH2 = 640 * 1024;
constexpr size_t WS_X1 = 128 * MiB;
constexpr size_t WS_H2HI = 384 * MiB, WS_H2LO = 416 * MiB;
constexpr size_t WS_H2F8 = 384 * MiB;

constexpr int RING_BYTES = 131072, LDS_BYTES = 163840, LDSCTL_OFF = LDS_BYTES - 1024, MISC_OFF = LDSCTL_OFF + 320;

__device__ __forceinline__ unsigned f2bf(float f) { unsigned u = __builtin_bit_cast(unsigned, f); return (u + 0x7fffu + ((u >> 16) & 1u)) >> 16; }
__device__ __forceinline__ unsigned pk2(float lo, float hi) { typedef float f32x2_ __attribute__((ext_vector_type(2))); typedef __bf16 bf16x2_ __attribute__((ext_vector_type(2))); const f32x2_ v = {lo, hi}; return __builtin_bit_cast(unsigned, __builtin_convertvector(v, bf16x2_)); }
__device__ __forceinline__ float bflo(unsigned w) { return __builtin_bit_cast(float, w << 16); }
__device__ __forceinline__ float bfhi(unsigned w) { return __builtin_bit_cast(float, w & 0xffff0000u); }
__device__ __forceinline__ float bf2f(bf16 h) { return __builtin_bit_cast(float, (unsigned)h << 16); }
#define LDS_WAIT() asm volatile("s_waitcnt lgkmcnt(0)" ::: "memory")
#define VM_WAIT() asm volatile("s_waitcnt vmcnt(0)" ::: "memory")

#define XB_TMO      128
#define XB_XCNT(j)  (256  + 64 * (j))
#define XB_XSUB(j)  (1280 + 64 * (j))
#define XB_XGEN(j)  (2304 + 64 * (j))
#define XB_TOP      3328
#define XB_TOPGEN   3392
#define XCD_BAR_WORDS 3456
#define XB_SPIN_CAP (1u << 26)

__device__ __forceinline__ unsigned xb_ld(unsigned* p)              { return __hip_atomic_load(p, __ATOMIC_RELAXED, __HIP_MEMORY_SCOPE_AGENT); }
__device__ __forceinline__ unsigned xb_add(unsigned* p, unsigned v) { return __hip_atomic_fetch_add(p, v, __ATOMIC_RELAXED, __HIP_MEMORY_SCOPE_AGENT); }
__device__ __forceinline__ unsigned xb_xcc_id() { return (unsigned)__builtin_amdgcn_s_getreg((3 << 11) | 20) & 0xFu; }
#define XB_SPIN(cond, bar) do { unsigned _sp = 0; while (cond) { __builtin_amdgcn_s_sleep(1); \
    if ((++_sp & 255u) == 0u) { if (xb_ld(&(bar)[XB_TMO])) break; if (_sp > XB_SPIN_CAP) { atomicAdd(&(bar)[XB_TMO], 1u); break; } } } } while (0)

struct XcdBarrier {
    unsigned* bar; unsigned x;
    volatile LAS unsigned* st;
};

__device__ __forceinline__ XcdBarrier xcd_barrier_post(unsigned* bar, volatile LAS unsigned* st) {
    XcdBarrier b; b.bar = bar; b.x = xb_xcc_id(); b.st = st;
    if (threadIdx.x == 0) (void)xb_add(&bar[XB_XCNT(b.x)], 1u);
    return b;
}
__device__ __forceinline__ void xcd_barrier_complete(unsigned* bar, unsigned x, unsigned& nloc, unsigned& nx) {
    const unsigned G = gridDim.x * gridDim.y * gridDim.z;
    unsigned sum, cnt, mine, sp = 0u;
    for (;;) {
        sum = 0u; cnt = 0u; mine = 0u;
#pragma unroll
        for (unsigned j = 0; j < 16; ++j) { const unsigned c = xb_ld(&bar[XB_XCNT(j)]); sum += c; cnt += (c > 0u) ? 1u : 0u; mine = (j == x) ? c : mine; }
        if (sum == G) break;
        __builtin_amdgcn_s_sleep(1);
        if ((++sp & 255u) == 0u) { if (xb_ld(&bar[XB_TMO])) break; if (sp > XB_SPIN_CAP) { atomicAdd(&bar[XB_TMO], 1u); break; } }
    }
    nloc = mine > 0u ? mine : 1u; nx = cnt > 0u ? cnt : 1u;
}

__device__ __forceinline__ void xcd_barrier(const XcdBarrier& b) {
    asm volatile("s_waitcnt vmcnt(0)" ::: "memory");
    __syncthreads();
    if (threadIdx.x == 0) {
        unsigned* bar = b.bar;
        __builtin_amdgcn_s_waitcnt(0);
        unsigned nloc = b.st[0], nx = b.st[1];
        if (nloc == 0u) { xcd_barrier_complete(bar, b.x, nloc, nx); b.st[0] = nloc; b.st[1] = nx; }
        const unsigned old = xb_add(&bar[XB_XSUB(b.x)], 1u);
        const unsigned gen = old / nloc;
        if (old + 1u == (gen + 1u) * nloc) {
            __builtin_amdgcn_fence(__ATOMIC_RELEASE, "agent");
            asm volatile("s_waitcnt vmcnt(0)" ::: "memory");
            const unsigned og = xb_add(&bar[XB_TOP], 1u);
            const unsigned tg = og / nx;
            if (og + 1u == (tg + 1u) * nx) xb_add(&bar[XB_TOPGEN], 1u);
            else XB_SPIN(xb_ld(&bar[XB_TOPGEN]) == tg, bar);
            __builtin_amdgcn_fence(__ATOMIC_ACQUIRE, "agent");
            xb_add(&bar[XB_XGEN(b.x)], 1u);
            asm volatile("s_waitcnt vmcnt(0)" ::: "memory");
        } else {
            XB_SPIN(xb_ld(&bar[XB_XGEN(b.x)]) == gen, bar);
            __builtin_amdgcn_fence(__ATOMIC_ACQUIRE, "agent");
            asm volatile("s_waitcnt vmcnt(0)" ::: "memory");
        }
    }
    __syncthreads();
}


struct Args {
    const float *x, *c, *w_ada, *b_ada, *g1, *w_in, *g_q, *g_k, *g_ik, *w_grp, *s_pool, *w_ua, *w_up, *w_out, *g2, *w_pq, *sk, *pu, *pv;
    float* out; unsigned char* ws;
};

struct Frame {
    LAS unsigned char* lds;
    int tid, lane, wave, vcu, G, gw, NGW;
};

__device__ __forceinline__ float wave_sum(float v) {
#pragma unroll
    for (int o = 1; o < 64; o <<= 1) v += __shfl_xor(v, o);
    return v;
}
__device__ __forceinline__ float xhalf_max(float m) { auto rr = __builtin_amdgcn_permlane32_swap(__float_as_uint(m), __float_as_uint(m), false, false); return fmaxf(__uint_as_float(rr[0]), __uint_as_float(rr[1])); }
__device__ __forceinline__ float xhalf_sum(float m) { auto rr = __builtin_amdgcn_permlane32_swap(__float_as_uint(m), __float_as_uint(m), false, false); return __uint_as_float(rr[0]) + __uint_as_float(rr[1]); }
__device__ __forceinline__ unsigned ordf(float f) { unsigned b = __float_as_uint(f); return b ^ ((b >> 31) ? 0xFFFFFFFFu : 0x80000000u); }
__device__ __forceinline__ float unordf(unsigned u) { unsigned b = u ^ ((u >> 31) ? 0x80000000u : 0xFFFFFFFFu); return __uint_as_float(b); }

__device__ __forceinline__ void transpose_item(const float* W, int ldw, int src_k0, int src_col0, int valid, bf16* WT, int ldwt, int dst_row0, int dst_k0, LAS float* scr, int lane) {
#pragma unroll 8
    for (int i = 0; i < 32; ++i) { const int kk = 2 * i + (lane >> 5), n = lane & 31; scr[kk * 33 + n] = (n < valid) ? W[(size_t)(src_k0 + kk) * ldw + src_col0 + n] : 0.f; }
    LDS_WAIT(); asm volatile("" ::: "memory");
    const int c = lane & 7;
#pragma unroll
    for (int j = 0; j < 4; ++j) { const int n = (lane >> 3) + 8 * j; const LAS float* s = scr + (8 * c) * 33 + n;
        v4u o; o.x = pk2(s[0 * 33], s[1 * 33]); o.y = pk2(s[2 * 33], s[3 * 33]); o.z = pk2(s[4 * 33], s[5 * 33]); o.w = pk2(s[6 * 33], s[7 * 33]);
        *(GAS v4u*)(WT + (size_t)(dst_row0 + n) * ldwt + dst_k0 + 8 * c) = o; }
    LDS_WAIT(); asm volatile("" ::: "memory");
}
__device__ __forceinline__ void zcol_src(int nb, int& src, int& valid) {
    const int n0 = nb * 32; valid = 32;
    if (n0 < 640) src = n0;
    else if (n0 < 704) src = 896 + (n0 - 640);
    else if (n0 < 736) { src = 960; valid = 4; }
    else if (n0 < 768) { src = 0; valid = 0; }
    else if (n0 < 1024) src = 640 + (n0 - 768);
    else if (n0 < 1536) src = 964 + (n0 - 1024);
    else src = 1476 + (n0 - 1536);
}
__device__ __forceinline__ void cvt_stream(const float* src, bf16* dst, size_t n8, int gtid, int gthreads) {
    for (size_t i = gtid; i < n8; i += gthreads) {
        const f32x4 a = ((const GAS f32x4*)src)[2 * i], b = ((const GAS f32x4*)src)[2 * i + 1];
        v4u o; o.x = pk2(a.x, a.y); o.y = pk2(a.z, a.w); o.z = pk2(b.x, b.y); o.w = pk2(b.z, b.w);
        ((GAS v4u*)dst)[i] = o;
    }
}
__device__ __forceinline__ void p0_prologue(Frame& F, const Args& A) {
    unsigned char* ws = A.ws;
    float* ADA = (float*)(ws + WS_ADA);
#ifdef ADA_SPREAD
    if (F.vcu * NWAVES < 1536) {
        LAS float* cT = (LAS float*)F.lds;
        LAS float* part = (LAS float*)(F.lds + 131072);
        for (int idx = F.tid; idx < NB * D; idx += NTHR) cT[(idx & (D - 1)) * NB + (idx >> 10)] = A.c[idx];
        __syncthreads();
      for (int item = F.gw; item < 1536; item += F.NGW) {
        const int task = item >> 2, quarter = item & 3;
        {
            const int col = task * 16 + (F.lane & 15), ks = F.lane >> 4;
            float acc[NB];
#pragma unroll
            for (int b = 0; b < NB; ++b) acc[b] = 0.f;
#pragma unroll 4
            for (int i = 0; i < 64; ++i) {
                const int k = quarter * 256 + 4 * i + ks;
                const float w = A.w_ada[(size_t)k * 6144 + col];
                const LAS f32x4* cr = (const LAS f32x4*)(cT + k * NB);
#pragma unroll
                for (int b4 = 0; b4 < 8; ++b4) { const f32x4 cv = cr[b4]; acc[4 * b4] = fmaf(cv.x, w, acc[4 * b4]); acc[4 * b4 + 1] = fmaf(cv.y, w, acc[4 * b4 + 1]); acc[4 * b4 + 2] = fmaf(cv.z, w, acc[4 * b4 + 2]); acc[4 * b4 + 3] = fmaf(cv.w, w, acc[4 * b4 + 3]); }
            }
#pragma unroll
            for (int b = 0; b < NB; ++b) { float v = acc[b]; v += __shfl_xor(v, 16); v += __shfl_xor(v, 32); acc[b] = v; }
            if (ks == 0) {
                LAS f32x4* pp = (LAS f32x4*)(part + (F.wave * 16 + (F.lane & 15)) * NB);
#pragma unroll
                for (int b4 = 0; b4 < 8; ++b4) pp[b4] = (f32x4){acc[4 * b4], acc[4 * b4 + 1], acc[4 * b4 + 2], acc[4 * b4 + 3]};
            }
        }
        __syncthreads();
        if (quarter == 0) {
#pragma unroll
            for (int j = 0; j < 8; ++j) {
                const int o = F.lane * 8 + j, cc = o >> 5, bb = o & 31;
                const float v = part[((F.wave + 0) * 16 + cc) * NB + bb] + part[((F.wave + 1) * 16 + cc) * NB + bb] + part[((F.wave + 2) * 16 + cc) * NB + bb] + part[((F.wave + 3) * 16 + cc) * NB + bb];
                ADA[bb * 6144 + task * 16 + cc] = v + A.b_ada[task * 16 + cc];
            }
        }
        __syncthreads();
      }
    }
#else
    if (F.vcu * NWAVES < 384) {
        LAS float* cT = (LAS float*)F.lds;
        for (int idx = F.tid; idx < NB * D; idx += NTHR) cT[(idx & (D - 1)) * NB + (idx >> 10)] = A.c[idx];
        __syncthreads();
        for (int task = F.gw; task < 384; task += F.NGW) {
            const int col = task * 16 + (F.lane & 15), ks = F.lane >> 4;
            float acc[NB];
#pragma unroll
            for (int b = 0; b < NB; ++b) acc[b] = 0.f;
#pragma unroll 4
            for (int i = 0; i < 256; ++i) {
                const int k = 4 * i + ks;
                const float w = A.w_ada[(size_t)k * 6144 + col];
                const LAS f32x4* cr = (const LAS f32x4*)(cT + k * NB);
#pragma unroll
                for (int b4 = 0; b4 < 8; ++b4) { const f32x4 cv = cr[b4]; acc[4 * b4] = fmaf(cv.x, w, acc[4 * b4]); acc[4 * b4 + 1] = fmaf(cv.y, w, acc[4 * b4 + 1]); acc[4 * b4 + 2] = fmaf(cv.z, w, acc[4 * b4 + 2]); acc[4 * b4 + 3] = fmaf(cv.w, w, acc[4 * b4 + 3]); }
            }
#pragma unroll
            for (int b = 0; b < NB; ++b) { float v = acc[b]; v += __shfl_xor(v, 16); v += __shfl_xor(v, 32); acc[b] = v; }
            if (ks == 0) {
                const float bb = A.b_ada[col];
#pragma unroll
                for (int b = 0; b < NB; ++b) ADA[b * 6144 + col] = acc[b] + bb;
            }
        }
        __syncthreads();
    }
#endif
    LAS float* scr = (LAS float*)(F.lds + F.wave * 16384);
    bf16* WIN = (bf16*)(ws + WS_WIN); bf16* WUA = (bf16*)(ws + WS_WUA); bf16* WUP = (bf16*)(ws + WS_WUP); bf16* WOUT = (bf16*)(ws + WS_WOUT); bf16* WPQ = (bf16*)(ws + WS_WPQ); bf16* WGRP = (bf16*)(ws + WS_WGRP);
    constexpr int I_IN = 16 * 112, I_UA = 8 * 32, I_UP = 8 * 32, I_OUT = 16 * 32, I_PQ = 16 * 32;
    constexpr int NITEMS = I_IN + I_UA + I_UP + I_OUT + I_PQ;
    for (int it = F.gw; it < NITEMS; it += F.NGW) {
        int r = it;
        if (r < I_IN) { const int kb = r / 112, nb = r % 112; int src, valid; zcol_src(nb, src, valid); transpose_item(A.w_in, INW, kb * 64, src, valid, WIN, 1024, nb * 32, kb * 64, scr, F.lane); continue; } r -= I_IN;
        if (r < I_UA) { const int kb = r / 32, nb = r % 32; transpose_item(A.w_ua, 1024, kb * 64, nb * 32, 32, WUA, 512, nb * 32, kb * 64, scr, F.lane); continue; } r -= I_UA;
        if (r < I_UP) { continue; } r -= I_UP;
        if (r < I_OUT) { const int kb = r / 32, nb = r % 32; transpose_item(A.w_out, 1024, kb * 64, nb * 32, 32, WOUT, 1024, nb * 32, kb * 64, scr, F.lane); continue; } r -= I_OUT;
        if (r < I_PQ) { const int kb = r / 32, nb = r % 32; transpose_item(A.w_pq, 1024, kb * 64, nb * 32, 32, WPQ, 1024, nb * 32, kb * 64, scr, F.lane); continue; } r -= I_PQ;
        (void)WGRP;
    }
    const int gtid = F.gw * 64 + F.lane, gthreads = F.NGW * 64;
    for (int it = F.gw; it < 512 * 4; it += F.NGW) {
        const int k = it >> 2, n = (it & 3) * 256 + F.lane, g = k >> 7;
        const float* wg = A.w_grp + (size_t)k * 128; const float* sp = A.s_pool + g * 128; const float* wu = A.w_up + (size_t)g * 128 * 1024 + n;
        float a0 = 0.f, a1 = 0.f, a2 = 0.f, a3 = 0.f;
#pragma unroll 8
        for (int d = 0; d < 128; ++d) { const float ws_ = wg[d] * sp[d]; const float* wr = wu + (size_t)d * 1024;
            a0 = fmaf(ws_, wr[0], a0); a1 = fmaf(ws_, wr[64], a1); a2 = fmaf(ws_, wr[128], a2); a3 = fmaf(ws_, wr[192], a3); }
        WUP[(size_t)n * 512 + k] = (bf16)f2bf(a0); WUP[(size_t)(n + 64) * 512 + k] = (bf16)f2bf(a1); WUP[(size_t)(n + 128) * 512 + k] = (bf16)f2bf(a2); WUP[(size_t)(n + 192) * 512 + k] = (bf16)f2bf(a3);
    }
    cvt_stream(A.sk, (bf16*)(ws + WS_SK), (size_t)16 * 128 * 64 / 8, gtid, gthreads);
#ifdef QUANT2
#ifndef QUANT_R
#define QUANT_R 2
#endif
    for (int row = F.gw; row < 2 * 16384; row += QUANT_R * F.NGW) {
        f32x4 av[QUANT_R][4]; float m[QUANT_R];
#pragma unroll
        for (int q = 0; q < QUANT_R; ++q) { int rq = row + q * F.NGW; rq = rq < 2 * 16384 ? rq : row; const bool isv = rq >= 16384; const int r = isv ? rq - 16384 : rq; const float* src = (isv ? A.pv : A.pu) + (size_t)r * 1024 + 16 * F.lane;
#pragma unroll
            for (int j = 0; j < 4; ++j) av[q][j] = *(const GAS f32x4*)(src + 4 * j); }
#pragma unroll
        for (int q = 0; q < QUANT_R; ++q) { float t = 0.f;
#pragma unroll
            for (int j = 0; j < 4; ++j) t = fmaxf(t, fmaxf(fmaxf(fabsf(av[q][j].x), fabsf(av[q][j].y)), fmaxf(fabsf(av[q][j].z), fabsf(av[q][j].w))));
            m[q] = t; }
#pragma unroll
        for (int o = 1; o < 64; o <<= 1) {
#pragma unroll
            for (int q = 0; q < QUANT_R; ++q) m[q] = fmaxf(m[q], __shfl_xor(m[q], o)); }
#pragma unroll
        for (int q = 0; q < QUANT_R; ++q) {
            int rq = row + q * F.NGW; rq = rq < 2 * 16384 ? rq : row; const bool isv = rq >= 16384; const int r = isv ? rq - 16384 : rq;
            const float sc = m[q] > 0.f ? (isv ? 6.0f / m[q] : 10.0f / m[q]) : 1.0f;
            unsigned w[2] = {0u, 0u};
#pragma unroll
            for (int j = 0; j < 4; ++j)
#pragma unroll
                for (int k = 0; k < 4; ++k) {
                    const float x = av[q][j][k], a = fabsf(x) * sc;
                    const unsigned c = (a >= 0.25f) + (a >= 0.75f) + (a >= 1.25f) + (a >= 1.75f) + (a >= 2.5f) + (a >= 3.5f) + (a >= 5.0f);
                    unsigned nib = c | (x < 0.f ? 8u : 0u);
                    if (!isv) { int qi = (int)rintf(x * sc); qi = qi < -8 ? -8 : (qi > 7 ? 7 : qi); nib = (unsigned)qi & 15u; }
                    const int el = 4 * j + k;
                    w[el >> 3] |= nib << (4 * (el & 7));
                }
            *(GAS v2u*)(ws + (isv ? WS_V : WS_U) + (size_t)(F.lane >> 4) * (16384 * 128) + (size_t)r * 128 + 8 * (F.lane & 15)) = (v2u){w[0], w[1]};
            if (F.lane == 0) ((float*)(ws + (isv ? WS_SV : WS_SU)))[r] = m[q] > 0.f ? (isv ? m[q] * (1.0f / 6.0f) : m[q] * 0.1f) : 1.0f;
        }
    }
}
#else
    for (int row = F.gw; row < 2 * 16384; row += F.NGW) {
        const bool isv = row >= 16384; const int r = isv ? row - 16384 : row;
        const float* src = (isv ? A.pv : A.pu) + (size_t)r * 1024 + 16 * F.lane;
        f32x4 av[4];
#pragma unroll
        for (int j = 0; j < 4; ++j) av[j] = *(const GAS f32x4*)(src + 4 * j);
        float m = 0.f;
#pragma unroll
        for (int j = 0; j < 4; ++j) m = fmaxf(m, fmaxf(fmaxf(fabsf(av[j].x), fabsf(av[j].y)), fmaxf(fabsf(av[j].z), fabsf(av[j].w))));
#pragma unroll
        for (int o = 1; o < 64; o <<= 1) m = fmaxf(m, __shfl_xor(m, o));
        const float sc = m > 0.f ? (isv ? 6.0f / m : 10.0f / m) : 1.0f;
        unsigned w[2] = {0u, 0u};
#pragma unroll
        for (int j = 0; j < 4; ++j)
#pragma unroll
            for (int k = 0; k < 4; ++k) {
                const float x = av[j][k], a = fabsf(x) * sc;
                const unsigned c = (a >= 0.25f) + (a >= 0.75f) + (a >= 1.25f) + (a >= 1.75f) + (a >= 2.5f) + (a >= 3.5f) + (a >= 5.0f);
                unsigned nib = c | (x < 0.f ? 8u : 0u);
                if (!isv) { int qi = (int)rintf(x * sc); qi = qi < -8 ? -8 : (qi > 7 ? 7 : qi); nib = (unsigned)qi & 15u; }
                const int el = 4 * j + k;
#if defined(U4_SWAP) && !defined(OLD_GATHER)
                w[el >> 3] |= nib << (4 * (isv ? (el & 7) : ((el & 7) ^ 1)));
#else
                w[el >> 3] |= nib << (4 * (el & 7));
#endif
            }
#ifdef OLD_GATHER
        *(GAS v2u*)(ws + (isv ? WS_V : WS_U) + (size_t)r * 512 + 8 * F.lane) = (v2u){w[0], w[1]};
#else
        *(GAS v2u*)(ws + (isv ? WS_V : WS_U) + (size_t)(F.lane >> 4) * (16384 * 128) + (size_t)r * 128 + 8 * (F.lane & 15)) = (v2u){w[0], w[1]};
#endif
        if (F.lane == 0) ((float*)(ws + (isv ? WS_SV : WS_SU)))[r] = m > 0.f ? (isv ? m * (1.0f / 6.0f) : m * 0.1f) : 1.0f;
    }
}
#endif

__device__ __forceinline__ void norm_rows(Frame& F, const float* X, const float* g, const float* ADA, int shift_off, int scale_off, bf16* O, unsigned char* O8, float* S8, const bf16* XB = nullptr) {
    const int rpw = T / F.NGW, m_begin = F.gw * rpw, b = m_begin >> 11;
    f32x4 cg[4], sh[4];
#pragma unroll
    for (int j = 0; j < 4; ++j) { const int col = 4 * F.lane + 256 * j;
        const f32x4 gg = *(const GAS f32x4*)(g + col), sc = *(const GAS f32x4*)(ADA + b * 6144 + scale_off + col);
        cg[j] = gg * (sc + 1.0f); sh[j] = *(const GAS f32x4*)(ADA + b * 6144 + shift_off + col); }
    for (int m0 = m_begin; m0 < m_begin + rpw; m0 += 4) {
        f32x4 v[4][4]; float s[4];
#pragma unroll
        for (int r = 0; r < 4; ++r) {
            if (XB) {
                const GAS v2u* ar = (const GAS v2u*)(XB + (size_t)(m0 + r) * D) + F.lane;
#pragma unroll
                for (int j = 0; j < 4; ++j) { const v2u a = ar[64 * j]; v[r][j] = (f32x4){__uint_as_float(a.x << 16), __uint_as_float(a.x & 0xffff0000u), __uint_as_float(a.y << 16), __uint_as_float(a.y & 0xffff0000u)}; }
            } else {
                const GAS f32x4* xr = (const GAS f32x4*)(X + (size_t)(m0 + r) * D) + F.lane;
#pragma unroll
                for (int j = 0; j < 4; ++j) v[r][j] = xr[64 * j];
            } }
#pragma unroll
        for (int r = 0; r < 4; ++r) { float t = 0.f;
#pragma unroll
            for (int j = 0; j < 4; ++j) t += (v[r][j].x * v[r][j].x + v[r][j].y * v[r][j].y) + (v[r][j].z * v[r][j].z + v[r][j].w * v[r][j].w);
            s[r] = t; }
#pragma unroll
        for (int o = 1; o < 64; o <<= 1) {
#pragma unroll
            for (int r = 0; r < 4; ++r) s[r] += __shfl_xor(s[r], o);
        }
#pragma unroll
        for (int r = 0; r < 4; ++r) {
            const float rstd = 1.0f / sqrtf(s[r] * (1.f / D) + EPS);
            GAS unsigned long long* o8 = (GAS unsigned long long*)(O + (size_t)(m0 + r) * D) + F.lane;
#pragma unroll
            for (int j = 0; j < 4; ++j) { const f32x4 y = (v[r][j] * rstd) * cg[j] + sh[j]; o8[64 * j] = (unsigned long long)pk2(y.x, y.y) | ((unsigned long long)pk2(y.z, y.w) << 32); v[r][j] = y; }
        }
        if (O8) {
            float am[4];
#pragma unroll
            for (int r = 0; r < 4; ++r) { float t = 0.f;
#pragma unroll
                for (int j = 0; j < 4; ++j) t = fmaxf(t, fmaxf(fmaxf(fabsf(v[r][j].x), fabsf(v[r][j].y)), fmaxf(fabsf(v[r][j].z), fabsf(v[r][j].w))));
                am[r] = t; }
#pragma unroll
            for (int o = 1; o < 64; o <<= 1) {
#pragma unroll
                for (int r = 0; r < 4; ++r) am[r] = fmaxf(am[r], __shfl_xor(am[r], o));
            }
#pragma unroll
            for (int r = 0; r < 4; ++r) {
                const float q = am[r] > 0.f ? 119.0f / am[r] : 1.0f;
                GAS unsigned* hi = (GAS unsigned*)(O8 + (size_t)(m0 + r) * 512); GAS unsigned* lo = (GAS unsigned*)(O8 + (WS_H2LO - WS_H2HI) + (size_t)(m0 + r) * 512);
#pragma unroll
                for (int j = 0; j < 4; ++j) {
                    unsigned h16 = 0u, l16 = 0u;
#pragma unroll
                    for (int k = 0; k < 4; ++k) { const int x = (int)rintf(v[r][j][k] * q); const int l4 = ((x + 8) & 15) - 8; const int h4 = (x - l4) >> 4; h16 |= ((unsigned)h4 & 15u) << (4 * k); l16 |= ((unsigned)l4 & 15u) << (4 * k); }
                    const unsigned ph = (unsigned)__shfl_xor((int)h16, 1), pl = (unsigned)__shfl_xor((int)l16, 1);
                    if (!(F.lane & 1)) { hi[32 * j + (F.lane >> 1)] = h16 | (ph << 16); lo[32 * j + (F.lane >> 1)] = l16 | (pl << 16); }
                }
                if (F.lane == 0) S8[m0 + r] = am[r] > 0.f ? am[r] * (1.0f / 119.0f) : 1.0f;
            }
        }
    }
}

namespace pg8 {
__device__ __forceinline__ float sigm(float v) { return __builtin_amdgcn_rcpf(1.0f + __builtin_amdgcn_exp2f(-1.4426950408889634f * v)); }
template <int MODE> struct EpiB {
    static constexpr bool PERM = true, AFTER_DRAIN = false;
    bf16_t* O; int ldc; int sig_from; const float* colscale; const bf16_t* G; int ldg; int gcol0; int zp8_from;
    __device__ __forceinline__ void operator()(const f32x4 (&acc)[2][2][4][2], const Unit& u, int wr, int wc, int fr, int fq) const {
        const int row0 = u.pm * BM + wr * 64 + fr, col0 = u.pn * BM + wc * 32 + 8 * fq;
        const bool sg = (MODE == 0) && (u.pn >= sig_from);
        f32x4 cs[2][2];
        if (MODE == 1) {
#pragma unroll
            for (int bj = 0; bj < 2; ++bj)
#pragma unroll
                for (int n = 0; n < 2; ++n) cs[bj][n] = *(const f32x4*)(colscale + col0 + bj * HALF + 4 * n);
        }
#pragma unroll
        for (int ai = 0; ai < 2; ++ai)
#pragma unroll
            for (int m = 0; m < 4; ++m) { const size_t row = (size_t)(row0 + ai * HALF + m * 16); bf16_t* rowp = O + row * ldc + col0;
#pragma unroll
                for (int bj = 0; bj < 2; ++bj) { f32x4 v0 = acc[ai][bj][m][0], v1 = acc[ai][bj][m][1];
                    if (MODE == 0) { if (sg) { v0 = (f32x4){sigm(v0[0]), sigm(v0[1]), sigm(v0[2]), sigm(v0[3])}; v1 = (f32x4){sigm(v1[0]), sigm(v1[1]), sigm(v1[2]), sigm(v1[3])}; } }
                    if (MODE == 1) { v0 = v0 * cs[bj][0]; v1 = v1 * cs[bj][1]; }
#ifdef GATE_FP8
                    if (MODE == 2 || MODE == 3) {
                        typedef float f32x2g __attribute__((ext_vector_type(2)));
                        const unsigned long long g8 = *(const unsigned long long*)((const unsigned char*)G + row * (size_t)(ldg * 2) + 3072 + (gcol0 - 1536 + col0 + bj * HALF));
                        const unsigned glo = (unsigned)g8, ghi = (unsigned)(g8 >> 32);
                        const f32x2g a0 = __builtin_amdgcn_cvt_pk_f32_fp8(glo, false), a1 = __builtin_amdgcn_cvt_pk_f32_fp8(glo, true), a2 = __builtin_amdgcn_cvt_pk_f32_fp8(ghi, false), a3 = __builtin_amdgcn_cvt_pk_f32_fp8(ghi, true);
                        v0 = v0 * (f32x4){a0.x, a0.y, a1.x, a1.y}; v1 = v1 * (f32x4){a2.x, a2.y, a3.x, a3.y};
                    }
#else
                    if (MODE == 2 || MODE == 3) {
                        const u32x4 gw = *(const u32x4*)(G + row * ldg + gcol0 + col0 + bj * HALF);
                        v0 = v0 * (f32x4){__builtin_bit_cast(float, gw.x << 16), __builtin_bit_cast(float, gw.x & 0xffff0000u), __builtin_bit_cast(float, gw.y << 16), __builtin_bit_cast(float, gw.y & 0xffff0000u)};
                        v1 = v1 * (f32x4){__builtin_bit_cast(float, gw.z << 16), __builtin_bit_cast(float, gw.z & 0xffff0000u), __builtin_bit_cast(float, gw.w << 16), __builtin_bit_cast(float, gw.w & 0xffff0000u)};
                    }
#endif
#ifdef MIN_FP8
                    if (MODE == 3) {
                        typedef float f32x2g __attribute__((ext_vector_type(2)));
                        const unsigned long long o8 = *(const unsigned long long*)((const unsigned char*)G + row * (size_t)(ldg * 2) + 5120 + (col0 + bj * HALF));
                        const unsigned olo = (unsigned)o8, ohi = (unsigned)(o8 >> 32);
                        const f32x2g a0 = __builtin_amdgcn_cvt_pk_f32_fp8(olo, false), a1 = __builtin_amdgcn_cvt_pk_f32_fp8(olo, true), a2 = __builtin_amdgcn_cvt_pk_f32_fp8(ohi, false), a3 = __builtin_amdgcn_cvt_pk_f32_fp8(ohi, true);
                        v0 = v0 + (f32x4){a0.x, a0.y, a1.x, a1.y}; v1 = v1 + (f32x4){a2.x, a2.y, a3.x, a3.y};
                    }
                    if (MODE == 2) {
                        int lo = 0, hi = 0;
                        lo = __builtin_amdgcn_cvt_pk_fp8_f32(v0[0], v0[1], lo, false); lo = __builtin_amdgcn_cvt_pk_fp8_f32(v0[2], v0[3], lo, true);
                        hi = __builtin_amdgcn_cvt_pk_fp8_f32(v1[0], v1[1], hi, false); hi = __builtin_amdgcn_cvt_pk_fp8_f32(v1[2], v1[3], hi, true);
                        *(unsigned long long*)((unsigned char*)G + row * (size_t)(ldg * 2) + 5120 + (col0 + bj * HALF)) = (unsigned long long)(unsigned)lo | ((unsigned long long)(unsigned)hi << 32);
                        continue;
                    }
#else
                    if (MODE == 3) {
                        const u32x4 ow = *(const u32x4*)(rowp + bj * HALF);
                        v0 = v0 + (f32x4){__builtin_bit_cast(float, ow.x << 16), __builtin_bit_cast(float, ow.x & 0xffff0000u), __builtin_bit_cast(float, ow.y << 16), __builtin_bit_cast(float, ow.y & 0xffff0000u)};
                        v1 = v1 + (f32x4){__builtin_bit_cast(float, ow.z << 16), __builtin_bit_cast(float, ow.z & 0xffff0000u), __builtin_bit_cast(float, ow.w << 16), __builtin_bit_cast(float, ow.w & 0xffff0000u)};
                    }
#endif
#ifdef ZP_FP8
                    if (MODE == 0 && zp8_from > 0 && u.pn >= zp8_from && u.pn < sig_from) {
                        int lo = 0, hi = 0;
                        lo = __builtin_amdgcn_cvt_pk_fp8_f32(v0[0], v0[1], lo, false); lo = __builtin_amdgcn_cvt_pk_fp8_f32(v0[2], v0[3], lo, true);
                        hi = __builtin_amdgcn_cvt_pk_fp8_f32(v1[0], v1[1], hi, false); hi = __builtin_amdgcn_cvt_pk_fp8_f32(v1[2], v1[3], hi, true);
                        *(unsigned long long*)((unsigned char*)O + row * (size_t)(ldc * 2) + 6144 + (col0 - 256 * zp8_from + bj * HALF)) = (unsigned long long)(unsigned)lo | ((unsigned long long)(unsigned)hi << 32);
                        continue;
                    }
#endif
#ifdef GATE_FP8
                    if (MODE == 0 && sg) {
                        int lo = 0, hi = 0;
                        lo = __builtin_amdgcn_cvt_pk_fp8_f32(v0[0], v0[1], lo, false); lo = __builtin_amdgcn_cvt_pk_fp8_f32(v0[2], v0[3], lo, true);
                        hi = __builtin_amdgcn_cvt_pk_fp8_f32(v1[0], v1[1], hi, false); hi = __builtin_amdgcn_cvt_pk_fp8_f32(v1[2], v1[3], hi, true);
                        *(unsigned long long*)((unsigned char*)O + row * (size_t)(ldc * 2) + 3072 + (col0 - 1536 + bj * HALF)) = (unsigned long long)(unsigned)lo | ((unsigned long long)(unsigned)hi << 32);
                        continue;
                    }
#endif
                    u32x4 w; w.x = cvt_pk_bf16(v0[0], v0[1]); w.y = cvt_pk_bf16(v0[2], v0[3]); w.z = cvt_pk_bf16(v1[0], v1[1]); w.w = cvt_pk_bf16(v1[2], v1[3]);
                    *(u32x4*)(rowp + bj * HALF) = w; } }
    }
};
struct EpiRes {
    static constexpr bool PERM = false, AFTER_DRAIN = false;
    const float* X; float* C; const float* gate;
    __device__ __forceinline__ void operator()(const f32x4 (&acc)[2][2][4][2], const Unit& u, int wr, int wc, int fr, int fq) const {
        const int row0 = u.pm * BM + wr * 64 + fr, col0 = u.pn * BM + wc * 32 + 4 * fq;
        const int b = (u.pm * BM) >> 11;
        f32x4 gv[2][2];
#pragma unroll
        for (int bj = 0; bj < 2; ++bj)
#pragma unroll
            for (int n = 0; n < 2; ++n) gv[bj][n] = *(const f32x4*)(gate + b * 6144 + col0 + bj * HALF + n * 16);
#pragma unroll
        for (int ai = 0; ai < 2; ++ai)
#pragma unroll
            for (int m = 0; m < 4; ++m) { const size_t off = (size_t)(row0 + ai * HALF + m * 16) * 1024 + col0;
#pragma unroll
                for (int bj = 0; bj < 2; ++bj)
#pragma unroll
                    for (int n = 0; n < 2; ++n) { const f32x4 xv = *(const f32x4*)(X + off + bj * HALF + n * 16); *(f32x4*)(C + off + bj * HALF + n * 16) = xv + gv[bj][n] * acc[ai][bj][m][n]; } }
    }
};
struct EpiX1 {
    static constexpr bool PERM = true, AFTER_DRAIN = false;
    const float* X; bf16_t* O; const float* gate;
    __device__ __forceinline__ void operator()(const f32x4 (&acc)[2][2][4][2], const Unit& u, int wr, int wc, int fr, int fq) const {
        const int row0 = u.pm * BM + wr * 64 + fr, col0 = u.pn * BM + wc * 32 + 8 * fq;
        const int b = (u.pm * BM) >> 11;
        f32x4 gv[2][2];
#pragma unroll
        for (int bj = 0; bj < 2; ++bj)
#pragma unroll
            for (int n = 0; n < 2; ++n) gv[bj][n] = *(const f32x4*)(gate + b * 6144 + col0 + bj * HALF + 4 * n);
#pragma unroll
        for (int ai = 0; ai < 2; ++ai)
#pragma unroll
            for (int m = 0; m < 4; ++m) { const size_t off = (size_t)(row0 + ai * HALF + m * 16) * 1024 + col0;
#pragma unroll
                for (int bj = 0; bj < 2; ++bj) {
                    const f32x4 v0 = *(const f32x4*)(X + off + bj * HALF) + gv[bj][0] * acc[ai][bj][m][0], v1 = *(const f32x4*)(X + off + bj * HALF + 4) + gv[bj][1] * acc[ai][bj][m][1];
                    u32x4 w; w.x = cvt_pk_bf16(v0[0], v0[1]); w.y = cvt_pk_bf16(v0[2], v0[3]); w.z = cvt_pk_bf16(v1[0], v1[1]); w.w = cvt_pk_bf16(v1[2], v1[3]);
                    *(u32x4*)(O + off + bj * HALF) = w; } }
    }
};
}

__device__ __forceinline__ void p3_fixup(Frame& F, const Args& A) {
    unsigned char* ws = A.ws;
    bf16* Z = (bf16*)(ws + WS_Z); bf16* IKX = (bf16*)(ws + WS_IKX); bf16* KX = (bf16*)(ws + WS_KX); bf16* VX = (bf16*)(ws + WS_VX); float* IW = (float*)(ws + WS_IW); bf16* POOLED = (bf16*)(ws + WS_POOLED);
    const int lane = F.lane;
    const int rpw = T / F.NGW, m_begin = F.gw * rpw;
    for (int m0 = m_begin; m0 < m_begin + rpw; m0 += 2) {
        const int g = lane >> 4, w = 2 << g;
#ifdef ZP_FP8
        typedef float f32x2z __attribute__((ext_vector_type(2)));
        float sum[2][8], self[2][8]; int cnt[2];
#pragma unroll
        for (int r = 0; r < 2; ++r) {
            const int m = m0 + r, s = m & (SEQ - 1);
            const int lo = (s + 1 - w) > 0 ? (s + 1 - w) : 0; cnt[r] = s + 1 - lo;
            const unsigned char* zp8 = (const unsigned char*)Z + (size_t)m * (ZW * 2) + 6144 + 8 * lane;
#pragma unroll
            for (int j = 0; j < 8; ++j) { sum[r][j] = 0.f; self[r][j] = 0.f; }
#pragma unroll
            for (int i = 0; i < 16; ++i) {
                if (i < cnt[r]) { const v2u q = *(const GAS v2u*)(zp8 - (size_t)i * (ZW * 2));
                    const f32x2z a0 = __builtin_amdgcn_cvt_pk_f32_fp8(q.x, false), a1 = __builtin_amdgcn_cvt_pk_f32_fp8(q.x, true), a2 = __builtin_amdgcn_cvt_pk_f32_fp8(q.y, false), a3 = __builtin_amdgcn_cvt_pk_f32_fp8(q.y, true);
                    const float fv[8] = {a0.x, a0.y, a1.x, a1.y, a2.x, a2.y, a3.x, a3.y};
#pragma unroll
                    for (int j = 0; j < 8; ++j) { sum[r][j] += fv[j]; if (i == 0) self[r][j] = fv[j]; } }
            }
        }
#pragma unroll
        for (int r = 0; r < 2; ++r) {
            const float inv = 1.0f / (float)cnt[r];
            v4u o; o.x = pk2(sum[r][0] * inv - self[r][0], sum[r][1] * inv - self[r][1]); o.y = pk2(sum[r][2] * inv - self[r][2], sum[r][3] * inv - self[r][3]);
            o.z = pk2(sum[r][4] * inv - self[r][4], sum[r][5] * inv - self[r][5]); o.w = pk2(sum[r][6] * inv - self[r][6], sum[r][7] * inv - self[r][7]);
            *(GAS v4u*)(POOLED + (size_t)(m0 + r) * 512 + 8 * lane) = o;
        }
    }
#else
        float sum[2][8]; v4u self[2]; int cnt[2];
#pragma unroll
        for (int r = 0; r < 2; ++r) {
            const int m = m0 + r, s = m & (SEQ - 1);
            const int lo = (s + 1 - w) > 0 ? (s + 1 - w) : 0; cnt[r] = s + 1 - lo;
            const bf16* zp = Z + (size_t)m * ZW + ZC_ZP + 8 * lane;
#pragma unroll
            for (int j = 0; j < 8; ++j) sum[r][j] = 0.f;
            self[r] = (v4u){0u, 0u, 0u, 0u};
#pragma unroll
            for (int i = 0; i < 16; ++i) {
                if (i < cnt[r]) { const v4u q = *(const GAS v4u*)(zp - (size_t)i * ZW); if (i == 0) self[r] = q;
                    sum[r][0] += bflo(q.x); sum[r][1] += bfhi(q.x); sum[r][2] += bflo(q.y); sum[r][3] += bfhi(q.y); sum[r][4] += bflo(q.z); sum[r][5] += bfhi(q.z); sum[r][6] += bflo(q.w); sum[r][7] += bfhi(q.w); }
            }
        }
#pragma unroll
        for (int r = 0; r < 2; ++r) {
            const float inv = 1.0f / (float)cnt[r];
            v4u o; o.x = pk2(sum[r][0] * inv - bflo(self[r].x), sum[r][1] * inv - bfhi(self[r].x)); o.y = pk2(sum[r][2] * inv - bflo(self[r].y), sum[r][3] * inv - bfhi(self[r].y));
            o.z = pk2(sum[r][4] * inv - bflo(self[r].z), sum[r][5] * inv - bfhi(self[r].z)); o.w = pk2(sum[r][6] * inv - bflo(self[r].w), sum[r][7] * inv - bfhi(self[r].w));
            *(GAS v4u*)(POOLED + (size_t)(m0 + r) * 512 + 8 * lane) = o;
        }
    }
#endif
    for (int tile = F.gw; tile < T / 32; tile += F.NGW) {
        const bf16* vsrc = Z + (size_t)tile * 32 * ZW + ZC_V;
        bf16* vdst = VX + (size_t)tile * 2048;
#pragma unroll
        for (int i = 0; i < 4; ++i) {
            const int pi = lane + 64 * i, h = pi & 1, d = (pi >> 1) & 31, s = (pi >> 6) & 1, rt = pi >> 7;
            unsigned e[8];
#pragma unroll
            for (int j = 0; j < 8; ++j) { const int key = 16 * s + 8 * (j >> 2) + 4 * h + (j & 3); e[j] = vsrc[(size_t)key * ZW + d + 32 * rt]; }
            v4u o; o.x = e[0] | (e[1] << 16); o.y = e[2] | (e[3] << 16); o.z = e[4] | (e[5] << 16); o.w = e[6] | (e[7] << 16);
            *(GAS v4u*)(vdst + pi * 8) = o;
        }
    }
    float gqv[8];
#pragma unroll
    for (int j = 0; j < 8; ++j) gqv[j] = A.g_q[8 * (lane & 7) + j];
    const float gkv = A.g_k[lane], gikv = A.g_ik[lane];
    for (int m0 = m_begin; m0 < m_begin + rpw; m0 += 4) {
        v4u qr[4]; float kv[4], ikv[4], iwr[4];
#pragma unroll
        for (int r = 0; r < 4; ++r) { bf16* zr = Z + (size_t)(m0 + r) * ZW;
#ifndef QN_DSA
            qr[r] = *(GAS v4u*)(zr + 8 * lane);
#endif
            kv[r] = bf2f(zr[ZC_K + lane]); ikv[r] = bf2f(zr[ZC_IK + lane]); iwr[r] = bf2f(zr[ZC_IW + (lane & 3)]); }
        float sk[4], sik[4];
#pragma unroll
        for (int r = 0; r < 4; ++r) { sk[r] = kv[r] * kv[r]; sik[r] = ikv[r] * ikv[r]; }
#pragma unroll
        for (int o = 1; o < 64; o <<= 1) {
#pragma unroll
            for (int r = 0; r < 4; ++r) { sk[r] += __shfl_xor(sk[r], o); sik[r] += __shfl_xor(sik[r], o); }
        }
#pragma unroll
        for (int r = 0; r < 4; ++r) {
            const int m = m0 + r, b = m >> 11, s = m & (SEQ - 1);
            bf16* zr = Z + (size_t)m * ZW;
#ifndef QN_DSA
            float q[8] = {bflo(qr[r].x), bfhi(qr[r].x), bflo(qr[r].y), bfhi(qr[r].y), bflo(qr[r].z), bfhi(qr[r].z), bflo(qr[r].w), bfhi(qr[r].w)};
            float ss = 0.f;
#pragma unroll
            for (int j = 0; j < 8; ++j) ss += q[j] * q[j];
            ss += __shfl_xor(ss, 1); ss += __shfl_xor(ss, 2); ss += __shfl_xor(ss, 4);
            const float rstd = QSCALE / sqrtf(ss * (1.f / 64.f) + EPS);
#pragma unroll
            for (int j = 0; j < 8; ++j) q[j] = q[j] * rstd * gqv[j];
            v4u o; o.x = pk2(q[0], q[1]); o.y = pk2(q[2], q[3]); o.z = pk2(q[4], q[5]); o.w = pk2(q[6], q[7]);
            *(GAS v4u*)(zr + 8 * lane) = o;
#else
            (void)zr; (void)gqv;
#endif
            const float rk = 1.0f / sqrtf(sk[r] * (1.f / 64.f) + EPS), rik = 0.125f / sqrtf(sik[r] * (1.f / 64.f) + EPS);
            const size_t xo = ((((size_t)b * 64 + (s >> 5)) * 4 + (lane >> 4)) * 32 + (s & 31)) * 16 + (lane & 15);
            KX[xo] = (bf16)f2bf(kv[r] * rk * gkv);
            IKX[xo] = (bf16)f2bf(ikv[r] * rik * gikv);
            if (lane < 4) IW[(size_t)m * 4 + lane] = 0.5f * iwr[r];
        }
    }
}


__device__ __forceinline__ void p4_naive(Frame& F, const Args& A) {
    const bf16* POOLED = (const bf16*)(A.ws + WS_POOLED); bf16* PM = (bf16*)(A.ws + WS_PM);
    const int lane = F.lane, g = lane >> 4, d0 = 8 * (lane & 15);
    for (int m = F.gw; m < T; m += F.NGW) {
        float acc[8];
#pragma unroll
        for (int j = 0; j < 8; ++j) acc[j] = 0.f;
        for (int c = 0; c < 128; ++c) {
            const float p = bf2f(POOLED[(size_t)m * 512 + g * 128 + c]);
            const float* w = A.w_grp + ((size_t)g * 128 + c) * 128 + d0;
#pragma unroll
            for (int j = 0; j < 8; ++j) acc[j] = fmaf(p, w[j], acc[j]);
        }
        const float* sp = A.s_pool + g * 128 + d0;
        v4u o; o.x = pk2(acc[0] * sp[0], acc[1] * sp[1]); o.y = pk2(acc[2] * sp[2], acc[3] * sp[3]); o.z = pk2(acc[4] * sp[4], acc[5] * sp[5]); o.w = pk2(acc[6] * sp[6], acc[7] * sp[7]);
        *(GAS v4u*)(PM + (size_t)m * 512 + 8 * lane) = o;
    }
}


__device__ __forceinline__ void dbg_pool_check(Frame& F, const Args& A) {
    if (blockIdx.x != 0) return;
    unsigned char* ws = A.ws;
    const bf16* Z = (const bf16*)(ws + WS_Z); const bf16* POOLED = (const bf16*)(ws + WS_POOLED); const bf16* PM = (const bf16*)(ws + WS_PM); const bf16* MIN = (const bf16*)(ws + WS_MIN); const bf16* WUP = (const bf16*)(ws + WS_WUP);
    unsigned* flag = (unsigned*)(ws + WS_CTL) + 64;
    const int t = F.tid;
    const int r = (int)(((long long)t * 2579 + 17) % T), c = (t * 131 + 5) % 1024;
    unsigned f = 0u;
    { const int k = (t * 7) % 512; if (WUP[(size_t)c * 512 + k] != (bf16)f2bf(A.w_up[(size_t)k * 1024 + c])) f |= 8u; }
    const int n = c % 512, g = n >> 7, w = 2 << g, s = r & (SEQ - 1);
    { const int lo = (s + 1 - w) > 0 ? (s + 1 - w) : 0, cnt = s + 1 - lo; float sum = 0.f;
      for (int i = 0; i < cnt; ++i) sum += bf2f(Z[(size_t)(r - i) * ZW + ZC_ZP + n]);
      const float e = sum / (float)cnt - bf2f(Z[(size_t)r * ZW + ZC_ZP + n]), got = bf2f(POOLED[(size_t)r * 512 + n]);
      if (fabsf(got - e) > 0.02f * fabsf(e) + 0.02f) f |= 1u; }
    { float acc = 0.f; for (int cc = 0; cc < 128; ++cc) acc += bf2f(POOLED[(size_t)r * 512 + g * 128 + cc]) * A.w_grp[((size_t)g * 128 + cc) * 128 + (n & 127)];
      const float e = acc * A.s_pool[n], got = bf2f(PM[(size_t)r * 512 + n]);
      if (fabsf(got - e) > 0.02f * fabsf(e) + 0.02f) f |= 2u; }
    { float acc = 0.f; for (int k = 0; k < 512; ++k) acc += bf2f(PM[(size_t)r * 512 + k]) * A.w_up[(size_t)k * 1024 + c];
      const float e = acc * bf2f(Z[(size_t)r * ZW + ZC_GP + c]), got = bf2f(MIN[(size_t)r * 1024 + c]);
      if (fabsf(got - e) > 0.02f * fabsf(e) + 0.02f) f |= 4u; }
    if (f) atomicOr(flag, f);
}
__device__ __forceinline__ void dbg_min_check(Frame& F, const Args& A) {
    if (blockIdx.x != 0) return;
    unsigned char* ws = A.ws;
    const bf16* Z = (const bf16*)(ws + WS_Z); const bf16* PM = (const bf16*)(ws + WS_PM); const bf16* MIN = (const bf16*)(ws + WS_MIN); const bf16* ATT = (const bf16*)(ws + WS_ATT);
    unsigned* flag = (unsigned*)(ws + WS_CTL) + 64;
    const int t = F.tid;
    const int r = (int)(((long long)t * 2579 + 17) % T), c = (t * 131 + 5) % 1024;
    float a1 = 0.f, a2 = 0.f;
    for (int k = 0; k < 512; ++k) { a1 += bf2f(PM[(size_t)r * 512 + k]) * A.w_up[(size_t)k * 1024 + c]; a2 += bf2f(ATT[(size_t)r * 512 + k]) * A.w_ua[(size_t)k * 1024 + c]; }
    const float e = a1 * bf2f(Z[(size_t)r * ZW + ZC_GP + c]) + a2 * bf2f(Z[(size_t)r * ZW + ZC_GA + c]), got = bf2f(MIN[(size_t)r * 1024 + c]);
    if (fabsf(got - e) > 0.03f * fabsf(e) + 0.03f) atomicOr(flag, 32u);
}
__device__ __forceinline__ void dbg_report(const Args& A) {
    if (blockIdx.x == 0 && threadIdx.x == 0) {
        const unsigned f = *((volatile unsigned*)(A.ws + WS_CTL) + 64);
        float add = 0.f; if (f & 1u) add += 1e4f; if (f & 2u) add += 1e5f; if (f & 4u) add += 1e6f; if (f & 8u) add += 1e7f; if (f & 16u) add += 3e3f; if (f & 32u) add += 1e8f;
        A.out[0] += add;
    }
}

constexpr int DSA_HS = 288;
constexpr int DSA_HIST = 0, DSA_STG = 73728, DSA_STGB = 32768, DSA_MASK = DSA_STG + 65536, DSA_PRE = DSA_MASK + 16384, DSA_KREM = DSA_PRE + 256;
static_assert(64 * DSA_HS * 4 <= DSA_STG, "DSA histogram rows");
static_assert(DSA_KREM + 256 <= LDSCTL_OFF, "DSA LDS map");

__device__ __forceinline__ unsigned umax(unsigned a, unsigned b) { return a > b ? a : b; }
__device__ __forceinline__ unsigned umin(unsigned a, unsigned b) { return a < b ? a : b; }
#define GLDS16(gsrc, ldst) __builtin_amdgcn_global_load_lds((const unsigned*)(gsrc), (LAS unsigned*)(ldst), 16, 0, 0)
__device__ __forceinline__ void idx_scores(const LAS unsigned char* ikt, const bf16x8 (&aiq)[4], const f32x4 (&iwv)[4], int lane, unsigned (&u)[4]) {
    f32x16 acc;
#pragma unroll
    for (int r = 0; r < 16; ++r) acc[r] = 0.f;
    const LAS unsigned char* p = ikt + (lane & 31) * 32 + (lane >> 5) * 16;
#pragma unroll
    for (int ks = 0; ks < 4; ++ks) { const bf16x8 bik = *(const LAS bf16x8*)(p + ks * 1024); acc = __builtin_amdgcn_mfma_f32_32x32x16_bf16(aiq[ks], bik, acc, 0, 0, 0); }
#pragma unroll
    for (int j = 0; j < 4; ++j) {
        float s = fmaxf(acc[4 * j + 0], 0.f) * iwv[j][0];
        s = __builtin_fmaf(fmaxf(acc[4 * j + 1], 0.f), iwv[j][1], s);
        s = __builtin_fmaf(fmaxf(acc[4 * j + 2], 0.f), iwv[j][2], s);
        s = __builtin_fmaf(fmaxf(acc[4 * j + 3], 0.f), iwv[j][3], s);
        u[j] = (s == 0.f) ? 0x80000000u : ordf(s);
    }
}

__device__ __forceinline__ bool hist_scan(LAS unsigned* HIST, LAS unsigned* PRE, LAS unsigned* KREM, int wave, int lane) {
    bool exact = true;
    for (int i = 0; i < 8; ++i) {
        const int q = 8 * wave + i;
        const v4u c4 = *(const LAS v4u*)(HIST + q * DSA_HS + 252 - 4 * lane);
        const unsigned c0 = c4.w, c1 = c4.z, c2 = c4.y, c3 = c4.x, ssum = c0 + c1 + c2 + c3;
        unsigned incl = ssum;
#pragma unroll
        for (int o = 1; o < 64; o <<= 1) { const unsigned t = __shfl_up(incl, o); if (lane >= o) incl += t; }
        const unsigned k = KREM[q], pold = PRE[q];
        const unsigned long long bal = __ballot(incl >= k);
        const int L = bal ? (__ffsll((long long)bal) - 1) : 63;
        unsigned a = __shfl(incl - ssum, L);
        const unsigned d0 = __shfl(c0, L), d1 = __shfl(c1, L), d2 = __shfl(c2, L), d3 = __shfl(c3, L);
        int bin; unsigned dsel;
        if (a + d0 >= k) { bin = 255 - 4 * L; dsel = d0; }
        else { a += d0; if (a + d1 >= k) { bin = 254 - 4 * L; dsel = d1; } else { a += d1; if (a + d2 >= k) { bin = 253 - 4 * L; dsel = d2; } else { a += d2; bin = 252 - 4 * L; dsel = d3; } } }
        const unsigned pnew = (pold << 8) | (unsigned)bin;
        exact = exact && (dsel == k - a) && (pnew != 0u);
        if (lane == 0) { PRE[q] = pnew; KREM[q] = k - a; }
    }
    return __builtin_amdgcn_readfirstlane((int)exact) != 0;
}

template <int VAR> __device__ __forceinline__ void dsa_attend(const bf16* Z, const unsigned char* KX, const unsigned char* VX, bf16* ATT, LAS unsigned char* STG, LAS unsigned* MASKW,
                                                          int tq, size_t kblk0, int nsteps, int c, int lane, int wave, int tid, const float* GQ) {
        const int half = lane >> 5, l31 = lane & 31;
#ifdef NO_PRIO_DSA
        if (wave >> 2) __builtin_amdgcn_s_setprio(2);
#endif
        bf16x8 bq[2][4];
#pragma unroll
        for (int ct = 0; ct < 2; ++ct) { const bf16* qp = Z + (size_t)(tq + 4 * ct + (l31 >> 3)) * ZW + ZC_Q + (l31 & 7) * 64 + half * 8;
#pragma unroll
            for (int ks = 0; ks < 4; ++ks) bq[ct][ks] = *(const GAS bf16x8*)(qp + 16 * ks); }
#ifdef QN_DSA
#pragma unroll
        for (int ct = 0; ct < 2; ++ct) {
            float qf[4][8]; float ss = 0.f;
#pragma unroll
            for (int ks = 0; ks < 4; ++ks) { const v4u w = __builtin_bit_cast(v4u, bq[ct][ks]);
                qf[ks][0] = bflo(w.x); qf[ks][1] = bfhi(w.x); qf[ks][2] = bflo(w.y); qf[ks][3] = bfhi(w.y); qf[ks][4] = bflo(w.z); qf[ks][5] = bfhi(w.z); qf[ks][6] = bflo(w.w); qf[ks][7] = bfhi(w.w);
#pragma unroll
                for (int jj = 0; jj < 8; ++jj) ss += qf[ks][jj] * qf[ks][jj]; }
            ss = xhalf_sum(ss);
            const float rstd = QSCALE / sqrtf(ss * (1.f / 64.f) + EPS);
#pragma unroll
            for (int ks = 0; ks < 4; ++ks) { const f32x4 g0 = *(const GAS f32x4*)(GQ + 16 * ks + 8 * half), g1 = *(const GAS f32x4*)(GQ + 16 * ks + 8 * half + 4);
                v4u o; o.x = pk2(qf[ks][0] * rstd * g0.x, qf[ks][1] * rstd * g0.y); o.y = pk2(qf[ks][2] * rstd * g0.z, qf[ks][3] * rstd * g0.w);
                o.z = pk2(qf[ks][4] * rstd * g1.x, qf[ks][5] * rstd * g1.y); o.w = pk2(qf[ks][6] * rstd * g1.z, qf[ks][7] * rstd * g1.w);
                bq[ct][ks] = __builtin_bit_cast(bf16x8, o); }
        }
#endif
        f32x16 O[2][2];
#pragma unroll
        for (int ct = 0; ct < 2; ++ct)
#pragma unroll
            for (int rt = 0; rt < 2; ++rt)
#pragma unroll
                for (int r = 0; r < 16; ++r) O[ct][rt][r] = 0.f;
        float m_run[2] = {-1e30f, -1e30f}, l_run[2] = {0.f, 0.f};
        const int qsel = (lane >> 3) & 3;
        const bool all_on = (c < 4);
#ifdef ATT_BIG8
        constexpr int AB = 4; LAS unsigned char* const ABASE = STG - DSA_STG; constexpr int ABUFB = 65536;
        __syncthreads();
#else
#ifndef ATT_AB
#define ATT_AB 2
#endif
        constexpr int AB = ATT_AB; LAS unsigned char* const ABASE = STG; constexpr int ABUFB = DSA_STGB;
#endif
        constexpr int AVOFF = AB * 8192;
        const int nbig2 = (nsteps + AB - 1) / AB;
        { const int ns0 = nsteps < AB ? nsteps : AB;
#pragma unroll
          for (int k = 0; k < AB; ++k) if (k < ns0) { GLDS16(KX + kblk0 + (size_t)k * 8192 + (size_t)tid * 16, ABASE + k * 8192 + wave * 1024); GLDS16(VX + kblk0 + (size_t)k * 8192 + (size_t)tid * 16, ABASE + AVOFF + k * 8192 + wave * 1024); } }
        __syncthreads();
        for (int bs = 0; bs < nbig2; ++bs) {
            const int nsub = (nsteps - AB * bs) < AB ? (nsteps - AB * bs) : AB;
            const int nnext = (bs + 1 < nbig2) ? ((nsteps - AB * (bs + 1)) < AB ? (nsteps - AB * (bs + 1)) : AB) : 0;
#pragma unroll
            for (int k = 0; k < AB; ++k) if (VAR != 5 && k < nnext) { const size_t o = kblk0 + (size_t)(AB * (bs + 1) + k) * 8192 + (size_t)tid * 16; LAS unsigned char* nb = ABASE + ((bs + 1) & 1) * ABUFB + k * 8192 + wave * 1024; GLDS16(KX + o, nb); GLDS16(VX + o, nb + AVOFF); }
            const LAS unsigned char* buf = ABASE + (bs & 1) * ABUFB;
#pragma unroll 1
            for (int tl = 0; tl < 2 * nsub; ++tl) {
                const LAS unsigned char* kp = buf + (VAR == 4 ? 0 : tl) * 4096 + l31 * 32 + half * 16;
                bf16x8 kf[4];
#pragma unroll
                for (int ks = 0; ks < 4; ++ks) kf[ks] = *(const LAS bf16x8*)(kp + ks * 1024);
                const LAS unsigned char* vp = buf + AVOFF + (VAR == 4 ? 0 : tl) * 4096 + l31 * 32 + half * 16;
                bf16x8 vf[2][2];
#pragma unroll
                for (int rt = 0; rt < 2; ++rt)
#pragma unroll
                    for (int s = 0; s < 2; ++s) vf[rt][s] = *(const LAS bf16x8*)(vp + (rt * 2 + s) * 1024);
#ifdef ATT_S2
                f32x16 sacc2[2];
#pragma unroll
                for (int ct = 0; ct < 2; ++ct) {
#pragma unroll
                    for (int r = 0; r < 16; ++r) sacc2[ct][r] = 0.f;
#pragma unroll
                    for (int ks = 0; ks < 4; ++ks) sacc2[ct] = __builtin_amdgcn_mfma_f32_32x32x16_bf16(kf[ks], bq[ct][ks], sacc2[ct], 0, 0, 0);
                }
#endif
#pragma unroll
                for (int ct = 0; ct < 2; ++ct) {
#ifdef ATT_S2
                    const f32x16 sacc = sacc2[ct];
#else
                    f32x16 sacc;
#pragma unroll
                    for (int r = 0; r < 16; ++r) sacc[r] = 0.f;
#pragma unroll
                    for (int ks = 0; ks < (VAR == 2 ? 1 : 4); ++ks) sacc = __builtin_amdgcn_mfma_f32_32x32x16_bf16(kf[ks], bq[ct][ks], sacc, 0, 0, 0);
#endif
                    const unsigned Wq = all_on ? 0xFFFFFFFFu : MASKW[(8 * wave + 4 * ct + qsel) * 64 + 2 * AB * bs + tl];
                    const unsigned Wh = Wq >> (4 * half);
                    float mx = fmaxf(fmaxf(sacc[0], sacc[1]), sacc[2]);
#pragma unroll
                    for (int r = 3; r < 15; r += 2) mx = fmaxf(fmaxf(mx, sacc[r]), sacc[r + 1]);
                    mx = fmaxf(mx, sacc[15]);
                    mx = xhalf_max(mx);
                    const float m_new = fmaxf(m_run[ct], mx);
                    const float alpha = __builtin_amdgcn_exp2f(m_run[ct] - m_new);
                    m_run[ct] = m_new;
                    unsigned pw[8]; float psum = 0.f;
#pragma unroll
                    for (int i = 0; i < 8; ++i) {
                        const int r0 = 2 * i, b0 = (r0 & 3) + 8 * (r0 >> 2);
                        const unsigned k0 = (unsigned)__builtin_amdgcn_sbfe((int)Wh, b0, 1), k1 = (unsigned)__builtin_amdgcn_sbfe((int)Wh, b0 + 1, 1);
                        const unsigned keep = __builtin_amdgcn_perm(k1, k0, 0x05040100u);
                        const unsigned pk = (VAR == 1 ? pk2(sacc[r0] - m_new, sacc[r0 + 1] - m_new) : pk2(__builtin_amdgcn_exp2f(sacc[r0] - m_new), __builtin_amdgcn_exp2f(sacc[r0 + 1] - m_new))) & keep;
                        pw[i] = pk;
                        psum = __builtin_amdgcn_fdot2_f32_bf16(__builtin_bit_cast(bf16x2_t, pk), __builtin_bit_cast(bf16x2_t, 0x3F803F80u), psum, false);
                    }
                    l_run[ct] = l_run[ct] * alpha + psum;
                    if (__any(alpha != 1.0f)) {
#pragma unroll
                        for (int rt = 0; rt < 2; ++rt)
#pragma unroll
                            for (int r = 0; r < 16; ++r) O[ct][rt][r] *= alpha;
                    }
                    bf16x8 pb[2];
#pragma unroll
                    for (int s = 0; s < 2; ++s) pb[s] = __builtin_bit_cast(bf16x8, (v4u){pw[4 * s], pw[4 * s + 1], pw[4 * s + 2], pw[4 * s + 3]});
#pragma unroll
                    for (int rt = 0; rt < (VAR == 3 ? 1 : 2); ++rt)
#pragma unroll
                        for (int s = 0; s < (VAR == 3 ? 1 : 2); ++s) O[ct][rt] = __builtin_amdgcn_mfma_f32_32x32x16_bf16(vf[rt][s], pb[s], O[ct][rt], 0, 0, 0);
                }
            }
            if (VAR != 5) __syncthreads();
        }
        if (VAR == 5) __syncthreads();
#pragma unroll
        for (int ct = 0; ct < 2; ++ct) {
            const float inv = 1.0f / xhalf_sum(l_run[ct]);
            bf16* op = ATT + (size_t)(tq + 4 * ct + (l31 >> 3)) * 512 + (l31 & 7) * 64 + 4 * half;
#pragma unroll
            for (int rt = 0; rt < 2; ++rt)
#pragma unroll
                for (int g = 0; g < 4; ++g) {
                    v2u w; w.x = pk2(O[ct][rt][4 * g] * inv, O[ct][rt][4 * g + 1] * inv); w.y = pk2(O[ct][rt][4 * g + 2] * inv, O[ct][rt][4 * g + 3] * inv);
                    *(GAS v2u*)(op + 32 * rt + 8 * g) = w;
                }
        }
#ifdef NO_PRIO_DSA
        __builtin_amdgcn_s_setprio(0);
#endif
}

__device__ __forceinline__ void dsa_phase(Frame& F, const Args& A) {
    unsigned char* ws = A.ws;
    const bf16* Z = (const bf16*)(ws + WS_Z); const unsigned char* IKX = ws + WS_IKX; const unsigned char* KX = ws + WS_KX; const unsigned char* VX = ws + WS_VX;
    const float* IW = (const float*)(ws + WS_IW); bf16* ATT = (bf16*)(ws + WS_ATT);
    const int lane = F.lane, wave = F.wave, tid = F.tid, half = lane >> 5, l31 = lane & 31;
    LAS unsigned* HIST = (LAS unsigned*)(F.lds + DSA_HIST);
    LAS unsigned* PRE = (LAS unsigned*)(F.lds + DSA_PRE);
    LAS unsigned* KREM = (LAS unsigned*)(F.lds + DSA_KREM);
    LAS unsigned* MASKW = (LAS unsigned*)(F.lds + DSA_MASK);
    LAS unsigned char* STG = F.lds + DSA_STG;

    for (int P = F.vcu; P < 512; P += F.G) {
      for (int side = 0; side < 2; ++side) {
        const int b = P >> 4, c = side ? 31 - (P & 15) : (P & 15);
        const int nsteps = c + 1;
        const int tq = b * SEQ + 64 * c + 8 * wave;
        const size_t kblk0 = (size_t)b * 64 * 4096;
#ifndef DSA_REP_SEL
#define DSA_REP_SEL 1
#endif
#ifndef DSA_REP_ATT
#define DSA_REP_ATT 1
#endif
        for (int rs_ = 0; rs_ < DSA_REP_SEL; ++rs_)
        if (c >= 4) {
            const int v_ = F.vcu;
            const size_t scb = v_ < 128 ? WS_PM + (size_t)v_ * (512 * 1024) : v_ < 172 ? 42 * MiB + (size_t)(v_ - 128) * (512 * 1024) : v_ < 220 ? 72 * MiB + (size_t)(v_ - 172) * (512 * 1024) : 104 * MiB + (size_t)(v_ - 220) * (512 * 1024);
            unsigned* SC = (unsigned*)(ws + scb) + (size_t)(wave * 64 + lane) * 4;
            if (lane < 8) { PRE[8 * wave + lane] = 0u; KREM[8 * wave + lane] = 256u; }
#ifndef DSA_REP_P0
#define DSA_REP_P0 1
#endif
            for (int rp0_ = 0; rp0_ < DSA_REP_P0; ++rp0_) {
#pragma unroll
            for (int i = 0; i < 8; ++i) *(LAS v4u*)(HIST + (wave * 8 + i) * DSA_HS + lane * 4) = (v4u){0u, 0u, 0u, 0u};
            {
                bf16x8 aiq[4];
                { const bf16* zq = Z + (size_t)(tq + (l31 >> 2)) * ZW + ZC_IQ + (l31 & 3) * 64 + half * 8;
#pragma unroll
                  for (int ks = 0; ks < 4; ++ks) aiq[ks] = *(const GAS bf16x8*)(zq + 16 * ks); }
                f32x4 iwv[4];
#pragma unroll
                for (int j = 0; j < 4; ++j) iwv[j] = *(const GAS f32x4*)(IW + (size_t)(tq + 2 * j + half) * 4);
                const int nbig = (nsteps + 3) >> 2;
                { const int ns0 = nsteps < 4 ? nsteps : 4;
#pragma unroll
                  for (int k = 0; k < 4; ++k) if (k < ns0) GLDS16(IKX + kblk0 + (size_t)k * 8192 + (size_t)tid * 16, STG + k * 8192 + wave * 1024); }
                __syncthreads();
                unsigned WB = 0u; unsigned long long pkc[4] = {0ull, 0ull, 0ull, 0ull};
                for (int bs = 0; bs < nbig; ++bs) {
                    const int nsub = (nsteps - 4 * bs) < 4 ? (nsteps - 4 * bs) : 4;
                    const int nnext = (bs + 1 < nbig) ? ((nsteps - 4 * (bs + 1)) < 4 ? (nsteps - 4 * (bs + 1)) : 4) : 0;
#pragma unroll
                    for (int k = 0; k < 4; ++k) if (k < nnext) GLDS16(IKX + kblk0 + (size_t)(4 * (bs + 1) + k) * 8192 + (size_t)tid * 16, STG + ((bs + 1) & 1) * DSA_STGB + k * 8192 + wave * 1024);
                    const LAS unsigned char* buf = STG + (bs & 1) * DSA_STGB;
                    for (int sb = 0; sb < nsub; ++sb) {
                        unsigned uu[2][4];
                        idx_scores(buf + sb * 8192, aiq, iwv, lane, uu[0]);
                        idx_scores(buf + sb * 8192 + 4096, aiq, iwv, lane, uu[1]);
                        if (bs == 0 && sb == 0) {
                            unsigned fm = 0u;
#pragma unroll
                            for (int t2 = 0; t2 < 2; ++t2)
#pragma unroll
                                for (int j = 0; j < 4; ++j) { const unsigned u = uu[t2][j]; fm = umax(fm, umax(u >> 24, (~u) >> 24)); }
#pragma unroll
                            for (int o = 1; o < 64; o <<= 1) fm = umax(fm, (unsigned)__shfl_xor((int)fm, o));
                            WB = (unsigned)__builtin_amdgcn_readfirstlane((int)fm) - 3u;
                        }
#pragma unroll
                        for (int t2 = 0; t2 < 2; ++t2) {
                            const int tile = 8 * bs + 2 * sb + t2;
                            *(GAS v4u*)(SC + (size_t)tile * 2048) = (v4u){uu[t2][0], uu[t2][1], uu[t2][2], uu[t2][3]};
#pragma unroll
                            for (int j = 0; j < 4; ++j) {
                                const unsigned u = uu[t2][j], bin = u >> 24, nb = (~u) >> 24, slot = umax(bin, nb) - WB;
                                if (slot < 4u) pkc[j] += 1ull << (8u * slot + ((nb >> 7) << 5));
                                else __hip_atomic_fetch_add(HIST + (8 * wave + 2 * j + half) * DSA_HS + bin, 1u, __ATOMIC_RELAXED, __HIP_MEMORY_SCOPE_WORKGROUP);
                            }
                        }
                    }
                    __syncthreads();
                }
#pragma unroll
                for (int j = 0; j < 4; ++j) {
                    const unsigned lo = (unsigned)pkc[j], hi = (unsigned)(pkc[j] >> 32);
                    unsigned f[4] = {lo & 0x00FF00FFu, (lo >> 8) & 0x00FF00FFu, hi & 0x00FF00FFu, (hi >> 8) & 0x00FF00FFu};
#pragma unroll
                    for (int o = 1; o < 32; o <<= 1)
#pragma unroll
                        for (int i = 0; i < 4; ++i) f[i] += (unsigned)__shfl_xor((int)f[i], o);
                    const unsigned sc8[8] = {f[0] & 0xFFFFu, f[1] & 0xFFFFu, f[0] >> 16, f[1] >> 16, f[2] & 0xFFFFu, f[3] & 0xFFFFu, f[2] >> 16, f[3] >> 16};
                    unsigned mine = 0u;
#pragma unroll
                    for (int s8 = 0; s8 < 8; ++s8) mine = (l31 == s8) ? sc8[s8] : mine;
                    const unsigned fbv = WB + (unsigned)(l31 & 3), bin = (l31 & 4) ? (255u - fbv) : fbv;
                    if (l31 < 8 && mine != 0u) __hip_atomic_fetch_add(HIST + (8 * wave + 2 * j + half) * DSA_HS + (bin & 255u), mine, __ATOMIC_RELAXED, __HIP_MEMORY_SCOPE_WORKGROUP);
                }
            }
            }
            bool exact = hist_scan(HIST, PRE, KREM, wave, lane);
            for (int pass = 1; pass < 5; ++pass) {
                if (pass < 4 && exact) {
                    if (lane < 8) { const int q = 8 * wave + lane; PRE[q] = (PRE[q] << (8 * (4 - pass))) - 1u; KREM[q] = 0u; }
                    pass = 4;
                }
                unsigned pre[4], krem[4], eqrun[4];
#pragma unroll
                for (int j = 0; j < 4; ++j) { pre[j] = PRE[8 * wave + 2 * j + half]; krem[j] = KREM[8 * wave + 2 * j + half]; eqrun[j] = 0u; }
                if (pass < 4) {
#pragma unroll
                    for (int i = 0; i < 8; ++i) *(LAS v4u*)(HIST + (wave * 8 + i) * DSA_HS + lane * 4) = (v4u){0u, 0u, 0u, 0u};
                }
                const int sh_hi = 32 - 8 * pass, sh_lo = 24 - 8 * pass;
                const unsigned lmask = (1u << l31) - 1u;
                {
                    const int ntiles = 2 * nsteps;
                    v4u nx[4];
#pragma unroll
                    for (int k = 0; k < 4; ++k) { nx[k] = (v4u){0u, 0u, 0u, 0u}; if (k < ntiles) nx[k] = *(const GAS v4u*)(SC + (size_t)k * 2048); }
                    for (int t0 = 0; t0 < ntiles; t0 += 4) {
                        v4u cur[4];
#pragma unroll
                        for (int k = 0; k < 4; ++k) { cur[k] = nx[k]; if (t0 + 4 + k < ntiles) nx[k] = *(const GAS v4u*)(SC + (size_t)(t0 + 4 + k) * 2048); }
#pragma unroll
                        for (int k = 0; k < 4; ++k) {
                            const int tile = t0 + k;
                            if (tile < ntiles) {
                                const unsigned u4[4] = {cur[k].x, cur[k].y, cur[k].z, cur[k].w};
                                if (pass < 4) {
#pragma unroll
                                    for (int j = 0; j < 4; ++j) {
                                        const unsigned u = u4[j];
                                        if ((u >> sh_hi) == pre[j]) __hip_atomic_fetch_add(HIST + (8 * wave + 2 * j + half) * DSA_HS + ((u >> sh_lo) & 255u), 1u, __ATOMIC_RELAXED, __HIP_MEMORY_SCOPE_WORKGROUP);
                                    }
                                } else {
#pragma unroll
                                    for (int j = 0; j < 4; ++j) {
                                        const unsigned u = u4[j];
                                        const bool e = (u == pre[j]);
                                        const unsigned long long em = __ballot(e);
                                        const unsigned mine = half ? (unsigned)(em >> 32) : (unsigned)em;
                                        const unsigned rank = eqrun[j] + __popc(mine & lmask);
                                        eqrun[j] += __popc(mine);
                                        const bool sel = (u > pre[j]) || (e && rank < krem[j]);
                                        const unsigned long long sm = __ballot(sel);
                                        if (lane == 0) { MASKW[(8 * wave + 2 * j) * 64 + tile] = (unsigned)sm; MASKW[(8 * wave + 2 * j + 1) * 64 + tile] = (unsigned)(sm >> 32); }
                                    }
                                }
                            }
                        }
                    }
                }
                if (pass < 4) exact = hist_scan(HIST, PRE, KREM, wave, lane);
            }
#ifdef DBG_SEL
            for (int i = 0; i < 8; ++i) {
                unsigned v = (lane < 2 * nsteps) ? (unsigned)__popc(MASKW[(8 * wave + i) * 64 + lane]) : 0u;
#pragma unroll
                for (int o = 1; o < 64; o <<= 1) v += (unsigned)__shfl_xor((int)v, o);
                if (lane == 0 && v != 256u) atomicOr((unsigned*)(ws + WS_CTL) + 64, 1u);
            }
#endif
        }

#if DSA_REP_ATT == 2
        dsa_attend<ATT_VARIANT>(Z, KX, VX, ATT, STG, MASKW, tq, kblk0, nsteps, c, lane, wave, tid, A.g_q);
#endif
        dsa_attend<0>(Z, KX, VX, ATT, STG, MASKW, tq, kblk0, nsteps, c, lane, wave, tid, A.g_q);
      }
    }
}

template <int BASE, int N> __device__ __forceinline__ void sort16(float (&v)[N]) {
    constexpr int NCE = 60;
    constexpr unsigned char CI[NCE] = {0,1,2,3,4,5,7,9, 0,1,2,3,6,8,10,11, 0,2,4,6,7,10,12,14, 0,1,4,5,6,8,12,13, 1,3,4,5,8,9,13, 1,2,5,7,9,11, 2,3,9,11, 3,6,7,10, 3,5,7,9,11, 6,8};
    constexpr unsigned char CJ[NCE] = {13,12,15,14,8,6,11,10, 5,7,9,4,13,14,15,12, 1,3,5,8,9,11,13,15, 2,3,10,11,7,9,14,15, 2,12,6,7,10,11,14, 4,6,8,10,13,14, 4,6,12,13, 5,8,9,12, 4,6,8,10,12, 7,9};
#pragma unroll
    for (int c = 0; c < NCE; ++c) { const float x = v[BASE + CI[c]], y = v[BASE + CJ[c]]; v[BASE + CI[c]] = fmaxf(x, y); v[BASE + CJ[c]] = fminf(x, y); }
}
template <int A0, int B0, int N> __device__ __forceinline__ void merge16(float (&v)[N]) {
#pragma unroll
    for (int i = 0; i < 16; ++i) v[A0 + i] = fmaxf(v[A0 + i], v[B0 + 15 - i]);
#pragma unroll
    for (int j = 8; j > 0; j >>= 1)
#pragma unroll
        for (int i = 0; i < 16; ++i) { const int l = i ^ j; if (l > i) { const float x = v[A0 + i], y = v[A0 + l]; v[A0 + i] = fmaxf(x, y); v[A0 + l] = fminf(x, y); } }
}
__device__ __forceinline__ void top16_of64(float (&v)[64]) {
    sort16<0, 64>(v); sort16<16, 64>(v); sort16<32, 64>(v); sort16<48, 64>(v);
    merge16<0, 16, 64>(v); merge16<32, 48, 64>(v); merge16<0, 32, 64>(v);
}
__device__ __forceinline__ void peer_half(const bf16x8 (&bqf)[4], const LAS unsigned char* skl, int p, int lane, float (&lst)[16]) {
    const int half = lane >> 5, l31 = lane & 31;
    float v[64];
    const LAS unsigned char* ap = skl + p * 16384 + l31 * 32 + half * 16;
#pragma unroll
    for (int rt = 0; rt < 4; ++rt) {
        f32x16 acc;
#pragma unroll
        for (int r = 0; r < 16; ++r) acc[r] = 0.f;
#pragma unroll
        for (int ks = 0; ks < 4; ++ks) { const bf16x8 af = *(const LAS bf16x8*)(ap + (rt * 4 + ks) * 1024); acc = __builtin_amdgcn_mfma_f32_32x32x16_bf16(af, bqf[ks], acc, 0, 0, 0); }
#pragma unroll
        for (int r = 0; r < 16; ++r) { const unsigned kidx = rt * 32 + (r & 3) + 8 * (r >> 2) + 4 * half; v[rt * 16 + r] = __uint_as_float((__float_as_uint(acc[r]) & ~127u) | (127u - kidx)); }
    }
    top16_of64(v);
    float both[32];
#pragma unroll
    for (int i = 0; i < 16; ++i) { both[i] = v[i]; both[16 + i] = __shfl_xor(v[i], 32); }
    merge16<0, 16, 32>(both);
#pragma unroll
    for (int i = 0; i < 16; ++i) lst[i] = both[i];
}
__device__ __forceinline__ void peer_route(Frame& F, const Args& A) {
    unsigned char* ws = A.ws;
    const bf16* PQ = (const bf16*)(ws + WS_PQ); const bf16* SK = (const bf16*)(ws + WS_SK); int* EIDX = (int*)(ws + WS_EIDX); float* EGATE = (float*)(ws + WS_EGATE);
    const int lane = F.lane;
    LAS unsigned* KL = (LAS unsigned*)(F.lds + F.wave * 8192);
    LAS unsigned char* SKL = F.lds + 65536;
    for (int hp = 0; hp < 4; ++hp) {
        __syncthreads();
#pragma unroll
        for (int i = 0; i < 8; ++i) {
            const int ch = F.tid + 512 * i, c8 = ch & 7, key = (ch >> 3) & 127, p = (ch >> 10) & 1, hh = ch >> 11;
            const v4u r = *(const GAS v4u*)(SK + ((size_t)((2 * hp + hh) * 2 + p) * 128 + key) * 64 + 8 * c8);
            *(LAS v4u*)(SKL + hh * 32768 + ((p * 4 + (key >> 5)) * 4 + (c8 >> 1)) * 1024 + (key & 31) * 32 + (c8 & 1) * 16) = r;
        }
        __syncthreads();
      for (int tt = F.gw * (T / 32 / F.NGW); tt < (F.gw + 1) * (T / 32 / F.NGW); ++tt) {
        const int token = tt * 32 + (lane & 31);
        float l0[16], l1[16];
        {
            const bool hi = lane >= 32;
            const bf16* qa = PQ + (size_t)token * 1024 + (2 * hp) * 128 + (lane >> 5) * 8; const bf16* qb = qa + 128;
            bf16x8 bq[4]; float t[16];
#pragma unroll
            for (int ks = 0; ks < 4; ++ks) bq[ks] = *(const GAS bf16x8*)(qa + 16 * ks);
            peer_half(bq, SKL, 0, lane, l0);
#pragma unroll
            for (int ks = 0; ks < 4; ++ks) bq[ks] = *(const GAS bf16x8*)(qb + 16 * ks);
            peer_half(bq, SKL + 32768, 0, lane, t);
#pragma unroll
            for (int i = 0; i < 16; ++i) l0[i] = hi ? t[i] : l0[i];
#pragma unroll
            for (int ks = 0; ks < 4; ++ks) bq[ks] = *(const GAS bf16x8*)(qa + 64 + 16 * ks);
            peer_half(bq, SKL, 1, lane, l1);
#pragma unroll
            for (int ks = 0; ks < 4; ++ks) bq[ks] = *(const GAS bf16x8*)(qb + 64 + 16 * ks);
            peer_half(bq, SKL + 32768, 1, lane, t);
#pragma unroll
            for (int i = 0; i < 16; ++i) l1[i] = hi ? t[i] : l1[i];
        }
        const int h = 2 * hp + (lane >> 5);
        float s0[16], s1[16];
#pragma unroll
        for (int i = 0; i < 16; ++i) { const unsigned b0 = __float_as_uint(l0[i]), b1 = __float_as_uint(l1[i]); s0[i] = __uint_as_float(b0 & ~127u); s1[i] = __uint_as_float(b1 & ~127u); KL[i * 64 + lane] = 127u - (b0 & 127u); KL[(16 + i) * 64 + lane] = 127u - (b1 & 127u); }
        float cs[64]; int nc = 0;
#pragma unroll
        for (int r = 0; r < 64; ++r) cs[r] = -3.0e38f;
#pragma unroll
        for (int i = 0; i < 16; ++i)
#pragma unroll
            for (int j = 0; j < 16; ++j)
                if ((i + 1) * (j + 1) <= 16) { cs[nc] = __uint_as_float((__float_as_uint(s0[i] + s1[j]) & ~255u) | (255u - (unsigned)(i * 16 + j))); ++nc; }
        top16_of64(cs);
        float ev[16]; unsigned be[16]; float sum = 0.f; const float mx = __uint_as_float(__float_as_uint(cs[0]) & ~255u);
#pragma unroll
        for (int i = 0; i < 16; ++i) {
            const unsigned cb = __float_as_uint(cs[i]); ev[i] = __expf(__uint_as_float(cb & ~255u) - mx); sum += ev[i];
            const unsigned fi = 255u - (cb & 255u);
            be[i] = KL[(fi >> 4) * 64 + lane] * 128u + KL[(16 + (fi & 15u)) * 64 + lane];
        }
        const float inv = 1.0f / sum;
        {
            int* ep = EIDX + (size_t)token * 128 + h * 16; float* gp = EGATE + (size_t)token * 128 + h * 16;
#pragma unroll
            for (int i = 0; i < 4; ++i) {
#ifndef EIDX16
                *(GAS v4u*)(ep + 4 * i) = (v4u){be[4 * i], be[4 * i + 1], be[4 * i + 2], be[4 * i + 3]};
#endif
                *(GAS f32x4*)(gp + 4 * i) = (f32x4){ev[4 * i] * inv, ev[4 * i + 1] * inv, ev[4 * i + 2] * inv, ev[4 * i + 3] * inv};
            }
#ifdef EIDX16
            {
                GAS v4u* e16 = (GAS v4u*)((unsigned short*)EIDX + (size_t)token * 128 + h * 16);
                e16[0] = (v4u){(unsigned)be[0] | ((unsigned)be[1] << 16), (unsigned)be[2] | ((unsigned)be[3] << 16), (unsigned)be[4] | ((unsigned)be[5] << 16), (unsigned)be[6] | ((unsigned)be[7] << 16)};
                e16[1] = (v4u){(unsigned)be[8] | ((unsigned)be[9] << 16), (unsigned)be[10] | ((unsigned)be[11] << 16), (unsigned)be[12] | ((unsigned)be[13] << 16), (unsigned)be[14] | ((unsigned)be[15] << 16)};
            }
#endif
        }
        LDS_WAIT(); asm volatile("" ::: "memory");
      }
    }
}

__device__ __forceinline__ float dot2bf(unsigned w, unsigned x, float acc) { return __builtin_amdgcn_fdot2_f32_bf16(__builtin_bit_cast(bf16x2_t, w), __builtin_bit_cast(bf16x2_t, x), acc, false); }
__device__ __forceinline__ float dot8(v4u a, v4u b, float acc) {
    const unsigned a0 = a.x, a1 = a.y, a2 = a.z, a3 = a.w, b0 = b.x, b1 = b.y, b2 = b.z, b3 = b.w;
    return dot2bf(a3, b3, dot2bf(a2, b2, dot2bf(a1, b1, dot2bf(a0, b0, acc))));
}
__device__ __forceinline__ float dot8f4(unsigned q, v4u h, float acc) {
    const unsigned h0 = h.x, h1 = h.y, h2 = h.z, h3 = h.w;
    acc = __builtin_amdgcn_fdot2_f32_bf16(__builtin_amdgcn_cvt_scalef32_pk_bf16_fp4(q, 1.0f, 0), __builtin_bit_cast(bf16x2_t, h0), acc, false);
    acc = __builtin_amdgcn_fdot2_f32_bf16(__builtin_amdgcn_cvt_scalef32_pk_bf16_fp4(q, 1.0f, 1), __builtin_bit_cast(bf16x2_t, h1), acc, false);
    acc = __builtin_amdgcn_fdot2_f32_bf16(__builtin_amdgcn_cvt_scalef32_pk_bf16_fp4(q, 1.0f, 2), __builtin_bit_cast(bf16x2_t, h2), acc, false);
    acc = __builtin_amdgcn_fdot2_f32_bf16(__builtin_amdgcn_cvt_scalef32_pk_bf16_fp4(q, 1.0f, 3), __builtin_bit_cast(bf16x2_t, h3), acc, false);
    return acc;
}
typedef float f32x2v __attribute__((ext_vector_type(2)));
__device__ __forceinline__ void peer_gather(Frame& F, const Args& A, const bool dummy) {
    unsigned char* ws = A.ws;
    const bf16* H2 = (const bf16*)(ws + WS_H); const unsigned char* U4 = ws + WS_U; const unsigned char* V4 = ws + WS_V;
    const float* SU = (const float*)(ws + WS_SU); const float* SV = (const float*)(ws + WS_SV);
    const int* EIDX = (const int*)(ws + WS_EIDX); const float* EGATE = (const float*)(ws + WS_EGATE); const float* ADA = (const float*)(ws + WS_ADA);
    const int lane = F.lane, grp = lane >> 3, i8 = lane & 7;
    LAS unsigned* WSM = (LAS unsigned*)(F.lds + F.wave * 1024);
    for (int n = F.gw; n < T; n += F.NGW) {
        const int b = n >> 11;
        v4u hh[4][4];
        { const bf16* hp = H2 + (size_t)n * 1024 + 32 * i8;
#pragma unroll
          for (int t = 0; t < 4; ++t)
#pragma unroll
              for (int k = 0; k < 4; ++k) hh[t][k] = *(const GAS v4u*)(hp + 256 * t + 8 * k); }
#pragma unroll 4
        for (int bb = 0; bb < 16; ++bb) {
            const int slot = bb * 8 + grp;
            const int eid = EIDX[(size_t)n * 128 + slot]; const float gt = EGATE[(size_t)n * 128 + slot];
            const unsigned char* up = U4 + (size_t)eid * 512 + 16 * i8;
            v4u q[4];
#pragma unroll
            for (int t = 0; t < 4; ++t) q[t] = *(const GAS v4u*)(up + 128 * t);
            const float su = SU[eid], sv = SV[eid];
            float d0 = 0.f, d1 = 0.f;
#pragma unroll
            for (int t = 0; t < 4; ++t) {
                const unsigned q0 = q[t].x, q1 = q[t].y, q2 = q[t].z, q3 = q[t].w;
                d0 = dot8f4(q0, hh[t][0], d0); d1 = dot8f4(q1, hh[t][1], d1); d0 = dot8f4(q2, hh[t][2], d0); d1 = dot8f4(q3, hh[t][3], d1);
            }
#ifdef GATHER_DUP_U
            { float e0 = 0.f, e1 = 0.f;
#pragma unroll
              for (int t = 0; t < 4; ++t) { const unsigned q0 = q[t].x ^ 0x88888888u, q1 = q[t].y ^ 0x88888888u, q2 = q[t].z ^ 0x88888888u, q3 = q[t].w ^ 0x88888888u;
                e0 = dot8f4(q0, hh[t][0], e0); e1 = dot8f4(q1, hh[t][1], e1); e0 = dot8f4(q2, hh[t][2], e0); e1 = dot8f4(q3, hh[t][3], e1); }
              d0 = 0.5f * (d0 - e0); d1 = 0.5f * (d1 - e1); }
#endif
            float dot = d0 + d1;
            dot += __shfl_xor(dot, 1); dot += __shfl_xor(dot, 2); dot += __shfl_xor(dot, 4);
            dot *= su;
            const float act = 0.5f * dot * (1.0f + erff(dot * 0.70710678118654752f));
            if (i8 == 0) { WSM[2 * slot] = (unsigned)eid; WSM[2 * slot + 1] = __float_as_uint(gt * act * sv); }
        }
        LDS_WAIT(); asm volatile("" ::: "memory");
        f32x2v acc[8];
#pragma unroll
        for (int j = 0; j < 8; ++j) acc[j] = (f32x2v){0.f, 0.f};
#pragma unroll 2
        for (int e0 = 0; e0 < 128; e0 += 16) {
            v2u vv[16]; float ww[16];
#pragma unroll
            for (int j = 0; j < 16; ++j) {
                const v2u ew = *(const LAS v2u*)(WSM + 2 * (e0 + j));
                const int eid = __builtin_amdgcn_readfirstlane((int)ew.x); ww[j] = __uint_as_float(__builtin_amdgcn_readfirstlane((int)ew.y));
                vv[j] = *(const GAS v2u*)(V4 + (size_t)eid * 512 + 8 * lane);
            }
#pragma unroll
            for (int j = 0; j < 16; ++j) {
                const unsigned v0 = vv[j].x, v1 = vv[j].y; const f32x2v w2 = (f32x2v){ww[j], ww[j]};
                acc[0] += w2 * __builtin_amdgcn_cvt_scalef32_pk_f32_fp4(v0, 1.0f, 0); acc[1] += w2 * __builtin_amdgcn_cvt_scalef32_pk_f32_fp4(v0, 1.0f, 1);
                acc[2] += w2 * __builtin_amdgcn_cvt_scalef32_pk_f32_fp4(v0, 1.0f, 2); acc[3] += w2 * __builtin_amdgcn_cvt_scalef32_pk_f32_fp4(v0, 1.0f, 3);
                acc[4] += w2 * __builtin_amdgcn_cvt_scalef32_pk_f32_fp4(v1, 1.0f, 0); acc[5] += w2 * __builtin_amdgcn_cvt_scalef32_pk_f32_fp4(v1, 1.0f, 1);
                acc[6] += w2 * __builtin_amdgcn_cvt_scalef32_pk_f32_fp4(v1, 1.0f, 2); acc[7] += w2 * __builtin_amdgcn_cvt_scalef32_pk_f32_fp4(v1, 1.0f, 3);
            }
        }
        LDS_WAIT(); asm volatile("" ::: "memory");
        const float* ip = A.out + (size_t)n * 1024 + 16 * lane; float* op = dummy ? (float*)(ws + WS_Z) + (size_t)n * 1024 + 16 * lane : A.out + (size_t)n * 1024 + 16 * lane; const float* g2p = ADA + b * 6144 + 5 * 1024 + 16 * lane;
#pragma unroll
        for (int q4 = 0; q4 < 4; ++q4) {
            const f32x4 xv = *(const GAS f32x4*)(ip + 4 * q4), gv = *(const GAS f32x4*)(g2p + 4 * q4);
            const f32x4 av = (f32x4){acc[2 * q4].x, acc[2 * q4].y, acc[2 * q4 + 1].x, acc[2 * q4 + 1].y};
            *(GAS f32x4*)(op + 4 * q4) = xv + gv * av;
        }
    }
}


constexpr int CW_Q1 = 8192, CW_Q3 = 8192 + 8 * 64;
__device__ __forceinline__ float quad_sum(float v) {
    v += __builtin_bit_cast(float, __builtin_amdgcn_update_dpp(0, __builtin_bit_cast(int, v), 0xB1, 0xF, 0xF, true));
    v += __builtin_bit_cast(float, __builtin_amdgcn_update_dpp(0, __builtin_bit_cast(int, v), 0x4E, 0xF, 0xF, true));
    return v;
}
__device__ __forceinline__ int next_item(Frame& F, unsigned* q) {
    LAS int* sh = (LAS int*)(F.lds);
    if (F.tid == 0) sh[0] = (int)__hip_atomic_fetch_add(q, 1u, __ATOMIC_RELAXED, __HIP_MEMORY_SCOPE_AGENT);
    __syncthreads(); const int it = sh[0]; __syncthreads();
    return it;
}
__device__ __forceinline__ void peer_g1(Frame& F, const Args& A) {
    unsigned char* ws = A.ws;
    const bf16* H2 = (const bf16*)(ws + WS_H); const unsigned char* U4 = ws + WS_U; const int* EIDX = (const int*)(ws + WS_EIDX); float* PD = (float*)(ws + WS_Z);
    unsigned* Q = (unsigned*)(ws + WS_CTL) + CW_Q1;
    const int lane = F.lane, tk = lane >> 3, c4 = lane & 7;
    const int s0 = (int)(xb_xcc_id() & 3u);
    for (int so = 0; so < 4; ++so) {
        const int s = (s0 + so) & 3;
        for (;;) {
            const int item = next_item(F, Q + 64 * s);
            if (item >= T / 128) break;
          for (int sub = 0; sub < 2; ++sub) {
            const int n = item * 128 + F.wave * 16 + sub * 8 + tk;
            v4u h2s[4];
            { const bf16* hp = H2 + (size_t)n * 1024 + 256 * s + 32 * c4;
#pragma unroll
              for (int k = 0; k < 4; ++k) h2s[k] = *(const GAS v4u*)(hp + 8 * k); }
            const unsigned char* ub = U4 + (size_t)s * (16384 * 128) + 16 * c4;
            float* pd = PD + ((size_t)s * T + n) * 128;
            const int* ep = EIDX + (size_t)n * 128;
            v4u idb[2], idc[2], rows[8], rnx[8];
            { const v4u i0 = *(const GAS v4u*)(ep), i1 = *(const GAS v4u*)(ep + 4); idb[0] = *(const GAS v4u*)(ep + 8); idb[1] = *(const GAS v4u*)(ep + 12);
              const unsigned a0 = i0.x, a1 = i0.y, a2 = i0.z, a3 = i0.w, a4 = i1.x, a5 = i1.y, a6 = i1.z, a7 = i1.w;
              rows[0] = *(const GAS v4u*)(ub + (size_t)a0 * 128); rows[1] = *(const GAS v4u*)(ub + (size_t)a1 * 128); rows[2] = *(const GAS v4u*)(ub + (size_t)a2 * 128); rows[3] = *(const GAS v4u*)(ub + (size_t)a3 * 128);
              rows[4] = *(const GAS v4u*)(ub + (size_t)a4 * 128); rows[5] = *(const GAS v4u*)(ub + (size_t)a5 * 128); rows[6] = *(const GAS v4u*)(ub + (size_t)a6 * 128); rows[7] = *(const GAS v4u*)(ub + (size_t)a7 * 128); }
            for (int g = 0; g < 16; ++g) {
                if (g + 2 < 16) { idc[0] = *(const GAS v4u*)(ep + 8 * (g + 2)); idc[1] = *(const GAS v4u*)(ep + 8 * (g + 2) + 4); }
                if (g + 1 < 16) {
                    const unsigned a0 = idb[0].x, a1 = idb[0].y, a2 = idb[0].z, a3 = idb[0].w, a4 = idb[1].x, a5 = idb[1].y, a6 = idb[1].z, a7 = idb[1].w;
                    rnx[0] = *(const GAS v4u*)(ub + (size_t)a0 * 128); rnx[1] = *(const GAS v4u*)(ub + (size_t)a1 * 128); rnx[2] = *(const GAS v4u*)(ub + (size_t)a2 * 128); rnx[3] = *(const GAS v4u*)(ub + (size_t)a3 * 128);
                    rnx[4] = *(const GAS v4u*)(ub + (size_t)a4 * 128); rnx[5] = *(const GAS v4u*)(ub + (size_t)a5 * 128); rnx[6] = *(const GAS v4u*)(ub + (size_t)a6 * 128); rnx[7] = *(const GAS v4u*)(ub + (size_t)a7 * 128);
                }
                float p[8];
#pragma unroll
                for (int k = 0; k < 8; ++k) { const unsigned x0 = rows[k].x, x1 = rows[k].y, x2 = rows[k].z, x3 = rows[k].w; float pp = quad_sum(dot8f4(x3, h2s[3], dot8f4(x2, h2s[2], dot8f4(x1, h2s[1], dot8f4(x0, h2s[0], 0.f))))); pp += __shfl_xor(pp, 4); p[k] = pp; }
                if (c4 == 0) { *(GAS f32x4*)(pd + 8 * g) = (f32x4){p[0], p[1], p[2], p[3]}; *(GAS f32x4*)(pd + 8 * g + 4) = (f32x4){p[4], p[5], p[6], p[7]}; }
#pragma unroll
                for (int k = 0; k < 8; ++k) rows[k] = rnx[k];
                idb[0] = idc[0]; idb[1] = idc[1];
            }
          }
        }
    }
}
__device__ __forceinline__ void peer_g2(Frame& F, const Args& A) {
    unsigned char* ws = A.ws;
    const int* EIDX = (const int*)(ws + WS_EIDX); float* EGATE = (float*)(ws + WS_EGATE); const float* PD = (const float*)(ws + WS_Z);
    const float* SU = (const float*)(ws + WS_SU); const float* SV = (const float*)(ws + WS_SV); const float* SH2 = (const float*)(ws + WS_SH2);
    const size_t gtid = (size_t)F.gw * 64 + F.lane, gthreads = (size_t)F.NGW * 64;
    for (size_t idx = gtid; idx < (size_t)T * 128; idx += gthreads) {
        float d = 0.f;
#pragma unroll
        for (int s = 0; s < 4; ++s) d += PD[(size_t)s * T * 128 + idx];
        const int eid = EIDX[idx];
        d *= SU[eid];
        const float act = 0.5f * d * (1.0f + erff(d * 0.70710678118654752f));
        EGATE[idx] = EGATE[idx] * act * SV[eid];
    }
}
__device__ __forceinline__ void peer_g3(Frame& F, const Args& A) {
    unsigned char* ws = A.ws;
    const unsigned char* V4 = ws + WS_V; const int* EIDX = (const int*)(ws + WS_EIDX); const float* W = (const float*)(ws + WS_EGATE); const float* ADA = (const float*)(ws + WS_ADA);
    unsigned* Q = (unsigned*)(ws + WS_CTL) + CW_Q3;
    const int lane = F.lane, tk = lane >> 3, c4 = lane & 7;
#ifdef G3_DUPLOAD
    const size_t zoff = (size_t)*((volatile unsigned*)(ws + WS_CTL) + 80);
#endif
    const int s0 = (int)(xb_xcc_id() & 3u);
    for (int so = 0; so < 4; ++so) {
        const int s = (s0 + so) & 3;
        for (;;) {
            const int item = next_item(F, Q + 64 * s);
            if (item >= T / 128) break;
          for (int sub = 0; sub < 2; ++sub) {
            const int n = item * 128 + F.wave * 16 + sub * 8 + tk;
            const unsigned char* vb = V4 + (size_t)s * (16384 * 128) + 16 * c4;
            f32x2v acc[16];
#pragma unroll
            for (int j = 0; j < 16; ++j) acc[j] = (f32x2v){0.f, 0.f};
            const int* ep = EIDX + (size_t)n * 128; const float* wp = W + (size_t)n * 128;
            v4u idb[2], idc[2], rows[8], rnx[8]; f32x4 wc[2], wb[2], wn[2];
            { const v4u i0 = *(const GAS v4u*)(ep), i1 = *(const GAS v4u*)(ep + 4); idb[0] = *(const GAS v4u*)(ep + 8); idb[1] = *(const GAS v4u*)(ep + 12);
              wc[0] = *(const GAS f32x4*)(wp); wc[1] = *(const GAS f32x4*)(wp + 4); wb[0] = *(const GAS f32x4*)(wp + 8); wb[1] = *(const GAS f32x4*)(wp + 12);
              const unsigned a0 = i0.x, a1 = i0.y, a2 = i0.z, a3 = i0.w, a4 = i1.x, a5 = i1.y, a6 = i1.z, a7 = i1.w;
              rows[0] = *(const GAS v4u*)(vb + (size_t)a0 * 128); rows[1] = *(const GAS v4u*)(vb + (size_t)a1 * 128); rows[2] = *(const GAS v4u*)(vb + (size_t)a2 * 128); rows[3] = *(const GAS v4u*)(vb + (size_t)a3 * 128);
              rows[4] = *(const GAS v4u*)(vb + (size_t)a4 * 128); rows[5] = *(const GAS v4u*)(vb + (size_t)a5 * 128); rows[6] = *(const GAS v4u*)(vb + (size_t)a6 * 128); rows[7] = *(const GAS v4u*)(vb + (size_t)a7 * 128); }
            for (int g = 0; g < 16; ++g) {
                if (g + 2 < 16) { idc[0] = *(const GAS v4u*)(ep + 8 * (g + 2)); idc[1] = *(const GAS v4u*)(ep + 8 * (g + 2) + 4); wn[0] = *(const GAS f32x4*)(wp + 8 * (g + 2)); wn[1] = *(const GAS f32x4*)(wp + 8 * (g + 2) + 4); }
                if (g + 1 < 16) {
                    const unsigned a0 = idb[0].x, a1 = idb[0].y, a2 = idb[0].z, a3 = idb[0].w, a4 = idb[1].x, a5 = idb[1].y, a6 = idb[1].z, a7 = idb[1].w;
                    rnx[0] = *(const GAS v4u*)(vb + (size_t)a0 * 128); rnx[1] = *(const GAS v4u*)(vb + (size_t)a1 * 128); rnx[2] = *(const GAS v4u*)(vb + (size_t)a2 * 128); rnx[3] = *(const GAS v4u*)(vb + (size_t)a3 * 128);
                    rnx[4] = *(const GAS v4u*)(vb + (size_t)a4 * 128); rnx[5] = *(const GAS v4u*)(vb + (size_t)a5 * 128); rnx[6] = *(const GAS v4u*)(vb + (size_t)a6 * 128); rnx[7] = *(const GAS v4u*)(vb + (size_t)a7 * 128);
                }
#ifdef G3_DUPLOAD
                v4u r2[8];
                if (g + 1 < 16) {
                    const unsigned a0 = idb[0].x, a1 = idb[0].y, a2 = idb[0].z, a3 = idb[0].w, a4 = idb[1].x, a5 = idb[1].y, a6 = idb[1].z, a7 = idb[1].w;
                    r2[0] = *(const GAS v4u*)(vb + zoff + (size_t)a0 * 128); r2[1] = *(const GAS v4u*)(vb + zoff + (size_t)a1 * 128); r2[2] = *(const GAS v4u*)(vb + zoff + (size_t)a2 * 128); r2[3] = *(const GAS v4u*)(vb + zoff + (size_t)a3 * 128);
                    r2[4] = *(const GAS v4u*)(vb + zoff + (size_t)a4 * 128); r2[5] = *(const GAS v4u*)(vb + zoff + (size_t)a5 * 128); r2[6] = *(const GAS v4u*)(vb + zoff + (size_t)a6 * 128); r2[7] = *(const GAS v4u*)(vb + zoff + (size_t)a7 * 128);
#pragma unroll
                    for (int k = 0; k < 8; ++k) { rnx[k].y = r2[k].y; rnx[k].w = r2[k].w; }
                }
#endif
#pragma unroll
                for (int k = 0; k < 8; ++k) {
                    const float wk = wc[k >> 2][k & 3]; const f32x2v w2 = (f32x2v){wk, wk};
                    const unsigned x0 = rows[k].x, x1 = rows[k].y, x2 = rows[k].z, x3 = rows[k].w;
                    acc[0] += w2 * __builtin_amdgcn_cvt_scalef32_pk_f32_fp4(x0, 1.0f, 0); acc[1] += w2 * __builtin_amdgcn_cvt_scalef32_pk_f32_fp4(x0, 1.0f, 1);
                    acc[2] += w2 * __builtin_amdgcn_cvt_scalef32_pk_f32_fp4(x0, 1.0f, 2); acc[3] += w2 * __builtin_amdgcn_cvt_scalef32_pk_f32_fp4(x0, 1.0f, 3);
                    acc[4] += w2 * __builtin_amdgcn_cvt_scalef32_pk_f32_fp4(x1, 1.0f, 0); acc[5] += w2 * __builtin_amdgcn_cvt_scalef32_pk_f32_fp4(x1, 1.0f, 1);
                    acc[6] += w2 * __builtin_amdgcn_cvt_scalef32_pk_f32_fp4(x1, 1.0f, 2); acc[7] += w2 * __builtin_amdgcn_cvt_scalef32_pk_f32_fp4(x1, 1.0f, 3);
                    acc[8] += w2 * __builtin_amdgcn_cvt_scalef32_pk_f32_fp4(x2, 1.0f, 0); acc[9] += w2 * __builtin_amdgcn_cvt_scalef32_pk_f32_fp4(x2, 1.0f, 1);
                    acc[10] += w2 * __builtin_amdgcn_cvt_scalef32_pk_f32_fp4(x2, 1.0f, 2); acc[11] += w2 * __builtin_amdgcn_cvt_scalef32_pk_f32_fp4(x2, 1.0f, 3);
                    acc[12] += w2 * __builtin_amdgcn_cvt_scalef32_pk_f32_fp4(x3, 1.0f, 0); acc[13] += w2 * __builtin_amdgcn_cvt_scalef32_pk_f32_fp4(x3, 1.0f, 1);
                    acc[14] += w2 * __builtin_amdgcn_cvt_scalef32_pk_f32_fp4(x3, 1.0f, 2); acc[15] += w2 * __builtin_amdgcn_cvt_scalef32_pk_f32_fp4(x3, 1.0f, 3);
                }
#pragma unroll
                for (int k = 0; k < 8; ++k) rows[k] = rnx[k];
                idb[0] = idc[0]; idb[1] = idc[1]; wc[0] = wb[0]; wc[1] = wb[1]; wb[0] = wn[0]; wb[1] = wn[1];
            }
            float* op = A.out + (size_t)n * 1024 + 256 * s + 32 * c4; const float* g2p = ADA + (n >> 11) * 6144 + 5 * 1024 + 256 * s + 32 * c4;
#pragma unroll
            for (int q4 = 0; q4 < 8; ++q4) {
                const f32x4 xv = *(const GAS f32x4*)(op + 4 * q4), gv = *(const GAS f32x4*)(g2p + 4 * q4);
                const f32x4 av = (f32x4){acc[2 * q4].x, acc[2 * q4].y, acc[2 * q4 + 1].x, acc[2 * q4 + 1].y};
                *(GAS f32x4*)(op + 4 * q4) = xv + gv * av;
            }
          }
        }
    }
}


__device__ __forceinline__ void peer_local(Frame& F, const Args& A, const XcdBarrier& xb) {
    unsigned char* ws = A.ws;
    const bf16* H2 = (const bf16*)(ws + WS_H); const unsigned char* U4 = ws + WS_U; const unsigned char* V4 = ws + WS_V;
    const int* EIDX = (const int*)(ws + WS_EIDX); const float* EGATE = (const float*)(ws + WS_EGATE); const float* ADA = (const float*)(ws + WS_ADA);
    const float* SU = (const float*)(ws + WS_SU); const float* SV = (const float*)(ws + WS_SV); const float* SH2 = (const float*)(ws + WS_SH2);
    const int lane = F.lane, tk = lane >> 3, c4 = lane & 7;
    const int tpw = T / F.NGW;
    LAS float* PDL = (LAS float*)F.lds + (size_t)F.wave * tpw * 128;
    const int nbase = F.gw * tpw;
    for (int i = lane; i < tpw * 128; i += 64) PDL[i] = 0.f;
    LDS_WAIT(); asm volatile("" ::: "memory");
    const unsigned char* HHI = ws + WS_H2HI; const unsigned char* HLO = ws + WS_H2LO;
    for (int s = 0; s < 4; ++s) {
#ifdef SLICE_BAR
        if (s) xcd_barrier(xb);
#endif
        const unsigned char* ub = U4 + (size_t)s * (16384 * 128) + 16 * c4;
        for (int sub = 0; sub < tpw; sub += 8) {
            const int n = nbase + sub + tk;
            const v4u hh = *(const GAS v4u*)(HHI + (size_t)n * 512 + 128 * s + 16 * c4), hl = *(const GAS v4u*)(HLO + (size_t)n * 512 + 128 * s + 16 * c4);
            const int h0 = (int)hh.x, h1 = (int)hh.y, h2_ = (int)hh.z, h3 = (int)hh.w, l0 = (int)hl.x, l1 = (int)hl.y, l2 = (int)hl.z, l3 = (int)hl.w;
            LAS float* pd = PDL + (sub + tk) * 128;
            const int* ep = EIDX + (size_t)n * 128;
            v4u idb[2], idc[2], rows[8], rnx[8];
#ifdef EIDX16
            const unsigned short* ep16 = (const unsigned short*)EIDX + (size_t)n * 128;
            { const v4u i0 = *(const GAS v4u*)(ep16); idb[0] = *(const GAS v4u*)(ep16 + 8); idb[1] = idb[0]; (void)ep;
              const unsigned a0 = i0.x & 0xFFFFu, a1 = i0.x >> 16, a2 = i0.y & 0xFFFFu, a3 = i0.y >> 16, a4 = i0.z & 0xFFFFu, a5 = i0.z >> 16, a6 = i0.w & 0xFFFFu, a7 = i0.w >> 16;
#else
            { const v4u i0 = *(const GAS v4u*)(ep), i1 = *(const GAS v4u*)(ep + 4); idb[0] = *(const GAS v4u*)(ep + 8); idb[1] = *(const GAS v4u*)(ep + 12);
              const unsigned a0 = i0.x, a1 = i0.y, a2 = i0.z, a3 = i0.w, a4 = i1.x, a5 = i1.y, a6 = i1.z, a7 = i1.w;
#endif
              rows[0] = *(const GAS v4u*)(ub + (size_t)a0 * 128); rows[1] = *(const GAS v4u*)(ub + (size_t)a1 * 128); rows[2] = *(const GAS v4u*)(ub + (size_t)a2 * 128); rows[3] = *(const GAS v4u*)(ub + (size_t)a3 * 128);
              rows[4] = *(const GAS v4u*)(ub + (size_t)a4 * 128); rows[5] = *(const GAS v4u*)(ub + (size_t)a5 * 128); rows[6] = *(const GAS v4u*)(ub + (size_t)a6 * 128); rows[7] = *(const GAS v4u*)(ub + (size_t)a7 * 128); }
            for (int g = 0; g < 16; ++g) {
#ifdef EIDX16
                if (g + 2 < 16) { idc[0] = *(const GAS v4u*)(ep16 + 8 * (g + 2)); idc[1] = idc[0]; }
                if (g + 1 < 16) {
                    const unsigned a0 = idb[0].x & 0xFFFFu, a1 = idb[0].x >> 16, a2 = idb[0].y & 0xFFFFu, a3 = idb[0].y >> 16, a4 = idb[0].z & 0xFFFFu, a5 = idb[0].z >> 16, a6 = idb[0].w & 0xFFFFu, a7 = idb[0].w >> 16;
#else
                if (g + 2 < 16) { idc[0] = *(const GAS v4u*)(ep + 8 * (g + 2)); idc[1] = *(const GAS v4u*)(ep + 8 * (g + 2) + 4); }
                if (g + 1 < 16) {
                    const unsigned a0 = idb[0].x, a1 = idb[0].y, a2 = idb[0].z, a3 = idb[0].w, a4 = idb[1].x, a5 = idb[1].y, a6 = idb[1].z, a7 = idb[1].w;
#endif
                    rnx[0] = *(const GAS v4u*)(ub + (size_t)a0 * 128); rnx[1] = *(const GAS v4u*)(ub + (size_t)a1 * 128); rnx[2] = *(const GAS v4u*)(ub + (size_t)a2 * 128); rnx[3] = *(const GAS v4u*)(ub + (size_t)a3 * 128);
                    rnx[4] = *(const GAS v4u*)(ub + (size_t)a4 * 128); rnx[5] = *(const GAS v4u*)(ub + (size_t)a5 * 128); rnx[6] = *(const GAS v4u*)(ub + (size_t)a6 * 128); rnx[7] = *(const GAS v4u*)(ub + (size_t)a7 * 128);
                }
                float p[8];
#pragma unroll
                for (int k = 0; k < 8; ++k) {
                    const int x0 = (int)rows[k].x, x1 = (int)rows[k].y, x2 = (int)rows[k].z, x3 = (int)rows[k].w;
                    const int ah = __builtin_amdgcn_sdot8(x3, h3, __builtin_amdgcn_sdot8(x2, h2_, __builtin_amdgcn_sdot8(x1, h1, __builtin_amdgcn_sdot8(x0, h0, 0, false), false), false), false);
                    const int al = __builtin_amdgcn_sdot8(x3, l3, __builtin_amdgcn_sdot8(x2, l2, __builtin_amdgcn_sdot8(x1, l1, __builtin_amdgcn_sdot8(x0, l0, 0, false), false), false), false);
                    int t = 16 * ah + al;
                    t += __builtin_amdgcn_update_dpp(0, t, 0xB1, 0xF, 0xF, true); t += __builtin_amdgcn_update_dpp(0, t, 0x4E, 0xF, 0xF, true); t += __shfl_xor(t, 4);
                    p[k] = (float)t;
                }
                if (c4 == 0) {
                    const f32x4 o0 = *(const LAS f32x4*)(pd + 8 * g), o1 = *(const LAS f32x4*)(pd + 8 * g + 4);
                    *(LAS f32x4*)(pd + 8 * g) = o0 + (f32x4){p[0], p[1], p[2], p[3]}; *(LAS f32x4*)(pd + 8 * g + 4) = o1 + (f32x4){p[4], p[5], p[6], p[7]};
                }
#pragma unroll
                for (int k = 0; k < 8; ++k) rows[k] = rnx[k];
                idb[0] = idc[0]; idb[1] = idc[1];
            }
        }
    }
    LDS_WAIT(); asm volatile("" ::: "memory");
    for (int i = lane; i < tpw * 128; i += 64) {
        const size_t gi = (size_t)nbase * 128 + i;
#ifdef EIDX16
        const int eid = ((const unsigned short*)EIDX)[gi];
#else
        const int eid = EIDX[gi];
#endif
        const float d = PDL[i] * SU[eid] * SH2[nbase + (i >> 7)];
        const float act = 0.5f * d * (1.0f + erff(d * 0.70710678118654752f));
        PDL[i] = EGATE[gi] * act * SV[eid];
    }
    LDS_WAIT(); asm volatile("" ::: "memory");
    for (int s = 0; s < 4; ++s) {
#ifdef SLICE_BAR
        xcd_barrier(xb);
#endif
        const unsigned char* vb = V4 + (size_t)s * (16384 * 128) + 16 * c4;
        for (int sub = 0; sub < tpw; sub += 8) {
            const int n = nbase + sub + tk;
            const LAS float* wl = PDL + (sub + tk) * 128;
            f32x2v acc[16];
#pragma unroll
            for (int j = 0; j < 16; ++j) acc[j] = (f32x2v){0.f, 0.f};
#ifdef P12_PREF
            f32x4 xpre[8];
            { const float* op0 = A.out + (size_t)n * 1024 + 256 * s + 32 * c4;
#pragma unroll
              for (int q4 = 0; q4 < 8; ++q4) xpre[q4] = *(const GAS f32x4*)(op0 + 4 * q4); }
#endif
            const int* ep = EIDX + (size_t)n * 128;
            v4u idb[2], idc[2], rows[8], rnx[8];
#ifdef EIDX16
            const unsigned short* ep16 = (const unsigned short*)EIDX + (size_t)n * 128;
            { const v4u i0 = *(const GAS v4u*)(ep16); idb[0] = *(const GAS v4u*)(ep16 + 8); idb[1] = idb[0]; (void)ep;
              const unsigned a0 = i0.x & 0xFFFFu, a1 = i0.x >> 16, a2 = i0.y & 0xFFFFu, a3 = i0.y >> 16, a4 = i0.z & 0xFFFFu, a5 = i0.z >> 16, a6 = i0.w & 0xFFFFu, a7 = i0.w >> 16;
#else
            { const v4u i0 = *(const GAS v4u*)(ep), i1 = *(const GAS v4u*)(ep + 4); idb[0] = *(const GAS v4u*)(ep + 8); idb[1] = *(const GAS v4u*)(ep + 12);
              const unsigned a0 = i0.x, a1 = i0.y, a2 = i0.z, a3 = i0.w, a4 = i1.x, a5 = i1.y, a6 = i1.z, a7 = i1.w;
#endif
              rows[0] = *(const GAS v4u*)(vb + (size_t)a0 * 128); rows[1] = *(const GAS v4u*)(vb + (size_t)a1 * 128); rows[2] = *(const GAS v4u*)(vb + (size_t)a2 * 128); rows[3] = *(const GAS v4u*)(vb + (size_t)a3 * 128);
              rows[4] = *(const GAS v4u*)(vb + (size_t)a4 * 128); rows[5] = *(const GAS v4u*)(vb + (size_t)a5 * 128); rows[6] = *(const GAS v4u*)(vb + (size_t)a6 * 128); rows[7] = *(const GAS v4u*)(vb + (size_t)a7 * 128); }
            for (int g = 0; g < 16; ++g) {
#ifdef EIDX16
                if (g + 2 < 16) { idc[0] = *(const GAS v4u*)(ep16 + 8 * (g + 2)); idc[1] = idc[0]; }
                if (g + 1 < 16) {
                    const unsigned a0 = idb[0].x & 0xFFFFu, a1 = idb[0].x >> 16, a2 = idb[0].y & 0xFFFFu, a3 = idb[0].y >> 16, a4 = idb[0].z & 0xFFFFu, a5 = idb[0].z >> 16, a6 = idb[0].w & 0xFFFFu, a7 = idb[0].w >> 16;
#else
                if (g + 2 < 16) { idc[0] = *(const GAS v4u*)(ep + 8 * (g + 2)); idc[1] = *(const GAS v4u*)(ep + 8 * (g + 2) + 4); }
                if (g + 1 < 16) {
                    const unsigned a0 = idb[0].x, a1 = idb[0].y, a2 = idb[0].z, a3 = idb[0].w, a4 = idb[1].x, a5 = idb[1].y, a6 = idb[1].z, a7 = idb[1].w;
#endif
                    rnx[0] = *(const GAS v4u*)(vb + (size_t)a0 * 128); rnx[1] = *(const GAS v4u*)(vb + (size_t)a1 * 128); rnx[2] = *(const GAS v4u*)(vb + (size_t)a2 * 128); rnx[3] = *(const GAS v4u*)(vb + (size_t)a3 * 128);
                    rnx[4] = *(const GAS v4u*)(vb + (size_t)a4 * 128); rnx[5] = *(const GAS v4u*)(vb + (size_t)a5 * 128); rnx[6] = *(const GAS v4u*)(vb + (size_t)a6 * 128); rnx[7] = *(const GAS v4u*)(vb + (size_t)a7 * 128);
                }
                const f32x4 w0 = *(const LAS f32x4*)(wl + 8 * g), w1 = *(const LAS f32x4*)(wl + 8 * g + 4);
#pragma unroll
                for (int k = 0; k < 8; ++k) {
                    const float wk = (k < 4) ? w0[k & 3] : w1[k & 3]; const f32x2v w2 = (f32x2v){wk, wk};
                    const unsigned x0 = rows[k].x, x1 = rows[k].y, x2 = rows[k].z, x3 = rows[k].w;
                    acc[0] += w2 * __builtin_amdgcn_cvt_scalef32_pk_f32_fp4(x0, 1.0f, 0); acc[1] += w2 * __builtin_amdgcn_cvt_scalef32_pk_f32_fp4(x0, 1.0f, 1);
                    acc[2] += w2 * __builtin_amdgcn_cvt_scalef32_pk_f32_fp4(x0, 1.0f, 2); acc[3] += w2 * __builtin_amdgcn_cvt_scalef32_pk_f32_fp4(x0, 1.0f, 3);
                    acc[4] += w2 * __builtin_amdgcn_cvt_scalef32_pk_f32_fp4(x1, 1.0f, 0); acc[5] += w2 * __builtin_amdgcn_cvt_scalef32_pk_f32_fp4(x1, 1.0f, 1);
                    acc[6] += w2 * __builtin_amdgcn_cvt_scalef32_pk_f32_fp4(x1, 1.0f, 2); acc[7] += w2 * __builtin_amdgcn_cvt_scalef32_pk_f32_fp4(x1, 1.0f, 3);
                    acc[8] += w2 * __builtin_amdgcn_cvt_scalef32_pk_f32_fp4(x2, 1.0f, 0); acc[9] += w2 * __builtin_amdgcn_cvt_scalef32_pk_f32_fp4(x2, 1.0f, 1);
                    acc[10] += w2 * __builtin_amdgcn_cvt_scalef32_pk_f32_fp4(x2, 1.0f, 2); acc[11] += w2 * __builtin_amdgcn_cvt_scalef32_pk_f32_fp4(x2, 1.0f, 3);
                    acc[12] += w2 * __builtin_amdgcn_cvt_scalef32_pk_f32_fp4(x3, 1.0f, 0); acc[13] += w2 * __builtin_amdgcn_cvt_scalef32_pk_f32_fp4(x3, 1.0f, 1);
                    acc[14] += w2 * __builtin_amdgcn_cvt_scalef32_pk_f32_fp4(x3, 1.0f, 2); acc[15] += w2 * __builtin_amdgcn_cvt_scalef32_pk_f32_fp4(x3, 1.0f, 3);
                }
#pragma unroll
                for (int k = 0; k < 8; ++k) rows[k] = rnx[k];
                idb[0] = idc[0]; idb[1] = idc[1];
            }
            float* op = A.out + (size_t)n * 1024 + 256 * s + 32 * c4; const float* g2p = ADA + (n >> 11) * 6144 + 5 * 1024 + 256 * s + 32 * c4;
#pragma unroll
            for (int q4 = 0; q4 < 8; ++q4) {
#if defined(X1_BF16)
#ifdef P12_NT
                const f32x4 gv = *(const GAS f32x4*)(g2p + 4 * q4); const v2u a_ = __builtin_nontemporal_load((const GAS v2u*)((const bf16*)(ws + WS_X1) + (size_t)n * 1024 + 256 * s + 32 * c4 + 4 * q4));
#else
                const f32x4 gv = *(const GAS f32x4*)(g2p + 4 * q4); const v2u a_ = *(const GAS v2u*)((const bf16*)(ws + WS_X1) + (size_t)n * 1024 + 256 * s + 32 * c4 + 4 * q4);
#endif
                const f32x4 xv = (f32x4){__uint_as_float(a_.x << 16), __uint_as_float(a_.x & 0xffff0000u), __uint_as_float(a_.y << 16), __uint_as_float(a_.y & 0xffff0000u)};
#elif defined(P12_PREF)
                const f32x4 xv = xpre[q4], gv = *(const GAS f32x4*)(g2p + 4 * q4);
#else
                const f32x4 xv = *(const GAS f32x4*)(op + 4 * q4), gv = *(const GAS f32x4*)(g2p + 4 * q4);
#endif
                const f32x4 av = (f32x4){acc[2 * q4].x, acc[2 * q4].y, acc[2 * q4 + 1].x, acc[2 * q4 + 1].y};
#ifdef P12_NT
                __builtin_nontemporal_store(xv + gv * av, (GAS f32x4*)(op + 4 * q4));
#else
                *(GAS f32x4*)(op + 4 * q4) = xv + gv * av;
#endif
            }
        }
    }
}

__device__ __forceinline__ void dbg_peer_check1(Frame& F, const Args& A) {
    if (blockIdx.x != 0) return;
    unsigned char* ws = A.ws;
    const bf16* H2 = (const bf16*)(ws + WS_H); const bf16* PQ = (const bf16*)(ws + WS_PQ); const bf16* SK = (const bf16*)(ws + WS_SK);
    const int* EIDX = (const int*)(ws + WS_EIDX); const float* EGATE = (const float*)(ws + WS_EGATE); float* DBG = (float*)(ws + 48 * MiB);
    unsigned* flag = (unsigned*)(ws + WS_CTL) + 64;
    const int t = F.tid;
    const int r = (int)(((long long)t * 2579 + 17) % T), c = (t * 131 + 5) % 1024;
    unsigned f = 0u;
    { float acc = 0.f; for (int k = 0; k < 1024; ++k) acc += bf2f(H2[(size_t)r * 1024 + k]) * A.w_pq[(size_t)k * 1024 + c];
      const float got = bf2f(PQ[(size_t)r * 1024 + c]); if (fabsf(got - acc) > 0.02f * fabsf(acc) + 0.02f) f |= 1u; }
    { const int h = t & 7; float s[2][128];
      float* sc = DBG + 4096 + (size_t)t * 256;
      for (int p = 0; p < 2; ++p) for (int k = 0; k < 128; ++k) { float acc = 0.f; for (int d = 0; d < 64; ++d) acc += bf2f(PQ[(size_t)r * 1024 + h * 128 + p * 64 + d]) * bf2f(SK[((size_t)(h * 2 + p) * 128 + k) * 64 + d]); sc[p * 128 + k] = acc; }
      (void)s;
      float t0v[16], t1v[16];
      for (int p = 0; p < 2; ++p) { float last = 3.0e38f; int lasti = -1; for (int i = 0; i < 16; ++i) { float best = -3.0e38f; int bi = -1; for (int k = 0; k < 128; ++k) { const float v = sc[p * 128 + k]; if ((v < last || (v == last && k > lasti)) && v > best) { best = v; bi = k; } } last = best; lasti = bi; if (p == 0) t0v[i] = best; else t1v[i] = best; } }
      float last = 3.0e38f; int cnt_ge = 0; float kth = 0.f;
      for (int it = 0; it < 16; ++it) { float best = -3.0e38f; for (int i = 0; i < 16; ++i) for (int j = 0; j < 16; ++j) { const float v = t0v[i] + t1v[j]; if (v < last && v > best) best = v; } last = best; kth = best; }
      (void)cnt_ge;
      float gs = 0.f; int badn = 0;
      for (int i = 0; i < 16; ++i) { const int e = EIDX[(size_t)r * 128 + h * 16 + i]; const float g = EGATE[(size_t)r * 128 + h * 16 + i]; gs += g;
          if (e < 0 || e >= 16384) { badn += 100; continue; }
          const float sm = sc[e >> 7] + sc[128 + (e & 127)]; if (sm < kth - 0.02f * fabsf(kth) - 0.02f) ++badn; }
      if (badn > 1) f |= 2u;
      if (fabsf(gs - 1.0f) > 0.01f) f |= 4u; }
    { float acc = 0.f;
      for (int e = 0; e < 128; ++e) { const int id = EIDX[(size_t)r * 128 + e]; const float g = EGATE[(size_t)r * 128 + e]; if (id < 0 || id >= 16384) continue;
          float d = 0.f; for (int k = 0; k < 1024; ++k) d += bf2f(H2[(size_t)r * 1024 + k]) * A.pu[(size_t)id * 1024 + k];
          const float act = 0.5f * d * (1.0f + erff(d * 0.70710678f)); acc += g * act * A.pv[(size_t)id * 1024 + c]; }
      DBG[t] = acc; DBG[512 + t] = A.out[(size_t)r * 1024 + c]; }
    if (f) atomicOr(flag, f);
}
__device__ __forceinline__ void dbg_peer_check2(Frame& F, const Args& A) {
    if (blockIdx.x != 0) return;
    unsigned char* ws = A.ws; const float* DBG = (const float*)(ws + 48 * MiB); const float* ADA = (const float*)(ws + WS_ADA);
    unsigned* flag = (unsigned*)(ws + WS_CTL) + 64;
    const int t = F.tid;
    const int r = (int)(((long long)t * 2579 + 17) % T), c = (t * 131 + 5) % 1024;
    const float e = DBG[512 + t] + ADA[(r >> 11) * 6144 + 5120 + c] * DBG[t], got = A.out[(size_t)r * 1024 + c];
    if (fabsf(got - e) > 0.03f * fabsf(DBG[t]) + 0.02f) atomicOr(flag, 8u);
}

__device__ __forceinline__ Args fresh_args() {
    const __attribute__((address_space(4))) Args* p = (const __attribute__((address_space(4))) Args*)__builtin_amdgcn_kernarg_segment_ptr();
    asm volatile("" : "+s"(p));
    return *(const Args*)p;
}
__global__ void __launch_bounds__(NTHR, 2) fwd_megakernel(Args args_byval) {
    extern __shared__ __attribute__((aligned(16))) unsigned char lds_raw[];
#define MAKE_FRAME() Frame F; F.lds = (LAS unsigned char*)lds_raw; F.tid = opaque_tid(); F.lane = F.tid & 63; F.wave = __builtin_amdgcn_readfirstlane(F.tid >> 6); \
    F.G = gridDim.x; { const int bx_ = blockIdx.x; F.vcu = (F.G % 8 == 0) ? (bx_ % 8) * (F.G / 8) + bx_ / 8 : bx_; } F.gw = F.vcu * NWAVES + F.wave; F.NGW = F.G * NWAVES;
    LAS unsigned char* const lds0 = (LAS unsigned char*)lds_raw;
    for (int u = threadIdx.x; u < (LDS_BYTES - LDSCTL_OFF) / 4; u += NTHR) ((LAS unsigned*)(lds0 + LDSCTL_OFF))[u] = 0u;
    __syncthreads();
    XcdBarrier bar = xcd_barrier_post((unsigned*)(fresh_args().ws + WS_CTL) + CW_BAR, (volatile LAS unsigned*)(lds0 + MISC_OFF) + 8);
#define GRID_BAR() xcd_barrier(bar)
    const int bx = (int)blockIdx.x;

    using pg8::Gemm; using pg8::StaticOrder; using pg8::EpiB; using pg8::EpiRes; using pg8::EpiX1;
#ifndef REP_P0
#define REP_P0 1
#endif
    for (int rep_ = 0; rep_ < REP_P0; ++rep_) {

#ifndef NO_PH_P0
    { const Args args = fresh_args(); MAKE_FRAME(); p0_prologue(F, args); }
#endif
    GRID_BAR();
    }

#ifndef REP_P1
#define REP_P1 1
#endif
    for (int rep_ = 0; rep_ < REP_P1; ++rep_) {

#ifndef NO_PH_NORM
    { const Args args = fresh_args(); MAKE_FRAME(); norm_rows(F, args.x, args.g1, ((const float*)(args.ws + WS_ADA)), 0, 1024, ((bf16*)(args.ws + WS_H)), nullptr, nullptr); }
#endif
    GRID_BAR();
    }

#ifdef EXTRA_BARS
    for (int xb_ = 0; xb_ < EXTRA_BARS; ++xb_) GRID_BAR();
#endif
#ifndef REP_P2
#define REP_P2 1
#endif
    for (int rep_ = 0; rep_ < REP_P2; ++rep_) {
#ifndef NO_PH_GEMM
    { const Args args = fresh_args(); MAKE_FRAME(); Gemm g{((bf16*)(args.ws + WS_H)), ((bf16*)(args.ws + WS_WIN)), T, ZW, 1024}; StaticOrder S; S.init(T, ZW, F.G, bx); EpiB<0> E{((bf16*)(args.ws + WS_Z)), ZW, 6, nullptr, nullptr, 0, 0, 4};
      pg8::gemm_phase<EpiB<0>, StaticOrder, false, true>(F.lds, g, S, E); }
#endif
    GRID_BAR();
    }


#ifndef NO_PH_P3
    { const Args args = fresh_args(); MAKE_FRAME();
#ifdef PRIO_P3
      if (F.wave >> 2) __builtin_amdgcn_s_setprio(2);
#endif
      p3_fixup(F, args);
#ifdef PRIO_P3
      __builtin_amdgcn_s_setprio(0);
#endif
     }
#endif
    GRID_BAR();
#ifndef NO_PH_GEMM
    { const Args args = fresh_args(); MAKE_FRAME(); Gemm g{((bf16*)(args.ws + WS_POOLED)), ((bf16*)(args.ws + WS_WUP)), T, 1024, 512}; StaticOrder S; S.init(T, 1024, F.G, bx);
#ifdef P5_NOGATE
      EpiB<0> E{((bf16*)(args.ws + WS_MIN)), 1024, 1000, nullptr, nullptr, 0, 0};
      pg8::gemm_phase<EpiB<0>, StaticOrder, false, true>(F.lds, g, S, E); }
#else
      EpiB<2> E{((bf16*)(args.ws + WS_MIN)), 1024, 0, nullptr, ((bf16*)(args.ws + WS_Z)), ZW, ZC_GP};
      pg8::gemm_phase<EpiB<2>, StaticOrder, true, true>(F.lds, g, S, E); }
#endif
#endif
#ifdef DBG_POOL
    GRID_BAR();
    { const Args args = fresh_args(); MAKE_FRAME(); dbg_pool_check(F, args); }
#endif
#ifdef P5P6_BAR
    GRID_BAR();
#endif
#ifndef REP_DSA
#define REP_DSA 1
#endif
    for (int rep_ = 0; rep_ < REP_DSA; ++rep_) {

#ifndef NO_PH_DSA
    { const Args args = fresh_args(); MAKE_FRAME();
#ifndef NO_PRIO_DSA
      if (F.wave >> 2) __builtin_amdgcn_s_setprio(2);
#endif
      dsa_phase(F, args);
#ifndef NO_PRIO_DSA
      __builtin_amdgcn_s_setprio(0);
#endif
     }
#endif
    GRID_BAR();
    }

#if !defined(NO_PH_GEMM) && !defined(NO_P7)
    { const Args args = fresh_args(); MAKE_FRAME(); Gemm g{((bf16*)(args.ws + WS_ATT)), ((bf16*)(args.ws + WS_WUA)), T, 1024, 512}; StaticOrder S; S.init(T, 1024, F.G, bx); EpiB<3> E{((bf16*)(args.ws + WS_MIN)), 1024, 0, nullptr, ((bf16*)(args.ws + WS_Z)), ZW, ZC_GA};
      pg8::gemm_phase<EpiB<3>, StaticOrder, true, true>(F.lds, g, S, E); }
#endif
    GRID_BAR();
#ifdef DBG_POOL
    { const Args args = fresh_args(); MAKE_FRAME(); dbg_min_check(F, args); }
    GRID_BAR();
#endif
#ifndef REP_P8
#define REP_P8 1
#endif
    for (int rep_ = 0; rep_ < REP_P8; ++rep_) {
#ifndef NO_PH_GEMM
    { const Args args = fresh_args(); MAKE_FRAME(); Gemm g{((bf16*)(args.ws + WS_MIN)), ((bf16*)(args.ws + WS_WOUT)), T, 1024, 1024}; StaticOrder S; S.init(T, 1024, F.G, bx);
#ifdef X1_BF16
      EpiX1 E{args.x, ((bf16*)(args.ws + WS_X1)), ((const float*)(args.ws + WS_ADA)) + 2048};
      pg8::gemm_phase<EpiX1, StaticOrder, true, true>(F.lds, g, S, E); }
#else
      EpiRes E{args.x, args.out, ((const float*)(args.ws + WS_ADA)) + 2048};
      pg8::gemm_phase<EpiRes, StaticOrder, true, true>(F.lds, g, S, E); }
#endif
#endif
    GRID_BAR();
    }

#ifndef REP_P9
#define REP_P9 1
#endif
    for (int rep_ = 0; rep_ < REP_P9; ++rep_) {

#ifndef NO_PH_NORM
    { const Args args = fresh_args(); MAKE_FRAME();
#ifdef X1_BF16
      norm_rows(F, nullptr, args.g2, ((const float*)(args.ws + WS_ADA)), 3072, 4096, ((bf16*)(args.ws + WS_H)), args.ws + WS_H2HI, (float*)(args.ws + WS_SH2), (const bf16*)(args.ws + WS_X1)); }
#else
      norm_rows(F, args.out, args.g2, ((const float*)(args.ws + WS_ADA)), 3072, 4096, ((bf16*)(args.ws + WS_H)), args.ws + WS_H2HI, (float*)(args.ws + WS_SH2)); }
#endif
#endif
    GRID_BAR();
    }

#ifndef REP_P10
#define REP_P10 1
#endif
    for (int rep_ = 0; rep_ < REP_P10; ++rep_) {
#ifndef NO_PH_GEMM
    { const Args args = fresh_args(); MAKE_FRAME(); Gemm g{((bf16*)(args.ws + WS_H)), ((bf16*)(args.ws + WS_WPQ)), T, 1024, 1024}; StaticOrder S; S.init(T, 1024, F.G, bx); EpiB<0> E{((bf16*)(args.ws + WS_PQ)), 1024, 1000, nullptr, nullptr, 0, 0};
      pg8::gemm_phase<EpiB<0>, StaticOrder, false, true>(F.lds, g, S, E); }
#endif
    GRID_BAR();
    }

#ifndef REP_P11
#define REP_P11 1
#endif
    for (int rep_ = 0; rep_ < REP_P11; ++rep_) {

#ifndef NO_PH_ROUTE
    { const Args args = fresh_args(); MAKE_FRAME();
#ifdef PRIO_ROUTE
      if (F.wave >> 2) __builtin_amdgcn_s_setprio(2);
#endif
      peer_route(F, args);
#ifdef PRIO_ROUTE
      __builtin_amdgcn_s_setprio(0);
#endif
     }
#endif
#ifdef PEER_QUEUED
    GRID_BAR();
#else
    VM_WAIT();
    __builtin_amdgcn_fence(__ATOMIC_ACQUIRE, "agent"); VM_WAIT();
    __syncthreads();
#endif
#ifdef DBG_PEER
    { const Args args = fresh_args(); MAKE_FRAME(); dbg_peer_check1(F, args); }
    GRID_BAR();
#endif
    }

#ifndef REP_GATHER
#define REP_GATHER 1
#endif
    for (int rep_ = 1; rep_ < REP_GATHER; ++rep_) { { const Args args = fresh_args(); MAKE_FRAME(); peer_gather(F, args, true); } GRID_BAR(); }

#ifdef OLD_GATHER
    { const Args args = fresh_args(); MAKE_FRAME(); peer_gather(F, args, false); }
#else
#ifdef PEER_QUEUED
    { const Args args = fresh_args(); MAKE_FRAME(); peer_g1(F, args); } GRID_BAR();
    { const Args args = fresh_args(); MAKE_FRAME(); peer_g2(F, args); } GRID_BAR();
    { const Args args = fresh_args(); MAKE_FRAME(); peer_g3(F, args); }
#else
    { const Args args = fresh_args(); MAKE_FRAME();
#ifdef PRIO_LOCAL
      if (F.wave >> 2) __builtin_amdgcn_s_setprio(2);
#endif
      peer_local(F, args, bar);
#ifdef PRIO_LOCAL
      __builtin_amdgcn_s_setprio(0);
#endif
     }
#endif
#endif

#ifdef DBG_PEER
    GRID_BAR();
    { const Args args = fresh_args(); MAKE_FRAME(); dbg_peer_check2(F, args); }
#endif
#if defined(DBG_POOL) || defined(DBG_PEER) || defined(DBG_SEL)
    GRID_BAR();
    { const Args args = fresh_args(); dbg_report(args); }
#endif
#ifdef DBG_FP4
    GRID_BAR();
    if (blockIdx.x == 0 && threadIdx.x == 0) {
        const Args args = fresh_args();
        volatile unsigned* src = (volatile unsigned*)(args.ws + WS_CTL) + 80;
        const unsigned x = 0x00007521u + *src; const float one = 1.0f + (float)*src, three = 3.0f + (float)*src;
        typedef float f32x2q __attribute__((ext_vector_type(2)));
        const f32x2q f0 = __builtin_amdgcn_cvt_scalef32_pk_f32_fp4(x, one, 0), f1 = __builtin_amdgcn_cvt_scalef32_pk_f32_fp4(x, one, 1), f3 = __builtin_amdgcn_cvt_scalef32_pk_f32_fp4(x, three, 0);
        const unsigned b0 = __builtin_bit_cast(unsigned, __builtin_amdgcn_cvt_scalef32_pk_bf16_fp4(x, one, 0));
        const bool A = (f0.x == 0.5f && f0.y == 1.0f && f1.x == 3.0f && f1.y == 6.0f && b0 == 0x3F803F00u);
        const bool Bf = (f3.x == 1.5f && f3.y == 3.0f), Cf = (f3.x == 1.0f && f3.y == 2.0f);
        const int code = (A ? 1 : 0) + (Bf ? 2 : 0) + (Cf ? 4 : 0);
        args.out[0] += 1000.0f * (float)(1 + code);
    }
#endif
#ifndef DBG_SCALE
#define DBG_SCALE 1000.0f
#endif
#ifdef DBG_MFMA8
    GRID_BAR();
    {
        const Args args = fresh_args();
        volatile unsigned* src = (volatile unsigned*)(args.ws + WS_CTL) + 80;
        const int z = (int)*src;
        const int lane_ = threadIdx.x & 63;
        typedef int v8i_ __attribute__((ext_vector_type(8)));
        v8i_ a = (v8i_){0x22222222 + z, 0x22222222, 0x22222222, 0x22222222, 0, 0, 0, 0};
        v8i_ bb = (v8i_){0x38383838 + z, 0x38383838, 0x38383838, 0x38383838, 0x38383838, 0x38383838, 0x38383838, 0x38383838};
#if DBG_MFMA8 == 2
        a = (v8i_){(lane_ < 32) ? (0x00200000 + z) : z, 0, 0, 0, 0, 0, 0, 0};
        { const unsigned sgn = (lane_ >= 32) ? 0x80808080u : 0u;
          const unsigned w0 = 0x48444038u | sgn, w1 = 0x504E4C4Au | sgn, w2 = 0x54535251u | sgn, w3 = 0x58575655u | sgn;
          bb = (v8i_){(int)w0 + z, (int)w1, (int)w2, (int)w3, (int)w0, (int)w1, (int)w2, (int)w3}; }
#endif
        f32x16 c;
#pragma unroll
        for (int i = 0; i < 16; ++i) c[i] = 0.f;
#if DBG_MFMA8 == 3
        a = bb;
        c = __builtin_amdgcn_mfma_scale_f32_32x32x64_f8f6f4(a, bb, c, 0, 0, 0, 127 + z, 0, 127 + z);
#else
        c = __builtin_amdgcn_mfma_scale_f32_32x32x64_f8f6f4(a, bb, c, 4, 0, 0, 127 + z, 0, 127 + z);
#endif
        if (blockIdx.x == 0 && threadIdx.x == 0) { const float v = c[0]; float code = (v != v) ? 2.0f : (fabsf(v) > 1.0e6f) ? 3.0f : (fminf(fmaxf(v, -28.0f), 100.0f) * 0.25f + 12.0f); args.out[0] += DBG_SCALE * code; }
    }
#endif
#ifdef DBG_MFMA16
    GRID_BAR();
    {
        const Args args = fresh_args();
        volatile unsigned* src = (volatile unsigned*)(args.ws + WS_CTL) + 80;
        const int z = (int)*src;
        const int lane_ = threadIdx.x & 63, q_ = lane_ >> 4;
        typedef int v8i_ __attribute__((ext_vector_type(8)));
        constexpr int PQ = DBG_MFMA16 / 100, PJ = DBG_MFMA16 % 100;
        unsigned aw[4] = {0u, 0u, 0u, 0u};
        if (q_ == PQ) aw[PJ >> 3] = 2u << (4 * (PJ & 7));
        v8i_ a = (v8i_){(int)aw[0] + z, (int)aw[1], (int)aw[2], (int)aw[3], 0, 0, 0, 0};
        const unsigned sgn = (q_ >= 2) ? 0x80808080u : 0u;
        const unsigned lo0 = 0x48444038u, lo1 = 0x504E4C4Au, hi0 = 0x54535251u, hi1 = 0x58575655u;
        const unsigned w0 = ((q_ & 1) ? hi0 : lo0) | sgn, w1 = ((q_ & 1) ? hi1 : lo1) | sgn;
        v8i_ bb = (v8i_){(int)w0 + z, (int)w1, (int)w0, (int)w1, (int)w0, (int)w1, (int)w0, (int)w1};
        pg8::f32x4 c = (pg8::f32x4){0.f, 0.f, 0.f, 0.f};
        c = __builtin_amdgcn_mfma_scale_f32_16x16x128_f8f6f4(a, bb, c, 4, 0, 0, 127 + z, 0, 127 + z);
        if (blockIdx.x == 0 && threadIdx.x == 0) { const float v = c[0]; float code = (v != v) ? 2.0f : (fabsf(v) > 1.0e6f) ? 3.0f : (fminf(fmaxf(v, -28.0f), 100.0f) * 0.25f + 12.0f); args.out[0] += DBG_SCALE * code; }
    }
#endif

}

extern "C" void kernel_launch(void* const* d_in, const int* in_sizes, int n_in, void* d_out, int out_size, void* d_ws, size_t ws_size, hipStream_t stream) {
    static int grid = 0;
    if (grid == 0) {
        if (n_in != 19 || in_sizes[0] != T * D || out_size != T * D || ws_size < WS_END) { fprintf(stderr, "kernel_launch: unexpected shapes (n_in %d, in0 %d, out %d, ws %zu < %zu); nothing launched\n", n_in, n_in > 0 ? in_sizes[0] : -1, out_size, ws_size, (size_t)WS_END); grid = -1; return; }
        int dev = 0, cus = 0, per_cu = 0;
        if (hipGetDevice(&dev) != hipSuccess || hipDeviceGetAttribute(&cus, hipDeviceAttributeMultiprocessorCount, dev) != hipSuccess) { grid = -1; return; }
        if (hipFuncSetAttribute((const void*)fwd_megakernel, hipFuncAttributeMaxDynamicSharedMemorySize, LDS_BYTES) != hipSuccess) { fprintf(stderr, "kernel_launch: hipFuncSetAttribute failed\n"); grid = -1; return; }
        if (hipOccupancyMaxActiveBlocksPerMultiprocessor(&per_cu, (const void*)fwd_megakernel, NTHR, LDS_BYTES) != hipSuccess || per_cu < 1) { fprintf(stderr, "kernel_launch: occupancy query says %d blocks per CU; nothing launched\n", per_cu); (void)hipGetLastError(); grid = -1; return; }
        grid = 256; while (grid > cus) grid >>= 1;
        if (grid < 8) { fprintf(stderr, "kernel_launch: only %d CUs; nothing launched\n", cus); grid = -1; return; }
    }
    if (grid < 0) return;
    if (hipMemsetAsync((char*)d_ws + WS_CTL, 0, CTL_ZERO_BYTES, stream) != hipSuccess) { fprintf(stderr, "kernel_launch: memset failed\n"); return; }
    Args a{};
    const float** ap = (const float**)&a;
    for (int i = 0; i < 19; ++i) ap[i] = (const float*)d_in[i];
    a.out = (float*)d_out; a.ws = (unsigned char*)d_ws;
    void* kargs[] = {&a};
    hipError_t e = hipLaunchCooperativeKernel((const void*)fwd_megakernel, dim3(grid), dim3(NTHR), kargs, LDS_BYTES, stream);
    if (e != hipSuccess) fprintf(stderr, "kernel_launch: cooperative launch failed: %s (grid %d)\n", hipGetErrorString(e), grid);
}
```

```cpp
#define GATE_I8 1
#define GATE_FP8 1
#define MIN_FP8 1
#define ZP_FP8 1
#define X1_BF16 1
#define QN_DSA 1
#define ADA_SPREAD 1
#define QUANT2 1
#define EIDX16 1
#include <hip/hip_runtime.h>
#include <hip/hip_bf16.h>
#include <cstdio>
#include <cstdint>
__device__ __forceinline__ int opaque_tid() { int t = threadIdx.x; asm volatile("" : "+v"(t)); return t; }
namespace pg8 {
#define PG8_LAS __attribute__((address_space(3)))
typedef unsigned short bf16_t;
typedef short bf16x8 __attribute__((ext_vector_type(8)));
typedef float f32x4 __attribute__((ext_vector_type(4)));
typedef unsigned u32x4 __attribute__((ext_vector_type(4)));
typedef int i32x4 __attribute__((ext_vector_type(4)));
constexpr int BM = 256, BK = 64, HALF = 128, HTB = HALF * BK * 2  , STAGE_BYTES = 8 * HTB, NXCD = 8, WGM = 8;

__host__ __device__ __forceinline__ int lds_byte(int r, int c) { const int st = (r >> 4) * 2 + (c >> 5), rr = r & 15, cc = c & 31, ob = rr * 64 + cc * 2; return st * 1024 + (ob ^ (((ob >> 9) & 1) << 5)); }
__host__ __device__ __forceinline__ void stage_rc(int b, int& R, int& C) { const int st = b / 1024, sb = b % 1024, swz = sb ^ (((sb >> 9) & 1) << 5); R = (st >> 1) * 16 + swz / 64; C = (st & 1) * 32 + (swz % 64) / 2; }
__host__ __device__ __forceinline__ int perm32(int rho) { const int n = rho >> 4, i = rho & 15; return 8 * (i >> 2) + 4 * n + (i & 3); }

struct Unit { int pm, pn; };
struct Gemm { const bf16_t* A; const bf16_t* Bt; int M, N, K; };

struct StaticOrder {
    int nM, nN, nwg, G, c;
    __host__ __device__ void init(int M, int N, int G_, int c_) { nM = M / BM; nN = N / BM; nwg = nM * nN; G = G_; c = c_; }
    __host__ __device__ bool next(int i, Unit& u) const {
        const long L = (long)i * G + c; if (L >= nwg) return false;
        int wgid = (int)L; { const int q = nwg / NXCD, r = nwg % NXCD, xcd = wgid % NXCD, off = wgid / NXCD; wgid = (xcd < r ? xcd * (q + 1) : r * (q + 1) + (xcd - r) * q) + off; }
        const int nig = WGM * nN, gid = wgid / nig, fm = gid * WGM, gsz = (nM - fm) < WGM ? (nM - fm) : WGM;
        u.pm = fm + ((wgid % nig) % gsz); u.pn = (wgid % nig) / gsz; return true;
    }
    __device__ __forceinline__ void a_ready(const Unit&) const {}
    __device__ __forceinline__ void done(const Unit&) const {}
};

__device__ __forceinline__ unsigned cvt_pk_bf16(float lo, float hi) { unsigned r; asm volatile("v_cvt_pk_bf16_f32 %0, %1, %2" : "=v"(r) : "v"(lo), "v"(hi)); return r; }
typedef float f32x2 __attribute__((ext_vector_type(2)));
__device__ __forceinline__ f32x2 gelu_pk(f32x2 v) {
    const f32x2 av = __builtin_elementwise_abs(v), d = av * 0.2316418882f + 1.0f;
    f32x2 t; t.x = __builtin_amdgcn_rcpf(d.x); t.y = __builtin_amdgcn_rcpf(d.y);
    f32x2 q = t * 0.5307027145f + (-0.7265760135f); q = q * t + 0.7107068705f; q = q * t + (-0.142248368f); q = q * t + 0.127414796f; q = q * t;
    const f32x2 s = (v * v) * (-0.72134752044f);
    f32x2 e; e.x = __builtin_amdgcn_exp2f(s.x); e.y = __builtin_amdgcn_exp2f(s.y);
    const f32x2 m = v * (q * e), r = v - m;
    f32x2 o; o.x = v.x < 0.f ? m.x : r.x; o.y = v.y < 0.f ? m.y : r.y; return o;
}

template <int ACT  > struct EpiBf16 {
    static constexpr bool PERM = true, AFTER_DRAIN = false; static_assert(ACT == 0 || ACT == 1, "EpiBf16: ACT is 0 (none) or 1 (gelu_pk)");
    bf16_t* O; int ldc; const float* bias; int split_cols; size_t split_stride; float scale0;
    __device__ __forceinline__ void operator()(const f32x4 (&acc)[2][2][4][2], const Unit& u, int wr, int wc, int fr, int fq) const {
        const int row0 = u.pm * BM + wr * 64 + fr; int colt = u.pn * BM; bf16_t* base = O;
        float sc = 1.f; if (split_cols) { const int t = colt / split_cols; base += (size_t)t * split_stride; colt -= t * split_cols; if (t == 0) sc = scale0; }
        const int col0 = colt + wc * 32 + 8 * fq, bcol0 = u.pn * BM + wc * 32 + 8 * fq;
        f32x4 bv[2][2];
#pragma unroll
        for (int bj = 0; bj < 2; ++bj)
#pragma unroll
            for (int n = 0; n < 2; ++n) bv[bj][n] = bias ? *(const f32x4*)(bias + bcol0 + bj * HALF + 4 * n) : (f32x4){0.f, 0.f, 0.f, 0.f};
#pragma unroll
        for (int ai = 0; ai < 2; ++ai)
#pragma unroll
            for (int m = 0; m < 4; ++m) { bf16_t* rowp = base + (size_t)(row0 + ai * HALF + m * 16) * ldc + col0;
#pragma unroll
                for (int bj = 0; bj < 2; ++bj) { f32x4 v0 = acc[ai][bj][m][0] + bv[bj][0], v1 = acc[ai][bj][m][1] + bv[bj][1];
                    if (ACT == 1) { f32x2 a = gelu_pk((f32x2){v0[0], v0[1]}), b = gelu_pk((f32x2){v0[2], v0[3]}), c = gelu_pk((f32x2){v1[0], v1[1]}), d = gelu_pk((f32x2){v1[2], v1[3]});
                        v0 = (f32x4){a.x, a.y, b.x, b.y}; v1 = (f32x4){c.x, c.y, d.x, d.y}; }
                    v0 = v0 * sc; v1 = v1 * sc; u32x4 w; w.x = cvt_pk_bf16(v0[0], v0[1]); w.y = cvt_pk_bf16(v0[2], v0[3]); w.z = cvt_pk_bf16(v1[0], v1[1]); w.w = cvt_pk_bf16(v1[2], v1[3]);
                    *(u32x4*)(rowp + bj * HALF) = w; } }
    }
};
template <class Epi, class Sched, bool ALIGN_EPI = false, bool SP2 = false, bool I8 = false>
__device__ __forceinline__ void gemm_phase(PG8_LAS unsigned char* lds, const Gemm g, const Sched& S, const Epi& E) {
    const int tid = opaque_tid(), wid = __builtin_amdgcn_readfirstlane(tid >> 6), lane = tid & 63, wr = wid >> 2, wc = wid & 3, fr = lane & 15, fq = lane >> 4;
    const int K = g.K, nt = K / BK;
    unsigned voffA[2], voffB[2];
#pragma unroll
    for (int i = 0; i < 2; ++i) { int R, C; stage_rc(tid * 16 + i * 8192, R, C); const int Rb = Epi::PERM ? ((R & ~31) + perm32(R & 31)) : R;
        voffA[i] = (unsigned)(R * K + C) * 2u; voffB[i] = (unsigned)(Rb * K + C) * 2u; }
    const size_t kstep = (size_t)(BK * 2);
    const size_t hstep = (size_t)HALF * K * 2;
    const size_t tstep = 2 * hstep;
    const unsigned ldsw = (unsigned)wid * 1024u;
    const int aoff = lds_byte(wr * 64 + fr, fq * 8), boff = lds_byte(wc * 32 + fr, fq * 8);
#define PG8_SA(b, h) (((b) * 2 + (h)) * HTB)
#define PG8_SB(b, h) ((4 + (b) * 2 + (h)) * HTB)
#define PG8_STAGE(bufoff, gbase, voff) do { _Pragma("unroll") for (int _i = 0; _i < 2; ++_i) \
        __builtin_amdgcn_global_load_lds((const unsigned*)((const char*)(gbase) + (voff)[_i]), (PG8_LAS unsigned*)(lds + (bufoff) + ldsw + _i * 8192), 16, 0, 0); } while (0)
#define PG8_LDA(dst, b, h) do { _Pragma("unroll") for (int m = 0; m < 4; ++m) _Pragma("unroll") for (int k = 0; k < 2; ++k) dst[m][k] = *(const PG8_LAS bf16x8*)(lds + PG8_SA(b, h) + aoff + m * 2048 + k * 1024); } while (0)
#define PG8_LDB(dst, b, h) do { _Pragma("unroll") for (int n = 0; n < 2; ++n) _Pragma("unroll") for (int k = 0; k < 2; ++k) dst[n][k] = *(const PG8_LAS bf16x8*)(lds + PG8_SB(b, h) + boff + n * 2048 + k * 1024); } while (0)
#define PG8_MMA(ai, bj, At, Bt) do { __builtin_amdgcn_s_setprio(1); _Pragma("unroll") for (int m = 0; m < 4; ++m) _Pragma("unroll") for (int n = 0; n < 2; ++n) _Pragma("unroll") for (int k = 0; k < 2; ++k) { \
        if constexpr (I8) acc[ai][bj][m][n] = __builtin_bit_cast(f32x4, __builtin_amdgcn_mfma_i32_16x16x64_i8(__builtin_bit_cast(i32x4, Bt[n][k]), __builtin_bit_cast(i32x4, At[m][k]), __builtin_bit_cast(i32x4, acc[ai][bj][m][n]), 0, 0, 0)); \
        else acc[ai][bj][m][n] = __builtin_amdgcn_mfma_f32_16x16x32_bf16(Bt[n][k], At[m][k], acc[ai][bj][m][n], 0, 0, 0); } __builtin_amdgcn_s_setprio(0); } while (0)
#define PG8_WAIT_V(n) asm volatile("s_waitcnt vmcnt(" #n ")" ::: "memory")
#define PG8_WAIT_L(n) asm volatile("s_waitcnt lgkmcnt(" #n ")" ::: "memory")
#define PG8_BAR __builtin_amdgcn_s_barrier()
#define PG8_SCHED __builtin_amdgcn_sched_barrier(0)
    Unit cur, nxt; int ui = 0;
    if (!S.next(0, cur)) return;
    f32x4 acc[2][2][4][2];
#pragma unroll
    for (int a = 0; a < 2; ++a)
#pragma unroll
        for (int b = 0; b < 2; ++b)
#pragma unroll
            for (int m = 0; m < 4; ++m)
#pragma unroll
                for (int n = 0; n < 2; ++n) acc[a][b][m][n] = (f32x4){0.f, 0.f, 0.f, 0.f};
    bf16x8 At[4][2], B0[2][2], B1[2][2];
    const char* cA = (const char*)g.A + (size_t)cur.pm * tstep; const char* cB = (const char*)g.Bt + (size_t)cur.pn * tstep;
    S.a_ready(cur);
    if constexpr (SP2) {
        PG8_STAGE(PG8_SB(0, 0), cB, voffB); PG8_STAGE(PG8_SB(0, 1), cB + hstep, voffB); PG8_STAGE(PG8_SA(0, 0), cA, voffA); PG8_STAGE(PG8_SA(0, 1), cA + hstep, voffA);
        if (wr == 1) PG8_BAR;
        PG8_WAIT_V(2); PG8_BAR;
        PG8_STAGE(PG8_SB(1, 0), cB + kstep, voffB); PG8_STAGE(PG8_SA(1, 0), cA + kstep, voffA); PG8_STAGE(PG8_SB(1, 1), cB + hstep + kstep, voffB);
        PG8_WAIT_V(6); PG8_BAR;
    } else {
        PG8_STAGE(PG8_SB(0, 0), cB, voffB); PG8_STAGE(PG8_SA(0, 0), cA, voffA); PG8_STAGE(PG8_SB(0, 1), cB + hstep, voffB); PG8_STAGE(PG8_SA(0, 1), cA + hstep, voffA);
        if (wr == 1) PG8_BAR;
        PG8_WAIT_V(4); PG8_BAR;
        PG8_STAGE(PG8_SB(1, 0), cB + kstep, voffB); PG8_STAGE(PG8_SA(1, 0), cA + kstep, voffA); PG8_STAGE(PG8_SB(1, 1), cB + hstep + kstep, voffB);
        PG8_WAIT_V(6); PG8_BAR;
    }
    for (;;) {
        const bool has_next = S.next(ui + 1, nxt);
        const char* nA = has_next ? (const char*)g.A + (size_t)nxt.pm * tstep : cA; const char* nB = has_next ? (const char*)g.Bt + (size_t)nxt.pn * tstep : cB;
        for (int t = 0; t < nt; t += 2) {
            const bool last = (t == nt - 2);
            const char* a1 = cA + (size_t)(t + 1) * kstep;
            const char* a2 = last ? nA : cA + (size_t)(t + 2) * kstep; const char* b2 = last ? nB : cB + (size_t)(t + 2) * kstep;
            const char* a3 = a2 + kstep; const char* b3 = b2 + kstep;
            if (last && has_next) S.a_ready(nxt);
            if constexpr (SP2) {
            PG8_LDB(B0, 0, 0); PG8_LDB(B1, 0, 1); PG8_SCHED; PG8_LDA(At, 0, 0); PG8_STAGE(PG8_SA(1, 1), a1 + hstep, voffA);
            PG8_WAIT_V(8); PG8_WAIT_L(0); PG8_BAR; PG8_MMA(0, 0, At, B0); PG8_MMA(0, 1, At, B1); PG8_BAR; PG8_SCHED;
            PG8_LDA(At, 0, 1); PG8_STAGE(PG8_SB(0, 0), b2, voffB); PG8_STAGE(PG8_SB(0, 1), b2 + hstep, voffB); PG8_STAGE(PG8_SA(0, 0), a2, voffA);
            PG8_WAIT_V(8); PG8_WAIT_L(0); PG8_BAR; PG8_MMA(1, 0, At, B0); PG8_MMA(1, 1, At, B1); PG8_BAR; PG8_SCHED;
            PG8_LDB(B0, 1, 0); PG8_LDB(B1, 1, 1); PG8_SCHED; PG8_LDA(At, 1, 0); PG8_STAGE(PG8_SA(0, 1), a2 + hstep, voffA);
            PG8_WAIT_V(8); PG8_WAIT_L(0); PG8_BAR; PG8_MMA(0, 0, At, B0); PG8_MMA(0, 1, At, B1); PG8_BAR; PG8_SCHED;
            PG8_LDA(At, 1, 1); PG8_STAGE(PG8_SB(1, 0), b3, voffB); PG8_STAGE(PG8_SB(1, 1), b3 + hstep, voffB); PG8_STAGE(PG8_SA(1, 0), a3, voffA);
            PG8_WAIT_V(8); PG8_WAIT_L(0); PG8_BAR; PG8_MMA(1, 0, At, B0); PG8_MMA(1, 1, At, B1); PG8_BAR; PG8_SCHED;
            } else {
            PG8_LDB(B0, 0, 0); PG8_SCHED; PG8_LDA(At, 0, 0); PG8_STAGE(PG8_SA(1, 1), a1 + hstep, voffA);
            PG8_WAIT_L(8); PG8_BAR; PG8_WAIT_L(0); PG8_MMA(0, 0, At, B0); PG8_BAR; PG8_SCHED;
            PG8_LDB(B1, 0, 1); PG8_STAGE(PG8_SB(0, 0), b2, voffB);
            PG8_BAR; PG8_WAIT_L(0); PG8_MMA(0, 1, At, B1); PG8_BAR;
            PG8_LDA(At, 0, 1); PG8_STAGE(PG8_SA(0, 0), a2, voffA);
            PG8_BAR; PG8_WAIT_L(0); PG8_MMA(1, 0, At, B0); PG8_BAR; PG8_SCHED;
            PG8_STAGE(PG8_SB(0, 1), b2 + hstep, voffB);
            PG8_WAIT_V(6); PG8_BAR; PG8_MMA(1, 1, At, B1); PG8_BAR;
            PG8_LDB(B0, 1, 0); PG8_SCHED; PG8_LDA(At, 1, 0); PG8_STAGE(PG8_SA(0, 1), a2 + hstep, voffA);
            PG8_WAIT_L(8); PG8_BAR; PG8_WAIT_L(0); PG8_MMA(0, 0, At, B0); PG8_BAR; PG8_SCHED;
            PG8_LDB(B1, 1, 1); PG8_STAGE(PG8_SB(1, 0), b3, voffB);
            PG8_BAR; PG8_WAIT_L(0); PG8_MMA(0, 1, At, B1); PG8_BAR;
            PG8_LDA(At, 1, 1); PG8_STAGE(PG8_SA(1, 0), a3, voffA);
            PG8_BAR; PG8_WAIT_L(0); PG8_MMA(1, 0, At, B0); PG8_BAR; PG8_SCHED;
            PG8_STAGE(PG8_SB(1, 1), b3 + hstep, voffB);
            PG8_WAIT_V(6); PG8_BAR; PG8_MMA(1, 1, At, B1); PG8_BAR;
            }
        }
        if constexpr (ALIGN_EPI) { if (wr == 0) PG8_BAR; }
        if constexpr (!Epi::AFTER_DRAIN) { E(acc, cur, wr, wc, fr, fq); S.done(cur); }
        if (!has_next) break;
#pragma unroll
        for (int a = 0; a < 2; ++a)
#pragma unroll
            for (int b = 0; b < 2; ++b)
#pragma unroll
                for (int m = 0; m < 4; ++m)
#pragma unroll
                    for (int n = 0; n < 2; ++n) acc[a][b][m][n] = (f32x4){0.f, 0.f, 0.f, 0.f};
        cur = nxt; cA = nA; cB = nB; ++ui;
        if constexpr (ALIGN_EPI) { if (wr == 1) PG8_BAR; }
    }
    PG8_WAIT_V(0);
    if constexpr (!ALIGN_EPI) { if (wr == 0) PG8_BAR; }
    PG8_BAR;
    if constexpr (Epi::AFTER_DRAIN) { E.fused(acc, cur, wr, wc, fr, fq, lds, wid, lane); S.done(cur); }
#undef PG8_SA
#undef PG8_SB
#undef PG8_STAGE
#undef PG8_LDA
#undef PG8_LDB
#undef PG8_MMA
#undef PG8_WAIT_V
#undef PG8_WAIT_L
#undef PG8_BAR
#undef PG8_SCHED
}
}

#define GAS __attribute__((address_space(1)))
#define LAS __attribute__((address_space(3)))
typedef unsigned short bf16;
typedef unsigned v4u __attribute__((ext_vector_type(4)));
typedef unsigned v2u __attribute__((ext_vector_type(2)));
typedef float f32x4 __attribute__((ext_vector_type(4)));
typedef float f32x16 __attribute__((ext_vector_type(16)));
typedef short bf16x8 __attribute__((ext_vector_type(8)));
typedef __bf16 bf16x2_t __attribute__((ext_vector_type(2)));

constexpr int NWAVES = 8, NTHR = 512;
constexpr int NB = 32, SEQ = 2048, T = NB * SEQ, D = 1024, ZW = 3584, INW = 3524;
constexpr int ZC_Q = 0, ZC_K = 512, ZC_V = 576, ZC_IK = 640, ZC_IW = 704, ZC_IQ = 768, ZC_ZP = 1024, ZC_GA = 1536, ZC_GP = 2560;
constexpr float EPS = 1e-6f;
constexpr float QSCALE = 0.125f * 1.4426950408889634f;

constexpr size_t MiB = 1u << 20;
constexpr size_t WS_CTL = 0, CTL_ZERO_BYTES = 65536;
constexpr size_t WS_ADA = 1 * MiB, WS_IW = 2 * MiB, WS_SK = 3 * MiB, WS_WGRP = 4 * MiB, WS_WUA = 5 * MiB, WS_WUP = 6 * MiB, WS_WOUT = 7 * MiB, WS_WPQ = 9 * MiB, WS_WIN = 11 * MiB;
constexpr size_t WS_IKX = 18 * MiB, WS_KX = 26 * MiB, WS_VX = 34 * MiB;
constexpr size_t WS_U = 64 * MiB, WS_V = 96 * MiB, WS_Z = 128 * MiB, WS_H = 576 * MiB, WS_POOLED = 576 * MiB, WS_PM = 640 * MiB;
constexpr size_t WS_ATT = 704 * MiB, WS_PQ = 704 * MiB, WS_MIN = 832 * MiB, WS_EIDX = 832 * MiB, WS_EGATE = 864 * MiB, WS_END = 960 * MiB;
constexpr int CW_BAR = 4096;
constexpr size_t WS_SU = 512 * 1024, WS_SV = 576 * 1024, WS_SH2 = 640 * 1024;
constexpr size_t WS_H8 = 704 * MiB;
constexpr size_t WS_WG8 = 44 * MiB, WS_CS8 = 46 * MiB, WS_S1 = 47 * MiB;
constexpr size_t WS_X1 = 128 * MiB;
constexpr size_t WS_H2HI = 384 * MiB, WS_H2LO = 416 * MiB;
constexpr size_t WS_H2F8 = 384 * MiB;

constexpr int RING_BYTES = 131072, LDS_BYTES = 163840, LDSCTL_OFF = LDS_BYTES - 1024, MISC_OFF = LDSCTL_OFF + 320;

__device__ __forceinline__ unsigned f2bf(float f) { unsigned u = __builtin_bit_cast(unsigned, f); return (u + 0x7fffu + ((u >> 16) & 1u)) >> 16; }
__device__ __forceinline__ unsigned pk2(float lo, float hi) { typedef float f32x2_ __attribute__((ext_vector_type(2))); typedef __bf16 bf16x2_ __attribute__((ext_vector_type(2))); const f32x2_ v = {lo, hi}; return __builtin_bit_cast(unsigned, __builtin_convertvector(v, bf16x2_)); }
__device__ __forceinline__ float bflo(unsigned w) { return __builtin_bit_cast(float, w << 16); }
__device__ __forceinline__ float bfhi(unsigned w) { return __builtin_bit_cast(float, w & 0xffff0000u); }
__device__ __forceinline__ float bf2f(bf16 h) { return __builtin_bit_cast(float, (unsigned)h << 16); }
#define LDS_WAIT() asm volatile("s_waitcnt lgkmcnt(0)" ::: "memory")
#define VM_WAIT() asm volatile("s_waitcnt vmcnt(0)" ::: "memory")

#define XB_TMO      128
#define XB_XCNT(j)  (256  + 64 * (j))
#define XB_XSUB(j)  (1280 + 64 * (j))
#define XB_XGEN(j)  (2304 + 64 * (j))
#define XB_TOP      3328
#define XB_TOPGEN   3392
#define XCD_BAR_WORDS 3456
#define XB_SPIN_CAP (1u << 26)

__device__ __forceinline__ unsigned xb_ld(unsigned* p)              { return __hip_atomic_load(p, __ATOMIC_RELAXED, __HIP_MEMORY_SCOPE_AGENT); }
__device__ __forceinline__ unsigned xb_add(unsigned* p, unsigned v) { return __hip_atomic_fetch_add(p, v, __ATOMIC_RELAXED, __HIP_MEMORY_SCOPE_AGENT); }
__device__ __forceinline__ unsigned xb_xcc_id() { return (unsigned)__builtin_amdgcn_s_getreg((3 << 11) | 20) & 0xFu; }
#define XB_SPIN(cond, bar) do { unsigned _sp = 0; while (cond) { __builtin_amdgcn_s_sleep(1); \
    if ((++_sp & 255u) == 0u) { if (xb_ld(&(bar)[XB_TMO])) break; if (_sp > XB_SPIN_CAP) { atomicAdd(&(bar)[XB_TMO], 1u); break; } } } } while (0)

struct XcdBarrier {
    unsigned* bar; unsigned x;
    volatile LAS unsigned* st;
};

__device__ __forceinline__ XcdBarrier xcd_barrier_post(unsigned* bar, volatile LAS unsigned* st) {
    XcdBarrier b; b.bar = bar; b.x = xb_xcc_id(); b.st = st;
    if (threadIdx.x == 0) (void)xb_add(&bar[XB_XCNT(b.x)], 1u);
    return b;
}
__device__ __forceinline__ void xcd_barrier_complete(unsigned* bar, unsigned x, unsigned& nloc, unsigned& nx) {
    const unsigned G = gridDim.x * gridDim.y * gridDim.z;
    unsigned sum, cnt, mine, sp = 0u;
    for (;;) {
        sum = 0u; cnt = 0u; mine = 0u;
#pragma unroll
        for (unsigned j = 0; j < 16; ++j) { const unsigned c = xb_ld(&bar[XB_XCNT(j)]); sum += c; cnt += (c > 0u) ? 1u : 0u; mine = (j == x) ? c : mine; }
        if (sum == G) break;
        __builtin_amdgcn_s_sleep(1);
        if ((++sp & 255u) == 0u) { if (xb_ld(&bar[XB_TMO])) break; if (sp > XB_SPIN_CAP) { atomicAdd(&bar[XB_TMO], 1u); break; } }
    }
    nloc = mine > 0u ? mine : 1u; nx = cnt > 0u ? cnt : 1u;
}

__device__ __forceinline__ void xcd_barrier(const XcdBarrier& b) {
    asm volatile("s_waitcnt vmcnt(0)" ::: "memory");
    __syncthreads();
    if (threadIdx.x == 0) {
        unsigned* bar = b.bar;
        __builtin_amdgcn_s_waitcnt(0);
        unsigned nloc = b.st[0], nx = b.st[1];
        if (nloc == 0u) { xcd_barrier_complete(bar, b.x, nloc, nx); b.st[0] = nloc; b.st[1] = nx; }
        const unsigned old = xb_add(&bar[XB_XSUB(b.x)], 1u);
        const unsigned gen = old / nloc;
        if (old + 1u == (gen + 1u) * nloc) {
            __builtin_amdgcn_fence(__ATOMIC_RELEASE, "agent");
            asm volatile("s_waitcnt vmcnt(0)" ::: "memory");
            const unsigned og = xb_add(&bar[XB_TOP], 1u);
            const unsigned tg = og / nx;
            if (og + 1u == (tg + 1u) * nx) xb_add(&bar[XB_TOPGEN], 1u);
            else XB_SPIN(xb_ld(&bar[XB_TOPGEN]) == tg, bar);
            __builtin_amdgcn_fence(__ATOMIC_ACQUIRE, "agent");
            xb_add(&bar[XB_XGEN(b.x)], 1u);
            asm volatile("s_waitcnt vmcnt(0)" ::: "memory");
        } else {
            XB_SPIN(xb_ld(&bar[XB_XGEN(b.x)]) == gen, bar);
            __builtin_amdgcn_fence(__ATOMIC_ACQUIRE, "agent");
            asm volatile("s_waitcnt vmcnt(0)" ::: "memory");
        }
    }
    __syncthreads();
}


struct Args {
    const float *x, *c, *w_ada, *b_ada, *g1, *w_in, *g_q, *g_k, *g_ik, *w_grp, *s_pool, *w_ua, *w_up, *w_out, *g2, *w_pq, *sk, *pu, *pv;
    float* out; unsigned char* ws;
};

struct Frame {
    LAS unsigned char* lds;
    int tid, lane, wave, vcu, G, gw, NGW;
};

__device__ __forceinline__ float wave_sum(float v) {
#pragma unroll
    for (int o = 1; o < 64; o <<= 1) v += __shfl_xor(v, o);
    return v;
}
__device__ __forceinline__ float xhalf_max(float m) { auto rr = __builtin_amdgcn_permlane32_swap(__float_as_uint(m), __float_as_uint(m), false, false); return fmaxf(__uint_as_float(rr[0]), __uint_as_float(rr[1])); }
__device__ __forceinline__ float xhalf_sum(float m) { auto rr = __builtin_amdgcn_permlane32_swap(__float_as_uint(m), __float_as_uint(m), false, false); return __uint_as_float(rr[0]) + __uint_as_float(rr[1]); }
__device__ __forceinline__ unsigned ordf(float f) { unsigned b = __float_as_uint(f); return b ^ ((b >> 31) ? 0xFFFFFFFFu : 0x80000000u); }
__device__ __forceinline__ float unordf(unsigned u) { unsigned b = u ^ ((u >> 31) ? 0x80000000u : 0xFFFFFFFFu); return __uint_as_float(b); }

__device__ __forceinline__ void transpose_item(const float* W, int ldw, int src_k0, int src_col0, int valid, bf16* WT, int ldwt, int dst_row0, int dst_k0, LAS float* scr, int lane) {
#pragma unroll 8
    for (int i = 0; i < 32; ++i) { const int kk = 2 * i + (lane >> 5), n = lane & 31; scr[kk * 33 + n] = (n < valid) ? W[(size_t)(src_k0 + kk) * ldw + src_col0 + n] : 0.f; }
    LDS_WAIT(); asm volatile("" ::: "memory");
    const int c = lane & 7;
#pragma unroll
    for (int j = 0; j < 4; ++j) { const int n = (lane >> 3) + 8 * j; const LAS float* s = scr + (8 * c) * 33 + n;
        v4u o; o.x = pk2(s[0 * 33], s[1 * 33]); o.y = pk2(s[2 * 33], s[3 * 33]); o.z = pk2(s[4 * 33], s[5 * 33]); o.w = pk2(s[6 * 33], s[7 * 33]);
        *(GAS v4u*)(WT + (size_t)(dst_row0 + n) * ldwt + dst_k0 + 8 * c) = o; }
    LDS_WAIT(); asm volatile("" ::: "memory");
}
__device__ __forceinline__ void zcol_src(int nb, int& src, int& valid) {
    const int n0 = nb * 32; valid = 32;
    if (n0 < 640) src = n0;
    else if (n0 < 704) src = 896 + (n0 - 640);
    else if (n0 < 736) { src = 960; valid = 4; }
    else if (n0 < 768) { src = 0; valid = 0; }
    else if (n0 < 1024) src = 640 + (n0 - 768);
    else if (n0 < 1536) src = 964 + (n0 - 1024);
    else src = 1476 + (n0 - 1536);
}
__device__ __forceinline__ void cvt_stream(const float* src, bf16* dst, size_t n8, int gtid, int gthreads) {
    for (size_t i = gtid; i < n8; i += gthreads) {
        const f32x4 a = ((const GAS f32x4*)src)[2 * i], b = ((const GAS f32x4*)src)[2 * i + 1];
        v4u o; o.x = pk2(a.x, a.y); o.y = pk2(a.z, a.w); o.z = pk2(b.x, b.y); o.w = pk2(b.z, b.w);
        ((GAS v4u*)dst)[i] = o;
    }
}
__device__ __forceinline__ void p0_prologue(Frame& F, const Args& A) {
    unsigned char* ws = A.ws;
    float* ADA = (float*)(ws + WS_ADA);
#ifdef ADA_SPREAD
    if (F.vcu * NWAVES < 1536) {
        LAS float* cT = (LAS float*)F.lds;
        LAS float* part = (LAS float*)(F.lds + 131072);
        for (int idx = F.tid; idx < NB * D; idx += NTHR) cT[(idx & (D - 1)) * NB + (idx >> 10)] = A.c[idx];
        __syncthreads();
      for (int item = F.gw; item < 1536; item += F.NGW) {
        const int task = item >> 2, quarter = item & 3;
        {
            const int col = task * 16 + (F.lane & 15), ks = F.lane >> 4;
            float acc[NB];
#pragma unroll
            for (int b = 0; b < NB; ++b) acc[b] = 0.f;
#pragma unroll 4
            for (int i = 0; i < 64; ++i) {
                const int k = quarter * 256 + 4 * i + ks;
                const float w = A.w_ada[(size_t)k * 6144 + col];
                const LAS f32x4* cr = (const LAS f32x4*)(cT + k * NB);
#pragma unroll
                for (int b4 = 0; b4 < 8; ++b4) { const f32x4 cv = cr[b4]; acc[4 * b4] = fmaf(cv.x, w, acc[4 * b4]); acc[4 * b4 + 1] = fmaf(cv.y, w, acc[4 * b4 + 1]); acc[4 * b4 + 2] = fmaf(cv.z, w, acc[4 * b4 + 2]); acc[4 * b4 + 3] = fmaf(cv.w, w, acc[4 * b4 + 3]); }
            }
#pragma unroll
            for (int b = 0; b < NB; ++b) { float v = acc[b]; v += __shfl_xor(v, 16); v += __shfl_xor(v, 32); acc[b] = v; }
            if (ks == 0) {
                LAS f32x4* pp = (LAS f32x4*)(part + (F.wave * 16 + (F.lane & 15)) * NB);
#pragma unroll
                for (int b4 = 0; b4 < 8; ++b4) pp[b4] = (f32x4){acc[4 * b4], acc[4 * b4 + 1], acc[4 * b4 + 2], acc[4 * b4 + 3]};
            }
        }
        __syncthreads();
        if (quarter == 0) {
#pragma unroll
            for (int j = 0; j < 8; ++j) {
                const int o = F.lane * 8 + j, cc = o >> 5, bb = o & 31;
                const float v = part[((F.wave + 0) * 16 + cc) * NB + bb] + part[((F.wave + 1) * 16 + cc) * NB + bb] + part[((F.wave + 2) * 16 + cc) * NB + bb] + part[((F.wave + 3) * 16 + cc) * NB + bb];
                ADA[bb * 6144 + task * 16 + cc] = v + A.b_ada[task * 16 + cc];
            }
        }
        __syncthreads();
      }
    }
#else
    if (F.vcu * NWAVES < 384) {
        LAS float* cT = (LAS float*)F.lds;
        for (int idx = F.tid; idx < NB * D; idx += NTHR) cT[(idx & (D - 1)) * NB + (idx >> 10)] = A.c[idx];
        __syncthreads();
        for (int task = F.gw; task < 384; task += F.NGW) {
            const int col = task * 16 + (F.lane & 15), ks = F.lane >> 4;
            float acc[NB];
#pragma unroll
            for (int b = 0; b < NB; ++b) acc[b] = 0.f;
#pragma unroll 4
            for (int i = 0; i < 256; ++i) {
                const int k = 4 * i + ks;
                const float w = A.w_ada[(size_t)k * 6144 + col];
                const LAS f32x4* cr = (const LAS f32x4*)(cT + k * NB);
#pragma unroll
                for (int b4 = 0; b4 < 8; ++b4) { const f32x4 cv = cr[b4]; acc[4 * b4] = fmaf(cv.x, w, acc[4 * b4]); acc[4 * b4 + 1] = fmaf(cv.y, w, acc[4 * b4 + 1]); acc[4 * b4 + 2] = fmaf(cv.z, w, acc[4 * b4 + 2]); acc[4 * b4 + 3] = fmaf(cv.w, w, acc[4 * b4 + 3]); }
            }
#pragma unroll
            for (int b = 0; b < NB; ++b) { float v = acc[b]; v += __shfl_xor(v, 16); v += __shfl_xor(v, 32); acc[b] = v; }
            if (ks == 0) {
                const float bb = A.b_ada[col];
#pragma unroll
                for (int b = 0; b < NB; ++b) ADA[b * 6144 + col] = acc[b] + bb;
            }
        }
        __syncthreads();
    }
#endif
    LAS float* scr = (LAS float*)(F.lds + F.wave * 16384);
    bf16* WIN = (bf16*)(ws + WS_WIN); bf16* WUA = (bf16*)(ws + WS_WUA); bf16* WUP = (bf16*)(ws + WS_WUP); bf16* WOUT = (bf16*)(ws + WS_WOUT); bf16* WPQ = (bf16*)(ws + WS_WPQ); bf16* WGRP = (bf16*)(ws + WS_WGRP);
    constexpr int I_IN = 16 * 112, I_UA = 8 * 32, I_UP = 8 * 32, I_OUT = 16 * 32, I_PQ = 16 * 32;
    constexpr int NITEMS = I_IN + I_UA + I_UP + I_OUT + I_PQ;
    for (int it = F.gw; it < NITEMS; it += F.NGW) {
        int r = it;
        if (r < I_IN) { const int kb = r / 112, nb = r % 112; int src, valid; zcol_src(nb, src, valid); transpose_item(A.w_in, INW, kb * 64, src, valid, WIN, 1024, nb * 32, kb * 64, scr, F.lane); continue; } r -= I_IN;
        if (r < I_UA) { const int kb = r / 32, nb = r % 32; transpose_item(A.w_ua, 1024, kb * 64, nb * 32, 32, WUA, 512, nb * 32, kb * 64, scr, F.lane); continue; } r -= I_UA;
        if (r < I_UP) { continue; } r -= I_UP;
        if (r < I_OUT) { const int kb = r / 32, nb = r % 32; transpose_item(A.w_out, 1024, kb * 64, nb * 32, 32, WOUT, 1024, nb * 32, kb * 64, scr, F.lane); continue; } r -= I_OUT;
        if (r < I_PQ) { const int kb = r / 32, nb = r % 32; transpose_item(A.w_pq, 1024, kb * 64, nb * 32, 32, WPQ, 1024, nb * 32, kb * 64, scr, F.lane); continue; } r -= I_PQ;
        (void)WGRP;
    }
    const int gtid = F.gw * 64 + F.lane, gthreads = F.NGW * 64;
    for (int it = F.gw; it < 512 * 4; it += F.NGW) {
        const int k = it >> 2, n = (it & 3) * 256 + F.lane, g = k >> 7;
        const float* wg = A.w_grp + (size_t)k * 128; const float* sp = A.s_pool + g * 128; const float* wu = A.w_up + (size_t)g * 128 * 1024 + n;
        float a0 = 0.f, a1 = 0.f, a2 = 0.f, a3 = 0.f;
#pragma unroll 8
        for (int d = 0; d < 128; ++d) { const float ws_ = wg[d] * sp[d]; const float* wr = wu + (size_t)d * 1024;
            a0 = fmaf(ws_, wr[0], a0); a1 = fmaf(ws_, wr[64], a1); a2 = fmaf(ws_, wr[128], a2); a3 = fmaf(ws_, wr[192], a3); }
        WUP[(size_t)n * 512 + k] = (bf16)f2bf(a0); WUP[(size_t)(n + 64) * 512 + k] = (bf16)f2bf(a1); WUP[(size_t)(n + 128) * 512 + k] = (bf16)f2bf(a2); WUP[(size_t)(n + 192) * 512 + k] = (bf16)f2bf(a3);
    }
    cvt_stream(A.sk, (bf16*)(ws + WS_SK), (size_t)16 * 128 * 64 / 8, gtid, gthreads);
#ifdef QUANT2
#ifndef QUANT_R
#define QUANT_R 2
#endif
    for (int row = F.gw; row < 2 * 16384; row += QUANT_R * F.NGW) {
        f32x4 av[QUANT_R][4]; float m[QUANT_R];
#pragma unroll
        for (int q = 0; q < QUANT_R; ++q) { int rq = row + q * F.NGW; rq = rq < 2 * 16384 ? rq : row; const bool isv = rq >= 16384; const int r = isv ? rq - 16384 : rq; const float* src = (isv ? A.pv : A.pu) + (size_t)r * 1024 + 16 * F.lane;
#pragma unroll
            for (int j = 0; j < 4; ++j) av[q][j] = *(const GAS f32x4*)(src + 4 * j); }
#pragma unroll
        for (int q = 0; q < QUANT_R; ++q) { float t = 0.f;
#pragma unroll
            for (int j = 0; j < 4; ++j) t = fmaxf(t, fmaxf(fmaxf(fabsf(av[q][j].x), fabsf(av[q][j].y)), fmaxf(fabsf(av[q][j].z), fabsf(av[q][j].w))));
            m[q] = t; }
#pragma unroll
        for (int o = 1; o < 64; o <<= 1) {
#pragma unroll
            for (int q = 0; q < QUANT_R; ++q) m[q] = fmaxf(m[q], __shfl_xor(m[q], o)); }
#pragma unroll
        for (int q = 0; q < QUANT_R; ++q) {
            int rq = row + q * F.NGW; rq = rq < 2 * 16384 ? rq : row; const bool isv = rq >= 16384; const int r = isv ? rq - 16384 : rq;
            const float sc = m[q] > 0.f ? (isv ? 6.0f / m[q] : 10.0f / m[q]) : 1.0f;
            unsigned w[2] = {0u, 0u};
#pragma unroll
            for (int j = 0; j < 4; ++j)
#pragma unroll
                for (int k = 0; k < 4; ++k) {
                    const float x = av[q][j][k], a = fabsf(x) * sc;
                    const unsigned c = (a >= 0.25f) + (a >= 0.75f) + (a >= 1.25f) + (a >= 1.75f) + (a >= 2.5f) + (a >= 3.5f) + (a >= 5.0f);
                    unsigned nib = c | (x < 0.f ? 8u : 0u);
                    if (!isv) { int qi = (int)rintf(x * sc); qi = qi < -8 ? -8 : (qi > 7 ? 7 : qi); nib = (unsigned)qi & 15u; }
                    const int el = 4 * j + k;
                    w[el >> 3] |= nib << (4 * (el & 7));
                }
            *(GAS v2u*)(ws + (isv ? WS_V : WS_U) + (size_t)(F.lane >> 4) * (16384 * 128) + (size_t)r * 128 + 8 * (F.lane & 15)) = (v2u){w[0], w[1]};
            if (F.lane == 0) ((float*)(ws + (isv ? WS_SV : WS_SU)))[r] = m[q] > 0.f ? (isv ? m[q] * (1.0f / 6.0f) : m[q] * 0.1f) : 1.0f;
        }
    }
}
#else
    for (int row = F.gw; row < 2 * 16384; row += F.NGW) {
        const bool isv = row >= 16384; const int r = isv ? row - 16384 : row;
        const float* src = (isv ? A.pv : A.pu) + (size_t)r * 1024 + 16 * F.lane;
        f32x4 av[4];
#pragma unroll
        for (int j = 0; j < 4; ++j) av[j] = *(const GAS f32x4*)(src + 4 * j);
        float m = 0.f;
#pragma unroll
        for (int j = 0; j < 4; ++j) m = fmaxf(m, fmaxf(fmaxf(fabsf(av[j].x), fabsf(av[j].y)), fmaxf(fabsf(av[j].z), fabsf(av[j].w))));
#pragma unroll
        for (int o = 1; o < 64; o <<= 1) m = fmaxf(m, __shfl_xor(m, o));
        const float sc = m > 0.f ? (isv ? 6.0f / m : 10.0f / m) : 1.0f;
        unsigned w[2] = {0u, 0u};
#pragma unroll
        for (int j = 0; j < 4; ++j)
#pragma unroll
            for (int k = 0; k < 4; ++k) {
                const float x = av[j][k], a = fabsf(x) * sc;
                const unsigned c = (a >= 0.25f) + (a >= 0.75f) + (a >= 1.25f) + (a >= 1.75f) + (a >= 2.5f) + (a >= 3.5f) + (a >= 5.0f);
                unsigned nib = c | (x < 0.f ? 8u : 0u);
                if (!isv) { int qi = (int)rintf(x * sc); qi = qi < -8 ? -8 : (qi > 7 ? 7 : qi); nib = (unsigned)qi & 15u; }
                const int el = 4 * j + k;
#if defined(U4_SWAP) && !defined(OLD_GATHER)
                w[el >> 3] |= nib << (4 * (isv ? (el & 7) : ((el & 7) ^ 1)));
#else
                w[el >> 3] |= nib << (4 * (el & 7));
#endif
            }
#ifdef OLD_GATHER
        *(GAS v2u*)(ws + (isv ? WS_V : WS_U) + (size_t)r * 512 + 8 * F.lane) = (v2u){w[0], w[1]};
#else
        *(GAS v2u*)(ws + (isv ? WS_V : WS_U) + (size_t)(F.lane >> 4) * (16384 * 128) + (size_t)r * 128 + 8 * (F.lane & 15)) = (v2u){w[0], w[1]};
#endif
        if (F.lane == 0) ((float*)(ws + (isv ? WS_SV : WS_SU)))[r] = m > 0.f ? (isv ? m * (1.0f / 6.0f) : m * 0.1f) : 1.0f;
    }
}
#endif

__device__ __forceinline__ void norm_rows(Frame& F, const float* X, const float* g, const float* ADA, int shift_off, int scale_off, bf16* O, unsigned char* O8, float* S8, const bf16* XB = nullptr, unsigned char* H8 = nullptr, float* S1 = nullptr) {
    const int rpw = T / F.NGW, m_begin = F.gw * rpw, b = m_begin >> 11;
    f32x4 cg[4], sh[4];
#pragma unroll
    for (int j = 0; j < 4; ++j) { const int col = 4 * F.lane + 256 * j;
        const f32x4 gg = *(const GAS f32x4*)(g + col), sc = *(const GAS f32x4*)(ADA + b * 6144 + scale_off + col);
        cg[j] = gg * (sc + 1.0f); sh[j] = *(const GAS f32x4*)(ADA + b * 6144 + shift_off + col); }
    for (int m0 = m_begin; m0 < m_begin + rpw; m0 += 4) {
        f32x4 v[4][4]; float s[4];
#pragma unroll
        for (int r = 0; r < 4; ++r) {
            if (XB) {
                const GAS v2u* ar = (const GAS v2u*)(XB + (size_t)(m0 + r) * D) + F.lane;
#pragma unroll
                for (int j = 0; j < 4; ++j) { const v2u a = ar[64 * j]; v[r][j] = (f32x4){__uint_as_float(a.x << 16), __uint_as_float(a.x & 0xffff0000u), __uint_as_float(a.y << 16), __uint_as_float(a.y & 0xffff0000u)}; }
            } else {
                const GAS f32x4* xr = (const GAS f32x4*)(X + (size_t)(m0 + r) * D) + F.lane;
#pragma unroll
                for (int j = 0; j < 4; ++j) v[r][j] = xr[64 * j];
            } }
#pragma unroll
        for (int r = 0; r < 4; ++r) { float t = 0.f;
#pragma unroll
            for (int j = 0; j < 4; ++j) t += (v[r][j].x * v[r][j].x + v[r][j].y * v[r][j].y) + (v[r][j].z * v[r][j].z + v[r][j].w * v[r][j].w);
            s[r] = t; }
#pragma unroll
        for (int o = 1; o < 64; o <<= 1) {
#pragma unroll
            for (int r = 0; r < 4; ++r) s[r] += __shfl_xor(s[r], o);
        }
#pragma unroll
        for (int r = 0; r < 4; ++r) {
            const float rstd = 1.0f / sqrtf(s[r] * (1.f / D) + EPS);
            GAS unsigned long long* o8 = (GAS unsigned long long*)(O + (size_t)(m0 + r) * D) + F.lane;
#pragma unroll
            for (int j = 0; j < 4; ++j) { const f32x4 y = (v[r][j] * rstd) * cg[j] + sh[j]; o8[64 * j] = (unsigned long long)pk2(y.x, y.y) | ((unsigned long long)pk2(y.z, y.w) << 32); v[r][j] = y; }
        }
        if (H8) {
            float am[4];
#pragma unroll
            for (int r = 0; r < 4; ++r) { float t = 0.f;
#pragma unroll
                for (int j = 0; j < 4; ++j) t = fmaxf(t, fmaxf(fmaxf(fabsf(v[r][j].x), fabsf(v[r][j].y)), fmaxf(fabsf(v[r][j].z), fabsf(v[r][j].w))));
                am[r] = t; }
#pragma unroll
            for (int o = 1; o < 64; o <<= 1) {
#pragma unroll
                for (int r = 0; r < 4; ++r) am[r] = fmaxf(am[r], __shfl_xor(am[r], o));
            }
#pragma unroll
            for (int r = 0; r < 4; ++r) {
                const float q = am[r] > 0.f ? 127.0f / am[r] : 1.0f;
                GAS unsigned* hb = (GAS unsigned*)(H8 + (size_t)(m0 + r) * D) + F.lane;
#pragma unroll
                for (int j = 0; j < 4; ++j) {
                    const int x0 = (int)rintf(v[r][j].x * q), x1 = (int)rintf(v[r][j].y * q), x2 = (int)rintf(v[r][j].z * q), x3 = (int)rintf(v[r][j].w * q);
                    hb[64 * j] = ((unsigned)x0 & 255u) | (((unsigned)x1 & 255u) << 8) | (((unsigned)x2 & 255u) << 16) | (((unsigned)x3 & 255u) << 24);
                }
                if (F.lane == 0) S1[m0 + r] = am[r] > 0.f ? am[r] * (1.0f / 127.0f) : 1.0f;
            }
        }
        if (O8) {
            float am[4];
#pragma unroll
            for (int r = 0; r < 4; ++r) { float t = 0.f;
#pragma unroll
                for (int j = 0; j < 4; ++j) t = fmaxf(t, fmaxf(fmaxf(fabsf(v[r][j].x), fabsf(v[r][j].y)), fmaxf(fabsf(v[r][j].z), fabsf(v[r][j].w))));
                am[r] = t; }
#pragma unroll
            for (int o = 1; o < 64; o <<= 1) {
#pragma unroll
                for (int r = 0; r < 4; ++r) am[r] = fmaxf(am[r], __shfl_xor(am[r], o));
            }
#pragma unroll
            for (int r = 0; r < 4; ++r) {
                const float q = am[r] > 0.f ? 119.0f / am[r] : 1.0f;
                GAS unsigned* hi = (GAS unsigned*)(O8 + (size_t)(m0 + r) * 512); GAS unsigned* lo = (GAS unsigned*)(O8 + (WS_H2LO - WS_H2HI) + (size_t)(m0 + r) * 512);
#pragma unroll
                for (int j = 0; j < 4; ++j) {
                    unsigned h16 = 0u, l16 = 0u;
#pragma unroll
                    for (int k = 0; k < 4; ++k) { const int x = (int)rintf(v[r][j][k] * q); const int l4 = ((x + 8) & 15) - 8; const int h4 = (x - l4) >> 4; h16 |= ((unsigned)h4 & 15u) << (4 * k); l16 |= ((unsigned)l4 & 15u) << (4 * k); }
                    const unsigned ph = (unsigned)__shfl_xor((int)h16, 1), pl = (unsigned)__shfl_xor((int)l16, 1);
                    if (!(F.lane & 1)) { hi[32 * j + (F.lane >> 1)] = h16 | (ph << 16); lo[32 * j + (F.lane >> 1)] = l16 | (pl << 16); }
                }
                if (F.lane == 0) S8[m0 + r] = am[r] > 0.f ? am[r] * (1.0f / 119.0f) : 1.0f;
            }
        }
    }
}

__device__ __forceinline__ void quant_gate_weights(Frame& F, unsigned char* ws) {
    const bf16* WIN = (const bf16*)(ws + WS_WIN); unsigned char* WG8 = ws + WS_WG8; float* CS8 = (float*)(ws + WS_CS8);
    for (int n = F.gw; n < 2048; n += F.NGW) {
        const v4u a = *(const GAS v4u*)(WIN + (size_t)(1536 + n) * 1024 + 16 * F.lane), c = *(const GAS v4u*)(WIN + (size_t)(1536 + n) * 1024 + 16 * F.lane + 8);
        const float f[16] = {bflo(a.x), bfhi(a.x), bflo(a.y), bfhi(a.y), bflo(a.z), bfhi(a.z), bflo(a.w), bfhi(a.w), bflo(c.x), bfhi(c.x), bflo(c.y), bfhi(c.y), bflo(c.z), bfhi(c.z), bflo(c.w), bfhi(c.w)};
        float m = 0.f;
#pragma unroll
        for (int i = 0; i < 16; ++i) m = fmaxf(m, fabsf(f[i]));
#pragma unroll
        for (int o = 1; o < 64; o <<= 1) m = fmaxf(m, __shfl_xor(m, o));
        const float q = m > 0.f ? 127.0f / m : 1.0f;
        unsigned w[4] = {0u, 0u, 0u, 0u};
#pragma unroll
        for (int i = 0; i < 16; ++i) w[i >> 2] |= ((unsigned)(int)rintf(f[i] * q) & 255u) << (8 * (i & 3));
        *(GAS v4u*)(WG8 + (size_t)n * 1024 + 16 * F.lane) = (v4u){w[0], w[1], w[2], w[3]};
        if (F.lane == 0) CS8[n] = m > 0.f ? m * (1.0f / 127.0f) : 1.0f;
    }
}

namespace pg8 {
__device__ __forceinline__ float sigm(float v) { return __builtin_amdgcn_rcpf(1.0f + __builtin_amdgcn_exp2f(-1.4426950408889634f * v)); }
template <int MODE> struct EpiB {
    static constexpr bool PERM = true, AFTER_DRAIN = false;
    bf16_t* O; int ldc; int sig_from; const float* colscale; const bf16_t* G; int ldg; int gcol0; int zp8_from;
    __device__ __forceinline__ void operator()(const f32x4 (&acc)[2][2][4][2], const Unit& u, int wr, int wc, int fr, int fq) const {
        const int row0 = u.pm * BM + wr * 64 + fr, col0 = u.pn * BM + wc * 32 + 8 * fq;
        const bool sg = (MODE == 0) && (u.pn >= sig_from);
        f32x4 cs[2][2];
        if (MODE == 1) {
#pragma unroll
            for (int bj = 0; bj < 2; ++bj)
#pragma unroll
                for (int n = 0; n < 2; ++n) cs[bj][n] = *(const f32x4*)(colscale + col0 + bj * HALF + 4 * n);
        }
#pragma unroll
        for (int ai = 0; ai < 2; ++ai)
#pragma unroll
            for (int m = 0; m < 4; ++m) { const size_t row = (size_t)(row0 + ai * HALF + m * 16); bf16_t* rowp = O + row * ldc + col0;
#pragma unroll
                for (int bj = 0; bj < 2; ++bj) { f32x4 v0 = acc[ai][bj][m][0], v1 = acc[ai][bj][m][1];
                    if (MODE == 0) { if (sg) { v0 = (f32x4){sigm(v0[0]), sigm(v0[1]), sigm(v0[2]), sigm(v0[3])}; v1 = (f32x4){sigm(v1[0]), sigm(v1[1]), sigm(v1[2]), sigm(v1[3])}; } }
                    if (MODE == 1) { v0 = v0 * cs[bj][0]; v1 = v1 * cs[bj][1]; }
#ifdef GATE_FP8
                    if (MODE == 2 || MODE == 3) {
                        typedef float f32x2g __attribute__((ext_vector_type(2)));
                        const unsigned long long g8 = *(const unsigned long long*)((const unsigned char*)G + row * (size_t)(ldg * 2) + 3072 + (gcol0 - 1536 + col0 + bj * HALF));
                        const unsigned glo = (unsigned)g8, ghi = (unsigned)(g8 >> 32);
                        const f32x2g a0 = __builtin_amdgcn_cvt_pk_f32_fp8(glo, false), a1 = __builtin_amdgcn_cvt_pk_f32_fp8(glo, true), a2 = __builtin_amdgcn_cvt_pk_f32_fp8(ghi, false), a3 = __builtin_amdgcn_cvt_pk_f32_fp8(ghi, true);
                        v0 = v0 * (f32x4){a0.x, a0.y, a1.x, a1.y}; v1 = v1 * (f32x4){a2.x, a2.y, a3.x, a3.y};
                    }
#else
                    if (MODE == 2 || MODE == 3) {
                        const u32x4 gw = *(const u32x4*)(G + row * ldg + gcol0 + col0 + bj * HALF);
                        v0 = v0 * (f32x4){__builtin_bit_cast(float, gw.x << 16), __builtin_bit_cast(float, gw.x & 0xffff0000u), __builtin_bit_cast(float, gw.y << 16), __builtin_bit_cast(float, gw.y & 0xffff0000u)};
                        v1 = v1 * (f32x4){__builtin_bit_cast(float, gw.z << 16), __builtin_bit_cast(float, gw.z & 0xffff0000u), __builtin_bit_cast(float, gw.w << 16), __builtin_bit_cast(float, gw.w & 0xffff0000u)};
                    }
#endif
#ifdef MIN_FP8
                    if (MODE == 3) {
                        typedef float f32x2g __attribute__((ext_vector_type(2)));
                        const unsigned long long o8 = *(const unsigned long long*)((const unsigned char*)G + row * (size_t)(ldg * 2) + 5120 + (col0 + bj * HALF));
                        const unsigned olo = (unsigned)o8, ohi = (unsigned)(o8 >> 32);
                        const f32x2g a0 = __builtin_amdgcn_cvt_pk_f32_fp8(olo, false), a1 = __builtin_amdgcn_cvt_pk_f32_fp8(olo, true), a2 = __builtin_amdgcn_cvt_pk_f32_fp8(ohi, false), a3 = __builtin_amdgcn_cvt_pk_f32_fp8(ohi, true);
                        v0 = v0 + (f32x4){a0.x, a0.y, a1.x, a1.y}; v1 = v1 + (f32x4){a2.x, a2.y, a3.x, a3.y};
                    }
                    if (MODE == 2) {
                        int lo = 0, hi = 0;
                        lo = __builtin_amdgcn_cvt_pk_fp8_f32(v0[0], v0[1], lo, false); lo = __builtin_amdgcn_cvt_pk_fp8_f32(v0[2], v0[3], lo, true);
                        hi = __builtin_amdgcn_cvt_pk_fp8_f32(v1[0], v1[1], hi, false); hi = __builtin_amdgcn_cvt_pk_fp8_f32(v1[2], v1[3], hi, true);
                        *(unsigned long long*)((unsigned char*)G + row * (size_t)(ldg * 2) + 5120 + (col0 + bj * HALF)) = (unsigned long long)(unsigned)lo | ((unsigned long long)(unsigned)hi << 32);
                        continue;
                    }
#else
                    if (MODE == 3) {
                        const u32x4 ow = *(const u32x4*)(rowp + bj * HALF);
                        v0 = v0 + (f32x4){__builtin_bit_cast(float, ow.x << 16), __builtin_bit_cast(float, ow.x & 0xffff0000u), __builtin_bit_cast(float, ow.y << 16), __builtin_bit_cast(float, ow.y & 0xffff0000u)};
                        v1 = v1 + (f32x4){__builtin_bit_cast(float, ow.z << 16), __builtin_bit_cast(float, ow.z & 0xffff0000u), __builtin_bit_cast(float, ow.w << 16), __builtin_bit_cast(float, ow.w & 0xffff0000u)};
                    }
#endif
#ifdef ZP_FP8
                    if (MODE == 0 && zp8_from > 0 && u.pn >= zp8_from && u.pn < sig_from) {
                        int lo = 0, hi = 0;
                        lo = __builtin_amdgcn_cvt_pk_fp8_f32(v0[0], v0[1], lo, false); lo = __builtin_amdgcn_cvt_pk_fp8_f32(v0[2], v0[3], lo, true);
                        hi = __builtin_amdgcn_cvt_pk_fp8_f32(v1[0], v1[1], hi, false); hi = __builtin_amdgcn_cvt_pk_fp8_f32(v1[2], v1[3], hi, true);
                        *(unsigned long long*)((unsigned char*)O + row * (size_t)(ldc * 2) + 6144 + (col0 - 256 * zp8_from + bj * HALF)) = (unsigned long long)(unsigned)lo | ((unsigned long long)(unsigned)hi << 32);
                        continue;
                    }
#endif
#ifdef GATE_FP8
                    if (MODE == 0 && sg) {
                        int lo = 0, hi = 0;
                        lo = __builtin_amdgcn_cvt_pk_fp8_f32(v0[0], v0[1], lo, false); lo = __builtin_amdgcn_cvt_pk_fp8_f32(v0[2], v0[3], lo, true);
                        hi = __builtin_amdgcn_cvt_pk_fp8_f32(v1[0], v1[1], hi, false); hi = __builtin_amdgcn_cvt_pk_fp8_f32(v1[2], v1[3], hi, true);
                        *(unsigned long long*)((unsigned char*)O + row * (size_t)(ldc * 2) + 3072 + (col0 - 1536 + bj * HALF)) = (unsigned long long)(unsigned)lo | ((unsigned long long)(unsigned)hi << 32);
                        continue;
                    }
#endif
                    u32x4 w; w.x = cvt_pk_bf16(v0[0], v0[1]); w.y = cvt_pk_bf16(v0[2], v0[3]); w.z = cvt_pk_bf16(v1[0], v1[1]); w.w = cvt_pk_bf16(v1[2], v1[3]);
                    *(u32x4*)(rowp + bj * HALF) = w; } }
    }
};
struct EpiRes {
    static constexpr bool PERM = false, AFTER_DRAIN = false;
    const float* X; float* C; const float* gate;
    __device__ __forceinline__ void operator()(const f32x4 (&acc)[2][2][4][2], const Unit& u, int wr, int wc, int fr, int fq) const {
        const int row0 = u.pm * BM + wr * 64 + fr, col0 = u.pn * BM + wc * 32 + 4 * fq;
        const int b = (u.pm * BM) >> 11;
        f32x4 gv[2][2];
#pragma unroll
        for (int bj = 0; bj < 2; ++bj)
#pragma unroll
            for (int n = 0; n < 2; ++n) gv[bj][n] = *(const f32x4*)(gate + b * 6144 + col0 + bj * HALF + n * 16);
#pragma unroll
        for (int ai = 0; ai < 2; ++ai)
#pragma unroll
            for (int m = 0; m < 4; ++m) { const size_t off = (size_t)(row0 + ai * HALF + m * 16) * 1024 + col0;
#pragma unroll
                for (int bj = 0; bj < 2; ++bj)
#pragma unroll
                    for (int n = 0; n < 2; ++n) { const f32x4 xv = *(const f32x4*)(X + off + bj * HALF + n * 16); *(f32x4*)(C + off + bj * HALF + n * 16) = xv + gv[bj][n] * acc[ai][bj][m][n]; } }
    }
};
struct EpiX1 {
    static constexpr bool PERM = true, AFTER_DRAIN = false;
    const float* X; bf16_t* O; const float* gate;
    __device__ __forceinline__ void operator()(const f32x4 (&acc)[2][2][4][2], const Unit& u, int wr, int wc, int fr, int fq) const {
        const int row0 = u.pm * BM + wr * 64 + fr, col0 = u.pn * BM + wc * 32 + 8 * fq;
        const int b = (u.pm * BM) >> 11;
        f32x4 gv[2][2];
#pragma unroll
        for (int bj = 0; bj < 2; ++bj)
#pragma unroll
            for (int n = 0; n < 2; ++n) gv[bj][n] = *(const f32x4*)(gate + b * 6144 + col0 + bj * HALF + 4 * n);
#pragma unroll
        for (int ai = 0; ai < 2; ++ai)
#pragma unroll
            for (int m = 0; m < 4; ++m) { const size_t off = (size_t)(row0 + ai * HALF + m * 16) * 1024 + col0;
#pragma unroll
                for (int bj = 0; bj < 2; ++bj) {
                    const f32x4 v0 = *(const f32x4*)(X + off + bj * HALF) + gv[bj][0] * acc[ai][bj][m][0], v1 = *(const f32x4*)(X + off + bj * HALF + 4) + gv[bj][1] * acc[ai][bj][m][1];
                    u32x4 w; w.x = cvt_pk_bf16(v0[0], v0[1]); w.y = cvt_pk_bf16(v0[2], v0[3]); w.z = cvt_pk_bf16(v1[0], v1[1]); w.w = cvt_pk_bf16(v1[2], v1[3]);
                    *(u32x4*)(O + off + bj * HALF) = w; } }
    }
};
struct EpiGate8 {
    static constexpr bool PERM = true, AFTER_DRAIN = false;
    unsigned char* Zb; int zpitch; const float* rs; const float* cs;
    __device__ __forceinline__ void operator()(const f32x4 (&acc)[2][2][4][2], const Unit& u, int wr, int wc, int fr, int fq) const {
        const int row0 = u.pm * BM + wr * 64 + fr, col0 = u.pn * BM + wc * 32 + 8 * fq;
        f32x4 cv[2][2];
#pragma unroll
        for (int bj = 0; bj < 2; ++bj)
#pragma unroll
            for (int n = 0; n < 2; ++n) cv[bj][n] = *(const f32x4*)(cs + col0 + bj * HALF + 4 * n);
#pragma unroll
        for (int ai = 0; ai < 2; ++ai)
#pragma unroll
            for (int m = 0; m < 4; ++m) { const size_t row = (size_t)(row0 + ai * HALF + m * 16); const float r = rs[row];
#pragma unroll
                for (int bj = 0; bj < 2; ++bj) {
                    const i32x4 a0 = __builtin_bit_cast(i32x4, acc[ai][bj][m][0]), a1 = __builtin_bit_cast(i32x4, acc[ai][bj][m][1]);
                    const f32x4 v0 = (f32x4){sigm((float)a0[0] * r * cv[bj][0][0]), sigm((float)a0[1] * r * cv[bj][0][1]), sigm((float)a0[2] * r * cv[bj][0][2]), sigm((float)a0[3] * r * cv[bj][0][3])};
                    const f32x4 v1 = (f32x4){sigm((float)a1[0] * r * cv[bj][1][0]), sigm((float)a1[1] * r * cv[bj][1][1]), sigm((float)a1[2] * r * cv[bj][1][2]), sigm((float)a1[3] * r * cv[bj][1][3])};
                    int lo = 0, hi = 0;
                    lo = __builtin_amdgcn_cvt_pk_fp8_f32(v0[0], v0[1], lo, false); lo = __builtin_amdgcn_cvt_pk_fp8_f32(v0[2], v0[3], lo, true);
                    hi = __builtin_amdgcn_cvt_pk_fp8_f32(v1[0], v1[1], hi, false); hi = __builtin_amdgcn_cvt_pk_fp8_f32(v1[2], v1[3], hi, true);
                    *(unsigned long long*)(Zb + row * (size_t)zpitch + 3072 + (col0 + bj * HALF)) = (unsigned long long)(unsigned)lo | ((unsigned long long)(unsigned)hi << 32);
                } }
    }
};
}

__device__ __forceinline__ void p3_fixup(Frame& F, const Args& A) {
    unsigned char* ws = A.ws;
    bf16* Z = (bf16*)(ws + WS_Z); bf16* IKX = (bf16*)(ws + WS_IKX); bf16* KX = (bf16*)(ws + WS_KX); bf16* VX = (bf16*)(ws + WS_VX); float* IW = (float*)(ws + WS_IW); bf16* POOLED = (bf16*)(ws + WS_POOLED);
    const int lane = F.lane;
    const int rpw = T / F.NGW, m_begin = F.gw * rpw;
    for (int m0 = m_begin; m0 < m_begin + rpw; m0 += 2) {
        const int g = lane >> 4, w = 2 << g;
#ifdef ZP_FP8
        typedef float f32x2z __attribute__((ext_vector_type(2)));
        float sum[2][8], self[2][8]; int cnt[2];
#pragma unroll
        for (int r = 0; r < 2; ++r) {
            const int m = m0 + r, s = m & (SEQ - 1);
            const int lo = (s + 1 - w) > 0 ? (s + 1 - w) : 0; cnt[r] = s + 1 - lo;
            const unsigned char* zp8 = (const unsigned char*)Z + (size_t)m * (ZW * 2) + 6144 + 8 * lane;
#pragma unroll
            for (int j = 0; j < 8; ++j) { sum[r][j] = 0.f; self[r][j] = 0.f; }
#pragma unroll
            for (int i = 0; i < 16; ++i) {
                if (i < cnt[r]) { const v2u q = *(const GAS v2u*)(zp8 - (size_t)i * (ZW * 2));
                    const f32x2z a0 = __builtin_amdgcn_cvt_pk_f32_fp8(q.x, false), a1 = __builtin_amdgcn_cvt_pk_f32_fp8(q.x, true), a2 = __builtin_amdgcn_cvt_pk_f32_fp8(q.y, false), a3 = __builtin_amdgcn_cvt_pk_f32_fp8(q.y, true);
                    const float fv[8] = {a0.x, a0.y, a1.x, a1.y, a2.x, a2.y, a3.x, a3.y};
#pragma unroll
                    for (int j = 0; j < 8; ++j) { sum[r][j] += fv[j]; if (i == 0) self[r][j] = fv[j]; } }
            }
        }
#pragma unroll
        for (int r = 0; r < 2; ++r) {
            const float inv = 1.0f / (float)cnt[r];
            v4u o; o.x = pk2(sum[r][0] * inv - self[r][0], sum[r][1] * inv - self[r][1]); o.y = pk2(sum[r][2] * inv - self[r][2], sum[r][3] * inv - self[r][3]);
            o.z = pk2(sum[r][4] * inv - self[r][4], sum[r][5] * inv - self[r][5]); o.w = pk2(sum[r][6] * inv - self[r][6], sum[r][7] * inv - self[r][7]);
            *(GAS v4u*)(POOLED + (size_t)(m0 + r) * 512 + 8 * lane) = o;
        }
    }
#else
        float sum[2][8]; v4u self[2]; int cnt[2];
#pragma unroll
        for (int r = 0; r < 2; ++r) {
            const int m = m0 + r, s = m & (SEQ - 1);
            const int lo = (s + 1 - w) > 0 ? (s + 1 - w) : 0; cnt[r] = s + 1 - lo;
            const bf16* zp = Z + (size_t)m * ZW + ZC_ZP + 8 * lane;
#pragma unroll
            for (int j = 0; j < 8; ++j) sum[r][j] = 0.f;
            self[r] = (v4u){0u, 0u, 0u, 0u};
#pragma unroll
            for (int i = 0; i < 16; ++i) {
                if (i < cnt[r]) { const v4u q = *(const GAS v4u*)(zp - (size_t)i * ZW); if (i == 0) self[r] = q;
                    sum[r][0] += bflo(q.x); sum[r][1] += bfhi(q.x); sum[r][2] += bflo(q.y); sum[r][3] += bfhi(q.y); sum[r][4] += bflo(q.z); sum[r][5] += bfhi(q.z); sum[r][6] += bflo(q.w); sum[r][7] += bfhi(q.w); }
            }
        }
#pragma unroll
        for (int r = 0; r < 2; ++r) {
            const float inv = 1.0f / (float)cnt[r];
            v4u o; o.x = pk2(sum[r][0] * inv - bflo(self[r].x), sum[r][1] * inv - bfhi(self[r].x)); o.y = pk2(sum[r][2] * inv - bflo(self[r].y), sum[r][3] * inv - bfhi(self[r].y));
            o.z = pk2(sum[r][4] * inv - bflo(self[r].z), sum[r][5] * inv - bfhi(self[r].z)); o.w = pk2(sum[r][6] * inv - bflo(self[r].w), sum[r][7] * inv - bfhi(self[r].w));
            *(GAS v4u*)(POOLED + (size_t)(m0 + r) * 512 + 8 * lane) = o;
        }
    }
#endif
    for (int tile = F.gw; tile < T / 32; tile += F.NGW) {
        const bf16* vsrc = Z + (size_t)tile * 32 * ZW + ZC_V;
        bf16* vdst = VX + (size_t)tile * 2048;
#pragma unroll
        for (int i = 0; i < 4; ++i) {
            const int pi = lane + 64 * i, h = pi & 1, d = (pi >> 1) & 31, s = (pi >> 6) & 1, rt = pi >> 7;
            unsigned e[8];
#pragma unroll
            for (int j = 0; j < 8; ++j) { const int key = 16 * s + 8 * (j >> 2) + 4 * h + (j & 3); e[j] = vsrc[(size_t)key * ZW + d + 32 * rt]; }
            v4u o; o.x = e[0] | (e[1] << 16); o.y = e[2] | (e[3] << 16); o.z = e[4] | (e[5] << 16); o.w = e[6] | (e[7] << 16);
            *(GAS v4u*)(vdst + pi * 8) = o;
        }
    }
    float gqv[8];
#pragma unroll
    for (int j = 0; j < 8; ++j) gqv[j] = A.g_q[8 * (lane & 7) + j];
    const float gkv = A.g_k[lane], gikv = A.g_ik[lane];
    for (int m0 = m_begin; m0 < m_begin + rpw; m0 += 4) {
        v4u qr[4]; float kv[4], ikv[4], iwr[4];
#pragma unroll
        for (int r = 0; r < 4; ++r) { bf16* zr = Z + (size_t)(m0 + r) * ZW;
#ifndef QN_DSA
            qr[r] = *(GAS v4u*)(zr + 8 * lane);
#endif
            kv[r] = bf2f(zr[ZC_K + lane]); ikv[r] = bf2f(zr[ZC_IK + lane]); iwr[r] = bf2f(zr[ZC_IW + (lane & 3)]); }
        float sk[4], sik[4];
#pragma unroll
        for (int r = 0; r < 4; ++r) { sk[r] = kv[r] * kv[r]; sik[r] = ikv[r] * ikv[r]; }
#pragma unroll
        for (int o = 1; o < 64; o <<= 1) {
#pragma unroll
            for (int r = 0; r < 4; ++r) { sk[r] += __shfl_xor(sk[r], o); sik[r] += __shfl_xor(sik[r], o); }
        }
#pragma unroll
        for (int r = 0; r < 4; ++r) {
            const int m = m0 + r, b = m >> 11, s = m & (SEQ - 1);
            bf16* zr = Z + (size_t)m * ZW;
#ifndef QN_DSA
            float q[8] = {bflo(qr[r].x), bfhi(qr[r].x), bflo(qr[r].y), bfhi(qr[r].y), bflo(qr[r].z), bfhi(qr[r].z), bflo(qr[r].w), bfhi(qr[r].w)};
            float ss = 0.f;
#pragma unroll
            for (int j = 0; j < 8; ++j) ss += q[j] * q[j];
            ss += __shfl_xor(ss, 1); ss += __shfl_xor(ss, 2); ss += __shfl_xor(ss, 4);
            const float rstd = QSCALE / sqrtf(ss * (1.f / 64.f) + EPS);
#pragma unroll
            for (int j = 0; j < 8; ++j) q[j] = q[j] * rstd * gqv[j];
            v4u o; o.x = pk2(q[0], q[1]); o.y = pk2(q[2], q[3]); o.z = pk2(q[4], q[5]); o.w = pk2(q[6], q[7]);
            *(GAS v4u*)(zr + 8 * lane) = o;
#else
            (void)zr; (void)gqv;
#endif
            const float rk = 1.0f / sqrtf(sk[r] * (1.f / 64.f) + EPS), rik = 0.125f / sqrtf(sik[r] * (1.f / 64.f) + EPS);
            const size_t xo = ((((size_t)b * 64 + (s >> 5)) * 4 + (lane >> 4)) * 32 + (s & 31)) * 16 + (lane & 15);
            KX[xo] = (bf16)f2bf(kv[r] * rk * gkv);
            IKX[xo] = (bf16)f2bf(ikv[r] * rik * gikv);
            if (lane < 4) IW[(size_t)m * 4 + lane] = 0.5f * iwr[r];
        }
    }
}


__device__ __forceinline__ void p4_naive(Frame& F, const Args& A) {
    const bf16* POOLED = (const bf16*)(A.ws + WS_POOLED); bf16* PM = (bf16*)(A.ws + WS_PM);
    const int lane = F.lane, g = lane >> 4, d0 = 8 * (lane & 15);
    for (int m = F.gw; m < T; m += F.NGW) {
        float acc[8];
#pragma unroll
        for (int j = 0; j < 8; ++j) acc[j] = 0.f;
        for (int c = 0; c < 128; ++c) {
            const float p = bf2f(POOLED[(size_t)m * 512 + g * 128 + c]);
            const float* w = A.w_grp + ((size_t)g * 128 + c) * 128 + d0;
#pragma unroll
            for (int j = 0; j < 8; ++j) acc[j] = fmaf(p, w[j], acc[j]);
        }
        const float* sp = A.s_pool + g * 128 + d0;
        v4u o; o.x = pk2(acc[0] * sp[0], acc[1] * sp[1]); o.y = pk2(acc[2] * sp[2], acc[3] * sp[3]); o.z = pk2(acc[4] * sp[4], acc[5] * sp[5]); o.w = pk2(acc[6] * sp[6], acc[7] * sp[7]);
        *(GAS v4u*)(PM + (size_t)m * 512 + 8 * lane) = o;
    }
}


__device__ __forceinline__ void dbg_pool_check(Frame& F, const Args& A) {
    if (blockIdx.x != 0) return;
    unsigned char* ws = A.ws;
    const bf16* Z = (const bf16*)(ws + WS_Z); const bf16* POOLED = (const bf16*)(ws + WS_POOLED); const bf16* PM = (const bf16*)(ws + WS_PM); const bf16* MIN = (const bf16*)(ws + WS_MIN); const bf16* WUP = (const bf16*)(ws + WS_WUP);
    unsigned* flag = (unsigned*)(ws + WS_CTL) + 64;
    const int t = F.tid;
    const int r = (int)(((long long)t * 2579 + 17) % T), c = (t * 131 + 5) % 1024;
    unsigned f = 0u;
    { const int k = (t * 7) % 512; if (WUP[(size_t)c * 512 + k] != (bf16)f2bf(A.w_up[(size_t)k * 1024 + c])) f |= 8u; }
    const int n = c % 512, g = n >> 7, w = 2 << g, s = r & (SEQ - 1);
    { const int lo = (s + 1 - w) > 0 ? (s + 1 - w) : 0, cnt = s + 1 - lo; float sum = 0.f;
      for (int i = 0; i < cnt; ++i) sum += bf2f(Z[(size_t)(r - i) * ZW + ZC_ZP + n]);
      const float e = sum / (float)cnt - bf2f(Z[(size_t)r * ZW + ZC_ZP + n]), got = bf2f(POOLED[(size_t)r * 512 + n]);
      if (fabsf(got - e) > 0.02f * fabsf(e) + 0.02f) f |= 1u; }
    { float acc = 0.f; for (int cc = 0; cc < 128; ++cc) acc += bf2f(POOLED[(size_t)r * 512 + g * 128 + cc]) * A.w_grp[((size_t)g * 128 + cc) * 128 + (n & 127)];
      const float e = acc * A.s_pool[n], got = bf2f(PM[(size_t)r * 512 + n]);
      if (fabsf(got - e) > 0.02f * fabsf(e) + 0.02f) f |= 2u; }
    { float acc = 0.f; for (int k = 0; k < 512; ++k) acc += bf2f(PM[(size_t)r * 512 + k]) * A.w_up[(size_t)k * 1024 + c];
      const float e = acc * bf2f(Z[(size_t)r * ZW + ZC_GP + c]), got = bf2f(MIN[(size_t)r * 1024 + c]);
      if (fabsf(got - e) > 0.02f * fabsf(e) + 0.02f) f |= 4u; }
    if (f) atomicOr(flag, f);
}
__device__ __forceinline__ void dbg_min_check(Frame& F, const Args& A) {
    if (blockIdx.x != 0) return;
    unsigned char* ws = A.ws;
    const bf16* Z = (const bf16*)(ws + WS_Z); const bf16* PM = (const bf16*)(ws + WS_PM); const bf16* MIN = (const bf16*)(ws + WS_MIN); const bf16* ATT = (const bf16*)(ws + WS_ATT);
    unsigned* flag = (unsigned*)(ws + WS_CTL) + 64;
    const int t = F.tid;
    const int r = (int)(((long long)t * 2579 + 17) % T), c = (t * 131 + 5) % 1024;
    float a1 = 0.f, a2 = 0.f;
    for (int k = 0; k < 512; ++k) { a1 += bf2f(PM[(size_t)r * 512 + k]) * A.w_up[(size_t)k * 1024 + c]; a2 += bf2f(ATT[(size_t)r * 512 + k]) * A.w_ua[(size_t)k * 1024 + c]; }
    const float e = a1 * bf2f(Z[(size_t)r * ZW + ZC_GP + c]) + a2 * bf2f(Z[(size_t)r * ZW + ZC_GA + c]), got = bf2f(MIN[(size_t)r * 1024 + c]);
    if (fabsf(got - e) > 0.03f * fabsf(e) + 0.03f) atomicOr(flag, 32u);
}
__device__ __forceinline__ void dbg_report(const Args& A) {
    if (blockIdx.x == 0 && threadIdx.x == 0) {
        const unsigned f = *((volatile unsigned*)(A.ws + WS_CTL) + 64);
        float add = 0.f; if (f & 1u) add += 1e4f; if (f & 2u) add += 1e5f; if (f & 4u) add += 1e6f; if (f & 8u) add += 1e7f; if (f & 16u) add += 3e3f; if (f & 32u) add += 1e8f;
        A.out[0] += add;
    }
}

constexpr int DSA_HS = 288;
constexpr int DSA_HIST = 0, DSA_STG = 73728, DSA_STGB = 32768, DSA_MASK = DSA_STG + 65536, DSA_PRE = DSA_MASK + 16384, DSA_KREM = DSA_PRE + 256;
static_assert(64 * DSA_HS * 4 <= DSA_STG, "DSA histogram rows");
static_assert(DSA_KREM + 256 <= LDSCTL_OFF, "DSA LDS map");

__device__ __forceinline__ unsigned umax(unsigned a, unsigned b) { return a > b ? a : b; }
__device__ __forceinline__ unsigned umin(unsigned a, unsigned b) { return a < b ? a : b; }
#define GLDS16(gsrc, ldst) __builtin_amdgcn_global_load_lds((const unsigned*)(gsrc), (LAS unsigned*)(ldst), 16, 0, 0)
__device__ __forceinline__ void idx_scores(const LAS unsigned char* ikt, const bf16x8 (&aiq)[4], const f32x4 (&iwv)[4], int lane, unsigned (&u)[4]) {
    f32x16 acc;
#pragma unroll
    for (int r = 0; r < 16; ++r) acc[r] = 0.f;
    const LAS unsigned char* p = ikt + (lane & 31) * 32 + (lane >> 5) * 16;
#pragma unroll
    for (int ks = 0; ks < 4; ++ks) { const bf16x8 bik = *(const LAS bf16x8*)(p + ks * 1024); acc = __builtin_amdgcn_mfma_f32_32x32x16_bf16(aiq[ks], bik, acc, 0, 0, 0); }
#pragma unroll
    for (int j = 0; j < 4; ++j) {
        float s = fmaxf(acc[4 * j + 0], 0.f) * iwv[j][0];
        s = __builtin_fmaf(fmaxf(acc[4 * j + 1], 0.f), iwv[j][1], s);
        s = __builtin_fmaf(fmaxf(acc[4 * j + 2], 0.f), iwv[j][2], s);
        s = __builtin_fmaf(fmaxf(acc[4 * j + 3], 0.f), iwv[j][3], s);
        u[j] = (s == 0.f) ? 0x80000000u : ordf(s);
    }
}

__device__ __forceinline__ bool hist_scan(LAS unsigned* HIST, LAS unsigned* PRE, LAS unsigned* KREM, int wave, int lane) {
    bool exact = true;
    for (int i = 0; i < 8; ++i) {
        const int q = 8 * wave + i;
        const v4u c4 = *(const LAS v4u*)(HIST + q * DSA_HS + 252 - 4 * lane);
        const unsigned c0 = c4.w, c1 = c4.z, c2 = c4.y, c3 = c4.x, ssum = c0 + c1 + c2 + c3;
        unsigned incl = ssum;
#pragma unroll
        for (int o = 1; o < 64; o <<= 1) { const unsigned t = __shfl_up(incl, o); if (lane >= o) incl += t; }
        const unsigned k = KREM[q], pold = PRE[q];
        const unsigned long long bal = __ballot(incl >= k);
        const int L = bal ? (__ffsll((long long)bal) - 1) : 63;
        unsigned a = __shfl(incl - ssum, L);
        const unsigned d0 = __shfl(c0, L), d1 = __shfl(c1, L), d2 = __shfl(c2, L), d3 = __shfl(c3, L);
        int bin; unsigned dsel;
        if (a + d0 >= k) { bin = 255 - 4 * L; dsel = d0; }
        else { a += d0; if (a + d1 >= k) { bin = 254 - 4 * L; dsel = d1; } else { a += d1; if (a + d2 >= k) { bin = 253 - 4 * L; dsel = d2; } else { a += d2; bin = 252 - 4 * L; dsel = d3; } } }
        const unsigned pnew = (pold << 8) | (unsigned)bin;
        exact = exact && (dsel == k - a) && (pnew != 0u);
        if (lane == 0) { PRE[q] = pnew; KREM[q] = k - a; }
    }
    return __builtin_amdgcn_readfirstlane((int)exact) != 0;
}

template <int VAR> __device__ __forceinline__ void dsa_attend(const bf16* Z, const unsigned char* KX, const unsigned char* VX, bf16* ATT, LAS unsigned char* STG, LAS unsigned* MASKW,
                                                          int tq, size_t kblk0, int nsteps, int c, int lane, int wave, int tid, const float* GQ) {
        const int half = lane >> 5, l31 = lane & 31;
#ifdef NO_PRIO_DSA
        if (wave >> 2) __builtin_amdgcn_s_setprio(2);
#endif
        bf16x8 bq[2][4];
#pragma unroll
        for (int ct = 0; ct < 2; ++ct) { const bf16* qp = Z + (size_t)(tq + 4 * ct + (l31 >> 3)) * ZW + ZC_Q + (l31 & 7) * 64 + half * 8;
#pragma unroll
            for (int ks = 0; ks < 4; ++ks) bq[ct][ks] = *(const GAS bf16x8*)(qp + 16 * ks); }
#ifdef QN_DSA
#pragma unroll
        for (int ct = 0; ct < 2; ++ct) {
            float qf[4][8]; float ss = 0.f;
#pragma unroll
            for (int ks = 0; ks < 4; ++ks) { const v4u w = __builtin_bit_cast(v4u, bq[ct][ks]);
                qf[ks][0] = bflo(w.x); qf[ks][1] = bfhi(w.x); qf[ks][2] = bflo(w.y); qf[ks][3] = bfhi(w.y); qf[ks][4] = bflo(w.z); qf[ks][5] = bfhi(w.z); qf[ks][6] = bflo(w.w); qf[ks][7] = bfhi(w.w);
#pragma unroll
                for (int jj = 0; jj < 8; ++jj) ss += qf[ks][jj] * qf[ks][jj]; }
            ss = xhalf_sum(ss);
            const float rstd = QSCALE / sqrtf(ss * (1.f / 64.f) + EPS);
#pragma unroll
            for (int ks = 0; ks < 4; ++ks) { const f32x4 g0 = *(const GAS f32x4*)(GQ + 16 * ks + 8 * half), g1 = *(const GAS f32x4*)(GQ + 16 * ks + 8 * half + 4);
                v4u o; o.x = pk2(qf[ks][0] * rstd * g0.x, qf[ks][1] * rstd * g0.y); o.y = pk2(qf[ks][2] * rstd * g0.z, qf[ks][3] * rstd * g0.w);
                o.z = pk2(qf[ks][4] * rstd * g1.x, qf[ks][5] * rstd * g1.y); o.w = pk2(qf[ks][6] * rstd * g1.z, qf[ks][7] * rstd * g1.w);
                bq[ct][ks] = __builtin_bit_cast(bf16x8, o); }
        }
#endif
        f32x16 O[2][2];
#pragma unroll
        for (int ct = 0; ct < 2; ++ct)
#pragma unroll
            for (int rt = 0; rt < 2; ++rt)
#pragma unroll
                for (int r = 0; r < 16; ++r) O[ct][rt][r] = 0.f;
        float m_run[2] = {-1e30f, -1e30f}, l_run[2] = {0.f, 0.f};
        const int qsel = (lane >> 3) & 3;
        const bool all_on = (c < 4);
#ifdef ATT_BIG8
        constexpr int AB = 4; LAS unsigned char* const ABASE = STG - DSA_STG; constexpr int ABUFB = 65536;
        __syncthreads();
#else
#ifndef ATT_AB
#define ATT_AB 2
#endif
        constexpr int AB = ATT_AB; LAS unsigned char* const ABASE = STG; constexpr int ABUFB = DSA_STGB;
#endif
        constexpr int AVOFF = AB * 8192;
        const int nbig2 = (nsteps + AB - 1) / AB;
        { const int ns0 = nsteps < AB ? nsteps : AB;
#pragma unroll
          for (int k = 0; k < AB; ++k) if (k < ns0) { GLDS16(KX + kblk0 + (size_t)k * 8192 + (size_t)tid * 16, ABASE + k * 8192 + wave * 1024); GLDS16(VX + kblk0 + (size_t)k * 8192 + (size_t)tid * 16, ABASE + AVOFF + k * 8192 + wave * 1024); } }
        __syncthreads();
        for (int bs = 0; bs < nbig2; ++bs) {
            const int nsub = (nsteps - AB * bs) < AB ? (nsteps - AB * bs) : AB;
            const int nnext = (bs + 1 < nbig2) ? ((nsteps - AB * (bs + 1)) < AB ? (nsteps - AB * (bs + 1)) : AB) : 0;
#pragma unroll
            for (int k = 0; k < AB; ++k) if (VAR != 5 && k < nnext) { const size_t o = kblk0 + (size_t)(AB * (bs + 1) + k) * 8192 + (size_t)tid * 16; LAS unsigned char* nb = ABASE + ((bs + 1) & 1) * ABUFB + k * 8192 + wave * 1024; GLDS16(KX + o, nb); GLDS16(VX + o, nb + AVOFF); }
            const LAS unsigned char* buf = ABASE + (bs & 1) * ABUFB;
#pragma unroll 1
            for (int tl = 0; tl < 2 * nsub; ++tl) {
                const LAS unsigned char* kp = buf + (VAR == 4 ? 0 : tl) * 4096 + l31 * 32 + half * 16;
                bf16x8 kf[4];
#pragma unroll
                for (int ks = 0; ks < 4; ++ks) kf[ks] = *(const LAS bf16x8*)(kp + ks * 1024);
                const LAS unsigned char* vp = buf + AVOFF + (VAR == 4 ? 0 : tl) * 4096 + l31 * 32 + half * 16;
                bf16x8 vf[2][2];
#pragma unroll
                for (int rt = 0; rt < 2; ++rt)
#pragma unroll
                    for (int s = 0; s < 2; ++s) vf[rt][s] = *(const LAS bf16x8*)(vp + (rt * 2 + s) * 1024);
#ifdef ATT_S2
                f32x16 sacc2[2];
#pragma unroll
                for (int ct = 0; ct < 2; ++ct) {
#pragma unroll
                    for (int r = 0; r < 16; ++r) sacc2[ct][r] = 0.f;
#pragma unroll
                    for (int ks = 0; ks < 4; ++ks) sacc2[ct] = __builtin_amdgcn_mfma_f32_32x32x16_bf16(kf[ks], bq[ct][ks], sacc2[ct], 0, 0, 0);
                }
#endif
#pragma unroll
                for (int ct = 0; ct < 2; ++ct) {
#ifdef ATT_S2
                    const f32x16 sacc = sacc2[ct];
#else
                    f32x16 sacc;
#pragma unroll
                    for (int r = 0; r < 16; ++r) sacc[r] = 0.f;
#pragma unroll
                    for (int ks = 0; ks < (VAR == 2 ? 1 : 4); ++ks) sacc = __builtin_amdgcn_mfma_f32_32x32x16_bf16(kf[ks], bq[ct][ks], sacc, 0, 0, 0);
#endif
                    const unsigned Wq = all_on ? 0xFFFFFFFFu : MASKW[(8 * wave + 4 * ct + qsel) * 64 + 2 * AB * bs + tl];
                    const unsigned Wh = Wq >> (4 * half);
                    float mx = fmaxf(fmaxf(sacc[0], sacc[1]), sacc[2]);
#pragma unroll
                    for (int r = 3; r < 15; r += 2) mx = fmaxf(fmaxf(mx, sacc[r]), sacc[r + 1]);
                    mx = fmaxf(mx, sacc[15]);
                    mx = xhalf_max(mx);
                    const float m_new = fmaxf(m_run[ct], mx);
                    const float alpha = __builtin_amdgcn_exp2f(m_run[ct] - m_new);
                    m_run[ct] = m_new;
                    unsigned pw[8]; float psum = 0.f;
#pragma unroll
                    for (int i = 0; i < 8; ++i) {
                        const int r0 = 2 * i, b0 = (r0 & 3) + 8 * (r0 >> 2);
                        const unsigned k0 = (unsigned)__builtin_amdgcn_sbfe((int)Wh, b0, 1), k1 = (unsigned)__builtin_amdgcn_sbfe((int)Wh, b0 + 1, 1);
                        const unsigned keep = __builtin_amdgcn_perm(k1, k0, 0x05040100u);
                        const unsigned pk = (VAR == 1 ? pk2(sacc[r0] - m_new, sacc[r0 + 1] - m_new) : pk2(__builtin_amdgcn_exp2f(sacc[r0] - m_new), __builtin_amdgcn_exp2f(sacc[r0 + 1] - m_new))) & keep;
                        pw[i] = pk;
                        psum = __builtin_amdgcn_fdot2_f32_bf16(__builtin_bit_cast(bf16x2_t, pk), __builtin_bit_cast(bf16x2_t, 0x3F803F80u), psum, false);
                    }
                    l_run[ct] = l_run[ct] * alpha + psum;
                    if (__any(alpha != 1.0f)) {
#pragma unroll
                        for (int rt = 0; rt < 2; ++rt)
#pragma unroll
                            for (int r = 0; r < 16; ++r) O[ct][rt][r] *= alpha;
                    }
                    bf16x8 pb[2];
#pragma unroll
                    for (int s = 0; s < 2; ++s) pb[s] = __builtin_bit_cast(bf16x8, (v4u){pw[4 * s], pw[4 * s + 1], pw[4 * s + 2], pw[4 * s + 3]});
#pragma unroll
                    for (int rt = 0; rt < (VAR == 3 ? 1 : 2); ++rt)
#pragma unroll
                        for (int s = 0; s < (VAR == 3 ? 1 : 2); ++s) O[ct][rt] = __builtin_amdgcn_mfma_f32_32x32x16_bf16(vf[rt][s], pb[s], O[ct][rt], 0, 0, 0);
                }
            }
            if (VAR != 5) __syncthreads();
        }
        if (VAR == 5) __syncthreads();
#pragma unroll
        for (int ct = 0; ct < 2; ++ct) {
            const float inv = 1.0f / xhalf_sum(l_run[ct]);
            bf16* op = ATT + (size_t)(tq + 4 * ct + (l31 >> 3)) * 512 + (l31 & 7) * 64 + 4 * half;
#pragma unroll
            for (int rt = 0; rt < 2; ++rt)
#pragma unroll
                for (int g = 0; g < 4; ++g) {
                    v2u w; w.x = pk2(O[ct][rt][4 * g] * inv, O[ct][rt][4 * g + 1] * inv); w.y = pk2(O[ct][rt][4 * g + 2] * inv, O[ct][rt][4 * g + 3] * inv);
                    *(GAS v2u*)(op + 32 * rt + 8 * g) = w;
                }
        }
#ifdef NO_PRIO_DSA
        __builtin_amdgcn_s_setprio(0);
#endif
}

__device__ __forceinline__ void dsa_phase(Frame& F, const Args& A) {
    unsigned char* ws = A.ws;
    const bf16* Z = (const bf16*)(ws + WS_Z); const unsigned char* IKX = ws + WS_IKX; const unsigned char* KX = ws + WS_KX; const unsigned char* VX = ws + WS_VX;
    const float* IW = (const float*)(ws + WS_IW); bf16* ATT = (bf16*)(ws + WS_ATT);
    const int lane = F.lane, wave = F.wave, tid = F.tid, half = lane >> 5, l31 = lane & 31;
    LAS unsigned* HIST = (LAS unsigned*)(F.lds + DSA_HIST);
    LAS unsigned* PRE = (LAS unsigned*)(F.lds + DSA_PRE);
    LAS unsigned* KREM = (LAS unsigned*)(F.lds + DSA_KREM);
    LAS unsigned* MASKW = (LAS unsigned*)(F.lds + DSA_MASK);
    LAS unsigned char* STG = F.lds + DSA_STG;

    for (int P = F.vcu; P < 512; P += F.G) {
      for (int side = 0; side < 2; ++side) {
        const int b = P >> 4, c = side ? 31 - (P & 15) : (P & 15);
        const int nsteps = c + 1;
        const int tq = b * SEQ + 64 * c + 8 * wave;
        const size_t kblk0 = (size_t)b * 64 * 4096;
#ifndef DSA_REP_SEL
#define DSA_REP_SEL 1
#endif
#ifndef DSA_REP_ATT
#define DSA_REP_ATT 1
#endif
        for (int rs_ = 0; rs_ < DSA_REP_SEL; ++rs_)
        if (c >= 4) {
            const int v_ = F.vcu;
            const size_t scb = v_ < 128 ? WS_PM + (size_t)v_ * (512 * 1024) : v_ < 172 ? 42 * MiB + (size_t)(v_ - 128) * (512 * 1024) : v_ < 220 ? 72 * MiB + (size_t)(v_ - 172) * (512 * 1024) : 104 * MiB + (size_t)(v_ - 220) * (512 * 1024);
            unsigned* SC = (unsigned*)(ws + scb) + (size_t)(wave * 64 + lane) * 4;
            if (lane < 8) { PRE[8 * wave + lane] = 0u; KREM[8 * wave + lane] = 256u; }
#ifndef DSA_REP_P0
#define DSA_REP_P0 1
#endif
            for (int rp0_ = 0; rp0_ < DSA_REP_P0; ++rp0_) {
#pragma unroll
            for (int i = 0; i < 8; ++i) *(LAS v4u*)(HIST + (wave * 8 + i) * DSA_HS + lane * 4) = (v4u){0u, 0u, 0u, 0u};
            {
                bf16x8 aiq[4];
                { const bf16* zq = Z + (size_t)(tq + (l31 >> 2)) * ZW + ZC_IQ + (l31 & 3) * 64 + half * 8;
#pragma unroll
                  for (int ks = 0; ks < 4; ++ks) aiq[ks] = *(const GAS bf16x8*)(zq + 16 * ks); }
                f32x4 iwv[4];
#pragma unroll
                for (int j = 0; j < 4; ++j) iwv[j] = *(const GAS f32x4*)(IW + (size_t)(tq + 2 * j + half) * 4);
                const int nbig = (nsteps + 3) >> 2;
                { const int ns0 = nsteps < 4 ? nsteps : 4;
#pragma unroll
                  for (int k = 0; k < 4; ++k) if (k < ns0) GLDS16(IKX + kblk0 + (size_t)k * 8192 + (size_t)tid * 16, STG + k * 8192 + wave * 1024); }
                __syncthreads();
                unsigned WB = 0u; unsigned long long pkc[4] = {0ull, 0ull, 0ull, 0ull};
                for (int bs = 0; bs < nbig; ++bs) {
                    const int nsub = (nsteps - 4 * bs) < 4 ? (nsteps - 4 * bs) : 4;
                    const int nnext = (bs + 1 < nbig) ? ((nsteps - 4 * (bs + 1)) < 4 ? (nsteps - 4 * (bs + 1)) : 4) : 0;
#pragma unroll
                    for (int k = 0; k < 4; ++k) if (k < nnext) GLDS16(IKX + kblk0 + (size_t)(4 * (bs + 1) + k) * 8192 + (size_t)tid * 16, STG + ((bs + 1) & 1) * DSA_STGB + k * 8192 + wave * 1024);
                    const LAS unsigned char* buf = STG + (bs & 1) * DSA_STGB;
                    for (int sb = 0; sb < nsub; ++sb) {
                        unsigned uu[2][4];
                        idx_scores(buf + sb * 8192, aiq, iwv, lane, uu[0]);
                        idx_scores(buf + sb * 8192 + 4096, aiq, iwv, lane, uu[1]);
                        if (bs == 0 && sb == 0) {
                            unsigned fm = 0u;
#pragma unroll
                            for (int t2 = 0; t2 < 2; ++t2)
#pragma unroll
                                for (int j = 0; j < 4; ++j) { const unsigned u = uu[t2][j]; fm = umax(fm, umax(u >> 24, (~u) >> 24)); }
#pragma unroll
                            for (int o = 1; o < 64; o <<= 1) fm = umax(fm, (unsigned)__shfl_xor((int)fm, o));
                            WB = (unsigned)__builtin_amdgcn_readfirstlane((int)fm) - 3u;
                        }
#pragma unroll
                        for (int t2 = 0; t2 < 2; ++t2) {
                            const int tile = 8 * bs + 2 * sb + t2;
                            *(GAS v4u*)(SC + (size_t)tile * 2048) = (v4u){uu[t2][0], uu[t2][1], uu[t2][2], uu[t2][3]};
#pragma unroll
                            for (int j = 0; j < 4; ++j) {
                                const unsigned u = uu[t2][j], bin = u >> 24, nb = (~u) >> 24, slot = umax(bin, nb) - WB;
                                if (slot < 4u) pkc[j] += 1ull << (8u * slot + ((nb >> 7) << 5));
                                else __hip_atomic_fetch_add(HIST + (8 * wave + 2 * j + half) * DSA_HS + bin, 1u, __ATOMIC_RELAXED, __HIP_MEMORY_SCOPE_WORKGROUP);
                            }
                        }
                    }
                    __syncthreads();
                }
#pragma unroll
                for (int j = 0; j < 4; ++j) {
                    const unsigned lo = (unsigned)pkc[j], hi = (unsigned)(pkc[j] >> 32);
                    unsigned f[4] = {lo & 0x00FF00FFu, (lo >> 8) & 0x00FF00FFu, hi & 0x00FF00FFu, (hi >> 8) & 0x00FF00FFu};
#pragma unroll
                    for (int o = 1; o < 32; o <<= 1)
#pragma unroll
                        for (int i = 0; i < 4; ++i) f[i] += (unsigned)__shfl_xor((int)f[i], o);
                    const unsigned sc8[8] = {f[0] & 0xFFFFu, f[1] & 0xFFFFu, f[0] >> 16, f[1] >> 16, f[2] & 0xFFFFu, f[3] & 0xFFFFu, f[2] >> 16, f[3] >> 16};
                    unsigned mine = 0u;
#pragma unroll
                    for (int s8 = 0; s8 < 8; ++s8) mine = (l31 == s8) ? sc8[s8] : mine;
                    const unsigned fbv = WB + (unsigned)(l31 & 3), bin = (l31 & 4) ? (255u - fbv) : fbv;
                    if (l31 < 8 && mine != 0u) __hip_atomic_fetch_add(HIST + (8 * wave + 2 * j + half) * DSA_HS + (bin & 255u), mine, __ATOMIC_RELAXED, __HIP_MEMORY_SCOPE_WORKGROUP);
                }
            }
            }
            bool exact = hist_scan(HIST, PRE, KREM, wave, lane);
            for (int pass = 1; pass < 5; ++pass) {
                if (pass < 4 && exact) {
                    if (lane < 8) { const int q = 8 * wave + lane; PRE[q] = (PRE[q] << (8 * (4 - pass))) - 1u; KREM[q] = 0u; }
                    pass = 4;
                }
                unsigned pre[4], krem[4], eqrun[4];
#pragma unroll
                for (int j = 0; j < 4; ++j) { pre[j] = PRE[8 * wave + 2 * j + half]; krem[j] = KREM[8 * wave + 2 * j + half]; eqrun[j] = 0u; }
                if (pass < 4) {
#pragma unroll
                    for (int i = 0; i < 8; ++i) *(LAS v4u*)(HIST + (wave * 8 + i) * DSA_HS + lane * 4) = (v4u){0u, 0u, 0u, 0u};
                }
                const int sh_hi = 32 - 8 * pass, sh_lo = 24 - 8 * pass;
                const unsigned lmask = (1u << l31) - 1u;
                {
                    const int ntiles = 2 * nsteps;
                    v4u nx[4];
#pragma unroll
                    for (int k = 0; k < 4; ++k) { nx[k] = (v4u){0u, 0u, 0u, 0u}; if (k < ntiles) nx[k] = *(const GAS v4u*)(SC + (size_t)k * 2048); }
                    for (int t0 = 0; t0 < ntiles; t0 += 4) {
                        v4u cur[4];
#pragma unroll
                        for (int k = 0; k < 4; ++k) { cur[k] = nx[k]; if (t0 + 4 + k < ntiles) nx[k] = *(const GAS v4u*)(SC + (size_t)(t0 + 4 + k) * 2048); }
#pragma unroll
                        for (int k = 0; k < 4; ++k) {
                            const int tile = t0 + k;
                            if (tile < ntiles) {
                                const unsigned u4[4] = {cur[k].x, cur[k].y, cur[k].z, cur[k].w};
                                if (pass < 4) {
#pragma unroll
                                    for (int j = 0; j < 4; ++j) {
                                        const unsigned u = u4[j];
                                        if ((u >> sh_hi) == pre[j]) __hip_atomic_fetch_add(HIST + (8 * wave + 2 * j + half) * DSA_HS + ((u >> sh_lo) & 255u), 1u, __ATOMIC_RELAXED, __HIP_MEMORY_SCOPE_WORKGROUP);
                                    }
                                } else {
#pragma unroll
                                    for (int j = 0; j < 4; ++j) {
                                        const unsigned u = u4[j];
                                        const bool e = (u == pre[j]);
                                        const unsigned long long em = __ballot(e);
                                        const unsigned mine = half ? (unsigned)(em >> 32) : (unsigned)em;
                                        const unsigned rank = eqrun[j] + __popc(mine & lmask);
                                        eqrun[j] += __popc(mine);
                                        const bool sel = (u > pre[j]) || (e && rank < krem[j]);
                                        const unsigned long long sm = __ballot(sel);
                                        if (lane == 0) { MASKW[(8 * wave + 2 * j) * 64 + tile] = (unsigned)sm; MASKW[(8 * wave + 2 * j + 1) * 64 + tile] = (unsigned)(sm >> 32); }
                                    }
                                }
                            }
                        }
                    }
                }
                if (pass < 4) exact = hist_scan(HIST, PRE, KREM, wave, lane);
            }
#ifdef DBG_SEL
            for (int i = 0; i < 8; ++i) {
                unsigned v = (lane < 2 * nsteps) ? (unsigned)__popc(MASKW[(8 * wave + i) * 64 + lane]) : 0u;
#pragma unroll
                for (int o = 1; o < 64; o <<= 1) v += (unsigned)__shfl_xor((int)v, o);
                if (lane == 0 && v != 256u) atomicOr((unsigned*)(ws + WS_CTL) + 64, 1u);
            }
#endif
        }

#if DSA_REP_ATT == 2
        dsa_attend<ATT_VARIANT>(Z, KX, VX, ATT, STG, MASKW, tq, kblk0, nsteps, c, lane, wave, tid, A.g_q);
#endif
        dsa_attend<0>(Z, KX, VX, ATT, STG, MASKW, tq, kblk0, nsteps, c, lane, wave, tid, A.g_q);
      }
    }
}

template <int BASE, int N> __device__ __forceinline__ void sort16(float (&v)[N]) {
    constexpr int NCE = 60;
    constexpr unsigned char CI[NCE] = {0,1,2,3,4,5,7,9, 0,1,2,3,6,8,10,11, 0,2,4,6,7,10,12,14, 0,1,4,5,6,8,12,13, 1,3,4,5,8,9,13, 1,2,5,7,9,11, 2,3,9,11, 3,6,7,10, 3,5,7,9,11, 6,8};
    constexpr unsigned char CJ[NCE] = {13,12,15,14,8,6,11,10, 5,7,9,4,13,14,15,12, 1,3,5,8,9,11,13,15, 2,3,10,11,7,9,14,15, 2,12,6,7,10,11,14, 4,6,8,10,13,14, 4,6,12,13, 5,8,9,12, 4,6,8,10,12, 7,9};
#pragma unroll
    for (int c = 0; c < NCE; ++c) { const float x = v[BASE + CI[c]], y = v[BASE + CJ[c]]; v[BASE + CI[c]] = fmaxf(x, y); v[BASE + CJ[c]] = fminf(x, y); }
}
template <int A0, int B0, int N> __device__ __forceinline__ void merge16(float (&v)[N]) {
#pragma unroll
    for (int i = 0; i < 16; ++i) v[A0 + i] = fmaxf(v[A0 + i], v[B0 + 15 - i]);
#pragma unroll
    for (int j = 8; j > 0; j >>= 1)
#pragma unroll
        for (int i = 0; i < 16; ++i) { const int l = i ^ j; if (l > i) { const float x = v[A0 + i], y = v[A0 + l]; v[A0 + i] = fmaxf(x, y); v[A0 + l] = fminf(x, y); } }
}
__device__ __forceinline__ void top16_of64(float (&v)[64]) {
    sort16<0, 64>(v); sort16<16, 64>(v); sort16<32, 64>(v); sort16<48, 64>(v);
    merge16<0, 16, 64>(v); merge16<32, 48, 64>(v); merge16<0, 32, 64>(v);
}
__device__ __forceinline__ void peer_half(const bf16x8 (&bqf)[4], const LAS unsigned char* skl, int p, int lane, float (&lst)[16]) {
    const int half = lane >> 5, l31 = lane & 31;
    float v[64];
    const LAS unsigned char* ap = skl + p * 16384 + l31 * 32 + half * 16;
#pragma unroll
    for (int rt = 0; rt < 4; ++rt) {
        f32x16 acc;
#pragma unroll
        for (int r = 0; r < 16; ++r) acc[r] = 0.f;
#pragma unroll
        for (int ks = 0; ks < 4; ++ks) { const bf16x8 af = *(const LAS bf16x8*)(ap + (rt * 4 + ks) * 1024); acc = __builtin_amdgcn_mfma_f32_32x32x16_bf16(af, bqf[ks], acc, 0, 0, 0); }
#pragma unroll
        for (int r = 0; r < 16; ++r) { const unsigned kidx = rt * 32 + (r & 3) + 8 * (r >> 2) + 4 * half; v[rt * 16 + r] = __uint_as_float((__float_as_uint(acc[r]) & ~127u) | (127u - kidx)); }
    }
    top16_of64(v);
    float both[32];
#pragma unroll
    for (int i = 0; i < 16; ++i) { both[i] = v[i]; both[16 + i] = __shfl_xor(v[i], 32); }
    merge16<0, 16, 32>(both);
#pragma unroll
    for (int i = 0; i < 16; ++i) lst[i] = both[i];
}
__device__ __forceinline__ void peer_route(Frame& F, const Args& A) {
    unsigned char* ws = A.ws;
    const bf16* PQ = (const bf16*)(ws + WS_PQ); const bf16* SK = (const bf16*)(ws + WS_SK); int* EIDX = (int*)(ws + WS_EIDX); float* EGATE = (float*)(ws + WS_EGATE);
    const int lane = F.lane;
    LAS unsigned* KL = (LAS unsigned*)(F.lds + F.wave * 8192);
    LAS unsigned char* SKL = F.lds + 65536;
    for (int hp = 0; hp < 4; ++hp) {
        __syncthreads();
#pragma unroll
        for (int i = 0; i < 8; ++i) {
            const int ch = F.tid + 512 * i, c8 = ch & 7, key = (ch >> 3) & 127, p = (ch >> 10) & 1, hh = ch >> 11;
            const v4u r = *(const GAS v4u*)(SK + ((size_t)((2 * hp + hh) * 2 + p) * 128 + key) * 64 + 8 * c8);
            *(LAS v4u*)(SKL + hh * 32768 + ((p * 4 + (key >> 5)) * 4 + (c8 >> 1)) * 1024 + (key & 31) * 32 + (c8 & 1) * 16) = r;
        }
        __syncthreads();
      for (int tt = F.gw * (T / 32 / F.NGW); tt < (F.gw + 1) * (T / 32 / F.NGW); ++tt) {
        const int token = tt * 32 + (lane & 31);
        float l0[16], l1[16];
        {
            const bool hi = lane >= 32;
            const bf16* qa = PQ + (size_t)token * 1024 + (2 * hp) * 128 + (lane >> 5) * 8; const bf16* qb = qa + 128;
            bf16x8 bq[4]; float t[16];
#pragma unroll
            for (int ks = 0; ks < 4; ++ks) bq[ks] = *(const GAS bf16x8*)(qa + 16 * ks);
            peer_half(bq, SKL, 0, lane, l0);
#pragma unroll
            for (int ks = 0; ks < 4; ++ks) bq[ks] = *(const GAS bf16x8*)(qb + 16 * ks);
            peer_half(bq, SKL + 32768, 0, lane, t);
#pragma unroll
            for (int i = 0; i < 16; ++i) l0[i] = hi ? t[i] : l0[i];
#pragma unroll
            for (int ks = 0; ks < 4; ++ks) bq[ks] = *(const GAS bf16x8*)(qa + 64 + 16 * ks);
            peer_half(bq, SKL, 1, lane, l1);
#pragma unroll
            for (int ks = 0; ks < 4; ++ks) bq[ks] = *(const GAS bf16x8*)(qb + 64 + 16 * ks);
            peer_half(bq, SKL + 32768, 1, lane, t);
#pragma unroll
            for (int i = 0; i < 16; ++i) l1[i] = hi ? t[i] : l1[i];
        }
        const int h = 2 * hp + (lane >> 5);
        float s0[16], s1[16];
#pragma unroll
        for (int i = 0; i < 16; ++i) { const unsigned b0 = __float_as_uint(l0[i]), b1 = __float_as_uint(l1[i]); s0[i] = __uint_as_float(b0 & ~127u); s1[i] = __uint_as_float(b1 & ~127u); KL[i * 64 + lane] = 127u - (b0 & 127u); KL[(16 + i) * 64 + lane] = 127u - (b1 & 127u); }
        float cs[64]; int nc = 0;
#pragma unroll
        for (int r = 0; r < 64; ++r) cs[r] = -3.0e38f;
#pragma unroll
        for (int i = 0; i < 16; ++i)
#pragma unroll
            for (int j = 0; j < 16; ++j)
                if ((i + 1) * (j + 1) <= 16) { cs[nc] = __uint_as_float((__float_as_uint(s0[i] + s1[j]) & ~255u) | (255u - (unsigned)(i * 16 + j))); ++nc; }
        top16_of64(cs);
        float ev[16]; unsigned be[16]; float sum = 0.f; const float mx = __uint_as_float(__float_as_uint(cs[0]) & ~255u);
#pragma unroll
        for (int i = 0; i < 16; ++i) {
            const unsigned cb = __float_as_uint(cs[i]); ev[i] = __expf(__uint_as_float(cb & ~255u) - mx); sum += ev[i];
            const unsigned fi = 255u - (cb & 255u);
            be[i] = KL[(fi >> 4) * 64 + lane] * 128u + KL[(16 + (fi & 15u)) * 64 + lane];
        }
        const float inv = 1.0f / sum;
        {
            int* ep = EIDX + (size_t)token * 128 + h * 16; float* gp = EGATE + (size_t)token * 128 + h * 16;
#pragma unroll
            for (int i = 0; i < 4; ++i) {
#ifndef EIDX16
                *(GAS v4u*)(ep + 4 * i) = (v4u){be[4 * i], be[4 * i + 1], be[4 * i + 2], be[4 * i + 3]};
#endif
                *(GAS f32x4*)(gp + 4 * i) = (f32x4){ev[4 * i] * inv, ev[4 * i + 1] * inv, ev[4 * i + 2] * inv, ev[4 * i + 3] * inv};
            }
#ifdef EIDX16
            {
                GAS v4u* e16 = (GAS v4u*)((unsigned short*)EIDX + (size_t)token * 128 + h * 16);
                e16[0] = (v4u){(unsigned)be[0] | ((unsigned)be[1] << 16), (unsigned)be[2] | ((unsigned)be[3] << 16), (unsigned)be[4] | ((unsigned)be[5] << 16), (unsigned)be[6] | ((unsigned)be[7] << 16)};
                e16[1] = (v4u){(unsigned)be[8] | ((unsigned)be[9] << 16), (unsigned)be[10] | ((unsigned)be[11] << 16), (unsigned)be[12] | ((unsigned)be[13] << 16), (unsigned)be[14] | ((unsigned)be[15] << 16)};
            }
#endif
        }
        LDS_WAIT(); asm volatile("" ::: "memory");
      }
    }
}

__device__ __forceinline__ float dot2bf(unsigned w, unsigned x, float acc) { return __builtin_amdgcn_fdot2_f32_bf16(__builtin_bit_cast(bf16x2_t, w), __builtin_bit_cast(bf16x2_t, x), acc, false); }
__device__ __forceinline__ float dot8(v4u a, v4u b, float acc) {
    const unsigned a0 = a.x, a1 = a.y, a2 = a.z, a3 = a.w, b0 = b.x, b1 = b.y, b2 = b.z, b3 = b.w;
    return dot2bf(a3, b3, dot2bf(a2, b2, dot2bf(a1, b1, dot2bf(a0, b0, acc))));
}
__device__ __forceinline__ float dot8f4(unsigned q, v4u h, float acc) {
    const unsigned h0 = h.x, h1 = h.y, h2 = h.z, h3 = h.w;
    acc = __builtin_amdgcn_fdot2_f32_bf16(__builtin_amdgcn_cvt_scalef32_pk_bf16_fp4(q, 1.0f, 0), __builtin_bit_cast(bf16x2_t, h0), acc, false);
    acc = __builtin_amdgcn_fdot2_f32_bf16(__builtin_amdgcn_cvt_scalef32_pk_bf16_fp4(q, 1.0f, 1), __builtin_bit_cast(bf16x2_t, h1), acc, false);
    acc = __builtin_amdgcn_fdot2_f32_bf16(__builtin_amdgcn_cvt_scalef32_pk_bf16_fp4(q, 1.0f, 2), __builtin_bit_cast(bf16x2_t, h2), acc, false);
    acc = __builtin_amdgcn_fdot2_f32_bf16(__builtin_amdgcn_cvt_scalef32_pk_bf16_fp4(q, 1.0f, 3), __builtin_bit_cast(bf16x2_t, h3), acc, false);
    return acc;
}
typedef float f32x2v __attribute__((ext_vector_type(2)));
__device__ __forceinline__ void peer_gather(Frame& F, const Args& A, const bool dummy) {
    unsigned char* ws = A.ws;
    const bf16* H2 = (const bf16*)(ws + WS_H); const unsigned char* U4 = ws + WS_U; const unsigned char* V4 = ws + WS_V;
    const float* SU = (const float*)(ws + WS_SU); const float* SV = (const float*)(ws + WS_SV);
    const int* EIDX = (const int*)(ws + WS_EIDX); const float* EGATE = (const float*)(ws + WS_EGATE); const float* ADA = (const float*)(ws + WS_ADA);
    const int lane = F.lane, grp = lane >> 3, i8 = lane & 7;
    LAS unsigned* WSM = (LAS unsigned*)(F.lds + F.wave * 1024);
    for (int n = F.gw; n < T; n += F.NGW) {
        const int b = n >> 11;
        v4u hh[4][4];
        { const bf16* hp = H2 + (size_t)n * 1024 + 32 * i8;
#pragma unroll
          for (int t = 0; t < 4; ++t)
#pragma unroll
              for (int k = 0; k < 4; ++k) hh[t][k] = *(const GAS v4u*)(hp + 256 * t + 8 * k); }
#pragma unroll 4
        for (int bb = 0; bb < 16; ++bb) {
            const int slot = bb * 8 + grp;
            const int eid = EIDX[(size_t)n * 128 + slot]; const float gt = EGATE[(size_t)n * 128 + slot];
            const unsigned char* up = U4 + (size_t)eid * 512 + 16 * i8;
            v4u q[4];
#pragma unroll
            for (int t = 0; t < 4; ++t) q[t] = *(const GAS v4u*)(up + 128 * t);
            const float su = SU[eid], sv = SV[eid];
            float d0 = 0.f, d1 = 0.f;
#pragma unroll
            for (int t = 0; t < 4; ++t) {
                const unsigned q0 = q[t].x, q1 = q[t].y, q2 = q[t].z, q3 = q[t].w;
                d0 = dot8f4(q0, hh[t][0], d0); d1 = dot8f4(q1, hh[t][1], d1); d0 = dot8f4(q2, hh[t][2], d0); d1 = dot8f4(q3, hh[t][3], d1);
            }
#ifdef GATHER_DUP_U
            { float e0 = 0.f, e1 = 0.f;
#pragma unroll
              for (int t = 0; t < 4; ++t) { const unsigned q0 = q[t].x ^ 0x88888888u, q1 = q[t].y ^ 0x88888888u, q2 = q[t].z ^ 0x88888888u, q3 = q[t].w ^ 0x88888888u;
                e0 = dot8f4(q0, hh[t][0], e0); e1 = dot8f4(q1, hh[t][1], e1); e0 = dot8f4(q2, hh[t][2], e0); e1 = dot8f4(q3, hh[t][3], e1); }
              d0 = 0.5f * (d0 - e0); d1 = 0.5f * (d1 - e1); }
#endif
            float dot = d0 + d1;
            dot += __shfl_xor(dot, 1); dot += __shfl_xor(dot, 2); dot += __shfl_xor(dot, 4);
            dot *= su;
            const float act = 0.5f * dot * (1.0f + erff(dot * 0.70710678118654752f));
            if (i8 == 0) { WSM[2 * slot] = (unsigned)eid; WSM[2 * slot + 1] = __float_as_uint(gt * act * sv); }
        }
        LDS_WAIT(); asm volatile("" ::: "memory");
        f32x2v acc[8];
#pragma unroll
        for (int j = 0; j < 8; ++j) acc[j] = (f32x2v){0.f, 0.f};
#pragma unroll 2
        for (int e0 = 0; e0 < 128; e0 += 16) {
            v2u vv[16]; float ww[16];
#pragma unroll
            for (int j = 0; j < 16; ++j) {
                const v2u ew = *(const LAS v2u*)(WSM + 2 * (e0 + j));
                const int eid = __builtin_amdgcn_readfirstlane((int)ew.x); ww[j] = __uint_as_float(__builtin_amdgcn_readfirstlane((int)ew.y));
                vv[j] = *(const GAS v2u*)(V4 + (size_t)eid * 512 + 8 * lane);
            }
#pragma unroll
            for (int j = 0; j < 16; ++j) {
                const unsigned v0 = vv[j].x, v1 = vv[j].y; const f32x2v w2 = (f32x2v){ww[j], ww[j]};
                acc[0] += w2 * __builtin_amdgcn_cvt_scalef32_pk_f32_fp4(v0, 1.0f, 0); acc[1] += w2 * __builtin_amdgcn_cvt_scalef32_pk_f32_fp4(v0, 1.0f, 1);
                acc[2] += w2 * __builtin_amdgcn_cvt_scalef32_pk_f32_fp4(v0, 1.0f, 2); acc[3] += w2 * __builtin_amdgcn_cvt_scalef32_pk_f32_fp4(v0, 1.0f, 3);
                acc[4] += w2 * __builtin_amdgcn_cvt_scalef32_pk_f32_fp4(v1, 1.0f, 0); acc[5] += w2 * __builtin_amdgcn_cvt_scalef32_pk_f32_fp4(v1, 1.0f, 1);
                acc[6] += w2 * __builtin_amdgcn_cvt_scalef32_pk_f32_fp4(v1, 1.0f, 2); acc[7] += w2 * __builtin_amdgcn_cvt_scalef32_pk_f32_fp4(v1, 1.0f, 3);
            }
        }
        LDS_WAIT(); asm volatile("" ::: "memory");
        const float* ip = A.out + (size_t)n * 1024 + 16 * lane; float* op = dummy ? (float*)(ws + WS_Z) + (size_t)n * 1024 + 16 * lane : A.out + (size_t)n * 1024 + 16 * lane; const float* g2p = ADA + b * 6144 + 5 * 1024 + 16 * lane;
#pragma unroll
        for (int q4 = 0; q4 < 4; ++q4) {
            const f32x4 xv = *(const GAS f32x4*)(ip + 4 * q4), gv = *(const GAS f32x4*)(g2p + 4 * q4);
            const f32x4 av = (f32x4){acc[2 * q4].x, acc[2 * q4].y, acc[2 * q4 + 1].x, acc[2 * q4 + 1].y};
            *(GAS f32x4*)(op + 4 * q4) = xv + gv * av;
        }
    }
}


constexpr int CW_Q1 = 8192, CW_Q3 = 8192 + 8 * 64;
__device__ __forceinline__ float quad_sum(float v) {
    v += __builtin_bit_cast(float, __builtin_amdgcn_update_dpp(0, __builtin_bit_cast(int, v), 0xB1, 0xF, 0xF, true));
    v += __builtin_bit_cast(float, __builtin_amdgcn_update_dpp(0, __builtin_bit_cast(int, v), 0x4E, 0xF, 0xF, true));
    return v;
}
__device__ __forceinline__ int next_item(Frame& F, unsigned* q) {
    LAS int* sh = (LAS int*)(F.lds);
    if (F.tid == 0) sh[0] = (int)__hip_atomic_fetch_add(q, 1u, __ATOMIC_RELAXED, __HIP_MEMORY_SCOPE_AGENT);
    __syncthreads(); const int it = sh[0]; __syncthreads();
    return it;
}
__device__ __forceinline__ void peer_g1(Frame& F, const Args& A) {
    unsigned char* ws = A.ws;
    const bf16* H2 = (const bf16*)(ws + WS_H); const unsigned char* U4 = ws + WS_U; const int* EIDX = (const int*)(ws + WS_EIDX); float* PD = (float*)(ws + WS_Z);
    unsigned* Q = (unsigned*)(ws + WS_CTL) + CW_Q1;
    const int lane = F.lane, tk = lane >> 3, c4 = lane & 7;
    const int s0 = (int)(xb_xcc_id() & 3u);
    for (int so = 0; so < 4; ++so) {
        const int s = (s0 + so) & 3;
        for (;;) {
            const int item = next_item(F, Q + 64 * s);
            if (item >= T / 128) break;
          for (int sub = 0; sub < 2; ++sub) {
            const int n = item * 128 + F.wave * 16 + sub * 8 + tk;
            v4u h2s[4];
            { const bf16* hp = H2 + (size_t)n * 1024 + 256 * s + 32 * c4;
#pragma unroll
              for (int k = 0; k < 4; ++k) h2s[k] = *(const GAS v4u*)(hp + 8 * k); }
            const unsigned char* ub = U4 + (size_t)s * (16384 * 128) + 16 * c4;
            float* pd = PD + ((size_t)s * T + n) * 128;
            const int* ep = EIDX + (size_t)n * 128;
            v4u idb[2], idc[2], rows[8], rnx[8];
            { const v4u i0 = *(const GAS v4u*)(ep), i1 = *(const GAS v4u*)(ep + 4); idb[0] = *(const GAS v4u*)(ep + 8); idb[1] = *(const GAS v4u*)(ep + 12);
              const unsigned a0 = i0.x, a1 = i0.y, a2 = i0.z, a3 = i0.w, a4 = i1.x, a5 = i1.y, a6 = i1.z, a7 = i1.w;
              rows[0] = *(const GAS v4u*)(ub + (size_t)a0 * 128); rows[1] = *(const GAS v4u*)(ub + (size_t)a1 * 128); rows[2] = *(const GAS v4u*)(ub + (size_t)a2 * 128); rows[3] = *(const GAS v4u*)(ub + (size_t)a3 * 128);
              rows[4] = *(const GAS v4u*)(ub + (size_t)a4 * 128); rows[5] = *(const GAS v4u*)(ub + (size_t)a5 * 128); rows[6] = *(const GAS v4u*)(ub + (size_t)a6 * 128); rows[7] = *(const GAS v4u*)(ub + (size_t)a7 * 128); }
            for (int g = 0; g < 16; ++g) {
                if (g + 2 < 16) { idc[0] = *(const GAS v4u*)(ep + 8 * (g + 2)); idc[1] = *(const GAS v4u*)(ep + 8 * (g + 2) + 4); }
                if (g + 1 < 16) {
                    const unsigned a0 = idb[0].x, a1 = idb[0].y, a2 = idb[0].z, a3 = idb[0].w, a4 = idb[1].x, a5 = idb[1].y, a6 = idb[1].z, a7 = idb[1].w;
                    rnx[0] = *(const GAS v4u*)(ub + (size_t)a0 * 128); rnx[1] = *(const GAS v4u*)(ub + (size_t)a1 * 128); rnx[2] = *(const GAS v4u*)(ub + (size_t)a2 * 128); rnx[3] = *(const GAS v4u*)(ub + (size_t)a3 * 128);
                    rnx[4] = *(const GAS v4u*)(ub + (size_t)a4 * 128); rnx[5] = *(const GAS v4u*)(ub + (size_t)a5 * 128); rnx[6] = *(const GAS v4u*)(ub + (size_t)a6 * 128); rnx[7] = *(const GAS v4u*)(ub + (size_t)a7 * 128);
                }
                float p[8];
#pragma unroll
                for (int k = 0; k < 8; ++k) { const unsigned x0 = rows[k].x, x1 = rows[k].y, x2 = rows[k].z, x3 = rows[k].w; float pp = quad_sum(dot8f4(x3, h2s[3], dot8f4(x2, h2s[2], dot8f4(x1, h2s[1], dot8f4(x0, h2s[0], 0.f))))); pp += __shfl_xor(pp, 4); p[k] = pp; }
                if (c4 == 0) { *(GAS f32x4*)(pd + 8 * g) = (f32x4){p[0], p[1], p[2], p[3]}; *(GAS f32x4*)(pd + 8 * g + 4) = (f32x4){p[4], p[5], p[6], p[7]}; }
#pragma unroll
                for (int k = 0; k < 8; ++k) rows[k] = rnx[k];
                idb[0] = idc[0]; idb[1] = idc[1];
            }
          }
        }
    }
}
__device__ __forceinline__ void peer_g2(Frame& F, const Args& A) {
    unsigned char* ws = A.ws;
    const int* EIDX = (const int*)(ws + WS_EIDX); float* EGATE = (float*)(ws + WS_EGATE); const float* PD = (const float*)(ws + WS_Z);
    const float* SU = (const float*)(ws + WS_SU); const float* SV = (const float*)(ws + WS_SV); const float* SH2 = (const float*)(ws + WS_SH2);
    const size_t gtid = (size_t)F.gw * 64 + F.lane, gthreads = (size_t)F.NGW * 64;
    for (size_t idx = gtid; idx < (size_t)T * 128; idx += gthreads) {
        float d = 0.f;
#pragma unroll
        for (int s = 0; s < 4; ++s) d += PD[(size_t)s * T * 128 + idx];
        const int eid = EIDX[idx];
        d *= SU[eid];
        const float act = 0.5f * d * (1.0f + erff(d * 0.70710678118654752f));
        EGATE[idx] = EGATE[idx] * act * SV[eid];
    }
}
__device__ __forceinline__ void peer_g3(Frame& F, const Args& A) {
    unsigned char* ws = A.ws;
    const unsigned char* V4 = ws + WS_V; const int* EIDX = (const int*)(ws + WS_EIDX); const float* W = (const float*)(ws + WS_EGATE); const float* ADA = (const float*)(ws + WS_ADA);
    unsigned* Q = (unsigned*)(ws + WS_CTL) + CW_Q3;
    const int lane = F.lane, tk = lane >> 3, c4 = lane & 7;
#ifdef G3_DUPLOAD
    const size_t zoff = (size_t)*((volatile unsigned*)(ws + WS_CTL) + 80);
#endif
    const int s0 = (int)(xb_xcc_id() & 3u);
    for (int so = 0; so < 4; ++so) {
        const int s = (s0 + so) & 3;
        for (;;) {
            const int item = next_item(F, Q + 64 * s);
            if (item >= T / 128) break;
          for (int sub = 0; sub < 2; ++sub) {
            const int n = item * 128 + F.wave * 16 + sub * 8 + tk;
            const unsigned char* vb = V4 + (size_t)s * (16384 * 128) + 16 * c4;
            f32x2v acc[16];
#pragma unroll
            for (int j = 0; j < 16; ++j) acc[j] = (f32x2v){0.f, 0.f};
            const int* ep = EIDX + (size_t)n * 128; const float* wp = W + (size_t)n * 128;
            v4u idb[2], idc[2], rows[8], rnx[8]; f32x4 wc[2], wb[2], wn[2];
            { const v4u i0 = *(const GAS v4u*)(ep), i1 = *(const GAS v4u*)(ep + 4); idb[0] = *(const GAS v4u*)(ep + 8); idb[1] = *(const GAS v4u*)(ep + 12);
              wc[0] = *(const GAS f32x4*)(wp); wc[1] = *(const GAS f32x4*)(wp + 4); wb[0] = *(const GAS f32x4*)(wp + 8); wb[1] = *(const GAS f32x4*)(wp + 12);
              const unsigned a0 = i0.x, a1 = i0.y, a2 = i0.z, a3 = i0.w, a4 = i1.x, a5 = i1.y, a6 = i1.z, a7 = i1.w;
              rows[0] = *(const GAS v4u*)(vb + (size_t)a0 * 128); rows[1] = *(const GAS v4u*)(vb + (size_t)a1 * 128); rows[2] = *(const GAS v4u*)(vb + (size_t)a2 * 128); rows[3] = *(const GAS v4u*)(vb + (size_t)a3 * 128);
              rows[4] = *(const GAS v4u*)(vb + (size_t)a4 * 128); rows[5] = *(const GAS v4u*)(vb + (size_t)a5 * 128); rows[6] = *(const GAS v4u*)(vb + (size_t)a6 * 128); rows[7] = *(const GAS v4u*)(vb + (size_t)a7 * 128); }
            for (int g = 0; g < 16; ++g) {
                if (g + 2 < 16) { idc[0] = *(const GAS v4u*)(ep + 8 * (g + 2)); idc[1] = *(const GAS v4u*)(ep + 8 * (g + 2) + 4); wn[0] = *(const GAS f32x4*)(wp + 8 * (g + 2)); wn[1] = *(const GAS f32x4*)(wp + 8 * (g + 2) + 4); }
                if (g + 1 < 16) {
                    const unsigned a0 = idb[0].x, a1 = idb[0].y, a2 = idb[0].z, a3 = idb[0].w, a4 = idb[1].x, a5 = idb[1].y, a6 = idb[1].z, a7 = idb[1].w;
                    rnx[0] = *(const GAS v4u*)(vb + (size_t)a0 * 128); rnx[1] = *(const GAS v4u*)(vb + (size_t)a1 * 128); rnx[2] = *(const GAS v4u*)(vb + (size_t)a2 * 128); rnx[3] = *(const GAS v4u*)(vb + (size_t)a3 * 128);
                    rnx[4] = *(const GAS v4u*)(vb + (size_t)a4 * 128); rnx[5] = *(const GAS v4u*)(vb + (size_t)a5 * 128); rnx[6] = *(const GAS v4u*)(vb + (size_t)a6 * 128); rnx[7] = *(const GAS v4u*)(vb + (size_t)a7 * 128);
                }
#ifdef G3_DUPLOAD
                v4u r2[8];
                if (g + 1 < 16) {
                    const unsigned a0 = idb[0].x, a1 = idb[0].y, a2 = idb[0].z, a3 = idb[0].w, a4 = idb[1].x, a5 = idb[1].y, a6 = idb[1].z, a7 = idb[1].w;
                    r2[0] = *(const GAS v4u*)(vb + zoff + (size_t)a0 * 128); r2[1] = *(const GAS v4u*)(vb + zoff + (size_t)a1 * 128); r2[2] = *(const GAS v4u*)(vb + zoff + (size_t)a2 * 128); r2[3] = *(const GAS v4u*)(vb + zoff + (size_t)a3 * 128);
                    r2[4] = *(const GAS v4u*)(vb + zoff + (size_t)a4 * 128); r2[5] = *(const GAS v4u*)(vb + zoff + (size_t)a5 * 128); r2[6] = *(const GAS v4u*)(vb + zoff + (size_t)a6 * 128); r2[7] = *(const GAS v4u*)(vb + zoff + (size_t)a7 * 128);
#pragma unroll
                    for (int k = 0; k < 8; ++k) { rnx[k].y = r2[k].y; rnx[k].w = r2[k].w; }
                }
#endif
#pragma unroll
                for (int k = 0; k < 8; ++k) {
                    const float wk = wc[k >> 2][k & 3]; const f32x2v w2 = (f32x2v){wk, wk};
                    const unsigned x0 = rows[k].x, x1 = rows[k].y, x2 = rows[k].z, x3 = rows[k].w;
                    acc[0] += w2 * __builtin_amdgcn_cvt_scalef32_pk_f32_fp4(x0, 1.0f, 0); acc[1] += w2 * __builtin_amdgcn_cvt_scalef32_pk_f32_fp4(x0, 1.0f, 1);
                    acc[2] += w2 * __builtin_amdgcn_cvt_scalef32_pk_f32_fp4(x0, 1.0f, 2); acc[3] += w2 * __builtin_amdgcn_cvt_scalef32_pk_f32_fp4(x0, 1.0f, 3);
                    acc[4] += w2 * __builtin_amdgcn_cvt_scalef32_pk_f32_fp4(x1, 1.0f, 0); acc[5] += w2 * __builtin_amdgcn_cvt_scalef32_pk_f32_fp4(x1, 1.0f, 1);
                    acc[6] += w2 * __builtin_amdgcn_cvt_scalef32_pk_f32_fp4(x1, 1.0f, 2); acc[7] += w2 * __builtin_amdgcn_cvt_scalef32_pk_f32_fp4(x1, 1.0f, 3);
                    acc[8] += w2 * __builtin_amdgcn_cvt_scalef32_pk_f32_fp4(x2, 1.0f, 0); acc[9] += w2 * __builtin_amdgcn_cvt_scalef32_pk_f32_fp4(x2, 1.0f, 1);
                    acc[10] += w2 * __builtin_amdgcn_cvt_scalef32_pk_f32_fp4(x2, 1.0f, 2); acc[11] += w2 * __builtin_amdgcn_cvt_scalef32_pk_f32_fp4(x2, 1.0f, 3);
                    acc[12] += w2 * __builtin_amdgcn_cvt_scalef32_pk_f32_fp4(x3, 1.0f, 0); acc[13] += w2 * __builtin_amdgcn_cvt_scalef32_pk_f32_fp4(x3, 1.0f, 1);
                    acc[14] += w2 * __builtin_amdgcn_cvt_scalef32_pk_f32_fp4(x3, 1.0f, 2); acc[15] += w2 * __builtin_amdgcn_cvt_scalef32_pk_f32_fp4(x3, 1.0f, 3);
                }
#pragma unroll
                for (int k = 0; k < 8; ++k) rows[k] = rnx[k];
                idb[0] = idc[0]; idb[1] = idc[1]; wc[0] = wb[0]; wc[1] = wb[1]; wb[0] = wn[0]; wb[1] = wn[1];
            }
            float* op = A.out + (size_t)n * 1024 + 256 * s + 32 * c4; const float* g2p = ADA + (n >> 11) * 6144 + 5 * 1024 + 256 * s + 32 * c4;
#pragma unroll
            for (int q4 = 0; q4 < 8; ++q4) {
                const f32x4 xv = *(const GAS f32x4*)(op + 4 * q4), gv = *(const GAS f32x4*)(g2p + 4 * q4);
                const f32x4 av = (f32x4){acc[2 * q4].x, acc[2 * q4].y, acc[2 * q4 + 1].x, acc[2 * q4 + 1].y};
                *(GAS f32x4*)(op + 4 * q4) = xv + gv * av;
            }
          }
        }
    }
}


__device__ __forceinline__ void peer_local(Frame& F, const Args& A, const XcdBarrier& xb) {
    unsigned char* ws = A.ws;
    const bf16* H2 = (const bf16*)(ws + WS_H); const unsigned char* U4 = ws + WS_U; const unsigned char* V4 = ws + WS_V;
    const int* EIDX = (const int*)(ws + WS_EIDX); const float* EGATE = (const float*)(ws + WS_EGATE); const float* ADA = (const float*)(ws + WS_ADA);
    const float* SU = (const float*)(ws + WS_SU); const float* SV = (const float*)(ws + WS_SV); const float* SH2 = (const float*)(ws + WS_SH2);
    const int lane = F.lane, tk = lane >> 3, c4 = lane & 7;
    const int tpw = T / F.NGW;
    LAS float* PDL = (LAS float*)F.lds + (size_t)F.wave * tpw * 128;
    const int nbase = F.gw * tpw;
    for (int i = lane; i < tpw * 128; i += 64) PDL[i] = 0.f;
    LDS_WAIT(); asm volatile("" ::: "memory");
    const unsigned char* HHI = ws + WS_H2HI; const unsigned char* HLO = ws + WS_H2LO;
    for (int s = 0; s < 4; ++s) {
#ifdef SLICE_BAR
        if (s) xcd_barrier(xb);
#endif
        const unsigned char* ub = U4 + (size_t)s * (16384 * 128) + 16 * c4;
        for (int sub = 0; sub < tpw; sub += 8) {
            const int n = nbase + sub + tk;
            const v4u hh = *(const GAS v4u*)(HHI + (size_t)n * 512 + 128 * s + 16 * c4), hl = *(const GAS v4u*)(HLO + (size_t)n * 512 + 128 * s + 16 * c4);
            const int h0 = (int)hh.x, h1 = (int)hh.y, h2_ = (int)hh.z, h3 = (int)hh.w, l0 = (int)hl.x, l1 = (int)hl.y, l2 = (int)hl.z, l3 = (int)hl.w;
            LAS float* pd = PDL + (sub + tk) * 128;
            const int* ep = EIDX + (size_t)n * 128;
            v4u idb[2], idc[2], rows[8], rnx[8];
#ifdef EIDX16
            const unsigned short* ep16 = (const unsigned short*)EIDX + (size_t)n * 128;
            { const v4u i0 = *(const GAS v4u*)(ep16); idb[0] = *(const GAS v4u*)(ep16 + 8); idb[1] = idb[0]; (void)ep;
              const unsigned a0 = i0.x & 0xFFFFu, a1 = i0.x >> 16, a2 = i0.y & 0xFFFFu, a3 = i0.y >> 16, a4 = i0.z & 0xFFFFu, a5 = i0.z >> 16, a6 = i0.w & 0xFFFFu, a7 = i0.w >> 16;
#else
            { const v4u i0 = *(const GAS v4u*)(ep), i1 = *(const GAS v4u*)(ep + 4); idb[0] = *(const GAS v4u*)(ep + 8); idb[1] = *(const GAS v4u*)(ep + 12);
              const unsigned a0 = i0.x, a1 = i0.y, a2 = i0.z, a3 = i0.w, a4 = i1.x, a5 = i1.y, a6 = i1.z, a7 = i1.w;
#endif
              rows[0] = *(const GAS v4u*)(ub + (size_t)a0 * 128); rows[1] = *(const GAS v4u*)(ub + (size_t)a1 * 128); rows[2] = *(const GAS v4u*)(ub + (size_t)a2 * 128); rows[3] = *(const GAS v4u*)(ub + (size_t)a3 * 128);
              rows[4] = *(const GAS v4u*)(ub + (size_t)a4 * 128); rows[5] = *(const GAS v4u*)(ub + (size_t)a5 * 128); rows[6] = *(const GAS v4u*)(ub + (size_t)a6 * 128); rows[7] = *(const GAS v4u*)(ub + (size_t)a7 * 128); }
            for (int g = 0; g < 16; ++g) {
#ifdef EIDX16
                if (g + 2 < 16) { idc[0] = *(const GAS v4u*)(ep16 + 8 * (g + 2)); idc[1] = idc[0]; }
                if (g + 1 < 16) {
                    const unsigned a0 = idb[0].x & 0xFFFFu, a1 = idb[0].x >> 16, a2 = idb[0].y & 0xFFFFu, a3 = idb[0].y >> 16, a4 = idb[0].z & 0xFFFFu, a5 = idb[0].z >> 16, a6 = idb[0].w & 0xFFFFu, a7 = idb[0].w >> 16;
#else
                if (g + 2 < 16) { idc[0] = *(const GAS v4u*)(ep + 8 * (g + 2)); idc[1] = *(const GAS v4u*)(ep + 8 * (g + 2) + 4); }
                if (g + 1 < 16) {
                    const unsigned a0 = idb[0].x, a1 = idb[0].y, a2 = idb[0].z, a3 = idb[0].w, a4 = idb[1].x, a5 = idb[1].y, a6 = idb[1].z, a7 = idb[1].w;
#endif
                    rnx[0] = *(const GAS v4u*)(ub + (size_t)a0 * 128); rnx[1] = *(const GAS v4u*)(ub + (size_t)a1 * 128); rnx[2] = *(const GAS v4u*)(ub + (size_t)a2 * 128); rnx[3] = *(const GAS v4u*)(ub + (size_t)a3 * 128);
                    rnx[4] = *(const GAS v4u*)(ub + (size_t)a4 * 128); rnx[5] = *(const GAS v4u*)(ub + (size_t)a5 * 128); rnx[6] = *(const GAS v4u*)(ub + (size_t)a6 * 128); rnx[7] = *(const GAS v4u*)(ub + (size_t)a7 * 128);
                }
                float p[8];
#pragma unroll
                for (int k = 0; k < 8; ++k) {
                    const int x0 = (int)rows[k].x, x1 = (int)rows[k].y, x2 = (int)rows[k].z, x3 = (int)rows[k].w;
                    const int ah = __builtin_amdgcn_sdot8(x3, h3, __builtin_amdgcn_sdot8(x2, h2_, __builtin_amdgcn_sdot8(x1, h1, __builtin_amdgcn_sdot8(x0, h0, 0, false), false), false), false);
                    const int al = __builtin_amdgcn_sdot8(x3, l3, __builtin_amdgcn_sdot8(x2, l2, __builtin_amdgcn_sdot8(x1, l1, __builtin_amdgcn_sdot8(x0, l0, 0, false), false), false), false);
                    int t = 16 * ah + al;
                    t += __builtin_amdgcn_update_dpp(0, t, 0xB1, 0xF, 0xF, true); t += __builtin_amdgcn_update_dpp(0, t, 0x4E, 0xF, 0xF, true); t += __shfl_xor(t, 4);
                    p[k] = (float)t;
                }
                if (c4 == 0) {
                    const f32x4 o0 = *(const LAS f32x4*)(pd + 8 * g), o1 = *(const LAS f32x4*)(pd + 8 * g + 4);
                    *(LAS f32x4*)(pd + 8 * g) = o0 + (f32x4){p[0], p[1], p[2], p[3]}; *(LAS f32x4*)(pd + 8 * g + 4) = o1 + (f32x4){p[4], p[5], p[6], p[7]};
                }
#pragma unroll
                for (int k = 0; k < 8; ++k) rows[k] = rnx[k];
                idb[0] = idc[0]; idb[1] = idc[1];
            }
        }
    }
    LDS_WAIT(); asm volatile("" ::: "memory");
    for (int i = lane; i < tpw * 128; i += 64) {
        const size_t gi = (size_t)nbase * 128 + i;
#ifdef EIDX16
        const int eid = ((const unsigned short*)EIDX)[gi];
#else
        const int eid = EIDX[gi];
#endif
        const float d = PDL[i] * SU[eid] * SH2[nbase + (i >> 7)];
        const float act = 0.5f * d * (1.0f + erff(d * 0.70710678118654752f));
        PDL[i] = EGATE[gi] * act * SV[eid];
    }
    LDS_WAIT(); asm volatile("" ::: "memory");
    for (int s = 0; s < 4; ++s) {
#ifdef SLICE_BAR
        xcd_barrier(xb);
#endif
        const unsigned char* vb = V4 + (size_t)s * (16384 * 128) + 16 * c4;
        for (int sub = 0; sub < tpw; sub += 8) {
            const int n = nbase + sub + tk;
            const LAS float* wl = PDL + (sub + tk) * 128;
            f32x2v acc[16];
#pragma unroll
            for (int j = 0; j < 16; ++j) acc[j] = (f32x2v){0.f, 0.f};
#ifdef P12_PREF
            f32x4 xpre[8];
            { const float* op0 = A.out + (size_t)n * 1024 + 256 * s + 32 * c4;
#pragma unroll
              for (int q4 = 0; q4 < 8; ++q4) xpre[q4] = *(const GAS f32x4*)(op0 + 4 * q4); }
#endif
            const int* ep = EIDX + (size_t)n * 128;
            v4u idb[2], idc[2], rows[8], rnx[8];
#ifdef EIDX16
            const unsigned short* ep16 = (const unsigned short*)EIDX + (size_t)n * 128;
            { const v4u i0 = *(const GAS v4u*)(ep16); idb[0] = *(const GAS v4u*)(ep16 + 8); idb[1] = idb[0]; (void)ep;
              const unsigned a0 = i0.x & 0xFFFFu, a1 = i0.x >> 16, a2 = i0.y & 0xFFFFu, a3 = i0.y >> 16, a4 = i0.z & 0xFFFFu, a5 = i0.z >> 16, a6 = i0.w & 0xFFFFu, a7 = i0.w >> 16;
#else
            { const v4u i0 = *(const GAS v4u*)(ep), i1 = *(const GAS v4u*)(ep + 4); idb[0] = *(const GAS v4u*)(ep + 8); idb[1] = *(const GAS v4u*)(ep + 12);
              const unsigned a0 = i0.x, a1 = i0.y, a2 = i0.z, a3 = i0.w, a4 = i1.x, a5 = i1.y, a6 = i1.z, a7 = i1.w;
#endif
              rows[0] = *(const GAS v4u*)(vb + (size_t)a0 * 128); rows[1] = *(const GAS v4u*)(vb + (size_t)a1 * 128); rows[2] = *(const GAS v4u*)(vb + (size_t)a2 * 128); rows[3] = *(const GAS v4u*)(vb + (size_t)a3 * 128);
              rows[4] = *(const GAS v4u*)(vb + (size_t)a4 * 128); rows[5] = *(const GAS v4u*)(vb + (size_t)a5 * 128); rows[6] = *(const GAS v4u*)(vb + (size_t)a6 * 128); rows[7] = *(const GAS v4u*)(vb + (size_t)a7 * 128); }
            for (int g = 0; g < 16; ++g) {
#ifdef EIDX16
                if (g + 2 < 16) { idc[0] = *(const GAS v4u*)(ep16 + 8 * (g + 2)); idc[1] = idc[0]; }
                if (g + 1 < 16) {
                    const unsigned a0 = idb[0].x & 0xFFFFu, a1 = idb[0].x >> 16, a2 = idb[0].y & 0xFFFFu, a3 = idb[0].y >> 16, a4 = idb[0].z & 0xFFFFu, a5 = idb[0].z >> 16, a6 = idb[0].w & 0xFFFFu, a7 = idb[0].w >> 16;
#else
                if (g + 2 < 16) { idc[0] = *(const GAS v4u*)(ep + 8 * (g + 2)); idc[1] = *(const GAS v4u*)(ep + 8 * (g + 2) + 4); }
                if (g + 1 < 16) {
                    const unsigned a0 = idb[0].x, a1 = idb[0].y, a2 = idb[0].z, a3 = idb[0].w, a4 = idb[1].x, a5 = idb[1].y, a6 = idb[1].z, a7 = idb[1].w;
#endif
                    rnx[0] = *(const GAS v4u*)(vb + (size_t)a0 * 128); rnx[1] = *(const GAS v4u*)(vb + (size_t)a1 * 128); rnx[2] = *(const GAS v4u*)(vb + (size_t)a2 * 128); rnx[3] = *(const GAS v4u*)(vb + (size_t)a3 * 128);
                    rnx[4] = *(const GAS v4u*)(vb + (size_t)a4 * 128); rnx[5] = *(const GAS v4u*)(vb + (size_t)a5 * 128); rnx[6] = *(const GAS v4u*)(vb + (size_t)a6 * 128); rnx[7] = *(const GAS v4u*)(vb + (size_t)a7 * 128);
                }
                const f32x4 w0 = *(const LAS f32x4*)(wl + 8 * g), w1 = *(const LAS f32x4*)(wl + 8 * g + 4);
#pragma unroll
                for (int k = 0; k < 8; ++k) {
                    const float wk = (k < 4) ? w0[k & 3] : w1[k & 3]; const f32x2v w2 = (f32x2v){wk, wk};
                    const unsigned x0 = rows[k].x, x1 = rows[k].y, x2 = rows[k].z, x3 = rows[k].w;
                    acc[0] += w2 * __builtin_amdgcn_cvt_scalef32_pk_f32_fp4(x0, 1.0f, 0); acc[1] += w2 * __builtin_amdgcn_cvt_scalef32_pk_f32_fp4(x0, 1.0f, 1);
                    acc[2] += w2 * __builtin_amdgcn_cvt_scalef32_pk_f32_fp4(x0, 1.0f, 2); acc[3] += w2 * __builtin_amdgcn_cvt_scalef32_pk_f32_fp4(x0, 1.0f, 3);
                    acc[4] += w2 * __builtin_amdgcn_cvt_scalef32_pk_f32_fp4(x1, 1.0f, 0); acc[5] += w2 * __builtin_amdgcn_cvt_scalef32_pk_f32_fp4(x1, 1.0f, 1);
                    acc[6] += w2 * __builtin_amdgcn_cvt_scalef32_pk_f32_fp4(x1, 1.0f, 2); acc[7] += w2 * __builtin_amdgcn_cvt_scalef32_pk_f32_fp4(x1, 1.0f, 3);
                    acc[8] += w2 * __builtin_amdgcn_cvt_scalef32_pk_f32_fp4(x2, 1.0f, 0); acc[9] += w2 * __builtin_amdgcn_cvt_scalef32_pk_f32_fp4(x2, 1.0f, 1);
                    acc[10] += w2 * __builtin_amdgcn_cvt_scalef32_pk_f32_fp4(x2, 1.0f, 2); acc[11] += w2 * __builtin_amdgcn_cvt_scalef32_pk_f32_fp4(x2, 1.0f, 3);
                    acc[12] += w2 * __builtin_amdgcn_cvt_scalef32_pk_f32_fp4(x3, 1.0f, 0); acc[13] += w2 * __builtin_amdgcn_cvt_scalef32_pk_f32_fp4(x3, 1.0f, 1);
                    acc[14] += w2 * __builtin_amdgcn_cvt_scalef32_pk_f32_fp4(x3, 1.0f, 2); acc[15] += w2 * __builtin_amdgcn_cvt_scalef32_pk_f32_fp4(x3, 1.0f, 3);
                }
#pragma unroll
                for (int k = 0; k < 8; ++k) rows[k] = rnx[k];
                idb[0] = idc[0]; idb[1] = idc[1];
            }
            float* op = A.out + (size_t)n * 1024 + 256 * s + 32 * c4; const float* g2p = ADA + (n >> 11) * 6144 + 5 * 1024 + 256 * s + 32 * c4;
#pragma unroll
            for (int q4 = 0; q4 < 8; ++q4) {
#if defined(X1_BF16)
#ifdef P12_NT
                const f32x4 gv = *(const GAS f32x4*)(g2p + 4 * q4); const v2u a_ = __builtin_nontemporal_load((const GAS v2u*)((const bf16*)(ws + WS_X1) + (size_t)n * 1024 + 256 * s + 32 * c4 + 4 * q4));
#else
                const f32x4 gv = *(const GAS f32x4*)(g2p + 4 * q4); const v2u a_ = *(const GAS v2u*)((const bf16*)(ws + WS_X1) + (size_t)n * 1024 + 256 * s + 32 * c4 + 4 * q4);
#endif
                const f32x4 xv = (f32x4){__uint_as_float(a_.x << 16), __uint_as_float(a_.x & 0xffff0000u), __uint_as_float(a_.y << 16), __uint_as_float(a_.y & 0xffff0000u)};
#elif defined(P12_PREF)
                const f32x4 xv = xpre[q4], gv = *(const GAS f32x4*)(g2p + 4 * q4);
#else
                const f32x4 xv = *(const GAS f32x4*)(op + 4 * q4), gv = *(const GAS f32x4*)(g2p + 4 * q4);
#endif
                const f32x4 av = (f32x4){acc[2 * q4].x, acc[2 * q4].y, acc[2 * q4 + 1].x, acc[2 * q4 + 1].y};
#ifdef P12_NT
                __builtin_nontemporal_store(xv + gv * av, (GAS f32x4*)(op + 4 * q4));
#else
                *(GAS f32x4*)(op + 4 * q4) = xv + gv * av;
#endif
            }
        }
    }
}

__device__ __forceinline__ void dbg_peer_check1(Frame& F, const Args& A) {
    if (blockIdx.x != 0) return;
    unsigned char* ws = A.ws;
    const bf16* H2 = (const bf16*)(ws + WS_H); const bf16* PQ = (const bf16*)(ws + WS_PQ); const bf16* SK = (const bf16*)(ws + WS_SK);
    const int* EIDX = (const int*)(ws + WS_EIDX); const float* EGATE = (const float*)(ws + WS_EGATE); float* DBG = (float*)(ws + 48 * MiB);
    unsigned* flag = (unsigned*)(ws + WS_CTL) + 64;
    const int t = F.tid;
    const int r = (int)(((long long)t * 2579 + 17) % T), c = (t * 131 + 5) % 1024;
    unsigned f = 0u;
    { float acc = 0.f; for (int k = 0; k < 1024; ++k) acc += bf2f(H2[(size_t)r * 1024 + k]) * A.w_pq[(size_t)k * 1024 + c];
      const float got = bf2f(PQ[(size_t)r * 1024 + c]); if (fabsf(got - acc) > 0.02f * fabsf(acc) + 0.02f) f |= 1u; }
    { const int h = t & 7; float s[2][128];
      float* sc = DBG + 4096 + (size_t)t * 256;
      for (int p = 0; p < 2; ++p) for (int k = 0; k < 128; ++k) { float acc = 0.f; for (int d = 0; d < 64; ++d) acc += bf2f(PQ[(size_t)r * 1024 + h * 128 + p * 64 + d]) * bf2f(SK[((size_t)(h * 2 + p) * 128 + k) * 64 + d]); sc[p * 128 + k] = acc; }
      (void)s;
      float t0v[16], t1v[16];
      for (int p = 0; p < 2; ++p) { float last = 3.0e38f; int lasti = -1; for (int i = 0; i < 16; ++i) { float best = -3.0e38f; int bi = -1; for (int k = 0; k < 128; ++k) { const float v = sc[p * 128 + k]; if ((v < last || (v == last && k > lasti)) && v > best) { best = v; bi = k; } } last = best; lasti = bi; if (p == 0) t0v[i] = best; else t1v[i] = best; } }
      float last = 3.0e38f; int cnt_ge = 0; float kth = 0.f;
      for (int it = 0; it < 16; ++it) { float best = -3.0e38f; for (int i = 0; i < 16; ++i) for (int j = 0; j < 16; ++j) { const float v = t0v[i] + t1v[j]; if (v < last && v > best) best = v; } last = best; kth = best; }
      (void)cnt_ge;
      float gs = 0.f; int badn = 0;
      for (int i = 0; i < 16; ++i) { const int e = EIDX[(size_t)r * 128 + h * 16 + i]; const float g = EGATE[(size_t)r * 128 + h * 16 + i]; gs += g;
          if (e < 0 || e >= 16384) { badn += 100; continue; }
          const float sm = sc[e >> 7] + sc[128 + (e & 127)]; if (sm < kth - 0.02f * fabsf(kth) - 0.02f) ++badn; }
      if (badn > 1) f |= 2u;
      if (fabsf(gs - 1.0f) > 0.01f) f |= 4u; }
    { float acc = 0.f;
      for (int e = 0; e < 128; ++e) { const int id = EIDX[(size_t)r * 128 + e]; const float g = EGATE[(size_t)r * 128 + e]; if (id < 0 || id >= 16384) continue;
          float d = 0.f; for (int k = 0; k < 1024; ++k) d += bf2f(H2[(size_t)r * 1024 + k]) * A.pu[(size_t)id * 1024 + k];
          const float act = 0.5f * d * (1.0f + erff(d * 0.70710678f)); acc += g * act * A.pv[(size_t)id * 1024 + c]; }
      DBG[t] = acc; DBG[512 + t] = A.out[(size_t)r * 1024 + c]; }
    if (f) atomicOr(flag, f);
}
__device__ __forceinline__ void dbg_peer_check2(Frame& F, const Args& A) {
    if (blockIdx.x != 0) return;
    unsigned char* ws = A.ws; const float* DBG = (const float*)(ws + 48 * MiB); const float* ADA = (const float*)(ws + WS_ADA);
    unsigned* flag = (unsigned*)(ws + WS_CTL) + 64;
    const int t = F.tid;
    const int r = (int)(((long long)t * 2579 + 17) % T), c = (t * 131 + 5) % 1024;
    const float e = DBG[512 + t] + ADA[(r >> 11) * 6144 + 5120 + c] * DBG[t], got = A.out[(size_t)r * 1024 + c];
    if (fabsf(got - e) > 0.03f * fabsf(DBG[t]) + 0.02f) atomicOr(flag, 8u);
}

__device__ __forceinline__ Args fresh_args() {
    const __attribute__((address_space(4))) Args* p = (const __attribute__((address_space(4))) Args*)__builtin_amdgcn_kernarg_segment_ptr();
    asm volatile("" : "+s"(p));
    return *(const Args*)p;
}
__global__ void __launch_bounds__(NTHR, 2) fwd_megakernel(Args args_byval) {
    extern __shared__ __attribute__((aligned(16))) unsigned char lds_raw[];
#define MAKE_FRAME() Frame F; F.lds = (LAS unsigned char*)lds_raw; F.tid = opaque_tid(); F.lane = F.tid & 63; F.wave = __builtin_amdgcn_readfirstlane(F.tid >> 6); \
    F.G = gridDim.x; { const int bx_ = blockIdx.x; F.vcu = (F.G % 8 == 0) ? (bx_ % 8) * (F.G / 8) + bx_ / 8 : bx_; } F.gw = F.vcu * NWAVES + F.wave; F.NGW = F.G * NWAVES;
    LAS unsigned char* const lds0 = (LAS unsigned char*)lds_raw;
    for (int u = threadIdx.x; u < (LDS_BYTES - LDSCTL_OFF) / 4; u += NTHR) ((LAS unsigned*)(lds0 + LDSCTL_OFF))[u] = 0u;
    __syncthreads();
    XcdBarrier bar = xcd_barrier_post((unsigned*)(fresh_args().ws + WS_CTL) + CW_BAR, (volatile LAS unsigned*)(lds0 + MISC_OFF) + 8);
#define GRID_BAR() xcd_barrier(bar)
    const int bx = (int)blockIdx.x;

    using pg8::Gemm; using pg8::StaticOrder; using pg8::EpiB; using pg8::EpiRes; using pg8::EpiX1; using pg8::EpiGate8;
#ifndef REP_P0
#define REP_P0 1
#endif
    for (int rep_ = 0; rep_ < REP_P0; ++rep_) {

#ifndef NO_PH_P0
    { const Args args = fresh_args(); MAKE_FRAME(); p0_prologue(F, args); }
#endif
    GRID_BAR();
    }

#ifndef REP_P1
#define REP_P1 1
#endif
    for (int rep_ = 0; rep_ < REP_P1; ++rep_) {

#ifndef NO_PH_NORM
#ifdef GATE_I8
    { const Args args = fresh_args(); MAKE_FRAME(); norm_rows(F, args.x, args.g1, ((const float*)(args.ws + WS_ADA)), 0, 1024, ((bf16*)(args.ws + WS_H)), nullptr, nullptr, nullptr, args.ws + WS_H8, (float*)(args.ws + WS_S1));
      quant_gate_weights(F, args.ws); }
#else
    { const Args args = fresh_args(); MAKE_FRAME(); norm_rows(F, args.x, args.g1, ((const float*)(args.ws + WS_ADA)), 0, 1024, ((bf16*)(args.ws + WS_H)), nullptr, nullptr); }
#endif
#endif
    GRID_BAR();
    }

#ifdef EXTRA_BARS
    for (int xb_ = 0; xb_ < EXTRA_BARS; ++xb_) GRID_BAR();
#endif
#ifndef REP_P2
#define REP_P2 1
#endif
    for (int rep_ = 0; rep_ < REP_P2; ++rep_) {
#ifndef NO_PH_GEMM
#ifdef GATE_I8
    { const Args args = fresh_args(); MAKE_FRAME(); Gemm g{((bf16*)(args.ws + WS_H)), ((bf16*)(args.ws + WS_WIN)), T, 1536, 1024}; StaticOrder S; S.init(T, 1536, F.G, bx); EpiB<0> E{((bf16*)(args.ws + WS_Z)), ZW, 6, nullptr, nullptr, 0, 0, 4};
      pg8::gemm_phase<EpiB<0>, StaticOrder, false, true>(F.lds, g, S, E); }
    { const Args args = fresh_args(); MAKE_FRAME(); Gemm g{((bf16*)(args.ws + WS_H8)), ((bf16*)(args.ws + WS_WG8)), T, 2048, 512}; StaticOrder S; S.init(T, 2048, F.G, bx); EpiGate8 E{args.ws + WS_Z, ZW * 2, (const float*)(args.ws + WS_S1), (const float*)(args.ws + WS_CS8)};
      pg8::gemm_phase<EpiGate8, StaticOrder, false, true, true>(F.lds, g, S, E); }
#else
    { const Args args = fresh_args(); MAKE_FRAME(); Gemm g{((bf16*)(args.ws + WS_H)), ((bf16*)(args.ws + WS_WIN)), T, ZW, 1024}; StaticOrder S; S.init(T, ZW, F.G, bx); EpiB<0> E{((bf16*)(args.ws + WS_Z)), ZW, 6, nullptr, nullptr, 0, 0, 4};
      pg8::gemm_phase<EpiB<0>, StaticOrder, false, true>(F.lds, g, S, E); }
#endif
#endif
    GRID_BAR();
    }


#ifndef NO_PH_P3
    { const Args args = fresh_args(); MAKE_FRAME();
#ifdef PRIO_P3
      if (F.wave >> 2) __builtin_amdgcn_s_setprio(2);
#endif
      p3_fixup(F, args);
#ifdef PRIO_P3
      __builtin_amdgcn_s_setprio(0);
#endif
     }
#endif
    GRID_BAR();
#ifndef NO_PH_GEMM
    { const Args args = fresh_args(); MAKE_FRAME(); Gemm g{((bf16*)(args.ws + WS_POOLED)), ((bf16*)(args.ws + WS_WUP)), T, 1024, 512}; StaticOrder S; S.init(T, 1024, F.G, bx);
#ifdef P5_NOGATE
      EpiB<0> E{((bf16*)(args.ws + WS_MIN)), 1024, 1000, nullptr, nullptr, 0, 0};
      pg8::gemm_phase<EpiB<0>, StaticOrder, false, true>(F.lds, g, S, E); }
#else
      EpiB<2> E{((bf16*)(args.ws + WS_MIN)), 1024, 0, nullptr, ((bf16*)(args.ws + WS_Z)), ZW, ZC_GP};
      pg8::gemm_phase<EpiB<2>, StaticOrder, true, true>(F.lds, g, S, E); }
#endif
#endif
#ifdef DBG_POOL
    GRID_BAR();
    { const Args args = fresh_args(); MAKE_FRAME(); dbg_pool_check(F, args); }
#endif
#ifdef P5P6_BAR
    GRID_BAR();
#endif
#ifndef REP_DSA
#define REP_DSA 1
#endif
    for (int rep_ = 0; rep_ < REP_DSA; ++rep_) {

#ifndef NO_PH_DSA
    { const Args args = fresh_args(); MAKE_FRAME();
#ifndef NO_PRIO_DSA
      if (F.wave >> 2) __builtin_amdgcn_s_setprio(2);
#endif
      dsa_phase(F, args);
#ifndef NO_PRIO_DSA
      __builtin_amdgcn_s_setprio(0);
#endif
     }
#endif
    GRID_BAR();
    }

#if !defined(NO_PH_GEMM) && !defined(NO_P7)
    { const Args args = fresh_args(); MAKE_FRAME(); Gemm g{((bf16*)(args.ws + WS_ATT)), ((bf16*)(args.ws + WS_WUA)), T, 1024, 512}; StaticOrder S; S.init(T, 1024, F.G, bx); EpiB<3> E{((bf16*)(args.ws + WS_MIN)), 1024, 0, nullptr, ((bf16*)(args.ws + WS_Z)), ZW, ZC_GA};
      pg8::gemm_phase<EpiB<3>, StaticOrder, true, true>(F.lds, g, S, E); }
#endif
    GRID_BAR();
#ifdef DBG_POOL
    { const Args args = fresh_args(); MAKE_FRAME(); dbg_min_check(F, args); }
    GRID_BAR();
#endif
#ifndef REP_P8
#define REP_P8 1
#endif
    for (int rep_ = 0; rep_ < REP_P8; ++rep_) {
#ifndef NO_PH_GEMM
    { const Args args = fresh_args(); MAKE_FRAME(); Gemm g{((bf16*)(args.ws + WS_MIN)), ((bf16*)(args.ws + WS_WOUT)), T, 1024, 1024}; StaticOrder S; S.init(T, 1024, F.G, bx);
#ifdef X1_BF16
      EpiX1 E{args.x, ((bf16*)(args.ws + WS_X1)), ((const float*)(args.ws + WS_ADA)) + 2048};
      pg8::gemm_phase<EpiX1, StaticOrder, true, true>(F.lds, g, S, E); }
#else
      EpiRes E{args.x, args.out, ((const float*)(args.ws + WS_ADA)) + 2048};
      pg8::gemm_phase<EpiRes, StaticOrder, true, true>(F.lds, g, S, E); }
#endif
#endif
    GRID_BAR();
    }

#ifndef REP_P9
#define REP_P9 1
#endif
    for (int rep_ = 0; rep_ < REP_P9; ++rep_) {

#ifndef NO_PH_NORM
    { const Args args = fresh_args(); MAKE_FRAME();
#ifdef X1_BF16
      norm_rows(F, nullptr, args.g2, ((const float*)(args.ws + WS_ADA)), 3072, 4096, ((bf16*)(args.ws + WS_H)), args.ws + WS_H2HI, (float*)(args.ws + WS_SH2), (const bf16*)(args.ws + WS_X1)); }
#else
      norm_rows(F, args.out, args.g2, ((const float*)(args.ws + WS_ADA)), 3072, 4096, ((bf16*)(args.ws + WS_H)), args.ws + WS_H2HI, (float*)(args.ws + WS_SH2)); }
#endif
#endif
    GRID_BAR();
    }

#ifndef REP_P10
#define REP_P10 1
#endif
    for (int rep_ = 0; rep_ < REP_P10; ++rep_) {
#ifndef NO_PH_GEMM
    { const Args args = fresh_args(); MAKE_FRAME(); Gemm g{((bf16*)(args.ws + WS_H)), ((bf16*)(args.ws + WS_WPQ)), T, 1024, 1024}; StaticOrder S; S.init(T, 1024, F.G, bx); EpiB<0> E{((bf16*)(args.ws + WS_PQ)), 1024, 1000, nullptr, nullptr, 0, 0};
      pg8::gemm_phase<EpiB<0>, StaticOrder, false, true>(F.lds, g, S, E); }
#endif
    GRID_BAR();
    }

#ifndef REP_P11
#define REP_P11 1
#endif
    for (int rep_ = 0; rep_ < REP_P11; ++rep_) {

#ifndef NO_PH_ROUTE
    { const Args args = fresh_args(); MAKE_FRAME();
#ifdef PRIO_ROUTE
      if (F.wave >> 2) __builtin_amdgcn_s_setprio(2);
#endif
      peer_route(F, args);
#ifdef PRIO_ROUTE
      __builtin_amdgcn_s_setprio(0);
#endif
     }
#endif
#ifdef PEER_QUEUED
    GRID_BAR();
#else
    VM_WAIT();
    __builtin_amdgcn_fence(__ATOMIC_ACQUIRE, "agent"); VM_WAIT();
    __syncthreads();
#endif
#ifdef DBG_PEER
    { const Args args = fresh_args(); MAKE_FRAME(); dbg_peer_check1(F, args); }
    GRID_BAR();
#endif
    }

#ifndef REP_GATHER
#define REP_GATHER 1
#endif
    for (int rep_ = 1; rep_ < REP_GATHER; ++rep_) { { const Args args = fresh_args(); MAKE_FRAME(); peer_gather(F, args, true); } GRID_BAR(); }

#ifdef OLD_GATHER
    { const Args args = fresh_args(); MAKE_FRAME(); peer_gather(F, args, false); }
#else
#ifdef PEER_QUEUED
    { const Args args = fresh_args(); MAKE_FRAME(); peer_g1(F, args); } GRID_BAR();
    { const Args args = fresh_args(); MAKE_FRAME(); peer_g2(F, args); } GRID_BAR();
    { const Args args = fresh_args(); MAKE_FRAME(); peer_g3(F, args); }
#else
    { const Args args = fresh_args(); MAKE_FRAME();
#ifdef PRIO_LOCAL
      if (F.wave >> 2) __builtin_amdgcn_s_setprio(2);
#endif
      peer_local(F, args, bar);
#ifdef PRIO_LOCAL
      __builtin_amdgcn_s_setprio(0);
#endif
     }
#endif
#endif

#ifdef DBG_PEER
    GRID_BAR();
    { const Args args = fresh_args(); MAKE_FRAME(); dbg_peer_check2(F, args); }
#endif
#if defined(DBG_POOL) || defined(DBG_PEER) || defined(DBG_SEL)
    GRID_BAR();
    { const Args args = fresh_args(); dbg_report(args); }
#endif
#ifdef DBG_FP4
    GRID_BAR();
    if (blockIdx.x == 0 && threadIdx.x == 0) {
        const Args args = fresh_args();
        volatile unsigned* src = (volatile unsigned*)(args.ws + WS_CTL) + 80;
        const unsigned x = 0x00007521u + *src; const float one = 1.0f + (float)*src, three = 3.0f + (float)*src;
        typedef float f32x2q __attribute__((ext_vector_type(2)));
        const f32x2q f0 = __builtin_amdgcn_cvt_scalef32_pk_f32_fp4(x, one, 0), f1 = __builtin_amdgcn_cvt_scalef32_pk_f32_fp4(x, one, 1), f3 = __builtin_amdgcn_cvt_scalef32_pk_f32_fp4(x, three, 0);
        const unsigned b0 = __builtin_bit_cast(unsigned, __builtin_amdgcn_cvt_scalef32_pk_bf16_fp4(x, one, 0));
        const bool A = (f0.x == 0.5f && f0.y == 1.0f && f1.x == 3.0f && f1.y == 6.0f && b0 == 0x3F803F00u);
        const bool Bf = (f3.x == 1.5f && f3.y == 3.0f), Cf = (f3.x == 1.0f && f3.y == 2.0f);
        const int code = (A ? 1 : 0) + (Bf ? 2 : 0) + (Cf ? 4 : 0);
        args.out[0] += 1000.0f * (float)(1 + code);
    }
#endif
#ifndef DBG_SCALE
#define DBG_SCALE 1000.0f
#endif
#ifdef DBG_MFMA8
    GRID_BAR();
    {
        const Args args = fresh_args();
        volatile unsigned* src = (volatile unsigned*)(args.ws + WS_CTL) + 80;
        const int z = (int)*src;
        const int lane_ = threadIdx.x & 63;
        typedef int v8i_ __attribute__((ext_vector_type(8)));
        v8i_ a = (v8i_){0x22222222 + z, 0x22222222, 0x22222222, 0x22222222, 0, 0, 0, 0};
        v8i_ bb = (v8i_){0x38383838 + z, 0x38383838, 0x38383838, 0x38383838, 0x38383838, 0x38383838, 0x38383838, 0x38383838};
#if DBG_MFMA8 == 2
        a = (v8i_){(lane_ < 32) ? (0x00200000 + z) : z, 0, 0, 0, 0, 0, 0, 0};
        { const unsigned sgn = (lane_ >= 32) ? 0x80808080u : 0u;
          const unsigned w0 = 0x48444038u | sgn, w1 = 0x504E4C4Au | sgn, w2 = 0x54535251u | sgn, w3 = 0x58575655u | sgn;
          bb = (v8i_){(int)w0 + z, (int)w1, (int)w2, (int)w3, (int)w0, (int)w1, (int)w2, (int)w3}; }
#endif
        f32x16 c;
#pragma unroll
        for (int i = 0; i < 16; ++i) c[i] = 0.f;
#if DBG_MFMA8 == 3
        a = bb;
        c = __builtin_amdgcn_mfma_scale_f32_32x32x64_f8f6f4(a, bb, c, 0, 0, 0, 127 + z, 0, 127 + z);
#else
        c = __builtin_amdgcn_mfma_scale_f32_32x32x64_f8f6f4(a, bb, c, 4, 0, 0, 127 + z, 0, 127 + z);
#endif
        if (blockIdx.x == 0 && threadIdx.x == 0) { const float v = c[0]; float code = (v != v) ? 2.0f : (fabsf(v) > 1.0e6f) ? 3.0f : (fminf(fmaxf(v, -28.0f), 100.0f) * 0.25f + 12.0f); args.out[0] += DBG_SCALE * code; }
    }
#endif
#ifdef DBG_MFMA16
    GRID_BAR();
    {
        const Args args = fresh_args();
        volatile unsigned* src = (volatile unsigned*)(args.ws + WS_CTL) + 80;
        const int z = (int)*src;
        const int lane_ = threadIdx.x & 63, q_ = lane_ >> 4;
        typedef int v8i_ __attribute__((ext_vector_type(8)));
        constexpr int PQ = DBG_MFMA16 / 100, PJ = DBG_MFMA16 % 100;
        unsigned aw[4] = {0u, 0u, 0u, 0u};
        if (q_ == PQ) aw[PJ >> 3] = 2u << (4 * (PJ & 7));
        v8i_ a = (v8i_){(int)aw[0] + z, (int)aw[1], (int)aw[2], (int)aw[3], 0, 0, 0, 0};
        const unsigned sgn = (q_ >= 2) ? 0x80808080u : 0u;
        const unsigned lo0 = 0x48444038u, lo1 = 0x504E4C4Au, hi0 = 0x54535251u, hi1 = 0x58575655u;
        const unsigned w0 = ((q_ & 1) ? hi0 : lo0) | sgn, w1 = ((q_ & 1) ? hi1 : lo1) | sgn;
        v8i_ bb = (v8i_){(int)w0 + z, (int)w1, (int)w0, (int)w1, (int)w0, (int)w1, (int)w0, (int)w1};
        pg8::f32x4 c = (pg8::f32x4){0.f, 0.f, 0.f, 0.f};
        c = __builtin_amdgcn_mfma_scale_f32_16x16x128_f8f6f4(a, bb, c, 4, 0, 0, 127 + z, 0, 127 + z);
        if (blockIdx.x == 0 && threadIdx.x == 0) { const float v = c[0]; float code = (v != v) ? 2.0f : (fabsf(v) > 1.0e6f) ? 3.0f : (fminf(fmaxf(v, -28.0f), 100.0f) * 0.25f + 12.0f); args.out[0] += DBG_SCALE * code; }
    }
#endif

}

extern "C" void kernel_launch(void* const* d_in, const int* in_sizes, int n_in, void* d_out, int out_size, void* d_ws, size_t ws_size, hipStream_t stream) {
    static int grid = 0;
    if (grid == 0) {
        if (n_in != 19 || in_sizes[0] != T * D || out_size != T * D || ws_size < WS_END) { fprintf(stderr, "kernel_launch: unexpected shapes (n_in %d, in0 %d, out %d, ws %zu < %zu); nothing launched\n", n_in, n_in > 0 ? in_sizes[0] : -1, out_size, ws_size, (size_t)WS_END); grid = -1; return; }
        int dev = 0, cus = 0, per_cu = 0;
        if (hipGetDevice(&dev) != hipSuccess || hipDeviceGetAttribute(&cus, hipDeviceAttributeMultiprocessorCount, dev) != hipSuccess) { grid = -1; return; }
        if (hipFuncSetAttribute((const void*)fwd_megakernel, hipFuncAttributeMaxDynamicSharedMemorySize, LDS_BYTES) != hipSuccess) { fprintf(stderr, "kernel_launch: hipFuncSetAttribute failed\n"); grid = -1; return; }
        if (hipOccupancyMaxActiveBlocksPerMultiprocessor(&per_cu, (const void*)fwd_megakernel, NTHR, LDS_BYTES) != hipSuccess || per_cu < 1) { fprintf(stderr, "kernel_launch: occupancy query says %d blocks per CU; nothing launched\n", per_cu); (void)hipGetLastError(); grid = -1; return; }
        grid = 256; while (grid > cus) grid >>= 1;
        if (grid < 8) { fprintf(stderr, "kernel_launch: only %d CUs; nothing launched\n", cus); grid = -1; return; }
    }
    if (grid < 0) return;
    if (hipMemsetAsync((char*)d_ws + WS_CTL, 0, CTL_ZERO_BYTES, stream) != hipSuccess) { fprintf(stderr, "kernel_launch: memset failed\n"); return; }
    Args a{};
    const float** ap = (const float**)&a;
    for (int i = 0; i < 19; ++i) ap[i] = (const float*)d_in[i];
    a.out = (float*)d_out; a.ws = (unsigned char*)d_ws;
    void* kargs[] = {&a};
    hipError_t e = hipLaunchCooperativeKernel((const void*)fwd_megakernel, dim3(grid), dim3(NTHR), kargs, LDS_BYTES, stream);
    if (e != hipSuccess) fprintf(stderr, "kernel_launch: cooperative launch failed: %s (grid %d)\n", hipGetErrorString(e), grid);
}
```

```cpp
#define Z_I8 1
#define GATE_I8 1
#define GATE_FP8 1
#define MIN_FP8 1
#define ZP_FP8 1
#define X1_BF16 1
#define QN_DSA 1
#define ADA_SPREAD 1
#define QUANT2 1
#define EIDX16 1
#include <hip/hip_runtime.h>
#include <hip/hip_bf16.h>
#include <cstdio>
#include <cstdint>
__device__ __forceinline__ int opaque_tid() { int t = threadIdx.x; asm volatile("" : "+v"(t)); return t; }
namespace pg8 {
#define PG8_LAS __attribute__((address_space(3)))
typedef unsigned short bf16_t;
typedef short bf16x8 __attribute__((ext_vector_type(8)));
typedef float f32x4 __attribute__((ext_vector_type(4)));
typedef unsigned u32x4 __attribute__((ext_vector_type(4)));
typedef int i32x4 __attribute__((ext_vector_type(4)));
constexpr int BM = 256, BK = 64, HALF = 128, HTB = HALF * BK * 2  , STAGE_BYTES = 8 * HTB, NXCD = 8, WGM = 8;

__host__ __device__ __forceinline__ int lds_byte(int r, int c) { const int st = (r >> 4) * 2 + (c >> 5), rr = r & 15, cc = c & 31, ob = rr * 64 + cc * 2; return st * 1024 + (ob ^ (((ob >> 9) & 1) << 5)); }
__host__ __device__ __forceinline__ void stage_rc(int b, int& R, int& C) { const int st = b / 1024, sb = b % 1024, swz = sb ^ (((sb >> 9) & 1) << 5); R = (st >> 1) * 16 + swz / 64; C = (st & 1) * 32 + (swz % 64) / 2; }
__host__ __device__ __forceinline__ int perm32(int rho) { const int n = rho >> 4, i = rho & 15; return 8 * (i >> 2) + 4 * n + (i & 3); }

struct Unit { int pm, pn; };
struct Gemm { const bf16_t* A; const bf16_t* Bt; int M, N, K; };

struct StaticOrder {
    int nM, nN, nwg, G, c;
    __host__ __device__ void init(int M, int N, int G_, int c_) { nM = M / BM; nN = N / BM; nwg = nM * nN; G = G_; c = c_; }
    __host__ __device__ bool next(int i, Unit& u) const {
        const long L = (long)i * G + c; if (L >= nwg) return false;
        int wgid = (int)L; { const int q = nwg / NXCD, r = nwg % NXCD, xcd = wgid % NXCD, off = wgid / NXCD; wgid = (xcd < r ? xcd * (q + 1) : r * (q + 1) + (xcd - r) * q) + off; }
        const int nig = WGM * nN, gid = wgid / nig, fm = gid * WGM, gsz = (nM - fm) < WGM ? (nM - fm) : WGM;
        u.pm = fm + ((wgid % nig) % gsz); u.pn = (wgid % nig) / gsz; return true;
    }
    __device__ __forceinline__ void a_ready(const Unit&) const {}
    __device__ __forceinline__ void done(const Unit&) const {}
};

__device__ __forceinline__ unsigned cvt_pk_bf16(float lo, float hi) { unsigned r; asm volatile("v_cvt_pk_bf16_f32 %0, %1, %2" : "=v"(r) : "v"(lo), "v"(hi)); return r; }
typedef float f32x2 __attribute__((ext_vector_type(2)));
__device__ __forceinline__ f32x2 gelu_pk(f32x2 v) {
    const f32x2 av = __builtin_elementwise_abs(v), d = av * 0.2316418882f + 1.0f;
    f32x2 t; t.x = __builtin_amdgcn_rcpf(d.x); t.y = __builtin_amdgcn_rcpf(d.y);
    f32x2 q = t * 0.5307027145f + (-0.7265760135f); q = q * t + 0.7107068705f; q = q * t + (-0.142248368f); q = q * t + 0.127414796f; q = q * t;
    const f32x2 s = (v * v) * (-0.72134752044f);
    f32x2 e; e.x = __builtin_amdgcn_exp2f(s.x); e.y = __builtin_amdgcn_exp2f(s.y);
    const f32x2 m = v * (q * e), r = v - m;
    f32x2 o; o.x = v.x < 0.f ? m.x : r.x; o.y = v.y < 0.f ? m.y : r.y; return o;
}

template <int ACT  > struct EpiBf16 {
    static constexpr bool PERM = true, AFTER_DRAIN = false; static_assert(ACT == 0 || ACT == 1, "EpiBf16: ACT is 0 (none) or 1 (gelu_pk)");
    bf16_t* O; int ldc; const float* bias; int split_cols; size_t split_stride; float scale0;
    __device__ __forceinline__ void operator()(const f32x4 (&acc)[2][2][4][2], const Unit& u, int wr, int wc, int fr, int fq) const {
        const int row0 = u.pm * BM + wr * 64 + fr; int colt = u.pn * BM; bf16_t* base = O;
        float sc = 1.f; if (split_cols) { const int t = colt / split_cols; base += (size_t)t * split_stride; colt -= t * split_cols; if (t == 0) sc = scale0; }
        const int col0 = colt + wc * 32 + 8 * fq, bcol0 = u.pn * BM + wc * 32 + 8 * fq;
        f32x4 bv[2][2];
#pragma unroll
        for (int bj = 0; bj < 2; ++bj)
#pragma unroll
            for (int n = 0; n < 2; ++n) bv[bj][n] = bias ? *(const f32x4*)(bias + bcol0 + bj * HALF + 4 * n) : (f32x4){0.f, 0.f, 0.f, 0.f};
#pragma unroll
        for (int ai = 0; ai < 2; ++ai)
#pragma unroll
            for (int m = 0; m < 4; ++m) { bf16_t* rowp = base + (size_t)(row0 + ai * HALF + m * 16) * ldc + col0;
#pragma unroll
                for (int bj = 0; bj < 2; ++bj) { f32x4 v0 = acc[ai][bj][m][0] + bv[bj][0], v1 = acc[ai][bj][m][1] + bv[bj][1];
                    if (ACT == 1) { f32x2 a = gelu_pk((f32x2){v0[0], v0[1]}), b = gelu_pk((f32x2){v0[2], v0[3]}), c = gelu_pk((f32x2){v1[0], v1[1]}), d = gelu_pk((f32x2){v1[2], v1[3]});
                        v0 = (f32x4){a.x, a.y, b.x, b.y}; v1 = (f32x4){c.x, c.y, d.x, d.y}; }
                    v0 = v0 * sc; v1 = v1 * sc; u32x4 w; w.x = cvt_pk_bf16(v0[0], v0[1]); w.y = cvt_pk_bf16(v0[2], v0[3]); w.z = cvt_pk_bf16(v1[0], v1[1]); w.w = cvt_pk_bf16(v1[2], v1[3]);
                    *(u32x4*)(rowp + bj * HALF) = w; } }
    }
};
template <class Epi, class Sched, bool ALIGN_EPI = false, bool SP2 = false, bool I8 = false>
__device__ __forceinline__ void gemm_phase(PG8_LAS unsigned char* lds, const Gemm g, const Sched& S, const Epi& E) {
    const int tid = opaque_tid(), wid = __builtin_amdgcn_readfirstlane(tid >> 6), lane = tid & 63, wr = wid >> 2, wc = wid & 3, fr = lane & 15, fq = lane >> 4;
    const int K = g.K, nt = K / BK;
    unsigned voffA[2], voffB[2];
#pragma unroll
    for (int i = 0; i < 2; ++i) { int R, C; stage_rc(tid * 16 + i * 8192, R, C); const int Rb = Epi::PERM ? ((R & ~31) + perm32(R & 31)) : R;
        voffA[i] = (unsigned)(R * K + C) * 2u; voffB[i] = (unsigned)(Rb * K + C) * 2u; }
    const size_t kstep = (size_t)(BK * 2);
    const size_t hstep = (size_t)HALF * K * 2;
    const size_t tstep = 2 * hstep;
    const unsigned ldsw = (unsigned)wid * 1024u;
    const int aoff = lds_byte(wr * 64 + fr, fq * 8), boff = lds_byte(wc * 32 + fr, fq * 8);
#define PG8_SA(b, h) (((b) * 2 + (h)) * HTB)
#define PG8_SB(b, h) ((4 + (b) * 2 + (h)) * HTB)
#define PG8_STAGE(bufoff, gbase, voff) do { _Pragma("unroll") for (int _i = 0; _i < 2; ++_i) \
        __builtin_amdgcn_global_load_lds((const unsigned*)((const char*)(gbase) + (voff)[_i]), (PG8_LAS unsigned*)(lds + (bufoff) + ldsw + _i * 8192), 16, 0, 0); } while (0)
#define PG8_LDA(dst, b, h) do { _Pragma("unroll") for (int m = 0; m < 4; ++m) _Pragma("unroll") for (int k = 0; k < 2; ++k) dst[m][k] = *(const PG8_LAS bf16x8*)(lds + PG8_SA(b, h) + aoff + m * 2048 + k * 1024); } while (0)
#define PG8_LDB(dst, b, h) do { _Pragma("unroll") for (int n = 0; n < 2; ++n) _Pragma("unroll") for (int k = 0; k < 2; ++k) dst[n][k] = *(const PG8_LAS bf16x8*)(lds + PG8_SB(b, h) + boff + n * 2048 + k * 1024); } while (0)
#define PG8_MMA(ai, bj, At, Bt) do { __builtin_amdgcn_s_setprio(1); _Pragma("unroll") for (int m = 0; m < 4; ++m) _Pragma("unroll") for (int n = 0; n < 2; ++n) _Pragma("unroll") for (int k = 0; k < 2; ++k) { \
        if constexpr (I8) acc[ai][bj][m][n] = __builtin_bit_cast(f32x4, __builtin_amdgcn_mfma_i32_16x16x64_i8(__builtin_bit_cast(i32x4, Bt[n][k]), __builtin_bit_cast(i32x4, At[m][k]), __builtin_bit_cast(i32x4, acc[ai][bj][m][n]), 0, 0, 0)); \
        else acc[ai][bj][m][n] = __builtin_amdgcn_mfma_f32_16x16x32_bf16(Bt[n][k], At[m][k], acc[ai][bj][m][n], 0, 0, 0); } __builtin_amdgcn_s_setprio(0); } while (0)
#define PG8_WAIT_V(n) asm volatile("s_waitcnt vmcnt(" #n ")" ::: "memory")
#define PG8_WAIT_L(n) asm volatile("s_waitcnt lgkmcnt(" #n ")" ::: "memory")
#define PG8_BAR __builtin_amdgcn_s_barrier()
#define PG8_SCHED __builtin_amdgcn_sched_barrier(0)
    Unit cur, nxt; int ui = 0;
    if (!S.next(0, cur)) return;
    f32x4 acc[2][2][4][2];
#pragma unroll
    for (int a = 0; a < 2; ++a)
#pragma unroll
        for (int b = 0; b < 2; ++b)
#pragma unroll
            for (int m = 0; m < 4; ++m)
#pragma unroll
                for (int n = 0; n < 2; ++n) acc[a][b][m][n] = (f32x4){0.f, 0.f, 0.f, 0.f};
    bf16x8 At[4][2], B0[2][2], B1[2][2];
    const char* cA = (const char*)g.A + (size_t)cur.pm * tstep; const char* cB = (const char*)g.Bt + (size_t)cur.pn * tstep;
    S.a_ready(cur);
    if constexpr (SP2) {
        PG8_STAGE(PG8_SB(0, 0), cB, voffB); PG8_STAGE(PG8_SB(0, 1), cB + hstep, voffB); PG8_STAGE(PG8_SA(0, 0), cA, voffA); PG8_STAGE(PG8_SA(0, 1), cA + hstep, voffA);
        if (wr == 1) PG8_BAR;
        PG8_WAIT_V(2); PG8_BAR;
        PG8_STAGE(PG8_SB(1, 0), cB + kstep, voffB); PG8_STAGE(PG8_SA(1, 0), cA + kstep, voffA); PG8_STAGE(PG8_SB(1, 1), cB + hstep + kstep, voffB);
        PG8_WAIT_V(6); PG8_BAR;
    } else {
        PG8_STAGE(PG8_SB(0, 0), cB, voffB); PG8_STAGE(PG8_SA(0, 0), cA, voffA); PG8_STAGE(PG8_SB(0, 1), cB + hstep, voffB); PG8_STAGE(PG8_SA(0, 1), cA + hstep, voffA);
        if (wr == 1) PG8_BAR;
        PG8_WAIT_V(4); PG8_BAR;
        PG8_STAGE(PG8_SB(1, 0), cB + kstep, voffB); PG8_STAGE(PG8_SA(1, 0), cA + kstep, voffA); PG8_STAGE(PG8_SB(1, 1), cB + hstep + kstep, voffB);
        PG8_WAIT_V(6); PG8_BAR;
    }
    for (;;) {
        const bool has_next = S.next(ui + 1, nxt);
        const char* nA = has_next ? (const char*)g.A + (size_t)nxt.pm * tstep : cA; const char* nB = has_next ? (const char*)g.Bt + (size_t)nxt.pn * tstep : cB;
        for (int t = 0; t < nt; t += 2) {
            const bool last = (t == nt - 2);
            const char* a1 = cA + (size_t)(t + 1) * kstep;
            const char* a2 = last ? nA : cA + (size_t)(t + 2) * kstep; const char* b2 = last ? nB : cB + (size_t)(t + 2) * kstep;
            const char* a3 = a2 + kstep; const char* b3 = b2 + kstep;
            if (last && has_next) S.a_ready(nxt);
            if constexpr (SP2) {
            PG8_LDB(B0, 0, 0); PG8_LDB(B1, 0, 1); PG8_SCHED; PG8_LDA(At, 0, 0); PG8_STAGE(PG8_SA(1, 1), a1 + hstep, voffA);
            PG8_WAIT_V(8); PG8_WAIT_L(0); PG8_BAR; PG8_MMA(0, 0, At, B0); PG8_MMA(0, 1, At, B1); PG8_BAR; PG8_SCHED;
            PG8_LDA(At, 0, 1); PG8_STAGE(PG8_SB(0, 0), b2, voffB); PG8_STAGE(PG8_SB(0, 1), b2 + hstep, voffB); PG8_STAGE(PG8_SA(0, 0), a2, voffA);
            PG8_WAIT_V(8); PG8_WAIT_L(0); PG8_BAR; PG8_MMA(1, 0, At, B0); PG8_MMA(1, 1, At, B1); PG8_BAR; PG8_SCHED;
            PG8_LDB(B0, 1, 0); PG8_LDB(B1, 1, 1); PG8_SCHED; PG8_LDA(At, 1, 0); PG8_STAGE(PG8_SA(0, 1), a2 + hstep, voffA);
            PG8_WAIT_V(8); PG8_WAIT_L(0); PG8_BAR; PG8_MMA(0, 0, At, B0); PG8_MMA(0, 1, At, B1); PG8_BAR; PG8_SCHED;
            PG8_LDA(At, 1, 1); PG8_STAGE(PG8_SB(1, 0), b3, voffB); PG8_STAGE(PG8_SB(1, 1), b3 + hstep, voffB); PG8_STAGE(PG8_SA(1, 0), a3, voffA);
            PG8_WAIT_V(8); PG8_WAIT_L(0); PG8_BAR; PG8_MMA(1, 0, At, B0); PG8_MMA(1, 1, At, B1); PG8_BAR; PG8_SCHED;
            } else {
            PG8_LDB(B0, 0, 0); PG8_SCHED; PG8_LDA(At, 0, 0); PG8_STAGE(PG8_SA(1, 1), a1 + hstep, voffA);
            PG8_WAIT_L(8); PG8_BAR; PG8_WAIT_L(0); PG8_MMA(0, 0, At, B0); PG8_BAR; PG8_SCHED;
            PG8_LDB(B1, 0, 1); PG8_STAGE(PG8_SB(0, 0), b2, voffB);
            PG8_BAR; PG8_WAIT_L(0); PG8_MMA(0, 1, At, B1); PG8_BAR;
            PG8_LDA(At, 0, 1); PG8_STAGE(PG8_SA(0, 0), a2, voffA);
            PG8_BAR; PG8_WAIT_L(0); PG8_MMA(1, 0, At, B0); PG8_BAR; PG8_SCHED;
            PG8_STAGE(PG8_SB(0, 1), b2 + hstep, voffB);
            PG8_WAIT_V(6); PG8_BAR; PG8_MMA(1, 1, At, B1); PG8_BAR;
            PG8_LDB(B0, 1, 0); PG8_SCHED; PG8_LDA(At, 1, 0); PG8_STAGE(PG8_SA(0, 1), a2 + hstep, voffA);
            PG8_WAIT_L(8); PG8_BAR; PG8_WAIT_L(0); PG8_MMA(0, 0, At, B0); PG8_BAR; PG8_SCHED;
            PG8_LDB(B1, 1, 1); PG8_STAGE(PG8_SB(1, 0), b3, voffB);
            PG8_BAR; PG8_WAIT_L(0); PG8_MMA(0, 1, At, B1); PG8_BAR;
            PG8_LDA(At, 1, 1); PG8_STAGE(PG8_SA(1, 0), a3, voffA);
            PG8_BAR; PG8_WAIT_L(0); PG8_MMA(1, 0, At, B0); PG8_BAR; PG8_SCHED;
            PG8_STAGE(PG8_SB(1, 1), b3 + hstep, voffB);
            PG8_WAIT_V(6); PG8_BAR; PG8_MMA(1, 1, At, B1); PG8_BAR;
            }
        }
        if constexpr (ALIGN_EPI) { if (wr == 0) PG8_BAR; }
        if constexpr (!Epi::AFTER_DRAIN) { E(acc, cur, wr, wc, fr, fq); S.done(cur); }
        if (!has_next) break;
#pragma unroll
        for (int a = 0; a < 2; ++a)
#pragma unroll
            for (int b = 0; b < 2; ++b)
#pragma unroll
                for (int m = 0; m < 4; ++m)
#pragma unroll
                    for (int n = 0; n < 2; ++n) acc[a][b][m][n] = (f32x4){0.f, 0.f, 0.f, 0.f};
        cur = nxt; cA = nA; cB = nB; ++ui;
        if constexpr (ALIGN_EPI) { if (wr == 1) PG8_BAR; }
    }
    PG8_WAIT_V(0);
    if constexpr (!ALIGN_EPI) { if (wr == 0) PG8_BAR; }
    PG8_BAR;
    if constexpr (Epi::AFTER_DRAIN) { E.fused(acc, cur, wr, wc, fr, fq, lds, wid, lane); S.done(cur); }
#undef PG8_SA
#undef PG8_SB
#undef PG8_STAGE
#undef PG8_LDA
#undef PG8_LDB
#undef PG8_MMA
#undef PG8_WAIT_V
#undef PG8_WAIT_L
#undef PG8_BAR
#undef PG8_SCHED
}
}

#define GAS __attribute__((address_space(1)))
#define LAS __attribute__((address_space(3)))
typedef unsigned short bf16;
typedef unsigned v4u __attribute__((ext_vector_type(4)));
typedef unsigned v2u __attribute__((ext_vector_type(2)));
typedef float f32x4 __attribute__((ext_vector_type(4)));
typedef float f32x16 __attribute__((ext_vector_type(16)));
typedef short bf16x8 __attribute__((ext_vector_type(8)));
typedef __bf16 bf16x2_t __attribute__((ext_vector_type(2)));

constexpr int NWAVES = 8, NTHR = 512;
constexpr int NB = 32, SEQ = 2048, T = NB * SEQ, D = 1024, ZW = 3584, INW = 3524;
constexpr int ZC_Q = 0, ZC_K = 512, ZC_V = 576, ZC_IK = 640, ZC_IW = 704, ZC_IQ = 768, ZC_ZP = 1024, ZC_GA = 1536, ZC_GP = 2560;
constexpr float EPS = 1e-6f;
constexpr float QSCALE = 0.125f * 1.4426950408889634f;

constexpr size_t MiB = 1u << 20;
constexpr size_t WS_CTL = 0, CTL_ZERO_BYTES = 65536;
constexpr size_t WS_ADA = 1 * MiB, WS_IW = 2 * MiB, WS_SK = 3 * MiB, WS_WGRP = 4 * MiB, WS_WUA = 5 * MiB, WS_WUP = 6 * MiB, WS_WOUT = 7 * MiB, WS_WPQ = 9 * MiB, WS_WIN = 11 * MiB;
constexpr size_t WS_IKX = 18 * MiB, WS_KX = 26 * MiB, WS_VX = 34 * MiB;
constexpr size_t WS_U = 64 * MiB, WS_V = 96 * MiB, WS_Z = 128 * MiB, WS_H = 576 * MiB, WS_POOLED = 576 * MiB, WS_PM = 640 * MiB;
constexpr size_t WS_ATT = 704 * MiB, WS_PQ = 704 * MiB, WS_MIN = 832 * MiB, WS_EIDX = 832 * MiB, WS_EGATE = 864 * MiB, WS_END = 960 * MiB;
constexpr int CW_BAR = 4096;
constexpr size_t WS_SU = 512 * 1024, WS_SV = 576 * 1024, WS_SH2 = 640 * 1024;
constexpr size_t WS_H8 = 704 * MiB;
#ifdef Z_I8
constexpr size_t WS_WG8 = 44 * MiB, WS_CS8 = 48 * MiB, WS_S1 = 49 * MiB;
#else
constexpr size_t WS_WG8 = 44 * MiB, WS_CS8 = 46 * MiB, WS_S1 = 47 * MiB;
#endif
constexpr size_t WS_X1 = 128 * MiB;
constexpr size_t WS_H2HI = 384 * MiB, WS_H2LO = 416 * MiB;
constexpr size_t WS_H2F8 = 384 * MiB;

constexpr int RING_BYTES = 131072, LDS_BYTES = 163840, LDSCTL_OFF = LDS_BYTES - 1024, MISC_OFF = LDSCTL_OFF + 320;

__device__ __forceinline__ unsigned f2bf(float f) { unsigned u = __builtin_bit_cast(unsigned, f); return (u + 0x7fffu + ((u >> 16) & 1u)) >> 16; }
__device__ __forceinline__ unsigned pk2(float lo, float hi) { typedef float f32x2_ __attribute__((ext_vector_type(2))); typedef __bf16 bf16x2_ __attribute__((ext_vector_type(2))); const f32x2_ v = {lo, hi}; return __builtin_bit_cast(unsigned, __builtin_convertvector(v, bf16x2_)); }
__device__ __forceinline__ float bflo(unsigned w) { return __builtin_bit_cast(float, w << 16); }
__device__ __forceinline__ float bfhi(unsigned w) { return __builtin_bit_cast(float, w & 0xffff0000u); }
__device__ __forceinline__ float bf2f(bf16 h) { return __builtin_bit_cast(float, (unsigned)h << 16); }
#define LDS_WAIT() asm volatile("s_waitcnt lgkmcnt(0)" ::: "memory")
#define VM_WAIT() asm volatile("s_waitcnt vmcnt(0)" ::: "memory")

#define XB_TMO      128
#define XB_XCNT(j)  (256  + 64 * (j))
#define XB_XSUB(j)  (1280 + 64 * (j))
#define XB_XGEN(j)  (2304 + 64 * (j))
#define XB_TOP      3328
#define XB_TOPGEN   3392
#define XCD_BAR_WORDS 3456
#define XB_SPIN_CAP (1u << 26)

__device__ __forceinline__ unsigned xb_ld(unsigned* p)              { return __hip_atomic_load(p, __ATOMIC_RELAXED, __HIP_MEMORY_SCOPE_AGENT); }
__device__ __forceinline__ unsigned xb_add(unsigned* p, unsigned v) { return __hip_atomic_fetch_add(p, v, __ATOMIC_RELAXED, __HIP_MEMORY_SCOPE_AGENT); }
__device__ __forceinline__ unsigned xb_xcc_id() { return (unsigned)__builtin_amdgcn_s_getreg((3 << 11) | 20) & 0xFu; }
#define XB_SPIN(cond, bar) do { unsigned _sp = 0; while (cond) { __builtin_amdgcn_s_sleep(1); \
    if ((++_sp & 255u) == 0u) { if (xb_ld(&(bar)[XB_TMO])) break; if (_sp > XB_SPIN_CAP) { atomicAdd(&(bar)[XB_TMO], 1u); break; } } } } while (0)

struct XcdBarrier {
    unsigned* bar; unsigned x;
    volatile LAS unsigned* st;
};

__device__ __forceinline__ XcdBarrier xcd_barrier_post(unsigned* bar, volatile LAS unsigned* st) {
    XcdBarrier b; b.bar = bar; b.x = xb_xcc_id(); b.st = st;
    if (threadIdx.x == 0) (void)xb_add(&bar[XB_XCNT(b.x)], 1u);
    return b;
}
__device__ __forceinline__ void xcd_barrier_complete(unsigned* bar, unsigned x, unsigned& nloc, unsigned& nx) {
    const unsigned G = gridDim.x * gridDim.y * gridDim.z;
    unsigned sum, cnt, mine, sp = 0u;
    for (;;) {
        sum = 0u; cnt = 0u; mine = 0u;
#pragma unroll
        for (unsigned j = 0; j < 16; ++j) { const unsigned c = xb_ld(&bar[XB_XCNT(j)]); sum += c; cnt += (c > 0u) ? 1u : 0u; mine = (j == x) ? c : mine; }
        if (sum == G) break;
        __builtin_amdgcn_s_sleep(1);
        if ((++sp & 255u) == 0u) { if (xb_ld(&bar[XB_TMO])) break; if (sp > XB_SPIN_CAP) { atomicAdd(&bar[XB_TMO], 1u); break; } }
    }
    nloc = mine > 0u ? mine : 1u; nx = cnt > 0u ? cnt : 1u;
}

__device__ __forceinline__ void xcd_barrier(const XcdBarrier& b) {
    asm volatile("s_waitcnt vmcnt(0)" ::: "memory");
    __syncthreads();
    if (threadIdx.x == 0) {
        unsigned* bar = b.bar;
        __builtin_amdgcn_s_waitcnt(0);
        unsigned nloc = b.st[0], nx = b.st[1];
        if (nloc == 0u) { xcd_barrier_complete(bar, b.x, nloc, nx); b.st[0] = nloc; b.st[1] = nx; }
        const unsigned old = xb_add(&bar[XB_XSUB(b.x)], 1u);
        const unsigned gen = old / nloc;
        if (old + 1u == (gen + 1u) * nloc) {
            __builtin_amdgcn_fence(__ATOMIC_RELEASE, "agent");
            asm volatile("s_waitcnt vmcnt(0)" ::: "memory");
            const unsigned og = xb_add(&bar[XB_TOP], 1u);
            const unsigned tg = og / nx;
            if (og + 1u == (tg + 1u) * nx) xb_add(&bar[XB_TOPGEN], 1u);
            else XB_SPIN(xb_ld(&bar[XB_TOPGEN]) == tg, bar);
            __builtin_amdgcn_fence(__ATOMIC_ACQUIRE, "agent");
            xb_add(&bar[XB_XGEN(b.x)], 1u);
            asm volatile("s_waitcnt vmcnt(0)" ::: "memory");
        } else {
            XB_SPIN(xb_ld(&bar[XB_XGEN(b.x)]) == gen, bar);
            __builtin_amdgcn_fence(__ATOMIC_ACQUIRE, "agent");
            asm volatile("s_waitcnt vmcnt(0)" ::: "memory");
        }
    }
    __syncthreads();
}


struct Args {
    const float *x, *c, *w_ada, *b_ada, *g1, *w_in, *g_q, *g_k, *g_ik, *w_grp, *s_pool, *w_ua, *w_up, *w_out, *g2, *w_pq, *sk, *pu, *pv;
    float* out; unsigned char* ws;
};

struct Frame {
    LAS unsigned char* lds;
    int tid, lane, wave, vcu, G, gw, NGW;
};

__device__ __forceinline__ float wave_sum(float v) {
#pragma unroll
    for (int o = 1; o < 64; o <<= 1) v += __shfl_xor(v, o);
    return v;
}
__device__ __forceinline__ float xhalf_max(float m) { auto rr = __builtin_amdgcn_permlane32_swap(__float_as_uint(m), __float_as_uint(m), false, false); return fmaxf(__uint_as_float(rr[0]), __uint_as_float(rr[1])); }
__device__ __forceinline__ float xhalf_sum(float m) { auto rr = __builtin_amdgcn_permlane32_swap(__float_as_uint(m), __float_as_uint(m), false, false); return __uint_as_float(rr[0]) + __uint_as_float(rr[1]); }
__device__ __forceinline__ unsigned ordf(float f) { unsigned b = __float_as_uint(f); return b ^ ((b >> 31) ? 0xFFFFFFFFu : 0x80000000u); }
__device__ __forceinline__ float unordf(unsigned u) { unsigned b = u ^ ((u >> 31) ? 0x80000000u : 0xFFFFFFFFu); return __uint_as_float(b); }

__device__ __forceinline__ void transpose_item(const float* W, int ldw, int src_k0, int src_col0, int valid, bf16* WT, int ldwt, int dst_row0, int dst_k0, LAS float* scr, int lane) {
#pragma unroll 8
    for (int i = 0; i < 32; ++i) { const int kk = 2 * i + (lane >> 5), n = lane & 31; scr[kk * 33 + n] = (n < valid) ? W[(size_t)(src_k0 + kk) * ldw + src_col0 + n] : 0.f; }
    LDS_WAIT(); asm volatile("" ::: "memory");
    const int c = lane & 7;
#pragma unroll
    for (int j = 0; j < 4; ++j) { const int n = (lane >> 3) + 8 * j; const LAS float* s = scr + (8 * c) * 33 + n;
        v4u o; o.x = pk2(s[0 * 33], s[1 * 33]); o.y = pk2(s[2 * 33], s[3 * 33]); o.z = pk2(s[4 * 33], s[5 * 33]); o.w = pk2(s[6 * 33], s[7 * 33]);
        *(GAS v4u*)(WT + (size_t)(dst_row0 + n) * ldwt + dst_k0 + 8 * c) = o; }
    LDS_WAIT(); asm volatile("" ::: "memory");
}
__device__ __forceinline__ void zcol_src(int nb, int& src, int& valid) {
    const int n0 = nb * 32; valid = 32;
    if (n0 < 640) src = n0;
    else if (n0 < 704) src = 896 + (n0 - 640);
    else if (n0 < 736) { src = 960; valid = 4; }
    else if (n0 < 768) { src = 0; valid = 0; }
    else if (n0 < 1024) src = 640 + (n0 - 768);
    else if (n0 < 1536) src = 964 + (n0 - 1024);
    else src = 1476 + (n0 - 1536);
}
__device__ __forceinline__ void cvt_stream(const float* src, bf16* dst, size_t n8, int gtid, int gthreads) {
    for (size_t i = gtid; i < n8; i += gthreads) {
        const f32x4 a = ((const GAS f32x4*)src)[2 * i], b = ((const GAS f32x4*)src)[2 * i + 1];
        v4u o; o.x = pk2(a.x, a.y); o.y = pk2(a.z, a.w); o.z = pk2(b.x, b.y); o.w = pk2(b.z, b.w);
        ((GAS v4u*)dst)[i] = o;
    }
}
__device__ __forceinline__ void p0_prologue(Frame& F, const Args& A) {
    unsigned char* ws = A.ws;
    float* ADA = (float*)(ws + WS_ADA);
#ifdef ADA_SPREAD
    if (F.vcu * NWAVES < 1536) {
        LAS float* cT = (LAS float*)F.lds;
        LAS float* part = (LAS float*)(F.lds + 131072);
        for (int idx = F.tid; idx < NB * D; idx += NTHR) cT[(idx & (D - 1)) * NB + (idx >> 10)] = A.c[idx];
        __syncthreads();
      for (int item = F.gw; item < 1536; item += F.NGW) {
        const int task = item >> 2, quarter = item & 3;
        {
            const int col = task * 16 + (F.lane & 15), ks = F.lane >> 4;
            float acc[NB];
#pragma unroll
            for (int b = 0; b < NB; ++b) acc[b] = 0.f;
#pragma unroll 4
            for (int i = 0; i < 64; ++i) {
                const int k = quarter * 256 + 4 * i + ks;
                const float w = A.w_ada[(size_t)k * 6144 + col];
                const LAS f32x4* cr = (const LAS f32x4*)(cT + k * NB);
#pragma unroll
                for (int b4 = 0; b4 < 8; ++b4) { const f32x4 cv = cr[b4]; acc[4 * b4] = fmaf(cv.x, w, acc[4 * b4]); acc[4 * b4 + 1] = fmaf(cv.y, w, acc[4 * b4 + 1]); acc[4 * b4 + 2] = fmaf(cv.z, w, acc[4 * b4 + 2]); acc[4 * b4 + 3] = fmaf(cv.w, w, acc[4 * b4 + 3]); }
            }
#pragma unroll
            for (int b = 0; b < NB; ++b) { float v = acc[b]; v += __shfl_xor(v, 16); v += __shfl_xor(v, 32); acc[b] = v; }
            if (ks == 0) {
                LAS f32x4* pp = (LAS f32x4*)(part + (F.wave * 16 + (F.lane & 15)) * NB);
#pragma unroll
                for (int b4 = 0; b4 < 8; ++b4) pp[b4] = (f32x4){acc[4 * b4], acc[4 * b4 + 1], acc[4 * b4 + 2], acc[4 * b4 + 3]};
            }
        }
        __syncthreads();
        if (quarter == 0) {
#pragma unroll
            for (int j = 0; j < 8; ++j) {
                const int o = F.lane * 8 + j, cc = o >> 5, bb = o & 31;
                const float v = part[((F.wave + 0) * 16 + cc) * NB + bb] + part[((F.wave + 1) * 16 + cc) * NB + bb] + part[((F.wave + 2) * 16 + cc) * NB + bb] + part[((F.wave + 3) * 16 + cc) * NB + bb];
                ADA[bb * 6144 + task * 16 + cc] = v + A.b_ada[task * 16 + cc];
            }
        }
        __syncthreads();
      }
    }
#else
    if (F.vcu * NWAVES < 384) {
        LAS float* cT = (LAS float*)F.lds;
        for (int idx = F.tid; idx < NB * D; idx += NTHR) cT[(idx & (D - 1)) * NB + (idx >> 10)] = A.c[idx];
        __syncthreads();
        for (int task = F.gw; task < 384; task += F.NGW) {
            const int col = task * 16 + (F.lane & 15), ks = F.lane >> 4;
            float acc[NB];
#pragma unroll
            for (int b = 0; b < NB; ++b) acc[b] = 0.f;
#pragma unroll 4
            for (int i = 0; i < 256; ++i) {
                const int k = 4 * i + ks;
                const float w = A.w_ada[(size_t)k * 6144 + col];
                const LAS f32x4* cr = (const LAS f32x4*)(cT + k * NB);
#pragma unroll
                for (int b4 = 0; b4 < 8; ++b4) { const f32x4 cv = cr[b4]; acc[4 * b4] = fmaf(cv.x, w, acc[4 * b4]); acc[4 * b4 + 1] = fmaf(cv.y, w, acc[4 * b4 + 1]); acc[4 * b4 + 2] = fmaf(cv.z, w, acc[4 * b4 + 2]); acc[4 * b4 + 3] = fmaf(cv.w, w, acc[4 * b4 + 3]); }
            }
#pragma unroll
            for (int b = 0; b < NB; ++b) { float v = acc[b]; v += __shfl_xor(v, 16); v += __shfl_xor(v, 32); acc[b] = v; }
            if (ks == 0) {
                const float bb = A.b_ada[col];
#pragma unroll
                for (int b = 0; b < NB; ++b) ADA[b * 6144 + col] = acc[b] + bb;
            }
        }
        __syncthreads();
    }
#endif
    LAS float* scr = (LAS float*)(F.lds + F.wave * 16384);
    bf16* WIN = (bf16*)(ws + WS_WIN); bf16* WUA = (bf16*)(ws + WS_WUA); bf16* WUP = (bf16*)(ws + WS_WUP); bf16* WOUT = (bf16*)(ws + WS_WOUT); bf16* WPQ = (bf16*)(ws + WS_WPQ); bf16* WGRP = (bf16*)(ws + WS_WGRP);
    constexpr int I_IN = 16 * 112, I_UA = 8 * 32, I_UP = 8 * 32, I_OUT = 16 * 32, I_PQ = 16 * 32;
    constexpr int NITEMS = I_IN + I_UA + I_UP + I_OUT + I_PQ;
    for (int it = F.gw; it < NITEMS; it += F.NGW) {
        int r = it;
        if (r < I_IN) { const int kb = r / 112, nb = r % 112; int src, valid; zcol_src(nb, src, valid); transpose_item(A.w_in, INW, kb * 64, src, valid, WIN, 1024, nb * 32, kb * 64, scr, F.lane); continue; } r -= I_IN;
        if (r < I_UA) { const int kb = r / 32, nb = r % 32; transpose_item(A.w_ua, 1024, kb * 64, nb * 32, 32, WUA, 512, nb * 32, kb * 64, scr, F.lane); continue; } r -= I_UA;
        if (r < I_UP) { continue; } r -= I_UP;
        if (r < I_OUT) { const int kb = r / 32, nb = r % 32; transpose_item(A.w_out, 1024, kb * 64, nb * 32, 32, WOUT, 1024, nb * 32, kb * 64, scr, F.lane); continue; } r -= I_OUT;
        if (r < I_PQ) { const int kb = r / 32, nb = r % 32; transpose_item(A.w_pq, 1024, kb * 64, nb * 32, 32, WPQ, 1024, nb * 32, kb * 64, scr, F.lane); continue; } r -= I_PQ;
        (void)WGRP;
    }
    const int gtid = F.gw * 64 + F.lane, gthreads = F.NGW * 64;
    for (int it = F.gw; it < 512 * 4; it += F.NGW) {
        const int k = it >> 2, n = (it & 3) * 256 + F.lane, g = k >> 7;
        const float* wg = A.w_grp + (size_t)k * 128; const float* sp = A.s_pool + g * 128; const float* wu = A.w_up + (size_t)g * 128 * 1024 + n;
        float a0 = 0.f, a1 = 0.f, a2 = 0.f, a3 = 0.f;
#pragma unroll 8
        for (int d = 0; d < 128; ++d) { const float ws_ = wg[d] * sp[d]; const float* wr = wu + (size_t)d * 1024;
            a0 = fmaf(ws_, wr[0], a0); a1 = fmaf(ws_, wr[64], a1); a2 = fmaf(ws_, wr[128], a2); a3 = fmaf(ws_, wr[192], a3); }
        WUP[(size_t)n * 512 + k] = (bf16)f2bf(a0); WUP[(size_t)(n + 64) * 512 + k] = (bf16)f2bf(a1); WUP[(size_t)(n + 128) * 512 + k] = (bf16)f2bf(a2); WUP[(size_t)(n + 192) * 512 + k] = (bf16)f2bf(a3);
    }
    cvt_stream(A.sk, (bf16*)(ws + WS_SK), (size_t)16 * 128 * 64 / 8, gtid, gthreads);
#ifdef QUANT2
#ifndef QUANT_R
#define QUANT_R 2
#endif
    for (int row = F.gw; row < 2 * 16384; row += QUANT_R * F.NGW) {
        f32x4 av[QUANT_R][4]; float m[QUANT_R];
#pragma unroll
        for (int q = 0; q < QUANT_R; ++q) { int rq = row + q * F.NGW; rq = rq < 2 * 16384 ? rq : row; const bool isv = rq >= 16384; const int r = isv ? rq - 16384 : rq; const float* src = (isv ? A.pv : A.pu) + (size_t)r * 1024 + 16 * F.lane;
#pragma unroll
            for (int j = 0; j < 4; ++j) av[q][j] = *(const GAS f32x4*)(src + 4 * j); }
#pragma unroll
        for (int q = 0; q < QUANT_R; ++q) { float t = 0.f;
#pragma unroll
            for (int j = 0; j < 4; ++j) t = fmaxf(t, fmaxf(fmaxf(fabsf(av[q][j].x), fabsf(av[q][j].y)), fmaxf(fabsf(av[q][j].z), fabsf(av[q][j].w))));
            m[q] = t; }
#pragma unroll
        for (int o = 1; o < 64; o <<= 1) {
#pragma unroll
            for (int q = 0; q < QUANT_R; ++q) m[q] = fmaxf(m[q], __shfl_xor(m[q], o)); }
#pragma unroll
        for (int q = 0; q < QUANT_R; ++q) {
            int rq = row + q * F.NGW; rq = rq < 2 * 16384 ? rq : row; const bool isv = rq >= 16384; const int r = isv ? rq - 16384 : rq;
            const float sc = m[q] > 0.f ? (isv ? 6.0f / m[q] : 10.0f / m[q]) : 1.0f;
            unsigned w[2] = {0u, 0u};
#pragma unroll
            for (int j = 0; j < 4; ++j)
#pragma unroll
                for (int k = 0; k < 4; ++k) {
                    const float x = av[q][j][k], a = fabsf(x) * sc;
                    const unsigned c = (a >= 0.25f) + (a >= 0.75f) + (a >= 1.25f) + (a >= 1.75f) + (a >= 2.5f) + (a >= 3.5f) + (a >= 5.0f);
                    unsigned nib = c | (x < 0.f ? 8u : 0u);
                    if (!isv) { int qi = (int)rintf(x * sc); qi = qi < -8 ? -8 : (qi > 7 ? 7 : qi); nib = (unsigned)qi & 15u; }
                    const int el = 4 * j + k;
                    w[el >> 3] |= nib << (4 * (el & 7));
                }
            *(GAS v2u*)(ws + (isv ? WS_V : WS_U) + (size_t)(F.lane >> 4) * (16384 * 128) + (size_t)r * 128 + 8 * (F.lane & 15)) = (v2u){w[0], w[1]};
            if (F.lane == 0) ((float*)(ws + (isv ? WS_SV : WS_SU)))[r] = m[q] > 0.f ? (isv ? m[q] * (1.0f / 6.0f) : m[q] * 0.1f) : 1.0f;
        }
    }
}
#else
    for (int row = F.gw; row < 2 * 16384; row += F.NGW) {
        const bool isv = row >= 16384; const int r = isv ? row - 16384 : row;
        const float* src = (isv ? A.pv : A.pu) + (size_t)r * 1024 + 16 * F.lane;
        f32x4 av[4];
#pragma unroll
        for (int j = 0; j < 4; ++j) av[j] = *(const GAS f32x4*)(src + 4 * j);
        float m = 0.f;
#pragma unroll
        for (int j = 0; j < 4; ++j) m = fmaxf(m, fmaxf(fmaxf(fabsf(av[j].x), fabsf(av[j].y)), fmaxf(fabsf(av[j].z), fabsf(av[j].w))));
#pragma unroll
        for (int o = 1; o < 64; o <<= 1) m = fmaxf(m, __shfl_xor(m, o));
        const float sc = m > 0.f ? (isv ? 6.0f / m : 10.0f / m) : 1.0f;
        unsigned w[2] = {0u, 0u};
#pragma unroll
        for (int j = 0; j < 4; ++j)
#pragma unroll
            for (int k = 0; k < 4; ++k) {
                const float x = av[j][k], a = fabsf(x) * sc;
                const unsigned c = (a >= 0.25f) + (a >= 0.75f) + (a >= 1.25f) + (a >= 1.75f) + (a >= 2.5f) + (a >= 3.5f) + (a >= 5.0f);
                unsigned nib = c | (x < 0.f ? 8u : 0u);
                if (!isv) { int qi = (int)rintf(x * sc); qi = qi < -8 ? -8 : (qi > 7 ? 7 : qi); nib = (unsigned)qi & 15u; }
                const int el = 4 * j + k;
#if defined(U4_SWAP) && !defined(OLD_GATHER)
                w[el >> 3] |= nib << (4 * (isv ? (el & 7) : ((el & 7) ^ 1)));
#else
                w[el >> 3] |= nib << (4 * (el & 7));
#endif
            }
#ifdef OLD_GATHER
        *(GAS v2u*)(ws + (isv ? WS_V : WS_U) + (size_t)r * 512 + 8 * F.lane) = (v2u){w[0], w[1]};
#else
        *(GAS v2u*)(ws + (isv ? WS_V : WS_U) + (size_t)(F.lane >> 4) * (16384 * 128) + (size_t)r * 128 + 8 * (F.lane & 15)) = (v2u){w[0], w[1]};
#endif
        if (F.lane == 0) ((float*)(ws + (isv ? WS_SV : WS_SU)))[r] = m > 0.f ? (isv ? m * (1.0f / 6.0f) : m * 0.1f) : 1.0f;
    }
}
#endif

__device__ __forceinline__ void norm_rows(Frame& F, const float* X, const float* g, const float* ADA, int shift_off, int scale_off, bf16* O, unsigned char* O8, float* S8, const bf16* XB = nullptr, unsigned char* H8 = nullptr, float* S1 = nullptr) {
    const int rpw = T / F.NGW, m_begin = F.gw * rpw, b = m_begin >> 11;
    f32x4 cg[4], sh[4];
#pragma unroll
    for (int j = 0; j < 4; ++j) { const int col = 4 * F.lane + 256 * j;
        const f32x4 gg = *(const GAS f32x4*)(g + col), sc = *(const GAS f32x4*)(ADA + b * 6144 + scale_off + col);
        cg[j] = gg * (sc + 1.0f); sh[j] = *(const GAS f32x4*)(ADA + b * 6144 + shift_off + col); }
    for (int m0 = m_begin; m0 < m_begin + rpw; m0 += 4) {
        f32x4 v[4][4]; float s[4];
#pragma unroll
        for (int r = 0; r < 4; ++r) {
            if (XB) {
                const GAS v2u* ar = (const GAS v2u*)(XB + (size_t)(m0 + r) * D) + F.lane;
#pragma unroll
                for (int j = 0; j < 4; ++j) { const v2u a = ar[64 * j]; v[r][j] = (f32x4){__uint_as_float(a.x << 16), __uint_as_float(a.x & 0xffff0000u), __uint_as_float(a.y << 16), __uint_as_float(a.y & 0xffff0000u)}; }
            } else {
                const GAS f32x4* xr = (const GAS f32x4*)(X + (size_t)(m0 + r) * D) + F.lane;
#pragma unroll
                for (int j = 0; j < 4; ++j) v[r][j] = xr[64 * j];
            } }
#pragma unroll
        for (int r = 0; r < 4; ++r) { float t = 0.f;
#pragma unroll
            for (int j = 0; j < 4; ++j) t += (v[r][j].x * v[r][j].x + v[r][j].y * v[r][j].y) + (v[r][j].z * v[r][j].z + v[r][j].w * v[r][j].w);
            s[r] = t; }
#pragma unroll
        for (int o = 1; o < 64; o <<= 1) {
#pragma unroll
            for (int r = 0; r < 4; ++r) s[r] += __shfl_xor(s[r], o);
        }
#pragma unroll
        for (int r = 0; r < 4; ++r) {
            const float rstd = 1.0f / sqrtf(s[r] * (1.f / D) + EPS);
            GAS unsigned long long* o8 = (GAS unsigned long long*)(O + (size_t)(m0 + r) * D) + F.lane;
#pragma unroll
            for (int j = 0; j < 4; ++j) { const f32x4 y = (v[r][j] * rstd) * cg[j] + sh[j]; if (O) o8[64 * j] = (unsigned long long)pk2(y.x, y.y) | ((unsigned long long)pk2(y.z, y.w) << 32); v[r][j] = y; }
        }
        if (H8) {
            float am[4];
#pragma unroll
            for (int r = 0; r < 4; ++r) { float t = 0.f;
#pragma unroll
                for (int j = 0; j < 4; ++j) t = fmaxf(t, fmaxf(fmaxf(fabsf(v[r][j].x), fabsf(v[r][j].y)), fmaxf(fabsf(v[r][j].z), fabsf(v[r][j].w))));
                am[r] = t; }
#pragma unroll
            for (int o = 1; o < 64; o <<= 1) {
#pragma unroll
                for (int r = 0; r < 4; ++r) am[r] = fmaxf(am[r], __shfl_xor(am[r], o));
            }
#pragma unroll
            for (int r = 0; r < 4; ++r) {
                const float q = am[r] > 0.f ? 127.0f / am[r] : 1.0f;
                GAS unsigned* hb = (GAS unsigned*)(H8 + (size_t)(m0 + r) * D) + F.lane;
#pragma unroll
                for (int j = 0; j < 4; ++j) {
                    const int x0 = (int)rintf(v[r][j].x * q), x1 = (int)rintf(v[r][j].y * q), x2 = (int)rintf(v[r][j].z * q), x3 = (int)rintf(v[r][j].w * q);
                    hb[64 * j] = ((unsigned)x0 & 255u) | (((unsigned)x1 & 255u) << 8) | (((unsigned)x2 & 255u) << 16) | (((unsigned)x3 & 255u) << 24);
                }
                if (F.lane == 0) S1[m0 + r] = am[r] > 0.f ? am[r] * (1.0f / 127.0f) : 1.0f;
            }
        }
        if (O8) {
            float am[4];
#pragma unroll
            for (int r = 0; r < 4; ++r) { float t = 0.f;
#pragma unroll
                for (int j = 0; j < 4; ++j) t = fmaxf(t, fmaxf(fmaxf(fabsf(v[r][j].x), fabsf(v[r][j].y)), fmaxf(fabsf(v[r][j].z), fabsf(v[r][j].w))));
                am[r] = t; }
#pragma unroll
            for (int o = 1; o < 64; o <<= 1) {
#pragma unroll
                for (int r = 0; r < 4; ++r) am[r] = fmaxf(am[r], __shfl_xor(am[r], o));
            }
#pragma unroll
            for (int r = 0; r < 4; ++r) {
                const float q = am[r] > 0.f ? 119.0f / am[r] : 1.0f;
                GAS unsigned* hi = (GAS unsigned*)(O8 + (size_t)(m0 + r) * 512); GAS unsigned* lo = (GAS unsigned*)(O8 + (WS_H2LO - WS_H2HI) + (size_t)(m0 + r) * 512);
#pragma unroll
                for (int j = 0; j < 4; ++j) {
                    unsigned h16 = 0u, l16 = 0u;
#pragma unroll
                    for (int k = 0; k < 4; ++k) { const int x = (int)rintf(v[r][j][k] * q); const int l4 = ((x + 8) & 15) - 8; const int h4 = (x - l4) >> 4; h16 |= ((unsigned)h4 & 15u) << (4 * k); l16 |= ((unsigned)l4 & 15u) << (4 * k); }
                    const unsigned ph = (unsigned)__shfl_xor((int)h16, 1), pl = (unsigned)__shfl_xor((int)l16, 1);
                    if (!(F.lane & 1)) { hi[32 * j + (F.lane >> 1)] = h16 | (ph << 16); lo[32 * j + (F.lane >> 1)] = l16 | (pl << 16); }
                }
                if (F.lane == 0) S8[m0 + r] = am[r] > 0.f ? am[r] * (1.0f / 119.0f) : 1.0f;
            }
        }
    }
}

__device__ __forceinline__ void quant_gate_weights(Frame& F, unsigned char* ws) {
    const bf16* WIN = (const bf16*)(ws + WS_WIN); unsigned char* WG8 = ws + WS_WG8; float* CS8 = (float*)(ws + WS_CS8);
#ifdef Z_I8
    constexpr int QW_ROWS = ZW, QW_FIRST = 0;
#else
    constexpr int QW_ROWS = 2048, QW_FIRST = 1536;
#endif
    for (int n = F.gw; n < QW_ROWS; n += F.NGW) {
        const v4u a = *(const GAS v4u*)(WIN + (size_t)(QW_FIRST + n) * 1024 + 16 * F.lane), c = *(const GAS v4u*)(WIN + (size_t)(QW_FIRST + n) * 1024 + 16 * F.lane + 8);
        const float f[16] = {bflo(a.x), bfhi(a.x), bflo(a.y), bfhi(a.y), bflo(a.z), bfhi(a.z), bflo(a.w), bfhi(a.w), bflo(c.x), bfhi(c.x), bflo(c.y), bfhi(c.y), bflo(c.z), bfhi(c.z), bflo(c.w), bfhi(c.w)};
        float m = 0.f;
#pragma unroll
        for (int i = 0; i < 16; ++i) m = fmaxf(m, fabsf(f[i]));
#pragma unroll
        for (int o = 1; o < 64; o <<= 1) m = fmaxf(m, __shfl_xor(m, o));
        const float q = m > 0.f ? 127.0f / m : 1.0f;
        unsigned w[4] = {0u, 0u, 0u, 0u};
#pragma unroll
        for (int i = 0; i < 16; ++i) w[i >> 2] |= ((unsigned)(int)rintf(f[i] * q) & 255u) << (8 * (i & 3));
        *(GAS v4u*)(WG8 + (size_t)n * 1024 + 16 * F.lane) = (v4u){w[0], w[1], w[2], w[3]};
        if (F.lane == 0) CS8[n] = m > 0.f ? m * (1.0f / 127.0f) : 1.0f;
    }
}

namespace pg8 {
__device__ __forceinline__ float sigm(float v) { return __builtin_amdgcn_rcpf(1.0f + __builtin_amdgcn_exp2f(-1.4426950408889634f * v)); }
template <int MODE> struct EpiB {
    static constexpr bool PERM = true, AFTER_DRAIN = false;
    bf16_t* O; int ldc; int sig_from; const float* colscale; const bf16_t* G; int ldg; int gcol0; int zp8_from;
    __device__ __forceinline__ void operator()(const f32x4 (&acc)[2][2][4][2], const Unit& u, int wr, int wc, int fr, int fq) const {
        const int row0 = u.pm * BM + wr * 64 + fr, col0 = u.pn * BM + wc * 32 + 8 * fq;
        const bool sg = (MODE == 0) && (u.pn >= sig_from);
        f32x4 cs[2][2];
        if (MODE == 1) {
#pragma unroll
            for (int bj = 0; bj < 2; ++bj)
#pragma unroll
                for (int n = 0; n < 2; ++n) cs[bj][n] = *(const f32x4*)(colscale + col0 + bj * HALF + 4 * n);
        }
#pragma unroll
        for (int ai = 0; ai < 2; ++ai)
#pragma unroll
            for (int m = 0; m < 4; ++m) { const size_t row = (size_t)(row0 + ai * HALF + m * 16); bf16_t* rowp = O + row * ldc + col0;
#pragma unroll
                for (int bj = 0; bj < 2; ++bj) { f32x4 v0 = acc[ai][bj][m][0], v1 = acc[ai][bj][m][1];
                    if (MODE == 0) { if (sg) { v0 = (f32x4){sigm(v0[0]), sigm(v0[1]), sigm(v0[2]), sigm(v0[3])}; v1 = (f32x4){sigm(v1[0]), sigm(v1[1]), sigm(v1[2]), sigm(v1[3])}; } }
                    if (MODE == 1) { v0 = v0 * cs[bj][0]; v1 = v1 * cs[bj][1]; }
#ifdef GATE_FP8
                    if (MODE == 2 || MODE == 3) {
                        typedef float f32x2g __attribute__((ext_vector_type(2)));
                        const unsigned long long g8 = *(const unsigned long long*)((const unsigned char*)G + row * (size_t)(ldg * 2) + 3072 + (gcol0 - 1536 + col0 + bj * HALF));
                        const unsigned glo = (unsigned)g8, ghi = (unsigned)(g8 >> 32);
                        const f32x2g a0 = __builtin_amdgcn_cvt_pk_f32_fp8(glo, false), a1 = __builtin_amdgcn_cvt_pk_f32_fp8(glo, true), a2 = __builtin_amdgcn_cvt_pk_f32_fp8(ghi, false), a3 = __builtin_amdgcn_cvt_pk_f32_fp8(ghi, true);
                        v0 = v0 * (f32x4){a0.x, a0.y, a1.x, a1.y}; v1 = v1 * (f32x4){a2.x, a2.y, a3.x, a3.y};
                    }
#else
                    if (MODE == 2 || MODE == 3) {
                        const u32x4 gw = *(const u32x4*)(G + row * ldg + gcol0 + col0 + bj * HALF);
                        v0 = v0 * (f32x4){__builtin_bit_cast(float, gw.x << 16), __builtin_bit_cast(float, gw.x & 0xffff0000u), __builtin_bit_cast(float, gw.y << 16), __builtin_bit_cast(float, gw.y & 0xffff0000u)};
                        v1 = v1 * (f32x4){__builtin_bit_cast(float, gw.z << 16), __builtin_bit_cast(float, gw.z & 0xffff0000u), __builtin_bit_cast(float, gw.w << 16), __builtin_bit_cast(float, gw.w & 0xffff0000u)};
                    }
#endif
#ifdef MIN_FP8
                    if (MODE == 3) {
                        typedef float f32x2g __attribute__((ext_vector_type(2)));
                        const unsigned long long o8 = *(const unsigned long long*)((const unsigned char*)G + row * (size_t)(ldg * 2) + 5120 + (col0 + bj * HALF));
                        const unsigned olo = (unsigned)o8, ohi = (unsigned)(o8 >> 32);
                        const f32x2g a0 = __builtin_amdgcn_cvt_pk_f32_fp8(olo, false), a1 = __builtin_amdgcn_cvt_pk_f32_fp8(olo, true), a2 = __builtin_amdgcn_cvt_pk_f32_fp8(ohi, false), a3 = __builtin_amdgcn_cvt_pk_f32_fp8(ohi, true);
                        v0 = v0 + (f32x4){a0.x, a0.y, a1.x, a1.y}; v1 = v1 + (f32x4){a2.x, a2.y, a3.x, a3.y};
                    }
                    if (MODE == 2) {
                        int lo = 0, hi = 0;
                        lo = __builtin_amdgcn_cvt_pk_fp8_f32(v0[0], v0[1], lo, false); lo = __builtin_amdgcn_cvt_pk_fp8_f32(v0[2], v0[3], lo, true);
                        hi = __builtin_amdgcn_cvt_pk_fp8_f32(v1[0], v1[1], hi, false); hi = __builtin_amdgcn_cvt_pk_fp8_f32(v1[2], v1[3], hi, true);
                        *(unsigned long long*)((unsigned char*)G + row * (size_t)(ldg * 2) + 5120 + (col0 + bj * HALF)) = (unsigned long long)(unsigned)lo | ((unsigned long long)(unsigned)hi << 32);
                        continue;
                    }
#else
                    if (MODE == 3) {
                        const u32x4 ow = *(const u32x4*)(rowp + bj * HALF);
                        v0 = v0 + (f32x4){__builtin_bit_cast(float, ow.x << 16), __builtin_bit_cast(float, ow.x & 0xffff0000u), __builtin_bit_cast(float, ow.y << 16), __builtin_bit_cast(float, ow.y & 0xffff0000u)};
                        v1 = v1 + (f32x4){__builtin_bit_cast(float, ow.z << 16), __builtin_bit_cast(float, ow.z & 0xffff0000u), __builtin_bit_cast(float, ow.w << 16), __builtin_bit_cast(float, ow.w & 0xffff0000u)};
                    }
#endif
#ifdef ZP_FP8
                    if (MODE == 0 && zp8_from > 0 && u.pn >= zp8_from && u.pn < sig_from) {
                        int lo = 0, hi = 0;
                        lo = __builtin_amdgcn_cvt_pk_fp8_f32(v0[0], v0[1], lo, false); lo = __builtin_amdgcn_cvt_pk_fp8_f32(v0[2], v0[3], lo, true);
                        hi = __builtin_amdgcn_cvt_pk_fp8_f32(v1[0], v1[1], hi, false); hi = __builtin_amdgcn_cvt_pk_fp8_f32(v1[2], v1[3], hi, true);
                        *(unsigned long long*)((unsigned char*)O + row * (size_t)(ldc * 2) + 6144 + (col0 - 256 * zp8_from + bj * HALF)) = (unsigned long long)(unsigned)lo | ((unsigned long long)(unsigned)hi << 32);
                        continue;
                    }
#endif
#ifdef GATE_FP8
                    if (MODE == 0 && sg) {
                        int lo = 0, hi = 0;
                        lo = __builtin_amdgcn_cvt_pk_fp8_f32(v0[0], v0[1], lo, false); lo = __builtin_amdgcn_cvt_pk_fp8_f32(v0[2], v0[3], lo, true);
                        hi = __builtin_amdgcn_cvt_pk_fp8_f32(v1[0], v1[1], hi, false); hi = __builtin_amdgcn_cvt_pk_fp8_f32(v1[2], v1[3], hi, true);
                        *(unsigned long long*)((unsigned char*)O + row * (size_t)(ldc * 2) + 3072 + (col0 - 1536 + bj * HALF)) = (unsigned long long)(unsigned)lo | ((unsigned long long)(unsigned)hi << 32);
                        continue;
                    }
#endif
                    u32x4 w; w.x = cvt_pk_bf16(v0[0], v0[1]); w.y = cvt_pk_bf16(v0[2], v0[3]); w.z = cvt_pk_bf16(v1[0], v1[1]); w.w = cvt_pk_bf16(v1[2], v1[3]);
                    *(u32x4*)(rowp + bj * HALF) = w; } }
    }
};
struct EpiRes {
    static constexpr bool PERM = false, AFTER_DRAIN = false;
    const float* X; float* C; const float* gate;
    __device__ __forceinline__ void operator()(const f32x4 (&acc)[2][2][4][2], const Unit& u, int wr, int wc, int fr, int fq) const {
        const int row0 = u.pm * BM + wr * 64 + fr, col0 = u.pn * BM + wc * 32 + 4 * fq;
        const int b = (u.pm * BM) >> 11;
        f32x4 gv[2][2];
#pragma unroll
        for (int bj = 0; bj < 2; ++bj)
#pragma unroll
            for (int n = 0; n < 2; ++n) gv[bj][n] = *(const f32x4*)(gate + b * 6144 + col0 + bj * HALF + n * 16);
#pragma unroll
        for (int ai = 0; ai < 2; ++ai)
#pragma unroll
            for (int m = 0; m < 4; ++m) { const size_t off = (size_t)(row0 + ai * HALF + m * 16) * 1024 + col0;
#pragma unroll
                for (int bj = 0; bj < 2; ++bj)
#pragma unroll
                    for (int n = 0; n < 2; ++n) { const f32x4 xv = *(const f32x4*)(X + off + bj * HALF + n * 16); *(f32x4*)(C + off + bj * HALF + n * 16) = xv + gv[bj][n] * acc[ai][bj][m][n]; } }
    }
};
struct EpiX1 {
    static constexpr bool PERM = true, AFTER_DRAIN = false;
    const float* X; bf16_t* O; const float* gate;
    __device__ __forceinline__ void operator()(const f32x4 (&acc)[2][2][4][2], const Unit& u, int wr, int wc, int fr, int fq) const {
        const int row0 = u.pm * BM + wr * 64 + fr, col0 = u.pn * BM + wc * 32 + 8 * fq;
        const int b = (u.pm * BM) >> 11;
        f32x4 gv[2][2];
#pragma unroll
        for (int bj = 0; bj < 2; ++bj)
#pragma unroll
            for (int n = 0; n < 2; ++n) gv[bj][n] = *(const f32x4*)(gate + b * 6144 + col0 + bj * HALF + 4 * n);
#pragma unroll
        for (int ai = 0; ai < 2; ++ai)
#pragma unroll
            for (int m = 0; m < 4; ++m) { const size_t off = (size_t)(row0 + ai * HALF + m * 16) * 1024 + col0;
#pragma unroll
                for (int bj = 0; bj < 2; ++bj) {
                    const f32x4 v0 = *(const f32x4*)(X + off + bj * HALF) + gv[bj][0] * acc[ai][bj][m][0], v1 = *(const f32x4*)(X + off + bj * HALF + 4) + gv[bj][1] * acc[ai][bj][m][1];
                    u32x4 w; w.x = cvt_pk_bf16(v0[0], v0[1]); w.y = cvt_pk_bf16(v0[2], v0[3]); w.z = cvt_pk_bf16(v1[0], v1[1]); w.w = cvt_pk_bf16(v1[2], v1[3]);
                    *(u32x4*)(O + off + bj * HALF) = w; } }
    }
};
struct EpiGate8 {
    static constexpr bool PERM = true, AFTER_DRAIN = false;
    unsigned char* Zb; int zpitch; const float* rs; const float* cs;
    __device__ __forceinline__ void operator()(const f32x4 (&acc)[2][2][4][2], const Unit& u, int wr, int wc, int fr, int fq) const {
        const int row0 = u.pm * BM + wr * 64 + fr, col0 = u.pn * BM + wc * 32 + 8 * fq;
        f32x4 cv[2][2];
#pragma unroll
        for (int bj = 0; bj < 2; ++bj)
#pragma unroll
            for (int n = 0; n < 2; ++n) cv[bj][n] = *(const f32x4*)(cs + col0 + bj * HALF + 4 * n);
#pragma unroll
        for (int ai = 0; ai < 2; ++ai)
#pragma unroll
            for (int m = 0; m < 4; ++m) { const size_t row = (size_t)(row0 + ai * HALF + m * 16); const float r = rs[row];
#pragma unroll
                for (int bj = 0; bj < 2; ++bj) {
                    const i32x4 a0 = __builtin_bit_cast(i32x4, acc[ai][bj][m][0]), a1 = __builtin_bit_cast(i32x4, acc[ai][bj][m][1]);
                    const f32x4 v0 = (f32x4){sigm((float)a0[0] * r * cv[bj][0][0]), sigm((float)a0[1] * r * cv[bj][0][1]), sigm((float)a0[2] * r * cv[bj][0][2]), sigm((float)a0[3] * r * cv[bj][0][3])};
                    const f32x4 v1 = (f32x4){sigm((float)a1[0] * r * cv[bj][1][0]), sigm((float)a1[1] * r * cv[bj][1][1]), sigm((float)a1[2] * r * cv[bj][1][2]), sigm((float)a1[3] * r * cv[bj][1][3])};
                    int lo = 0, hi = 0;
                    lo = __builtin_amdgcn_cvt_pk_fp8_f32(v0[0], v0[1], lo, false); lo = __builtin_amdgcn_cvt_pk_fp8_f32(v0[2], v0[3], lo, true);
                    hi = __builtin_amdgcn_cvt_pk_fp8_f32(v1[0], v1[1], hi, false); hi = __builtin_amdgcn_cvt_pk_fp8_f32(v1[2], v1[3], hi, true);
                    *(unsigned long long*)(Zb + row * (size_t)zpitch + 3072 + (col0 + bj * HALF)) = (unsigned long long)(unsigned)lo | ((unsigned long long)(unsigned)hi << 32);
                } }
    }
};
struct EpiZ8 {
    static constexpr bool PERM = true, AFTER_DRAIN = false;
    unsigned char* Zb; int zpitch; const float* rs; const float* cs;
    __device__ __forceinline__ void operator()(const f32x4 (&acc)[2][2][4][2], const Unit& u, int wr, int wc, int fr, int fq) const {
        const int row0 = u.pm * BM + wr * 64 + fr, col0 = u.pn * BM + wc * 32 + 8 * fq;
        f32x4 cv[2][2];
#pragma unroll
        for (int bj = 0; bj < 2; ++bj)
#pragma unroll
            for (int n = 0; n < 2; ++n) cv[bj][n] = *(const f32x4*)(cs + col0 + bj * HALF + 4 * n);
#pragma unroll
        for (int ai = 0; ai < 2; ++ai)
#pragma unroll
            for (int m = 0; m < 4; ++m) { const size_t row = (size_t)(row0 + ai * HALF + m * 16); const float r = rs[row];
#pragma unroll
                for (int bj = 0; bj < 2; ++bj) {
                    const i32x4 a0 = __builtin_bit_cast(i32x4, acc[ai][bj][m][0]), a1 = __builtin_bit_cast(i32x4, acc[ai][bj][m][1]);
                    f32x4 v0 = (f32x4){(float)a0[0], (float)a0[1], (float)a0[2], (float)a0[3]} * cv[bj][0] * r, v1 = (f32x4){(float)a1[0], (float)a1[1], (float)a1[2], (float)a1[3]} * cv[bj][1] * r;
                    if (u.pn < 4) {
                        u32x4 w; w.x = cvt_pk_bf16(v0[0], v0[1]); w.y = cvt_pk_bf16(v0[2], v0[3]); w.z = cvt_pk_bf16(v1[0], v1[1]); w.w = cvt_pk_bf16(v1[2], v1[3]);
                        *(u32x4*)(Zb + row * (size_t)zpitch + (size_t)(col0 + bj * HALF) * 2) = w;
                    } else {
                        if (u.pn >= 6) { v0 = (f32x4){sigm(v0[0]), sigm(v0[1]), sigm(v0[2]), sigm(v0[3])}; v1 = (f32x4){sigm(v1[0]), sigm(v1[1]), sigm(v1[2]), sigm(v1[3])}; }
                        int lo = 0, hi = 0;
                        lo = __builtin_amdgcn_cvt_pk_fp8_f32(v0[0], v0[1], lo, false); lo = __builtin_amdgcn_cvt_pk_fp8_f32(v0[2], v0[3], lo, true);
                        hi = __builtin_amdgcn_cvt_pk_fp8_f32(v1[0], v1[1], hi, false); hi = __builtin_amdgcn_cvt_pk_fp8_f32(v1[2], v1[3], hi, true);
                        const int boff = (u.pn >= 6) ? 3072 + (col0 - 1536 + bj * HALF) : 6144 + (col0 - 1024 + bj * HALF);
                        *(unsigned long long*)(Zb + row * (size_t)zpitch + boff) = (unsigned long long)(unsigned)lo | ((unsigned long long)(unsigned)hi << 32);
                    }
                } }
    }
};
}

__device__ __forceinline__ void p3_fixup(Frame& F, const Args& A) {
    unsigned char* ws = A.ws;
    bf16* Z = (bf16*)(ws + WS_Z); bf16* IKX = (bf16*)(ws + WS_IKX); bf16* KX = (bf16*)(ws + WS_KX); bf16* VX = (bf16*)(ws + WS_VX); float* IW = (float*)(ws + WS_IW); bf16* POOLED = (bf16*)(ws + WS_POOLED);
    const int lane = F.lane;
    const int rpw = T / F.NGW, m_begin = F.gw * rpw;
    for (int m0 = m_begin; m0 < m_begin + rpw; m0 += 2) {
        const int g = lane >> 4, w = 2 << g;
#ifdef ZP_FP8
        typedef float f32x2z __attribute__((ext_vector_type(2)));
        float sum[2][8], self[2][8]; int cnt[2];
#pragma unroll
        for (int r = 0; r < 2; ++r) {
            const int m = m0 + r, s = m & (SEQ - 1);
            const int lo = (s + 1 - w) > 0 ? (s + 1 - w) : 0; cnt[r] = s + 1 - lo;
            const unsigned char* zp8 = (const unsigned char*)Z + (size_t)m * (ZW * 2) + 6144 + 8 * lane;
#pragma unroll
            for (int j = 0; j < 8; ++j) { sum[r][j] = 0.f; self[r][j] = 0.f; }
#pragma unroll
            for (int i = 0; i < 16; ++i) {
                if (i < cnt[r]) { const v2u q = *(const GAS v2u*)(zp8 - (size_t)i * (ZW * 2));
                    const f32x2z a0 = __builtin_amdgcn_cvt_pk_f32_fp8(q.x, false), a1 = __builtin_amdgcn_cvt_pk_f32_fp8(q.x, true), a2 = __builtin_amdgcn_cvt_pk_f32_fp8(q.y, false), a3 = __builtin_amdgcn_cvt_pk_f32_fp8(q.y, true);
                    const float fv[8] = {a0.x, a0.y, a1.x, a1.y, a2.x, a2.y, a3.x, a3.y};
#pragma unroll
                    for (int j = 0; j < 8; ++j) { sum[r][j] += fv[j]; if (i == 0) self[r][j] = fv[j]; } }
            }
        }
#pragma unroll
        for (int r = 0; r < 2; ++r) {
            const float inv = 1.0f / (float)cnt[r];
            v4u o; o.x = pk2(sum[r][0] * inv - self[r][0], sum[r][1] * inv - self[r][1]); o.y = pk2(sum[r][2] * inv - self[r][2], sum[r][3] * inv - self[r][3]);
            o.z = pk2(sum[r][4] * inv - self[r][4], sum[r][5] * inv - self[r][5]); o.w = pk2(sum[r][6] * inv - self[r][6], sum[r][7] * inv - self[r][7]);
            *(GAS v4u*)(POOLED + (size_t)(m0 + r) * 512 + 8 * lane) = o;
        }
    }
#else
        float sum[2][8]; v4u self[2]; int cnt[2];
#pragma unroll
        for (int r = 0; r < 2; ++r) {
            const int m = m0 + r, s = m & (SEQ - 1);
            const int lo = (s + 1 - w) > 0 ? (s + 1 - w) : 0; cnt[r] = s + 1 - lo;
            const bf16* zp = Z + (size_t)m * ZW + ZC_ZP + 8 * lane;
#pragma unroll
            for (int j = 0; j < 8; ++j) sum[r][j] = 0.f;
            self[r] = (v4u){0u, 0u, 0u, 0u};
#pragma unroll
            for (int i = 0; i < 16; ++i) {
                if (i < cnt[r]) { const v4u q = *(const GAS v4u*)(zp - (size_t)i * ZW); if (i == 0) self[r] = q;
                    sum[r][0] += bflo(q.x); sum[r][1] += bfhi(q.x); sum[r][2] += bflo(q.y); sum[r][3] += bfhi(q.y); sum[r][4] += bflo(q.z); sum[r][5] += bfhi(q.z); sum[r][6] += bflo(q.w); sum[r][7] += bfhi(q.w); }
            }
        }
#pragma unroll
        for (int r = 0; r < 2; ++r) {
            const float inv = 1.0f / (float)cnt[r];
            v4u o; o.x = pk2(sum[r][0] * inv - bflo(self[r].x), sum[r][1] * inv - bfhi(self[r].x)); o.y = pk2(sum[r][2] * inv - bflo(self[r].y), sum[r][3] * inv - bfhi(self[r].y));
            o.z = pk2(sum[r][4] * inv - bflo(self[r].z), sum[r][5] * inv - bfhi(self[r].z)); o.w = pk2(sum[r][6] * inv - bflo(self[r].w), sum[r][7] * inv - bfhi(self[r].w));
            *(GAS v4u*)(POOLED + (size_t)(m0 + r) * 512 + 8 * lane) = o;
        }
    }
#endif
    for (int tile = F.gw; tile < T / 32; tile += F.NGW) {
        const bf16* vsrc = Z + (size_t)tile * 32 * ZW + ZC_V;
        bf16* vdst = VX + (size_t)tile * 2048;
#pragma unroll
        for (int i = 0; i < 4; ++i) {
            const int pi = lane + 64 * i, h = pi & 1, d = (pi >> 1) & 31, s = (pi >> 6) & 1, rt = pi >> 7;
            unsigned e[8];
#pragma unroll
            for (int j = 0; j < 8; ++j) { const int key = 16 * s + 8 * (j >> 2) + 4 * h + (j & 3); e[j] = vsrc[(size_t)key * ZW + d + 32 * rt]; }
            v4u o; o.x = e[0] | (e[1] << 16); o.y = e[2] | (e[3] << 16); o.z = e[4] | (e[5] << 16); o.w = e[6] | (e[7] << 16);
            *(GAS v4u*)(vdst + pi * 8) = o;
        }
    }
    float gqv[8];
#pragma unroll
    for (int j = 0; j < 8; ++j) gqv[j] = A.g_q[8 * (lane & 7) + j];
    const float gkv = A.g_k[lane], gikv = A.g_ik[lane];
    for (int m0 = m_begin; m0 < m_begin + rpw; m0 += 4) {
        v4u qr[4]; float kv[4], ikv[4], iwr[4];
#pragma unroll
        for (int r = 0; r < 4; ++r) { bf16* zr = Z + (size_t)(m0 + r) * ZW;
#ifndef QN_DSA
            qr[r] = *(GAS v4u*)(zr + 8 * lane);
#endif
            kv[r] = bf2f(zr[ZC_K + lane]); ikv[r] = bf2f(zr[ZC_IK + lane]); iwr[r] = bf2f(zr[ZC_IW + (lane & 3)]); }
        float sk[4], sik[4];
#pragma unroll
        for (int r = 0; r < 4; ++r) { sk[r] = kv[r] * kv[r]; sik[r] = ikv[r] * ikv[r]; }
#pragma unroll
        for (int o = 1; o < 64; o <<= 1) {
#pragma unroll
            for (int r = 0; r < 4; ++r) { sk[r] += __shfl_xor(sk[r], o); sik[r] += __shfl_xor(sik[r], o); }
        }
#pragma unroll
        for (int r = 0; r < 4; ++r) {
            const int m = m0 + r, b = m >> 11, s = m & (SEQ - 1);
            bf16* zr = Z + (size_t)m * ZW;
#ifndef QN_DSA
            float q[8] = {bflo(qr[r].x), bfhi(qr[r].x), bflo(qr[r].y), bfhi(qr[r].y), bflo(qr[r].z), bfhi(qr[r].z), bflo(qr[r].w), bfhi(qr[r].w)};
            float ss = 0.f;
#pragma unroll
            for (int j = 0; j < 8; ++j) ss += q[j] * q[j];
            ss += __shfl_xor(ss, 1); ss += __shfl_xor(ss, 2); ss += __shfl_xor(ss, 4);
            const float rstd = QSCALE / sqrtf(ss * (1.f / 64.f) + EPS);
#pragma unroll
            for (int j = 0; j < 8; ++j) q[j] = q[j] * rstd * gqv[j];
            v4u o; o.x = pk2(q[0], q[1]); o.y = pk2(q[2], q[3]); o.z = pk2(q[4], q[5]); o.w = pk2(q[6], q[7]);
            *(GAS v4u*)(zr + 8 * lane) = o;
#else
            (void)zr; (void)gqv;
#endif
            const float rk = 1.0f / sqrtf(sk[r] * (1.f / 64.f) + EPS), rik = 0.125f / sqrtf(sik[r] * (1.f / 64.f) + EPS);
            const size_t xo = ((((size_t)b * 64 + (s >> 5)) * 4 + (lane >> 4)) * 32 + (s & 31)) * 16 + (lane & 15);
            KX[xo] = (bf16)f2bf(kv[r] * rk * gkv);
            IKX[xo] = (bf16)f2bf(ikv[r] * rik * gikv);
            if (lane < 4) IW[(size_t)m * 4 + lane] = 0.5f * iwr[r];
        }
    }
}


__device__ __forceinline__ void p4_naive(Frame& F, const Args& A) {
    const bf16* POOLED = (const bf16*)(A.ws + WS_POOLED); bf16* PM = (bf16*)(A.ws + WS_PM);
    const int lane = F.lane, g = lane >> 4, d0 = 8 * (lane & 15);
    for (int m = F.gw; m < T; m += F.NGW) {
        float acc[8];
#pragma unroll
        for (int j = 0; j < 8; ++j) acc[j] = 0.f;
        for (int c = 0; c < 128; ++c) {
            const float p = bf2f(POOLED[(size_t)m * 512 + g * 128 + c]);
            const float* w = A.w_grp + ((size_t)g * 128 + c) * 128 + d0;
#pragma unroll
            for (int j = 0; j < 8; ++j) acc[j] = fmaf(p, w[j], acc[j]);
        }
        const float* sp = A.s_pool + g * 128 + d0;
        v4u o; o.x = pk2(acc[0] * sp[0], acc[1] * sp[1]); o.y = pk2(acc[2] * sp[2], acc[3] * sp[3]); o.z = pk2(acc[4] * sp[4], acc[5] * sp[5]); o.w = pk2(acc[6] * sp[6], acc[7] * sp[7]);
        *(GAS v4u*)(PM + (size_t)m * 512 + 8 * lane) = o;
    }
}


__device__ __forceinline__ void dbg_pool_check(Frame& F, const Args& A) {
    if (blockIdx.x != 0) return;
    unsigned char* ws = A.ws;
    const bf16* Z = (const bf16*)(ws + WS_Z); const bf16* POOLED = (const bf16*)(ws + WS_POOLED); const bf16* PM = (const bf16*)(ws + WS_PM); const bf16* MIN = (const bf16*)(ws + WS_MIN); const bf16* WUP = (const bf16*)(ws + WS_WUP);
    unsigned* flag = (unsigned*)(ws + WS_CTL) + 64;
    const int t = F.tid;
    const int r = (int)(((long long)t * 2579 + 17) % T), c = (t * 131 + 5) % 1024;
    unsigned f = 0u;
    { const int k = (t * 7) % 512; if (WUP[(size_t)c * 512 + k] != (bf16)f2bf(A.w_up[(size_t)k * 1024 + c])) f |= 8u; }
    const int n = c % 512, g = n >> 7, w = 2 << g, s = r & (SEQ - 1);
    { const int lo = (s + 1 - w) > 0 ? (s + 1 - w) : 0, cnt = s + 1 - lo; float sum = 0.f;
      for (int i = 0; i < cnt; ++i) sum += bf2f(Z[(size_t)(r - i) * ZW + ZC_ZP + n]);
      const float e = sum / (float)cnt - bf2f(Z[(size_t)r * ZW + ZC_ZP + n]), got = bf2f(POOLED[(size_t)r * 512 + n]);
      if (fabsf(got - e) > 0.02f * fabsf(e) + 0.02f) f |= 1u; }
    { float acc = 0.f; for (int cc = 0; cc < 128; ++cc) acc += bf2f(POOLED[(size_t)r * 512 + g * 128 + cc]) * A.w_grp[((size_t)g * 128 + cc) * 128 + (n & 127)];
      const float e = acc * A.s_pool[n], got = bf2f(PM[(size_t)r * 512 + n]);
      if (fabsf(got - e) > 0.02f * fabsf(e) + 0.02f) f |= 2u; }
    { float acc = 0.f; for (int k = 0; k < 512; ++k) acc += bf2f(PM[(size_t)r * 512 + k]) * A.w_up[(size_t)k * 1024 + c];
      const float e = acc * bf2f(Z[(size_t)r * ZW + ZC_GP + c]), got = bf2f(MIN[(size_t)r * 1024 + c]);
      if (fabsf(got - e) > 0.02f * fabsf(e) + 0.02f) f |= 4u; }
    if (f) atomicOr(flag, f);
}
__device__ __forceinline__ void dbg_min_check(Frame& F, const Args& A) {
    if (blockIdx.x != 0) return;
    unsigned char* ws = A.ws;
    const bf16* Z = (const bf16*)(ws + WS_Z); const bf16* PM = (const bf16*)(ws + WS_PM); const bf16* MIN = (const bf16*)(ws + WS_MIN); const bf16* ATT = (const bf16*)(ws + WS_ATT);
    unsigned* flag = (unsigned*)(ws + WS_CTL) + 64;
    const int t = F.tid;
    const int r = (int)(((long long)t * 2579 + 17) % T), c = (t * 131 + 5) % 1024;
    float a1 = 0.f, a2 = 0.f;
    for (int k = 0; k < 512; ++k) { a1 += bf2f(PM[(size_t)r * 512 + k]) * A.w_up[(size_t)k * 1024 + c]; a2 += bf2f(ATT[(size_t)r * 512 + k]) * A.w_ua[(size_t)k * 1024 + c]; }
    const float e = a1 * bf2f(Z[(size_t)r * ZW + ZC_GP + c]) + a2 * bf2f(Z[(size_t)r * ZW + ZC_GA + c]), got = bf2f(MIN[(size_t)r * 1024 + c]);
    if (fabsf(got - e) > 0.03f * fabsf(e) + 0.03f) atomicOr(flag, 32u);
}
__device__ __forceinline__ void dbg_report(const Args& A) {
    if (blockIdx.x == 0 && threadIdx.x == 0) {
        const unsigned f = *((volatile unsigned*)(A.ws + WS_CTL) + 64);
        float add = 0.f; if (f & 1u) add += 1e4f; if (f & 2u) add += 1e5f; if (f & 4u) add += 1e6f; if (f & 8u) add += 1e7f; if (f & 16u) add += 3e3f; if (f & 32u) add += 1e8f;
        A.out[0] += add;
    }
}

constexpr int DSA_HS = 288;
constexpr int DSA_HIST = 0, DSA_STG = 73728, DSA_STGB = 32768, DSA_MASK = DSA_STG + 65536, DSA_PRE = DSA_MASK + 16384, DSA_KREM = DSA_PRE + 256;
static_assert(64 * DSA_HS * 4 <= DSA_STG, "DSA histogram rows");
static_assert(DSA_KREM + 256 <= LDSCTL_OFF, "DSA LDS map");

__device__ __forceinline__ unsigned umax(unsigned a, unsigned b) { return a > b ? a : b; }
__device__ __forceinline__ unsigned umin(unsigned a, unsigned b) { return a < b ? a : b; }
#define GLDS16(gsrc, ldst) __builtin_amdgcn_global_load_lds((const unsigned*)(gsrc), (LAS unsigned*)(ldst), 16, 0, 0)
__device__ __forceinline__ void idx_scores(const LAS unsigned char* ikt, const bf16x8 (&aiq)[4], const f32x4 (&iwv)[4], int lane, unsigned (&u)[4]) {
    f32x16 acc;
#pragma unroll
    for (int r = 0; r < 16; ++r) acc[r] = 0.f;
    const LAS unsigned char* p = ikt + (lane & 31) * 32 + (lane >> 5) * 16;
#pragma unroll
    for (int ks = 0; ks < 4; ++ks) { const bf16x8 bik = *(const LAS bf16x8*)(p + ks * 1024); acc = __builtin_amdgcn_mfma_f32_32x32x16_bf16(aiq[ks], bik, acc, 0, 0, 0); }
#pragma unroll
    for (int j = 0; j < 4; ++j) {
        float s = fmaxf(acc[4 * j + 0], 0.f) * iwv[j][0];
        s = __builtin_fmaf(fmaxf(acc[4 * j + 1], 0.f), iwv[j][1], s);
        s = __builtin_fmaf(fmaxf(acc[4 * j + 2], 0.f), iwv[j][2], s);
        s = __builtin_fmaf(fmaxf(acc[4 * j + 3], 0.f), iwv[j][3], s);
        u[j] = (s == 0.f) ? 0x80000000u : ordf(s);
    }
}

__device__ __forceinline__ bool hist_scan(LAS unsigned* HIST, LAS unsigned* PRE, LAS unsigned* KREM, int wave, int lane) {
    bool exact = true;
    for (int i = 0; i < 8; ++i) {
        const int q = 8 * wave + i;
        const v4u c4 = *(const LAS v4u*)(HIST + q * DSA_HS + 252 - 4 * lane);
        const unsigned c0 = c4.w, c1 = c4.z, c2 = c4.y, c3 = c4.x, ssum = c0 + c1 + c2 + c3;
        unsigned incl = ssum;
#pragma unroll
        for (int o = 1; o < 64; o <<= 1) { const unsigned t = __shfl_up(incl, o); if (lane >= o) incl += t; }
        const unsigned k = KREM[q], pold = PRE[q];
        const unsigned long long bal = __ballot(incl >= k);
        const int L = bal ? (__ffsll((long long)bal) - 1) : 63;
        unsigned a = __shfl(incl - ssum, L);
        const unsigned d0 = __shfl(c0, L), d1 = __shfl(c1, L), d2 = __shfl(c2, L), d3 = __shfl(c3, L);
        int bin; unsigned dsel;
        if (a + d0 >= k) { bin = 255 - 4 * L; dsel = d0; }
        else { a += d0; if (a + d1 >= k) { bin = 254 - 4 * L; dsel = d1; } else { a += d1; if (a + d2 >= k) { bin = 253 - 4 * L; dsel = d2; } else { a += d2; bin = 252 - 4 * L; dsel = d3; } } }
        const unsigned pnew = (pold << 8) | (unsigned)bin;
        exact = exact && (dsel == k - a) && (pnew != 0u);
        if (lane == 0) { PRE[q] = pnew; KREM[q] = k - a; }
    }
    return __builtin_amdgcn_readfirstlane((int)exact) != 0;
}

template <int VAR> __device__ __forceinline__ void dsa_attend(const bf16* Z, const unsigned char* KX, const unsigned char* VX, bf16* ATT, LAS unsigned char* STG, LAS unsigned* MASKW,
                                                          int tq, size_t kblk0, int nsteps, int c, int lane, int wave, int tid, const float* GQ) {
        const int half = lane >> 5, l31 = lane & 31;
#ifdef NO_PRIO_DSA
        if (wave >> 2) __builtin_amdgcn_s_setprio(2);
#endif
        bf16x8 bq[2][4];
#pragma unroll
        for (int ct = 0; ct < 2; ++ct) { const bf16* qp = Z + (size_t)(tq + 4 * ct + (l31 >> 3)) * ZW + ZC_Q + (l31 & 7) * 64 + half * 8;
#pragma unroll
            for (int ks = 0; ks < 4; ++ks) bq[ct][ks] = *(const GAS bf16x8*)(qp + 16 * ks); }
#ifdef QN_DSA
#pragma unroll
        for (int ct = 0; ct < 2; ++ct) {
            float qf[4][8]; float ss = 0.f;
#pragma unroll
            for (int ks = 0; ks < 4; ++ks) { const v4u w = __builtin_bit_cast(v4u, bq[ct][ks]);
                qf[ks][0] = bflo(w.x); qf[ks][1] = bfhi(w.x); qf[ks][2] = bflo(w.y); qf[ks][3] = bfhi(w.y); qf[ks][4] = bflo(w.z); qf[ks][5] = bfhi(w.z); qf[ks][6] = bflo(w.w); qf[ks][7] = bfhi(w.w);
#pragma unroll
                for (int jj = 0; jj < 8; ++jj) ss += qf[ks][jj] * qf[ks][jj]; }
            ss = xhalf_sum(ss);
            const float rstd = QSCALE / sqrtf(ss * (1.f / 64.f) + EPS);
#pragma unroll
            for (int ks = 0; ks < 4; ++ks) { const f32x4 g0 = *(const GAS f32x4*)(GQ + 16 * ks + 8 * half), g1 = *(const GAS f32x4*)(GQ + 16 * ks + 8 * half + 4);
                v4u o; o.x = pk2(qf[ks][0] * rstd * g0.x, qf[ks][1] * rstd * g0.y); o.y = pk2(qf[ks][2] * rstd * g0.z, qf[ks][3] * rstd * g0.w);
                o.z = pk2(qf[ks][4] * rstd * g1.x, qf[ks][5] * rstd * g1.y); o.w = pk2(qf[ks][6] * rstd * g1.z, qf[ks][7] * rstd * g1.w);
                bq[ct][ks] = __builtin_bit_cast(bf16x8, o); }
        }
#endif
        f32x16 O[2][2];
#pragma unroll
        for (int ct = 0; ct < 2; ++ct)
#pragma unroll
            for (int rt = 0; rt < 2; ++rt)
#pragma unroll
                for (int r = 0; r < 16; ++r) O[ct][rt][r] = 0.f;
        float m_run[2] = {-1e30f, -1e30f}, l_run[2] = {0.f, 0.f};
        const int qsel = (lane >> 3) & 3;
        const bool all_on = (c < 4);
#ifdef ATT_BIG8
        constexpr int AB = 4; LAS unsigned char* const ABASE = STG - DSA_STG; constexpr int ABUFB = 65536;
        __syncthreads();
#else
#ifndef ATT_AB
#define ATT_AB 2
#endif
        constexpr int AB = ATT_AB; LAS unsigned char* const ABASE = STG; constexpr int ABUFB = DSA_STGB;
#endif
        constexpr int AVOFF = AB * 8192;
        const int nbig2 = (nsteps + AB - 1) / AB;
        { const int ns0 = nsteps < AB ? nsteps : AB;
#pragma unroll
          for (int k = 0; k < AB; ++k) if (k < ns0) { GLDS16(KX + kblk0 + (size_t)k * 8192 + (size_t)tid * 16, ABASE + k * 8192 + wave * 1024); GLDS16(VX + kblk0 + (size_t)k * 8192 + (size_t)tid * 16, ABASE + AVOFF + k * 8192 + wave * 1024); } }
        __syncthreads();
        for (int bs = 0; bs < nbig2; ++bs) {
            const int nsub = (nsteps - AB * bs) < AB ? (nsteps - AB * bs) : AB;
            const int nnext = (bs + 1 < nbig2) ? ((nsteps - AB * (bs + 1)) < AB ? (nsteps - AB * (bs + 1)) : AB) : 0;
#pragma unroll
            for (int k = 0; k < AB; ++k) if (VAR != 5 && k < nnext) { const size_t o = kblk0 + (size_t)(AB * (bs + 1) + k) * 8192 + (size_t)tid * 16; LAS unsigned char* nb = ABASE + ((bs + 1) & 1) * ABUFB + k * 8192 + wave * 1024; GLDS16(KX + o, nb); GLDS16(VX + o, nb + AVOFF); }
            const LAS unsigned char* buf = ABASE + (bs & 1) * ABUFB;
#pragma unroll 1
            for (int tl = 0; tl < 2 * nsub; ++tl) {
                const LAS unsigned char* kp = buf + (VAR == 4 ? 0 : tl) * 4096 + l31 * 32 + half * 16;
                bf16x8 kf[4];
#pragma unroll
                for (int ks = 0; ks < 4; ++ks) kf[ks] = *(const LAS bf16x8*)(kp + ks * 1024);
                const LAS unsigned char* vp = buf + AVOFF + (VAR == 4 ? 0 : tl) * 4096 + l31 * 32 + half * 16;
                bf16x8 vf[2][2];
#pragma unroll
                for (int rt = 0; rt < 2; ++rt)
#pragma unroll
                    for (int s = 0; s < 2; ++s) vf[rt][s] = *(const LAS bf16x8*)(vp + (rt * 2 + s) * 1024);
#ifdef ATT_S2
                f32x16 sacc2[2];
#pragma unroll
                for (int ct = 0; ct < 2; ++ct) {
#pragma unroll
                    for (int r = 0; r < 16; ++r) sacc2[ct][r] = 0.f;
#pragma unroll
                    for (int ks = 0; ks < 4; ++ks) sacc2[ct] = __builtin_amdgcn_mfma_f32_32x32x16_bf16(kf[ks], bq[ct][ks], sacc2[ct], 0, 0, 0);
                }
#endif
#pragma unroll
                for (int ct = 0; ct < 2; ++ct) {
#ifdef ATT_S2
                    const f32x16 sacc = sacc2[ct];
#else
                    f32x16 sacc;
#pragma unroll
                    for (int r = 0; r < 16; ++r) sacc[r] = 0.f;
#pragma unroll
                    for (int ks = 0; ks < (VAR == 2 ? 1 : 4); ++ks) sacc = __builtin_amdgcn_mfma_f32_32x32x16_bf16(kf[ks], bq[ct][ks], sacc, 0, 0, 0);
#endif
                    const unsigned Wq = all_on ? 0xFFFFFFFFu : MASKW[(8 * wave + 4 * ct + qsel) * 64 + 2 * AB * bs + tl];
                    const unsigned Wh = Wq >> (4 * half);
                    float mx = fmaxf(fmaxf(sacc[0], sacc[1]), sacc[2]);
#pragma unroll
                    for (int r = 3; r < 15; r += 2) mx = fmaxf(fmaxf(mx, sacc[r]), sacc[r + 1]);
                    mx = fmaxf(mx, sacc[15]);
                    mx = xhalf_max(mx);
                    const float m_new = fmaxf(m_run[ct], mx);
                    const float alpha = __builtin_amdgcn_exp2f(m_run[ct] - m_new);
                    m_run[ct] = m_new;
                    unsigned pw[8]; float psum = 0.f;
#pragma unroll
                    for (int i = 0; i < 8; ++i) {
                        const int r0 = 2 * i, b0 = (r0 & 3) + 8 * (r0 >> 2);
                        const unsigned k0 = (unsigned)__builtin_amdgcn_sbfe((int)Wh, b0, 1), k1 = (unsigned)__builtin_amdgcn_sbfe((int)Wh, b0 + 1, 1);
                        const unsigned keep = __builtin_amdgcn_perm(k1, k0, 0x05040100u);
                        const unsigned pk = (VAR == 1 ? pk2(sacc[r0] - m_new, sacc[r0 + 1] - m_new) : pk2(__builtin_amdgcn_exp2f(sacc[r0] - m_new), __builtin_amdgcn_exp2f(sacc[r0 + 1] - m_new))) & keep;
                        pw[i] = pk;
                        psum = __builtin_amdgcn_fdot2_f32_bf16(__builtin_bit_cast(bf16x2_t, pk), __builtin_bit_cast(bf16x2_t, 0x3F803F80u), psum, false);
                    }
                    l_run[ct] = l_run[ct] * alpha + psum;
                    if (__any(alpha != 1.0f)) {
#pragma unroll
                        for (int rt = 0; rt < 2; ++rt)
#pragma unroll
                            for (int r = 0; r < 16; ++r) O[ct][rt][r] *= alpha;
                    }
                    bf16x8 pb[2];
#pragma unroll
                    for (int s = 0; s < 2; ++s) pb[s] = __builtin_bit_cast(bf16x8, (v4u){pw[4 * s], pw[4 * s + 1], pw[4 * s + 2], pw[4 * s + 3]});
#pragma unroll
                    for (int rt = 0; rt < (VAR == 3 ? 1 : 2); ++rt)
#pragma unroll
                        for (int s = 0; s < (VAR == 3 ? 1 : 2); ++s) O[ct][rt] = __builtin_amdgcn_mfma_f32_32x32x16_bf16(vf[rt][s], pb[s], O[ct][rt], 0, 0, 0);
                }
            }
            if (VAR != 5) __syncthreads();
        }
        if (VAR == 5) __syncthreads();
#pragma unroll
        for (int ct = 0; ct < 2; ++ct) {
            const float inv = 1.0f / xhalf_sum(l_run[ct]);
            bf16* op = ATT + (size_t)(tq + 4 * ct + (l31 >> 3)) * 512 + (l31 & 7) * 64 + 4 * half;
#pragma unroll
            for (int rt = 0; rt < 2; ++rt)
#pragma unroll
                for (int g = 0; g < 4; ++g) {
                    v2u w; w.x = pk2(O[ct][rt][4 * g] * inv, O[ct][rt][4 * g + 1] * inv); w.y = pk2(O[ct][rt][4 * g + 2] * inv, O[ct][rt][4 * g + 3] * inv);
                    *(GAS v2u*)(op + 32 * rt + 8 * g) = w;
                }
        }
#ifdef NO_PRIO_DSA
        __builtin_amdgcn_s_setprio(0);
#endif
}

__device__ __forceinline__ void dsa_phase(Frame& F, const Args& A) {
    unsigned char* ws = A.ws;
    const bf16* Z = (const bf16*)(ws + WS_Z); const unsigned char* IKX = ws + WS_IKX; const unsigned char* KX = ws + WS_KX; const unsigned char* VX = ws + WS_VX;
    const float* IW = (const float*)(ws + WS_IW); bf16* ATT = (bf16*)(ws + WS_ATT);
    const int lane = F.lane, wave = F.wave, tid = F.tid, half = lane >> 5, l31 = lane & 31;
    LAS unsigned* HIST = (LAS unsigned*)(F.lds + DSA_HIST);
    LAS unsigned* PRE = (LAS unsigned*)(F.lds + DSA_PRE);
    LAS unsigned* KREM = (LAS unsigned*)(F.lds + DSA_KREM);
    LAS unsigned* MASKW = (LAS unsigned*)(F.lds + DSA_MASK);
    LAS unsigned char* STG = F.lds + DSA_STG;

    for (int P = F.vcu; P < 512; P += F.G) {
      for (int side = 0; side < 2; ++side) {
        const int b = P >> 4, c = side ? 31 - (P & 15) : (P & 15);
        const int nsteps = c + 1;
        const int tq = b * SEQ + 64 * c + 8 * wave;
        const size_t kblk0 = (size_t)b * 64 * 4096;
#ifndef DSA_REP_SEL
#define DSA_REP_SEL 1
#endif
#ifndef DSA_REP_ATT
#define DSA_REP_ATT 1
#endif
        for (int rs_ = 0; rs_ < DSA_REP_SEL; ++rs_)
        if (c >= 4) {
            const int v_ = F.vcu;
            const size_t scb = v_ < 128 ? WS_PM + (size_t)v_ * (512 * 1024) : v_ < 172 ? 42 * MiB + (size_t)(v_ - 128) * (512 * 1024) : v_ < 220 ? 72 * MiB + (size_t)(v_ - 172) * (512 * 1024) : 104 * MiB + (size_t)(v_ - 220) * (512 * 1024);
            unsigned* SC = (unsigned*)(ws + scb) + (size_t)(wave * 64 + lane) * 4;
            if (lane < 8) { PRE[8 * wave + lane] = 0u; KREM[8 * wave + lane] = 256u; }
#ifndef DSA_REP_P0
#define DSA_REP_P0 1
#endif
            for (int rp0_ = 0; rp0_ < DSA_REP_P0; ++rp0_) {
#pragma unroll
            for (int i = 0; i < 8; ++i) *(LAS v4u*)(HIST + (wave * 8 + i) * DSA_HS + lane * 4) = (v4u){0u, 0u, 0u, 0u};
            {
                bf16x8 aiq[4];
                { const bf16* zq = Z + (size_t)(tq + (l31 >> 2)) * ZW + ZC_IQ + (l31 & 3) * 64 + half * 8;
#pragma unroll
                  for (int ks = 0; ks < 4; ++ks) aiq[ks] = *(const GAS bf16x8*)(zq + 16 * ks); }
                f32x4 iwv[4];
#pragma unroll
                for (int j = 0; j < 4; ++j) iwv[j] = *(const GAS f32x4*)(IW + (size_t)(tq + 2 * j + half) * 4);
                const int nbig = (nsteps + 3) >> 2;
                { const int ns0 = nsteps < 4 ? nsteps : 4;
#pragma unroll
                  for (int k = 0; k < 4; ++k) if (k < ns0) GLDS16(IKX + kblk0 + (size_t)k * 8192 + (size_t)tid * 16, STG + k * 8192 + wave * 1024); }
                __syncthreads();
                unsigned WB = 0u; unsigned long long pkc[4] = {0ull, 0ull, 0ull, 0ull};
                for (int bs = 0; bs < nbig; ++bs) {
                    const int nsub = (nsteps - 4 * bs) < 4 ? (nsteps - 4 * bs) : 4;
                    const int nnext = (bs + 1 < nbig) ? ((nsteps - 4 * (bs + 1)) < 4 ? (nsteps - 4 * (bs + 1)) : 4) : 0;
#pragma unroll
                    for (int k = 0; k < 4; ++k) if (k < nnext) GLDS16(IKX + kblk0 + (size_t)(4 * (bs + 1) + k) * 8192 + (size_t)tid * 16, STG + ((bs + 1) & 1) * DSA_STGB + k * 8192 + wave * 1024);
                    const LAS unsigned char* buf = STG + (bs & 1) * DSA_STGB;
                    for (int sb = 0; sb < nsub; ++sb) {
                        unsigned uu[2][4];
                        idx_scores(buf + sb * 8192, aiq, iwv, lane, uu[0]);
                        idx_scores(buf + sb * 8192 + 4096, aiq, iwv, lane, uu[1]);
                        if (bs == 0 && sb == 0) {
                            unsigned fm = 0u;
#pragma unroll
                            for (int t2 = 0; t2 < 2; ++t2)
#pragma unroll
                                for (int j = 0; j < 4; ++j) { const unsigned u = uu[t2][j]; fm = umax(fm, umax(u >> 24, (~u) >> 24)); }
#pragma unroll
                            for (int o = 1; o < 64; o <<= 1) fm = umax(fm, (unsigned)__shfl_xor((int)fm, o));
                            WB = (unsigned)__builtin_amdgcn_readfirstlane((int)fm) - 3u;
                        }
#pragma unroll
                        for (int t2 = 0; t2 < 2; ++t2) {
                            const int tile = 8 * bs + 2 * sb + t2;
                            *(GAS v4u*)(SC + (size_t)tile * 2048) = (v4u){uu[t2][0], uu[t2][1], uu[t2][2], uu[t2][3]};
#pragma unroll
                            for (int j = 0; j < 4; ++j) {
                                const unsigned u = uu[t2][j], bin = u >> 24, nb = (~u) >> 24, slot = umax(bin, nb) - WB;
                                if (slot < 4u) pkc[j] += 1ull << (8u * slot + ((nb >> 7) << 5));
                                else __hip_atomic_fetch_add(HIST + (8 * wave + 2 * j + half) * DSA_HS + bin, 1u, __ATOMIC_RELAXED, __HIP_MEMORY_SCOPE_WORKGROUP);
                            }
                        }
                    }
                    __syncthreads();
                }
#pragma unroll
                for (int j = 0; j < 4; ++j) {
                    const unsigned lo = (unsigned)pkc[j], hi = (unsigned)(pkc[j] >> 32);
                    unsigned f[4] = {lo & 0x00FF00FFu, (lo >> 8) & 0x00FF00FFu, hi & 0x00FF00FFu, (hi >> 8) & 0x00FF00FFu};
#pragma unroll
                    for (int o = 1; o < 32; o <<= 1)
#pragma unroll
                        for (int i = 0; i < 4; ++i) f[i] += (unsigned)__shfl_xor((int)f[i], o);
                    const unsigned sc8[8] = {f[0] & 0xFFFFu, f[1] & 0xFFFFu, f[0] >> 16, f[1] >> 16, f[2] & 0xFFFFu, f[3] & 0xFFFFu, f[2] >> 16, f[3] >> 16};
                    unsigned mine = 0u;
#pragma unroll
                    for (int s8 = 0; s8 < 8; ++s8) mine = (l31 == s8) ? sc8[s8] : mine;
                    const unsigned fbv = WB + (unsigned)(l31 & 3), bin = (l31 & 4) ? (255u - fbv) : fbv;
                    if (l31 < 8 && mine != 0u) __hip_atomic_fetch_add(HIST + (8 * wave + 2 * j + half) * DSA_HS + (bin & 255u), mine, __ATOMIC_RELAXED, __HIP_MEMORY_SCOPE_WORKGROUP);
                }
            }
            }
            bool exact = hist_scan(HIST, PRE, KREM, wave, lane);
            for (int pass = 1; pass < 5; ++pass) {
                if (pass < 4 && exact) {
                    if (lane < 8) { const int q = 8 * wave + lane; PRE[q] = (PRE[q] << (8 * (4 - pass))) - 1u; KREM[q] = 0u; }
                    pass = 4;
                }
                unsigned pre[4], krem[4], eqrun[4];
#pragma unroll
                for (int j = 0; j < 4; ++j) { pre[j] = PRE[8 * wave + 2 * j + half]; krem[j] = KREM[8 * wave + 2 * j + half]; eqrun[j] = 0u; }
                if (pass < 4) {
#pragma unroll
                    for (int i = 0; i < 8; ++i) *(LAS v4u*)(HIST + (wave * 8 + i) * DSA_HS + lane * 4) = (v4u){0u, 0u, 0u, 0u};
                }
                const int sh_hi = 32 - 8 * pass, sh_lo = 24 - 8 * pass;
                const unsigned lmask = (1u << l31) - 1u;
                {
                    const int ntiles = 2 * nsteps;
                    v4u nx[4];
#pragma unroll
                    for (int k = 0; k < 4; ++k) { nx[k] = (v4u){0u, 0u, 0u, 0u}; if (k < ntiles) nx[k] = *(const GAS v4u*)(SC + (size_t)k * 2048); }
                    for (int t0 = 0; t0 < ntiles; t0 += 4) {
                        v4u cur[4];
#pragma unroll
                        for (int k = 0; k < 4; ++k) { cur[k] = nx[k]; if (t0 + 4 + k < ntiles) nx[k] = *(const GAS v4u*)(SC + (size_t)(t0 + 4 + k) * 2048); }
#pragma unroll
                        for (int k = 0; k < 4; ++k) {
                            const int tile = t0 + k;
                            if (tile < ntiles) {
                                const unsigned u4[4] = {cur[k].x, cur[k].y, cur[k].z, cur[k].w};
                                if (pass < 4) {
#pragma unroll
                                    for (int j = 0; j < 4; ++j) {
                                        const unsigned u = u4[j];
                                        if ((u >> sh_hi) == pre[j]) __hip_atomic_fetch_add(HIST + (8 * wave + 2 * j + half) * DSA_HS + ((u >> sh_lo) & 255u), 1u, __ATOMIC_RELAXED, __HIP_MEMORY_SCOPE_WORKGROUP);
                                    }
                                } else {
#pragma unroll
                                    for (int j = 0; j < 4; ++j) {
                                        const unsigned u = u4[j];
                                        const bool e = (u == pre[j]);
                                        const unsigned long long em = __ballot(e);
                                        const unsigned mine = half ? (unsigned)(em >> 32) : (unsigned)em;
                                        const unsigned rank = eqrun[j] + __popc(mine & lmask);
                                        eqrun[j] += __popc(mine);
                                        const bool sel = (u > pre[j]) || (e && rank < krem[j]);
                                        const unsigned long long sm = __ballot(sel);
                                        if (lane == 0) { MASKW[(8 * wave + 2 * j) * 64 + tile] = (unsigned)sm; MASKW[(8 * wave + 2 * j + 1) * 64 + tile] = (unsigned)(sm >> 32); }
                                    }
                                }
                            }
                        }
                    }
                }
                if (pass < 4) exact = hist_scan(HIST, PRE, KREM, wave, lane);
            }
#ifdef DBG_SEL
            for (int i = 0; i < 8; ++i) {
                unsigned v = (lane < 2 * nsteps) ? (unsigned)__popc(MASKW[(8 * wave + i) * 64 + lane]) : 0u;
#pragma unroll
                for (int o = 1; o < 64; o <<= 1) v += (unsigned)__shfl_xor((int)v, o);
                if (lane == 0 && v != 256u) atomicOr((unsigned*)(ws + WS_CTL) + 64, 1u);
            }
#endif
        }

#if DSA_REP_ATT == 2
        dsa_attend<ATT_VARIANT>(Z, KX, VX, ATT, STG, MASKW, tq, kblk0, nsteps, c, lane, wave, tid, A.g_q);
#endif
        dsa_attend<0>(Z, KX, VX, ATT, STG, MASKW, tq, kblk0, nsteps, c, lane, wave, tid, A.g_q);
      }
    }
}

template <int BASE, int N> __device__ __forceinline__ void sort16(float (&v)[N]) {
    constexpr int NCE = 60;
    constexpr unsigned char CI[NCE] = {0,1,2,3,4,5,7,9, 0,1,2,3,6,8,10,11, 0,2,4,6,7,10,12,14, 0,1,4,5,6,8,12,13, 1,3,4,5,8,9,13, 1,2,5,7,9,11, 2,3,9,11, 3,6,7,10, 3,5,7,9,11, 6,8};
    constexpr unsigned char CJ[NCE] = {13,12,15,14,8,6,11,10, 5,7,9,4,13,14,15,12, 1,3,5,8,9,11,13,15, 2,3,10,11,7,9,14,15, 2,12,6,7,10,11,14, 4,6,8,10,13,14, 4,6,12,13, 5,8,9,12, 4,6,8,10,12, 7,9};
#pragma unroll
    for (int c = 0; c < NCE; ++c) { const float x = v[BASE + CI[c]], y = v[BASE + CJ[c]]; v[BASE + CI[c]] = fmaxf(x, y); v[BASE + CJ[c]] = fminf(x, y); }
}
template <int A0, int B0, int N> __device__ __forceinline__ void merge16(float (&v)[N]) {
#pragma unroll
    for (int i = 0; i < 16; ++i) v[A0 + i] = fmaxf(v[A0 + i], v[B0 + 15 - i]);
#pragma unroll
    for (int j = 8; j > 0; j >>= 1)
#pragma unroll
        for (int i = 0; i < 16; ++i) { const int l = i ^ j; if (l > i) { const float x = v[A0 + i], y = v[A0 + l]; v[A0 + i] = fmaxf(x, y); v[A0 + l] = fminf(x, y); } }
}
__device__ __forceinline__ void top16_of64(float (&v)[64]) {
    sort16<0, 64>(v); sort16<16, 64>(v); sort16<32, 64>(v); sort16<48, 64>(v);
    merge16<0, 16, 64>(v); merge16<32, 48, 64>(v); merge16<0, 32, 64>(v);
}
__device__ __forceinline__ void peer_half(const bf16x8 (&bqf)[4], const LAS unsigned char* skl, int p, int lane, float (&lst)[16]) {
    const int half = lane >> 5, l31 = lane & 31;
    float v[64];
    const LAS unsigned char* ap = skl + p * 16384 + l31 * 32 + half * 16;
#pragma unroll
    for (int rt = 0; rt < 4; ++rt) {
        f32x16 acc;
#pragma unroll
        for (int r = 0; r < 16; ++r) acc[r] = 0.f;
#pragma unroll
        for (int ks = 0; ks < 4; ++ks) { const bf16x8 af = *(const LAS bf16x8*)(ap + (rt * 4 + ks) * 1024); acc = __builtin_amdgcn_mfma_f32_32x32x16_bf16(af, bqf[ks], acc, 0, 0, 0); }
#pragma unroll
        for (int r = 0; r < 16; ++r) { const unsigned kidx = rt * 32 + (r & 3) + 8 * (r >> 2) + 4 * half; v[rt * 16 + r] = __uint_as_float((__float_as_uint(acc[r]) & ~127u) | (127u - kidx)); }
    }
    top16_of64(v);
    float both[32];
#pragma unroll
    for (int i = 0; i < 16; ++i) { both[i] = v[i]; both[16 + i] = __shfl_xor(v[i], 32); }
    merge16<0, 16, 32>(both);
#pragma unroll
    for (int i = 0; i < 16; ++i) lst[i] = both[i];
}
__device__ __forceinline__ void peer_route(Frame& F, const Args& A) {
    unsigned char* ws = A.ws;
    const bf16* PQ = (const bf16*)(ws + WS_PQ); const bf16* SK = (const bf16*)(ws + WS_SK); int* EIDX = (int*)(ws + WS_EIDX); float* EGATE = (float*)(ws + WS_EGATE);
    const int lane = F.lane;
    LAS unsigned* KL = (LAS unsigned*)(F.lds + F.wave * 8192);
    LAS unsigned char* SKL = F.lds + 65536;
    for (int hp = 0; hp < 4; ++hp) {
        __syncthreads();
#pragma unroll
        for (int i = 0; i < 8; ++i) {
            const int ch = F.tid + 512 * i, c8 = ch & 7, key = (ch >> 3) & 127, p = (ch >> 10) & 1, hh = ch >> 11;
            const v4u r = *(const GAS v4u*)(SK + ((size_t)((2 * hp + hh) * 2 + p) * 128 + key) * 64 + 8 * c8);
            *(LAS v4u*)(SKL + hh * 32768 + ((p * 4 + (key >> 5)) * 4 + (c8 >> 1)) * 1024 + (key & 31) * 32 + (c8 & 1) * 16) = r;
        }
        __syncthreads();
      for (int tt = F.gw * (T / 32 / F.NGW); tt < (F.gw + 1) * (T / 32 / F.NGW); ++tt) {
        const int token = tt * 32 + (lane & 31);
        float l0[16], l1[16];
        {
            const bool hi = lane >= 32;
            const bf16* qa = PQ + (size_t)token * 1024 + (2 * hp) * 128 + (lane >> 5) * 8; const bf16* qb = qa + 128;
            bf16x8 bq[4]; float t[16];
#pragma unroll
            for (int ks = 0; ks < 4; ++ks) bq[ks] = *(const GAS bf16x8*)(qa + 16 * ks);
            peer_half(bq, SKL, 0, lane, l0);
#pragma unroll
            for (int ks = 0; ks < 4; ++ks) bq[ks] = *(const GAS bf16x8*)(qb + 16 * ks);
            peer_half(bq, SKL + 32768, 0, lane, t);
#pragma unroll
            for (int i = 0; i < 16; ++i) l0[i] = hi ? t[i] : l0[i];
#pragma unroll
            for (int ks = 0; ks < 4; ++ks) bq[ks] = *(const GAS bf16x8*)(qa + 64 + 16 * ks);
            peer_half(bq, SKL, 1, lane, l1);
#pragma unroll
            for (int ks = 0; ks < 4; ++ks) bq[ks] = *(const GAS bf16x8*)(qb + 64 + 16 * ks);
            peer_half(bq, SKL + 32768, 1, lane, t);
#pragma unroll
            for (int i = 0; i < 16; ++i) l1[i] = hi ? t[i] : l1[i];
        }
        const int h = 2 * hp + (lane >> 5);
        float s0[16], s1[16];
#pragma unroll
        for (int i = 0; i < 16; ++i) { const unsigned b0 = __float_as_uint(l0[i]), b1 = __float_as_uint(l1[i]); s0[i] = __uint_as_float(b0 & ~127u); s1[i] = __uint_as_float(b1 & ~127u); KL[i * 64 + lane] = 127u - (b0 & 127u); KL[(16 + i) * 64 + lane] = 127u - (b1 & 127u); }
        float cs[64]; int nc = 0;
#pragma unroll
        for (int r = 0; r < 64; ++r) cs[r] = -3.0e38f;
#pragma unroll
        for (int i = 0; i < 16; ++i)
#pragma unroll
            for (int j = 0; j < 16; ++j)
                if ((i + 1) * (j + 1) <= 16) { cs[nc] = __uint_as_float((__float_as_uint(s0[i] + s1[j]) & ~255u) | (255u - (unsigned)(i * 16 + j))); ++nc; }
        top16_of64(cs);
        float ev[16]; unsigned be[16]; float sum = 0.f; const float mx = __uint_as_float(__float_as_uint(cs[0]) & ~255u);
#pragma unroll
        for (int i = 0; i < 16; ++i) {
            const unsigned cb = __float_as_uint(cs[i]); ev[i] = __expf(__uint_as_float(cb & ~255u) - mx); sum += ev[i];
            const unsigned fi = 255u - (cb & 255u);
            be[i] = KL[(fi >> 4) * 64 + lane] * 128u + KL[(16 + (fi & 15u)) * 64 + lane];
        }
        const float inv = 1.0f / sum;
        {
            int* ep = EIDX + (size_t)token * 128 + h * 16; float* gp = EGATE + (size_t)token * 128 + h * 16;
#pragma unroll
            for (int i = 0; i < 4; ++i) {
#ifndef EIDX16
                *(GAS v4u*)(ep + 4 * i) = (v4u){be[4 * i], be[4 * i + 1], be[4 * i + 2], be[4 * i + 3]};
#endif
                *(GAS f32x4*)(gp + 4 * i) = (f32x4){ev[4 * i] * inv, ev[4 * i + 1] * inv, ev[4 * i + 2] * inv, ev[4 * i + 3] * inv};
            }
#ifdef EIDX16
            {
                GAS v4u* e16 = (GAS v4u*)((unsigned short*)EIDX + (size_t)token * 128 + h * 16);
                e16[0] = (v4u){(unsigned)be[0] | ((unsigned)be[1] << 16), (unsigned)be[2] | ((unsigned)be[3] << 16), (unsigned)be[4] | ((unsigned)be[5] << 16), (unsigned)be[6] | ((unsigned)be[7] << 16)};
                e16[1] = (v4u){(unsigned)be[8] | ((unsigned)be[9] << 16), (unsigned)be[10] | ((unsigned)be[11] << 16), (unsigned)be[12] | ((unsigned)be[13] << 16), (unsigned)be[14] | ((unsigned)be[15] << 16)};
            }
#endif
        }
        LDS_WAIT(); asm volatile("" ::: "memory");
      }
    }
}

__device__ __forceinline__ float dot2bf(unsigned w, unsigned x, float acc) { return __builtin_amdgcn_fdot2_f32_bf16(__builtin_bit_cast(bf16x2_t, w), __builtin_bit_cast(bf16x2_t, x), acc, false); }
__device__ __forceinline__ float dot8(v4u a, v4u b, float acc) {
    const unsigned a0 = a.x, a1 = a.y, a2 = a.z, a3 = a.w, b0 = b.x, b1 = b.y, b2 = b.z, b3 = b.w;
    return dot2bf(a3, b3, dot2bf(a2, b2, dot2bf(a1, b1, dot2bf(a0, b0, acc))));
}
__device__ __forceinline__ float dot8f4(unsigned q, v4u h, float acc) {
    const unsigned h0 = h.x, h1 = h.y, h2 = h.z, h3 = h.w;
    acc = __builtin_amdgcn_fdot2_f32_bf16(__builtin_amdgcn_cvt_scalef32_pk_bf16_fp4(q, 1.0f, 0), __builtin_bit_cast(bf16x2_t, h0), acc, false);
    acc = __builtin_amdgcn_fdot2_f32_bf16(__builtin_amdgcn_cvt_scalef32_pk_bf16_fp4(q, 1.0f, 1), __builtin_bit_cast(bf16x2_t, h1), acc, false);
    acc = __builtin_amdgcn_fdot2_f32_bf16(__builtin_amdgcn_cvt_scalef32_pk_bf16_fp4(q, 1.0f, 2), __builtin_bit_cast(bf16x2_t, h2), acc, false);
    acc = __builtin_amdgcn_fdot2_f32_bf16(__builtin_amdgcn_cvt_scalef32_pk_bf16_fp4(q, 1.0f, 3), __builtin_bit_cast(bf16x2_t, h3), acc, false);
    return acc;
}
typedef float f32x2v __attribute__((ext_vector_type(2)));
__device__ __forceinline__ void peer_gather(Frame& F, const Args& A, const bool dummy) {
    unsigned char* ws = A.ws;
    const bf16* H2 = (const bf16*)(ws + WS_H); const unsigned char* U4 = ws + WS_U; const unsigned char* V4 = ws + WS_V;
    const float* SU = (const float*)(ws + WS_SU); const float* SV = (const float*)(ws + WS_SV);
    const int* EIDX = (const int*)(ws + WS_EIDX); const float* EGATE = (const float*)(ws + WS_EGATE); const float* ADA = (const float*)(ws + WS_ADA);
    const int lane = F.lane, grp = lane >> 3, i8 = lane & 7;
    LAS unsigned* WSM = (LAS unsigned*)(F.lds + F.wave * 1024);
    for (int n = F.gw; n < T; n += F.NGW) {
        const int b = n >> 11;
        v4u hh[4][4];
        { const bf16* hp = H2 + (size_t)n * 1024 + 32 * i8;
#pragma unroll
          for (int t = 0; t < 4; ++t)
#pragma unroll
              for (int k = 0; k < 4; ++k) hh[t][k] = *(const GAS v4u*)(hp + 256 * t + 8 * k); }
#pragma unroll 4
        for (int bb = 0; bb < 16; ++bb) {
            const int slot = bb * 8 + grp;
            const int eid = EIDX[(size_t)n * 128 + slot]; const float gt = EGATE[(size_t)n * 128 + slot];
            const unsigned char* up = U4 + (size_t)eid * 512 + 16 * i8;
            v4u q[4];
#pragma unroll
            for (int t = 0; t < 4; ++t) q[t] = *(const GAS v4u*)(up + 128 * t);
            const float su = SU[eid], sv = SV[eid];
            float d0 = 0.f, d1 = 0.f;
#pragma unroll
            for (int t = 0; t < 4; ++t) {
                const unsigned q0 = q[t].x, q1 = q[t].y, q2 = q[t].z, q3 = q[t].w;
                d0 = dot8f4(q0, hh[t][0], d0); d1 = dot8f4(q1, hh[t][1], d1); d0 = dot8f4(q2, hh[t][2], d0); d1 = dot8f4(q3, hh[t][3], d1);
            }
#ifdef GATHER_DUP_U
            { float e0 = 0.f, e1 = 0.f;
#pragma unroll
              for (int t = 0; t < 4; ++t) { const unsigned q0 = q[t].x ^ 0x88888888u, q1 = q[t].y ^ 0x88888888u, q2 = q[t].z ^ 0x88888888u, q3 = q[t].w ^ 0x88888888u;
                e0 = dot8f4(q0, hh[t][0], e0); e1 = dot8f4(q1, hh[t][1], e1); e0 = dot8f4(q2, hh[t][2], e0); e1 = dot8f4(q3, hh[t][3], e1); }
              d0 = 0.5f * (d0 - e0); d1 = 0.5f * (d1 - e1); }
#endif
            float dot = d0 + d1;
            dot += __shfl_xor(dot, 1); dot += __shfl_xor(dot, 2); dot += __shfl_xor(dot, 4);
            dot *= su;
            const float act = 0.5f * dot * (1.0f + erff(dot * 0.70710678118654752f));
            if (i8 == 0) { WSM[2 * slot] = (unsigned)eid; WSM[2 * slot + 1] = __float_as_uint(gt * act * sv); }
        }
        LDS_WAIT(); asm volatile("" ::: "memory");
        f32x2v acc[8];
#pragma unroll
        for (int j = 0; j < 8; ++j) acc[j] = (f32x2v){0.f, 0.f};
#pragma unroll 2
        for (int e0 = 0; e0 < 128; e0 += 16) {
            v2u vv[16]; float ww[16];
#pragma unroll
            for (int j = 0; j < 16; ++j) {
                const v2u ew = *(const LAS v2u*)(WSM + 2 * (e0 + j));
                const int eid = __builtin_amdgcn_readfirstlane((int)ew.x); ww[j] = __uint_as_float(__builtin_amdgcn_readfirstlane((int)ew.y));
                vv[j] = *(const GAS v2u*)(V4 + (size_t)eid * 512 + 8 * lane);
            }
#pragma unroll
            for (int j = 0; j < 16; ++j) {
                const unsigned v0 = vv[j].x, v1 = vv[j].y; const f32x2v w2 = (f32x2v){ww[j], ww[j]};
                acc[0] += w2 * __builtin_amdgcn_cvt_scalef32_pk_f32_fp4(v0, 1.0f, 0); acc[1] += w2 * __builtin_amdgcn_cvt_scalef32_pk_f32_fp4(v0, 1.0f, 1);
                acc[2] += w2 * __builtin_amdgcn_cvt_scalef32_pk_f32_fp4(v0, 1.0f, 2); acc[3] += w2 * __builtin_amdgcn_cvt_scalef32_pk_f32_fp4(v0, 1.0f, 3);
                acc[4] += w2 * __builtin_amdgcn_cvt_scalef32_pk_f32_fp4(v1, 1.0f, 0); acc[5] += w2 * __builtin_amdgcn_cvt_scalef32_pk_f32_fp4(v1, 1.0f, 1);
                acc[6] += w2 * __builtin_amdgcn_cvt_scalef32_pk_f32_fp4(v1, 1.0f, 2); acc[7] += w2 * __builtin_amdgcn_cvt_scalef32_pk_f32_fp4(v1, 1.0f, 3);
            }
        }
        LDS_WAIT(); asm volatile("" ::: "memory");
        const float* ip = A.out + (size_t)n * 1024 + 16 * lane; float* op = dummy ? (float*)(ws + WS_Z) + (size_t)n * 1024 + 16 * lane : A.out + (size_t)n * 1024 + 16 * lane; const float* g2p = ADA + b * 6144 + 5 * 1024 + 16 * lane;
#pragma unroll
        for (int q4 = 0; q4 < 4; ++q4) {
            const f32x4 xv = *(const GAS f32x4*)(ip + 4 * q4), gv = *(const GAS f32x4*)(g2p + 4 * q4);
            const f32x4 av = (f32x4){acc[2 * q4].x, acc[2 * q4].y, acc[2 * q4 + 1].x, acc[2 * q4 + 1].y};
            *(GAS f32x4*)(op + 4 * q4) = xv + gv * av;
        }
    }
}


constexpr int CW_Q1 = 8192, CW_Q3 = 8192 + 8 * 64;
__device__ __forceinline__ float quad_sum(float v) {
    v += __builtin_bit_cast(float, __builtin_amdgcn_update_dpp(0, __builtin_bit_cast(int, v), 0xB1, 0xF, 0xF, true));
    v += __builtin_bit_cast(float, __builtin_amdgcn_update_dpp(0, __builtin_bit_cast(int, v), 0x4E, 0xF, 0xF, true));
    return v;
}
__device__ __forceinline__ int next_item(Frame& F, unsigned* q) {
    LAS int* sh = (LAS int*)(F.lds);
    if (F.tid == 0) sh[0] = (int)__hip_atomic_fetch_add(q, 1u, __ATOMIC_RELAXED, __HIP_MEMORY_SCOPE_AGENT);
    __syncthreads(); const int it = sh[0]; __syncthreads();
    return it;
}
__device__ __forceinline__ void peer_g1(Frame& F, const Args& A) {
    unsigned char* ws = A.ws;
    const bf16* H2 = (const bf16*)(ws + WS_H); const unsigned char* U4 = ws + WS_U; const int* EIDX = (const int*)(ws + WS_EIDX); float* PD = (float*)(ws + WS_Z);
    unsigned* Q = (unsigned*)(ws + WS_CTL) + CW_Q1;
    const int lane = F.lane, tk = lane >> 3, c4 = lane & 7;
    const int s0 = (int)(xb_xcc_id() & 3u);
    for (int so = 0; so < 4; ++so) {
        const int s = (s0 + so) & 3;
        for (;;) {
            const int item = next_item(F, Q + 64 * s);
            if (item >= T / 128) break;
          for (int sub = 0; sub < 2; ++sub) {
            const int n = item * 128 + F.wave * 16 + sub * 8 + tk;
            v4u h2s[4];
            { const bf16* hp = H2 + (size_t)n * 1024 + 256 * s + 32 * c4;
#pragma unroll
              for (int k = 0; k < 4; ++k) h2s[k] = *(const GAS v4u*)(hp + 8 * k); }
            const unsigned char* ub = U4 + (size_t)s * (16384 * 128) + 16 * c4;
            float* pd = PD + ((size_t)s * T + n) * 128;
            const int* ep = EIDX + (size_t)n * 128;
            v4u idb[2], idc[2], rows[8], rnx[8];
            { const v4u i0 = *(const GAS v4u*)(ep), i1 = *(const GAS v4u*)(ep + 4); idb[0] = *(const GAS v4u*)(ep + 8); idb[1] = *(const GAS v4u*)(ep + 12);
              const unsigned a0 = i0.x, a1 = i0.y, a2 = i0.z, a3 = i0.w, a4 = i1.x, a5 = i1.y, a6 = i1.z, a7 = i1.w;
              rows[0] = *(const GAS v4u*)(ub + (size_t)a0 * 128); rows[1] = *(const GAS v4u*)(ub + (size_t)a1 * 128); rows[2] = *(const GAS v4u*)(ub + (size_t)a2 * 128); rows[3] = *(const GAS v4u*)(ub + (size_t)a3 * 128);
              rows[4] = *(const GAS v4u*)(ub + (size_t)a4 * 128); rows[5] = *(const GAS v4u*)(ub + (size_t)a5 * 128); rows[6] = *(const GAS v4u*)(ub + (size_t)a6 * 128); rows[7] = *(const GAS v4u*)(ub + (size_t)a7 * 128); }
            for (int g = 0; g < 16; ++g) {
                if (g + 2 < 16) { idc[0] = *(const GAS v4u*)(ep + 8 * (g + 2)); idc[1] = *(const GAS v4u*)(ep + 8 * (g + 2) + 4); }
                if (g + 1 < 16) {
                    const unsigned a0 = idb[0].x, a1 = idb[0].y, a2 = idb[0].z, a3 = idb[0].w, a4 = idb[1].x, a5 = idb[1].y, a6 = idb[1].z, a7 = idb[1].w;
                    rnx[0] = *(const GAS v4u*)(ub + (size_t)a0 * 128); rnx[1] = *(const GAS v4u*)(ub + (size_t)a1 * 128); rnx[2] = *(const GAS v4u*)(ub + (size_t)a2 * 128); rnx[3] = *(const GAS v4u*)(ub + (size_t)a3 * 128);
                    rnx[4] = *(const GAS v4u*)(ub + (size_t)a4 * 128); rnx[5] = *(const GAS v4u*)(ub + (size_t)a5 * 128); rnx[6] = *(const GAS v4u*)(ub + (size_t)a6 * 128); rnx[7] = *(const GAS v4u*)(ub + (size_t)a7 * 128);
                }
                float p[8];
#pragma unroll
                for (int k = 0; k < 8; ++k) { const unsigned x0 = rows[k].x, x1 = rows[k].y, x2 = rows[k].z, x3 = rows[k].w; float pp = quad_sum(dot8f4(x3, h2s[3], dot8f4(x2, h2s[2], dot8f4(x1, h2s[1], dot8f4(x0, h2s[0], 0.f))))); pp += __shfl_xor(pp, 4); p[k] = pp; }
                if (c4 == 0) { *(GAS f32x4*)(pd + 8 * g) = (f32x4){p[0], p[1], p[2], p[3]}; *(GAS f32x4*)(pd + 8 * g + 4) = (f32x4){p[4], p[5], p[6], p[7]}; }
#pragma unroll
                for (int k = 0; k < 8; ++k) rows[k] = rnx[k];
                idb[0] = idc[0]; idb[1] = idc[1];
            }
          }
        }
    }
}
__device__ __forceinline__ void peer_g2(Frame& F, const Args& A) {
    unsigned char* ws = A.ws;
    const int* EIDX = (const int*)(ws + WS_EIDX); float* EGATE = (float*)(ws + WS_EGATE); const float* PD = (const float*)(ws + WS_Z);
    const float* SU = (const float*)(ws + WS_SU); const float* SV = (const float*)(ws + WS_SV); const float* SH2 = (const float*)(ws + WS_SH2);
    const size_t gtid = (size_t)F.gw * 64 + F.lane, gthreads = (size_t)F.NGW * 64;
    for (size_t idx = gtid; idx < (size_t)T * 128; idx += gthreads) {
        float d = 0.f;
#pragma unroll
        for (int s = 0; s < 4; ++s) d += PD[(size_t)s * T * 128 + idx];
        const int eid = EIDX[idx];
        d *= SU[eid];
        const float act = 0.5f * d * (1.0f + erff(d * 0.70710678118654752f));
        EGATE[idx] = EGATE[idx] * act * SV[eid];
    }
}
__device__ __forceinline__ void peer_g3(Frame& F, const Args& A) {
    unsigned char* ws = A.ws;
    const unsigned char* V4 = ws + WS_V; const int* EIDX = (const int*)(ws + WS_EIDX); const float* W = (const float*)(ws + WS_EGATE); const float* ADA = (const float*)(ws + WS_ADA);
    unsigned* Q = (unsigned*)(ws + WS_CTL) + CW_Q3;
    const int lane = F.lane, tk = lane >> 3, c4 = lane & 7;
#ifdef G3_DUPLOAD
    const size_t zoff = (size_t)*((volatile unsigned*)(ws + WS_CTL) + 80);
#endif
    const int s0 = (int)(xb_xcc_id() & 3u);
    for (int so = 0; so < 4; ++so) {
        const int s = (s0 + so) & 3;
        for (;;) {
            const int item = next_item(F, Q + 64 * s);
            if (item >= T / 128) break;
          for (int sub = 0; sub < 2; ++sub) {
            const int n = item * 128 + F.wave * 16 + sub * 8 + tk;
            const unsigned char* vb = V4 + (size_t)s * (16384 * 128) + 16 * c4;
            f32x2v acc[16];
#pragma unroll
            for (int j = 0; j < 16; ++j) acc[j] = (f32x2v){0.f, 0.f};
            const int* ep = EIDX + (size_t)n * 128; const float* wp = W + (size_t)n * 128;
            v4u idb[2], idc[2], rows[8], rnx[8]; f32x4 wc[2], wb[2], wn[2];
            { const v4u i0 = *(const GAS v4u*)(ep), i1 = *(const GAS v4u*)(ep + 4); idb[0] = *(const GAS v4u*)(ep + 8); idb[1] = *(const GAS v4u*)(ep + 12);
              wc[0] = *(const GAS f32x4*)(wp); wc[1] = *(const GAS f32x4*)(wp + 4); wb[0] = *(const GAS f32x4*)(wp + 8); wb[1] = *(const GAS f32x4*)(wp + 12);
              const unsigned a0 = i0.x, a1 = i0.y, a2 = i0.z, a3 = i0.w, a4 = i1.x, a5 = i1.y, a6 = i1.z, a7 = i1.w;
              rows[0] = *(const GAS v4u*)(vb + (size_t)a0 * 128); rows[1] = *(const GAS v4u*)(vb + (size_t)a1 * 128); rows[2] = *(const GAS v4u*)(vb + (size_t)a2 * 128); rows[3] = *(const GAS v4u*)(vb + (size_t)a3 * 128);
              rows[4] = *(const GAS v4u*)(vb + (size_t)a4 * 128); rows[5] = *(const GAS v4u*)(vb + (size_t)a5 * 128); rows[6] = *(const GAS v4u*)(vb + (size_t)a6 * 128); rows[7] = *(const GAS v4u*)(vb + (size_t)a7 * 128); }
            for (int g = 0; g < 16; ++g) {
                if (g + 2 < 16) { idc[0] = *(const GAS v4u*)(ep + 8 * (g + 2)); idc[1] = *(const GAS v4u*)(ep + 8 * (g + 2) + 4); wn[0] = *(const GAS f32x4*)(wp + 8 * (g + 2)); wn[1] = *(const GAS f32x4*)(wp + 8 * (g + 2) + 4); }
                if (g + 1 < 16) {
                    const unsigned a0 = idb[0].x, a1 = idb[0].y, a2 = idb[0].z, a3 = idb[0].w, a4 = idb[1].x, a5 = idb[1].y, a6 = idb[1].z, a7 = idb[1].w;
                    rnx[0] = *(const GAS v4u*)(vb + (size_t)a0 * 128); rnx[1] = *(const GAS v4u*)(vb + (size_t)a1 * 128); rnx[2] = *(const GAS v4u*)(vb + (size_t)a2 * 128); rnx[3] = *(const GAS v4u*)(vb + (size_t)a3 * 128);
                    rnx[4] = *(const GAS v4u*)(vb + (size_t)a4 * 128); rnx[5] = *(const GAS v4u*)(vb + (size_t)a5 * 128); rnx[6] = *(const GAS v4u*)(vb + (size_t)a6 * 128); rnx[7] = *(const GAS v4u*)(vb + (size_t)a7 * 128);
                }
#ifdef G3_DUPLOAD
                v4u r2[8];
                if (g + 1 < 16) {
                    const unsigned a0 = idb[0].x, a1 = idb[0].y, a2 = idb[0].z, a3 = idb[0].w, a4 = idb[1].x, a5 = idb[1].y, a6 = idb[1].z, a7 = idb[1].w;
                    r2[0] = *(const GAS v4u*)(vb + zoff + (size_t)a0 * 128); r2[1] = *(const GAS v4u*)(vb + zoff + (size_t)a1 * 128); r2[2] = *(const GAS v4u*)(vb + zoff + (size_t)a2 * 128); r2[3] = *(const GAS v4u*)(vb + zoff + (size_t)a3 * 128);
                    r2[4] = *(const GAS v4u*)(vb + zoff + (size_t)a4 * 128); r2[5] = *(const GAS v4u*)(vb + zoff + (size_t)a5 * 128); r2[6] = *(const GAS v4u*)(vb + zoff + (size_t)a6 * 128); r2[7] = *(const GAS v4u*)(vb + zoff + (size_t)a7 * 128);
#pragma unroll
                    for (int k = 0; k < 8; ++k) { rnx[k].y = r2[k].y; rnx[k].w = r2[k].w; }
                }
#endif
#pragma unroll
                for (int k = 0; k < 8; ++k) {
                    const float wk = wc[k >> 2][k & 3]; const f32x2v w2 = (f32x2v){wk, wk};
                    const unsigned x0 = rows[k].x, x1 = rows[k].y, x2 = rows[k].z, x3 = rows[k].w;
                    acc[0] += w2 * __builtin_amdgcn_cvt_scalef32_pk_f32_fp4(x0, 1.0f, 0); acc[1] += w2 * __builtin_amdgcn_cvt_scalef32_pk_f32_fp4(x0, 1.0f, 1);
                    acc[2] += w2 * __builtin_amdgcn_cvt_scalef32_pk_f32_fp4(x0, 1.0f, 2); acc[3] += w2 * __builtin_amdgcn_cvt_scalef32_pk_f32_fp4(x0, 1.0f, 3);
                    acc[4] += w2 * __builtin_amdgcn_cvt_scalef32_pk_f32_fp4(x1, 1.0f, 0); acc[5] += w2 * __builtin_amdgcn_cvt_scalef32_pk_f32_fp4(x1, 1.0f, 1);
                    acc[6] += w2 * __builtin_amdgcn_cvt_scalef32_pk_f32_fp4(x1, 1.0f, 2); acc[7] += w2 * __builtin_amdgcn_cvt_scalef32_pk_f32_fp4(x1, 1.0f, 3);
                    acc[8] += w2 * __builtin_amdgcn_cvt_scalef32_pk_f32_fp4(x2, 1.0f, 0); acc[9] += w2 * __builtin_amdgcn_cvt_scalef32_pk_f32_fp4(x2, 1.0f, 1);
                    acc[10] += w2 * __builtin_amdgcn_cvt_scalef32_pk_f32_fp4(x2, 1.0f, 2); acc[11] += w2 * __builtin_amdgcn_cvt_scalef32_pk_f32_fp4(x2, 1.0f, 3);
                    acc[12] += w2 * __builtin_amdgcn_cvt_scalef32_pk_f32_fp4(x3, 1.0f, 0); acc[13] += w2 * __builtin_amdgcn_cvt_scalef32_pk_f32_fp4(x3, 1.0f, 1);
                    acc[14] += w2 * __builtin_amdgcn_cvt_scalef32_pk_f32_fp4(x3, 1.0f, 2); acc[15] += w2 * __builtin_amdgcn_cvt_scalef32_pk_f32_fp4(x3, 1.0f, 3);
                }
#pragma unroll
                for (int k = 0; k < 8; ++k) rows[k] = rnx[k];
                idb[0] = idc[0]; idb[1] = idc[1]; wc[0] = wb[0]; wc[1] = wb[1]; wb[0] = wn[0]; wb[1] = wn[1];
            }
            float* op = A.out + (size_t)n * 1024 + 256 * s + 32 * c4; const float* g2p = ADA + (n >> 11) * 6144 + 5 * 1024 + 256 * s + 32 * c4;
#pragma unroll
            for (int q4 = 0; q4 < 8; ++q4) {
                const f32x4 xv = *(const GAS f32x4*)(op + 4 * q4), gv = *(const GAS f32x4*)(g2p + 4 * q4);
                const f32x4 av = (f32x4){acc[2 * q4].x, acc[2 * q4].y, acc[2 * q4 + 1].x, acc[2 * q4 + 1].y};
                *(GAS f32x4*)(op + 4 * q4) = xv + gv * av;
            }
          }
        }
    }
}


__device__ __forceinline__ void peer_local(Frame& F, const Args& A, const XcdBarrier& xb) {
    unsigned char* ws = A.ws;
    const bf16* H2 = (const bf16*)(ws + WS_H); const unsigned char* U4 = ws + WS_U; const unsigned char* V4 = ws + WS_V;
    const int* EIDX = (const int*)(ws + WS_EIDX); const float* EGATE = (const float*)(ws + WS_EGATE); const float* ADA = (const float*)(ws + WS_ADA);
    const float* SU = (const float*)(ws + WS_SU); const float* SV = (const float*)(ws + WS_SV); const float* SH2 = (const float*)(ws + WS_SH2);
    const int lane = F.lane, tk = lane >> 3, c4 = lane & 7;
    const int tpw = T / F.NGW;
    LAS float* PDL = (LAS float*)F.lds + (size_t)F.wave * tpw * 128;
    const int nbase = F.gw * tpw;
    for (int i = lane; i < tpw * 128; i += 64) PDL[i] = 0.f;
    LDS_WAIT(); asm volatile("" ::: "memory");
    const unsigned char* HHI = ws + WS_H2HI; const unsigned char* HLO = ws + WS_H2LO;
    for (int s = 0; s < 4; ++s) {
#ifdef SLICE_BAR
        if (s) xcd_barrier(xb);
#endif
        const unsigned char* ub = U4 + (size_t)s * (16384 * 128) + 16 * c4;
        for (int sub = 0; sub < tpw; sub += 8) {
            const int n = nbase + sub + tk;
            const v4u hh = *(const GAS v4u*)(HHI + (size_t)n * 512 + 128 * s + 16 * c4), hl = *(const GAS v4u*)(HLO + (size_t)n * 512 + 128 * s + 16 * c4);
            const int h0 = (int)hh.x, h1 = (int)hh.y, h2_ = (int)hh.z, h3 = (int)hh.w, l0 = (int)hl.x, l1 = (int)hl.y, l2 = (int)hl.z, l3 = (int)hl.w;
            LAS float* pd = PDL + (sub + tk) * 128;
            const int* ep = EIDX + (size_t)n * 128;
            v4u idb[2], idc[2], rows[8], rnx[8];
#ifdef EIDX16
            const unsigned short* ep16 = (const unsigned short*)EIDX + (size_t)n * 128;
            { const v4u i0 = *(const GAS v4u*)(ep16); idb[0] = *(const GAS v4u*)(ep16 + 8); idb[1] = idb[0]; (void)ep;
              const unsigned a0 = i0.x & 0xFFFFu, a1 = i0.x >> 16, a2 = i0.y & 0xFFFFu, a3 = i0.y >> 16, a4 = i0.z & 0xFFFFu, a5 = i0.z >> 16, a6 = i0.w & 0xFFFFu, a7 = i0.w >> 16;
#else
            { const v4u i0 = *(const GAS v4u*)(ep), i1 = *(const GAS v4u*)(ep + 4); idb[0] = *(const GAS v4u*)(ep + 8); idb[1] = *(const GAS v4u*)(ep + 12);
              const unsigned a0 = i0.x, a1 = i0.y, a2 = i0.z, a3 = i0.w, a4 = i1.x, a5 = i1.y, a6 = i1.z, a7 = i1.w;
#endif
              rows[0] = *(const GAS v4u*)(ub + (size_t)a0 * 128); rows[1] = *(const GAS v4u*)(ub + (size_t)a1 * 128); rows[2] = *(const GAS v4u*)(ub + (size_t)a2 * 128); rows[3] = *(const GAS v4u*)(ub + (size_t)a3 * 128);
              rows[4] = *(const GAS v4u*)(ub + (size_t)a4 * 128); rows[5] = *(const GAS v4u*)(ub + (size_t)a5 * 128); rows[6] = *(const GAS v4u*)(ub + (size_t)a6 * 128); rows[7] = *(const GAS v4u*)(ub + (size_t)a7 * 128); }
            for (int g = 0; g < 16; ++g) {
#ifdef EIDX16
                if (g + 2 < 16) { idc[0] = *(const GAS v4u*)(ep16 + 8 * (g + 2)); idc[1] = idc[0]; }
                if (g + 1 < 16) {
                    const unsigned a0 = idb[0].x & 0xFFFFu, a1 = idb[0].x >> 16, a2 = idb[0].y & 0xFFFFu, a3 = idb[0].y >> 16, a4 = idb[0].z & 0xFFFFu, a5 = idb[0].z >> 16, a6 = idb[0].w & 0xFFFFu, a7 = idb[0].w >> 16;
#else
                if (g + 2 < 16) { idc[0] = *(const GAS v4u*)(ep + 8 * (g + 2)); idc[1] = *(const GAS v4u*)(ep + 8 * (g + 2) + 4); }
                if (g + 1 < 16) {
                    const unsigned a0 = idb[0].x, a1 = idb[0].y, a2 = idb[0].z, a3 = idb[0].w, a4 = idb[1].x, a5 = idb[1].y, a6 = idb[1].z, a7 = idb[1].w;
#endif
                    rnx[0] = *(const GAS v4u*)(ub + (size_t)a0 * 128); rnx[1] = *(const GAS v4u*)(ub + (size_t)a1 * 128); rnx[2] = *(const GAS v4u*)(ub + (size_t)a2 * 128); rnx[3] = *(const GAS v4u*)(ub + (size_t)a3 * 128);
                    rnx[4] = *(const GAS v4u*)(ub + (size_t)a4 * 128); rnx[5] = *(const GAS v4u*)(ub + (size_t)a5 * 128); rnx[6] = *(const GAS v4u*)(ub + (size_t)a6 * 128); rnx[7] = *(const GAS v4u*)(ub + (size_t)a7 * 128);
                }
                float p[8];
#pragma unroll
                for (int k = 0; k < 8; ++k) {
                    const int x0 = (int)rows[k].x, x1 = (int)rows[k].y, x2 = (int)rows[k].z, x3 = (int)rows[k].w;
                    const int ah = __builtin_amdgcn_sdot8(x3, h3, __builtin_amdgcn_sdot8(x2, h2_, __builtin_amdgcn_sdot8(x1, h1, __builtin_amdgcn_sdot8(x0, h0, 0, false), false), false), false);
                    const int al = __builtin_amdgcn_sdot8(x3, l3, __builtin_amdgcn_sdot8(x2, l2, __builtin_amdgcn_sdot8(x1, l1, __builtin_amdgcn_sdot8(x0, l0, 0, false), false), false), false);
                    int t = 16 * ah + al;
                    t += __builtin_amdgcn_update_dpp(0, t, 0xB1, 0xF, 0xF, true); t += __builtin_amdgcn_update_dpp(0, t, 0x4E, 0xF, 0xF, true); t += __shfl_xor(t, 4);
                    p[k] = (float)t;
                }
                if (c4 == 0) {
                    const f32x4 o0 = *(const LAS f32x4*)(pd + 8 * g), o1 = *(const LAS f32x4*)(pd + 8 * g + 4);
                    *(LAS f32x4*)(pd + 8 * g) = o0 + (f32x4){p[0], p[1], p[2], p[3]}; *(LAS f32x4*)(pd + 8 * g + 4) = o1 + (f32x4){p[4], p[5], p[6], p[7]};
                }
#pragma unroll
                for (int k = 0; k < 8; ++k) rows[k] = rnx[k];
                idb[0] = idc[0]; idb[1] = idc[1];
            }
        }
    }
    LDS_WAIT(); asm volatile("" ::: "memory");
    for (int i = lane; i < tpw * 128; i += 64) {
        const size_t gi = (size_t)nbase * 128 + i;
#ifdef EIDX16
        const int eid = ((const unsigned short*)EIDX)[gi];
#else
        const int eid = EIDX[gi];
#endif
        const float d = PDL[i] * SU[eid] * SH2[nbase + (i >> 7)];
        const float act = 0.5f * d * (1.0f + erff(d * 0.70710678118654752f));
        PDL[i] = EGATE[gi] * act * SV[eid];
    }
    LDS_WAIT(); asm volatile("" ::: "memory");
    for (int s = 0; s < 4; ++s) {
#ifdef SLICE_BAR
        xcd_barrier(xb);
#endif
        const unsigned char* vb = V4 + (size_t)s * (16384 * 128) + 16 * c4;
        for (int sub = 0; sub < tpw; sub += 8) {
            const int n = nbase + sub + tk;
            const LAS float* wl = PDL + (sub + tk) * 128;
            f32x2v acc[16];
#pragma unroll
            for (int j = 0; j < 16; ++j) acc[j] = (f32x2v){0.f, 0.f};
#ifdef P12_PREF
            f32x4 xpre[8];
            { const float* op0 = A.out + (size_t)n * 1024 + 256 * s + 32 * c4;
#pragma unroll
              for (int q4 = 0; q4 < 8; ++q4) xpre[q4] = *(const GAS f32x4*)(op0 + 4 * q4); }
#endif
            const int* ep = EIDX + (size_t)n * 128;
            v4u idb[2], idc[2], rows[8], rnx[8];
#ifdef EIDX16
            const unsigned short* ep16 = (const unsigned short*)EIDX + (size_t)n * 128;
            { const v4u i0 = *(const GAS v4u*)(ep16); idb[0] = *(const GAS v4u*)(ep16 + 8); idb[1] = idb[0]; (void)ep;
              const unsigned a0 = i0.x & 0xFFFFu, a1 = i0.x >> 16, a2 = i0.y & 0xFFFFu, a3 = i0.y >> 16, a4 = i0.z & 0xFFFFu, a5 = i0.z >> 16, a6 = i0.w & 0xFFFFu, a7 = i0.w >> 16;
#else
            { const v4u i0 = *(const GAS v4u*)(ep), i1 = *(const GAS v4u*)(ep + 4); idb[0] = *(const GAS v4u*)(ep + 8); idb[1] = *(const GAS v4u*)(ep + 12);
              const unsigned a0 = i0.x, a1 = i0.y, a2 = i0.z, a3 = i0.w, a4 = i1.x, a5 = i1.y, a6 = i1.z, a7 = i1.w;
#endif
              rows[0] = *(const GAS v4u*)(vb + (size_t)a0 * 128); rows[1] = *(const GAS v4u*)(vb + (size_t)a1 * 128); rows[2] = *(const GAS v4u*)(vb + (size_t)a2 * 128); rows[3] = *(const GAS v4u*)(vb + (size_t)a3 * 128);
              rows[4] = *(const GAS v4u*)(vb + (size_t)a4 * 128); rows[5] = *(const GAS v4u*)(vb + (size_t)a5 * 128); rows[6] = *(const GAS v4u*)(vb + (size_t)a6 * 128); rows[7] = *(const GAS v4u*)(vb + (size_t)a7 * 128); }
            for (int g = 0; g < 16; ++g) {
#ifdef EIDX16
                if (g + 2 < 16) { idc[0] = *(const GAS v4u*)(ep16 + 8 * (g + 2)); idc[1] = idc[0]; }
                if (g + 1 < 16) {
                    const unsigned a0 = idb[0].x & 0xFFFFu, a1 = idb[0].x >> 16, a2 = idb[0].y & 0xFFFFu, a3 = idb[0].y >> 16, a4 = idb[0].z & 0xFFFFu, a5 = idb[0].z >> 16, a6 = idb[0].w & 0xFFFFu, a7 = idb[0].w >> 16;
#else
                if (g + 2 < 16) { idc[0] = *(const GAS v4u*)(ep + 8 * (g + 2)); idc[1] = *(const GAS v4u*)(ep + 8 * (g + 2) + 4); }
                if (g + 1 < 16) {
                    const unsigned a0 = idb[0].x, a1 = idb[0].y, a2 = idb[0].z, a3 = idb[0].w, a4 = idb[1].x, a5 = idb[1].y, a6 = idb[1].z, a7 = idb[1].w;
#endif
                    rnx[0] = *(const GAS v4u*)(vb + (size_t)a0 * 128); rnx[1] = *(const GAS v4u*)(vb + (size_t)a1 * 128); rnx[2] = *(const GAS v4u*)(vb + (size_t)a2 * 128); rnx[3] = *(const GAS v4u*)(vb + (size_t)a3 * 128);
                    rnx[4] = *(const GAS v4u*)(vb + (size_t)a4 * 128); rnx[5] = *(const GAS v4u*)(vb + (size_t)a5 * 128); rnx[6] = *(const GAS v4u*)(vb + (size_t)a6 * 128); rnx[7] = *(const GAS v4u*)(vb + (size_t)a7 * 128);
                }
                const f32x4 w0 = *(const LAS f32x4*)(wl + 8 * g), w1 = *(const LAS f32x4*)(wl + 8 * g + 4);
#pragma unroll
                for (int k = 0; k < 8; ++k) {
                    const float wk = (k < 4) ? w0[k & 3] : w1[k & 3]; const f32x2v w2 = (f32x2v){wk, wk};
                    const unsigned x0 = rows[k].x, x1 = rows[k].y, x2 = rows[k].z, x3 = rows[k].w;
                    acc[0] += w2 * __builtin_amdgcn_cvt_scalef32_pk_f32_fp4(x0, 1.0f, 0); acc[1] += w2 * __builtin_amdgcn_cvt_scalef32_pk_f32_fp4(x0, 1.0f, 1);
                    acc[2] += w2 * __builtin_amdgcn_cvt_scalef32_pk_f32_fp4(x0, 1.0f, 2); acc[3] += w2 * __builtin_amdgcn_cvt_scalef32_pk_f32_fp4(x0, 1.0f, 3);
                    acc[4] += w2 * __builtin_amdgcn_cvt_scalef32_pk_f32_fp4(x1, 1.0f, 0); acc[5] += w2 * __builtin_amdgcn_cvt_scalef32_pk_f32_fp4(x1, 1.0f, 1);
                    acc[6] += w2 * __builtin_amdgcn_cvt_scalef32_pk_f32_fp4(x1, 1.0f, 2); acc[7] += w2 * __builtin_amdgcn_cvt_scalef32_pk_f32_fp4(x1, 1.0f, 3);
                    acc[8] += w2 * __builtin_amdgcn_cvt_scalef32_pk_f32_fp4(x2, 1.0f, 0); acc[9] += w2 * __builtin_amdgcn_cvt_scalef32_pk_f32_fp4(x2, 1.0f, 1);
                    acc[10] += w2 * __builtin_amdgcn_cvt_scalef32_pk_f32_fp4(x2, 1.0f, 2); acc[11] += w2 * __builtin_amdgcn_cvt_scalef32_pk_f32_fp4(x2, 1.0f, 3);
                    acc[12] += w2 * __builtin_amdgcn_cvt_scalef32_pk_f32_fp4(x3, 1.0f, 0); acc[13] += w2 * __builtin_amdgcn_cvt_scalef32_pk_f32_fp4(x3, 1.0f, 1);
                    acc[14] += w2 * __builtin_amdgcn_cvt_scalef32_pk_f32_fp4(x3, 1.0f, 2); acc[15] += w2 * __builtin_amdgcn_cvt_scalef32_pk_f32_fp4(x3, 1.0f, 3);
                }
#pragma unroll
                for (int k = 0; k < 8; ++k) rows[k] = rnx[k];
                idb[0] = idc[0]; idb[1] = idc[1];
            }
            float* op = A.out + (size_t)n * 1024 + 256 * s + 32 * c4; const float* g2p = ADA + (n >> 11) * 6144 + 5 * 1024 + 256 * s + 32 * c4;
#pragma unroll
            for (int q4 = 0; q4 < 8; ++q4) {
#if defined(X1_BF16)
#ifdef P12_NT
                const f32x4 gv = *(const GAS f32x4*)(g2p + 4 * q4); const v2u a_ = __builtin_nontemporal_load((const GAS v2u*)((const bf16*)(ws + WS_X1) + (size_t)n * 1024 + 256 * s + 32 * c4 + 4 * q4));
#else
                const f32x4 gv = *(const GAS f32x4*)(g2p + 4 * q4); const v2u a_ = *(const GAS v2u*)((const bf16*)(ws + WS_X1) + (size_t)n * 1024 + 256 * s + 32 * c4 + 4 * q4);
#endif
                const f32x4 xv = (f32x4){__uint_as_float(a_.x << 16), __uint_as_float(a_.x & 0xffff0000u), __uint_as_float(a_.y << 16), __uint_as_float(a_.y & 0xffff0000u)};
#elif defined(P12_PREF)
                const f32x4 xv = xpre[q4], gv = *(const GAS f32x4*)(g2p + 4 * q4);
#else
                const f32x4 xv = *(const GAS f32x4*)(op + 4 * q4), gv = *(const GAS f32x4*)(g2p + 4 * q4);
#endif
                const f32x4 av = (f32x4){acc[2 * q4].x, acc[2 * q4].y, acc[2 * q4 + 1].x, acc[2 * q4 + 1].y};
#ifdef P12_NT
                __builtin_nontemporal_store(xv + gv * av, (GAS f32x4*)(op + 4 * q4));
#else
                *(GAS f32x4*)(op + 4 * q4) = xv + gv * av;
#endif
            }
        }
    }
}

__device__ __forceinline__ void dbg_peer_check1(Frame& F, const Args& A) {
    if (blockIdx.x != 0) return;
    unsigned char* ws = A.ws;
    const bf16* H2 = (const bf16*)(ws + WS_H); const bf16* PQ = (const bf16*)(ws + WS_PQ); const bf16* SK = (const bf16*)(ws + WS_SK);
    const int* EIDX = (const int*)(ws + WS_EIDX); const float* EGATE = (const float*)(ws + WS_EGATE); float* DBG = (float*)(ws + 48 * MiB);
    unsigned* flag = (unsigned*)(ws + WS_CTL) + 64;
    const int t = F.tid;
    const int r = (int)(((long long)t * 2579 + 17) % T), c = (t * 131 + 5) % 1024;
    unsigned f = 0u;
    { float acc = 0.f; for (int k = 0; k < 1024; ++k) acc += bf2f(H2[(size_t)r * 1024 + k]) * A.w_pq[(size_t)k * 1024 + c];
      const float got = bf2f(PQ[(size_t)r * 1024 + c]); if (fabsf(got - acc) > 0.02f * fabsf(acc) + 0.02f) f |= 1u; }
    { const int h = t & 7; float s[2][128];
      float* sc = DBG + 4096 + (size_t)t * 256;
      for (int p = 0; p < 2; ++p) for (int k = 0; k < 128; ++k) { float acc = 0.f; for (int d = 0; d < 64; ++d) acc += bf2f(PQ[(size_t)r * 1024 + h * 128 + p * 64 + d]) * bf2f(SK[((size_t)(h * 2 + p) * 128 + k) * 64 + d]); sc[p * 128 + k] = acc; }
      (void)s;
      float t0v[16], t1v[16];
      for (int p = 0; p < 2; ++p) { float last = 3.0e38f; int lasti = -1; for (int i = 0; i < 16; ++i) { float best = -3.0e38f; int bi = -1; for (int k = 0; k < 128; ++k) { const float v = sc[p * 128 + k]; if ((v < last || (v == last && k > lasti)) && v > best) { best = v; bi = k; } } last = best; lasti = bi; if (p == 0) t0v[i] = best; else t1v[i] = best; } }
      float last = 3.0e38f; int cnt_ge = 0; float kth = 0.f;
      for (int it = 0; it < 16; ++it) { float best = -3.0e38f; for (int i = 0; i < 16; ++i) for (int j = 0; j < 16; ++j) { const float v = t0v[i] + t1v[j]; if (v < last && v > best) best = v; } last = best; kth = best; }
      (void)cnt_ge;
      float gs = 0.f; int badn = 0;
      for (int i = 0; i < 16; ++i) { const int e = EIDX[(size_t)r * 128 + h * 16 + i]; const float g = EGATE[(size_t)r * 128 + h * 16 + i]; gs += g;
          if (e < 0 || e >= 16384) { badn += 100; continue; }
          const float sm = sc[e >> 7] + sc[128 + (e & 127)]; if (sm < kth - 0.02f * fabsf(kth) - 0.02f) ++badn; }
      if (badn > 1) f |= 2u;
      if (fabsf(gs - 1.0f) > 0.01f) f |= 4u; }
    { float acc = 0.f;
      for (int e = 0; e < 128; ++e) { const int id = EIDX[(size_t)r * 128 + e]; const float g = EGATE[(size_t)r * 128 + e]; if (id < 0 || id >= 16384) continue;
          float d = 0.f; for (int k = 0; k < 1024; ++k) d += bf2f(H2[(size_t)r * 1024 + k]) * A.pu[(size_t)id * 1024 + k];
          const float act = 0.5f * d * (1.0f + erff(d * 0.70710678f)); acc += g * act * A.pv[(size_t)id * 1024 + c]; }
      DBG[t] = acc; DBG[512 + t] = A.out[(size_t)r * 1024 + c]; }
    if (f) atomicOr(flag, f);
}
__device__ __forceinline__ void dbg_peer_check2(Frame& F, const Args& A) {
    if (blockIdx.x != 0) return;
    unsigned char* ws = A.ws; const float* DBG = (const float*)(ws + 48 * MiB); const float* ADA = (const float*)(ws + WS_ADA);
    unsigned* flag = (unsigned*)(ws + WS_CTL) + 64;
    const int t = F.tid;
    const int r = (int)(((long long)t * 2579 + 17) % T), c = (t * 131 + 5) % 1024;
    const float e = DBG[512 + t] + ADA[(r >> 11) * 6144 + 5120 + c] * DBG[t], got = A.out[(size_t)r * 1024 + c];
    if (fabsf(got - e) > 0.03f * fabsf(DBG[t]) + 0.02f) atomicOr(flag, 8u);
}

__device__ __forceinline__ Args fresh_args() {
    const __attribute__((address_space(4))) Args* p = (const __attribute__((address_space(4))) Args*)__builtin_amdgcn_kernarg_segment_ptr();
    asm volatile("" : "+s"(p));
    return *(const Args*)p;
}
__global__ void __launch_bounds__(NTHR, 2) fwd_megakernel(Args args_byval) {
    extern __shared__ __attribute__((aligned(16))) unsigned char lds_raw[];
#define MAKE_FRAME() Frame F; F.lds = (LAS unsigned char*)lds_raw; F.tid = opaque_tid(); F.lane = F.tid & 63; F.wave = __builtin_amdgcn_readfirstlane(F.tid >> 6); \
    F.G = gridDim.x; { const int bx_ = blockIdx.x; F.vcu = (F.G % 8 == 0) ? (bx_ % 8) * (F.G / 8) + bx_ / 8 : bx_; } F.gw = F.vcu * NWAVES + F.wave; F.NGW = F.G * NWAVES;
    LAS unsigned char* const lds0 = (LAS unsigned char*)lds_raw;
    for (int u = threadIdx.x; u < (LDS_BYTES - LDSCTL_OFF) / 4; u += NTHR) ((LAS unsigned*)(lds0 + LDSCTL_OFF))[u] = 0u;
    __syncthreads();
    XcdBarrier bar = xcd_barrier_post((unsigned*)(fresh_args().ws + WS_CTL) + CW_BAR, (volatile LAS unsigned*)(lds0 + MISC_OFF) + 8);
#define GRID_BAR() xcd_barrier(bar)
    const int bx = (int)blockIdx.x;

    using pg8::Gemm; using pg8::StaticOrder; using pg8::EpiB; using pg8::EpiRes; using pg8::EpiX1; using pg8::EpiGate8; using pg8::EpiZ8;
#ifndef REP_P0
#define REP_P0 1
#endif
    for (int rep_ = 0; rep_ < REP_P0; ++rep_) {

#ifndef NO_PH_P0
    { const Args args = fresh_args(); MAKE_FRAME(); p0_prologue(F, args); }
#endif
    GRID_BAR();
    }

#ifndef REP_P1
#define REP_P1 1
#endif
    for (int rep_ = 0; rep_ < REP_P1; ++rep_) {

#ifndef NO_PH_NORM
#if defined(Z_I8)
    { const Args args = fresh_args(); MAKE_FRAME(); norm_rows(F, args.x, args.g1, ((const float*)(args.ws + WS_ADA)), 0, 1024, nullptr, nullptr, nullptr, nullptr, args.ws + WS_H8, (float*)(args.ws + WS_S1));
      quant_gate_weights(F, args.ws); }
#elif defined(GATE_I8)
    { const Args args = fresh_args(); MAKE_FRAME(); norm_rows(F, args.x, args.g1, ((const float*)(args.ws + WS_ADA)), 0, 1024, ((bf16*)(args.ws + WS_H)), nullptr, nullptr, nullptr, args.ws + WS_H8, (float*)(args.ws + WS_S1));
      quant_gate_weights(F, args.ws); }
#else
    { const Args args = fresh_args(); MAKE_FRAME(); norm_rows(F, args.x, args.g1, ((const float*)(args.ws + WS_ADA)), 0, 1024, ((bf16*)(args.ws + WS_H)), nullptr, nullptr); }
#endif
#endif
    GRID_BAR();
    }

#ifdef EXTRA_BARS
    for (int xb_ = 0; xb_ < EXTRA_BARS; ++xb_) GRID_BAR();
#endif
#ifndef REP_P2
#define REP_P2 1
#endif
    for (int rep_ = 0; rep_ < REP_P2; ++rep_) {
#ifndef NO_PH_GEMM
#if defined(Z_I8)
    { const Args args = fresh_args(); MAKE_FRAME(); Gemm g{((bf16*)(args.ws + WS_H8)), ((bf16*)(args.ws + WS_WG8)), T, ZW, 512}; StaticOrder S; S.init(T, ZW, F.G, bx); EpiZ8 E{args.ws + WS_Z, ZW * 2, (const float*)(args.ws + WS_S1), (const float*)(args.ws + WS_CS8)};
      pg8::gemm_phase<EpiZ8, StaticOrder, false, true, true>(F.lds, g, S, E); }
#elif defined(GATE_I8)
    { const Args args = fresh_args(); MAKE_FRAME(); Gemm g{((bf16*)(args.ws + WS_H)), ((bf16*)(args.ws + WS_WIN)), T, 1536, 1024}; StaticOrder S; S.init(T, 1536, F.G, bx); EpiB<0> E{((bf16*)(args.ws + WS_Z)), ZW, 6, nullptr, nullptr, 0, 0, 4};
      pg8::gemm_phase<EpiB<0>, StaticOrder, false, true>(F.lds, g, S, E); }
    { const Args args = fresh_args(); MAKE_FRAME(); Gemm g{((bf16*)(args.ws + WS_H8)), ((bf16*)(args.ws + WS_WG8)), T, 2048, 512}; StaticOrder S; S.init(T, 2048, F.G, bx); EpiGate8 E{args.ws + WS_Z, ZW * 2, (const float*)(args.ws + WS_S1), (const float*)(args.ws + WS_CS8)};
      pg8::gemm_phase<EpiGate8, StaticOrder, false, true, true>(F.lds, g, S, E); }
#else
    { const Args args = fresh_args(); MAKE_FRAME(); Gemm g{((bf16*)(args.ws + WS_H)), ((bf16*)(args.ws + WS_WIN)), T, ZW, 1024}; StaticOrder S; S.init(T, ZW, F.G, bx); EpiB<0> E{((bf16*)(args.ws + WS_Z)), ZW, 6, nullptr, nullptr, 0, 0, 4};
      pg8::gemm_phase<EpiB<0>, StaticOrder, false, true>(F.lds, g, S, E); }
#endif
#endif
    GRID_BAR();
    }


#ifndef NO_PH_P3
    { const Args args = fresh_args(); MAKE_FRAME();
#ifdef PRIO_P3
      if (F.wave >> 2) __builtin_amdgcn_s_setprio(2);
#endif
      p3_fixup(F, args);
#ifdef PRIO_P3
      __builtin_amdgcn_s_setprio(0);
#endif
     }
#endif
    GRID_BAR();
#ifndef NO_PH_GEMM
    { const Args args = fresh_args(); MAKE_FRAME(); Gemm g{((bf16*)(args.ws + WS_POOLED)), ((bf16*)(args.ws + WS_WUP)), T, 1024, 512}; StaticOrder S; S.init(T, 1024, F.G, bx);
#ifdef P5_NOGATE
      EpiB<0> E{((bf16*)(args.ws + WS_MIN)), 1024, 1000, nullptr, nullptr, 0, 0};
      pg8::gemm_phase<EpiB<0>, StaticOrder, false, true>(F.lds, g, S, E); }
#else
      EpiB<2> E{((bf16*)(args.ws + WS_MIN)), 1024, 0, nullptr, ((bf16*)(args.ws + WS_Z)), ZW, ZC_GP};
      pg8::gemm_phase<EpiB<2>, StaticOrder, true, true>(F.lds, g, S, E); }
#endif
#endif
#ifdef DBG_POOL
    GRID_BAR();
    { const Args args = fresh_args(); MAKE_FRAME(); dbg_pool_check(F, args); }
#endif
#ifdef P5P6_BAR
    GRID_BAR();
#endif
#ifndef REP_DSA
#define REP_DSA 1
#endif
    for (int rep_ = 0; rep_ < REP_DSA; ++rep_) {

#ifndef NO_PH_DSA
    { const Args args = fresh_args(); MAKE_FRAME();
#ifndef NO_PRIO_DSA
      if (F.wave >> 2) __builtin_amdgcn_s_setprio(2);
#endif
      dsa_phase(F, args);
#ifndef NO_PRIO_DSA
      __builtin_amdgcn_s_setprio(0);
#endif
     }
#endif
    GRID_BAR();
    }

#if !defined(NO_PH_GEMM) && !defined(NO_P7)
    { const Args args = fresh_args(); MAKE_FRAME(); Gemm g{((bf16*)(args.ws + WS_ATT)), ((bf16*)(args.ws + WS_WUA)), T, 1024, 512}; StaticOrder S; S.init(T, 1024, F.G, bx); EpiB<3> E{((bf16*)(args.ws + WS_MIN)), 1024, 0, nullptr, ((bf16*)(args.ws + WS_Z)), ZW, ZC_GA};
      pg8::gemm_phase<EpiB<3>, StaticOrder, true, true>(F.lds, g, S, E); }
#endif
    GRID_BAR();
#ifdef DBG_POOL
    { const Args args = fresh_args(); MAKE_FRAME(); dbg_min_check(F, args); }
    GRID_BAR();
#endif
#ifndef REP_P8
#define REP_P8 1
#endif
    for (int rep_ = 0; rep_ < REP_P8; ++rep_) {
#ifndef NO_PH_GEMM
    { const Args args = fresh_args(); MAKE_FRAME(); Gemm g{((bf16*)(args.ws + WS_MIN)), ((bf16*)(args.ws + WS_WOUT)), T, 1024, 1024}; StaticOrder S; S.init(T, 1024, F.G, bx);
#ifdef X1_BF16
      EpiX1 E{args.x, ((bf16*)(args.ws + WS_X1)), ((const float*)(args.ws + WS_ADA)) + 2048};
      pg8::gemm_phase<EpiX1, StaticOrder, true, true>(F.lds, g, S, E); }
#else
      EpiRes E{args.x, args.out, ((const float*)(args.ws + WS_ADA)) + 2048};
      pg8::gemm_phase<EpiRes, StaticOrder, true, true>(F.lds, g, S, E); }
#endif
#endif
    GRID_BAR();
    }

#ifndef REP_P9
#define REP_P9 1
#endif
    for (int rep_ = 0; rep_ < REP_P9; ++rep_) {

#ifndef NO_PH_NORM
    { const Args args = fresh_args(); MAKE_FRAME();
#ifdef X1_BF16
      norm_rows(F, nullptr, args.g2, ((const float*)(args.ws + WS_ADA)), 3072, 4096, ((bf16*)(args.ws + WS_H)), args.ws + WS_H2HI, (float*)(args.ws + WS_SH2), (const bf16*)(args.ws + WS_X1)); }
#else
      norm_rows(F, args.out, args.g2, ((const float*)(args.ws + WS_ADA)), 3072, 4096, ((bf16*)(args.ws + WS_H)), args.ws + WS_H2HI, (float*)(args.ws + WS_SH2)); }
#endif
#endif
    GRID_BAR();
    }

#ifndef REP_P10
#define REP_P10 1
#endif
    for (int rep_ = 0; rep_ < REP_P10; ++rep_) {
#ifndef NO_PH_GEMM
    { const Args args = fresh_args(); MAKE_FRAME(); Gemm g{((bf16*)(args.ws + WS_H)), ((bf16*)(args.ws + WS_WPQ)), T, 1024, 1024}; StaticOrder S; S.init(T, 1024, F.G, bx); EpiB<0> E{((bf16*)(args.ws + WS_PQ)), 1024, 1000, nullptr, nullptr, 0, 0};
      pg8::gemm_phase<EpiB<0>, StaticOrder, false, true>(F.lds, g, S, E); }
#endif
    GRID_BAR();
    }

#ifndef REP_P11
#define REP_P11 1
#endif
    for (int rep_ = 0; rep_ < REP_P11; ++rep_) {

#ifndef NO_PH_ROUTE
    { const Args args = fresh_args(); MAKE_FRAME();
#ifdef PRIO_ROUTE
      if (F.wave >> 2) __builtin_amdgcn_s_setprio(2);
#endif
      peer_route(F, args);
#ifdef PRIO_ROUTE
      __builtin_amdgcn_s_setprio(0);
#endif
     }
#endif
#ifdef PEER_QUEUED
    GRID_BAR();
#else
    VM_WAIT();
    __builtin_amdgcn_fence(__ATOMIC_ACQUIRE, "agent"); VM_WAIT();
    __syncthreads();
#endif
#ifdef DBG_PEER
    { const Args args = fresh_args(); MAKE_FRAME(); dbg_peer_check1(F, args); }
    GRID_BAR();
#endif
    }

#ifndef REP_GATHER
#define REP_GATHER 1
#endif
    for (int rep_ = 1; rep_ < REP_GATHER; ++rep_) { { const Args args = fresh_args(); MAKE_FRAME(); peer_gather(F, args, true); } GRID_BAR(); }

#ifdef OLD_GATHER
    { const Args args = fresh_args(); MAKE_FRAME(); peer_gather(F, args, false); }
#else
#ifdef PEER_QUEUED
    { const Args args = fresh_args(); MAKE_FRAME(); peer_g1(F, args); } GRID_BAR();
    { const Args args = fresh_args(); MAKE_FRAME(); peer_g2(F, args); } GRID_BAR();
    { const Args args = fresh_args(); MAKE_FRAME(); peer_g3(F, args); }
#else
    { const Args args = fresh_args(); MAKE_FRAME();
#ifdef PRIO_LOCAL
      if (F.wave >> 2) __builtin_amdgcn_s_setprio(2);
#endif
      peer_local(F, args, bar);
#ifdef PRIO_LOCAL
      __builtin_amdgcn_s_setprio(0);
#endif
     }
#endif
#endif

#ifdef DBG_PEER
    GRID_BAR();
    { const Args args = fresh_args(); MAKE_FRAME(); dbg_peer_check2(F, args); }
#endif
#if defined(DBG_POOL) || defined(DBG_PEER) || defined(DBG_SEL)
    GRID_BAR();
    { const Args args = fresh_args(); dbg_report(args); }
#endif
#ifdef DBG_FP4
    GRID_BAR();
    if (blockIdx.x == 0 && threadIdx.x == 0) {
        const Args args = fresh_args();
        volatile unsigned* src = (volatile unsigned*)(args.ws + WS_CTL) + 80;
        const unsigned x = 0x00007521u + *src; const float one = 1.0f + (float)*src, three = 3.0f + (float)*src;
        typedef float f32x2q __attribute__((ext_vector_type(2)));
        const f32x2q f0 = __builtin_amdgcn_cvt_scalef32_pk_f32_fp4(x, one, 0), f1 = __builtin_amdgcn_cvt_scalef32_pk_f32_fp4(x, one, 1), f3 = __builtin_amdgcn_cvt_scalef32_pk_f32_fp4(x, three, 0);
        const unsigned b0 = __builtin_bit_cast(unsigned, __builtin_amdgcn_cvt_scalef32_pk_bf16_fp4(x, one, 0));
        const bool A = (f0.x == 0.5f && f0.y == 1.0f && f1.x == 3.0f && f1.y == 6.0f && b0 == 0x3F803F00u);
        const bool Bf = (f3.x == 1.5f && f3.y == 3.0f), Cf = (f3.x == 1.0f && f3.y == 2.0f);
        const int code = (A ? 1 : 0) + (Bf ? 2 : 0) + (Cf ? 4 : 0);
        args.out[0] += 1000.0f * (float)(1 + code);
    }
#endif
#ifndef DBG_SCALE
#define DBG_SCALE 1000.0f
#endif
#ifdef DBG_MFMA8
    GRID_BAR();
    {
        const Args args = fresh_args();
        volatile unsigned* src = (volatile unsigned*)(args.ws + WS_CTL) + 80;
        const int z = (int)*src;
        const int lane_ = threadIdx.x & 63;
        typedef int v8i_ __attribute__((ext_vector_type(8)));
        v8i_ a = (v8i_){0x22222222 + z, 0x22222222, 0x22222222, 0x22222222, 0, 0, 0, 0};
        v8i_ bb = (v8i_){0x38383838 + z, 0x38383838, 0x38383838, 0x38383838, 0x38383838, 0x38383838, 0x38383838, 0x38383838};
#if DBG_MFMA8 == 2
        a = (v8i_){(lane_ < 32) ? (0x00200000 + z) : z, 0, 0, 0, 0, 0, 0, 0};
        { const unsigned sgn = (lane_ >= 32) ? 0x80808080u : 0u;
          const unsigned w0 = 0x48444038u | sgn, w1 = 0x504E4C4Au | sgn, w2 = 0x54535251u | sgn, w3 = 0x58575655u | sgn;
          bb = (v8i_){(int)w0 + z, (int)w1, (int)w2, (int)w3, (int)w0, (int)w1, (int)w2, (int)w3}; }
#endif
        f32x16 c;
#pragma unroll
        for (int i = 0; i < 16; ++i) c[i] = 0.f;
#if DBG_MFMA8 == 3
        a = bb;
        c = __builtin_amdgcn_mfma_scale_f32_32x32x64_f8f6f4(a, bb, c, 0, 0, 0, 127 + z, 0, 127 + z);
#else
        c = __builtin_amdgcn_mfma_scale_f32_32x32x64_f8f6f4(a, bb, c, 4, 0, 0, 127 + z, 0, 127 + z);
#endif
        if (blockIdx.x == 0 && threadIdx.x == 0) { const float v = c[0]; float code = (v != v) ? 2.0f : (fabsf(v) > 1.0e6f) ? 3.0f : (fminf(fmaxf(v, -28.0f), 100.0f) * 0.25f + 12.0f); args.out[0] += DBG_SCALE * code; }
    }
#endif
#ifdef DBG_MFMA16
    GRID_BAR();
    {
        const Args args = fresh_args();
        volatile unsigned* src = (volatile unsigned*)(args.ws + WS_CTL) + 80;
        const int z = (int)*src;
        const int lane_ = threadIdx.x & 63, q_ = lane_ >> 4;
        typedef int v8i_ __attribute__((ext_vector_type(8)));
        constexpr int PQ = DBG_MFMA16 / 100, PJ = DBG_MFMA16 % 100;
        unsigned aw[4] = {0u, 0u, 0u, 0u};
        if (q_ == PQ) aw[PJ >> 3] = 2u << (4 * (PJ & 7));
        v8i_ a = (v8i_){(int)aw[0] + z, (int)aw[1], (int)aw[2], (int)aw[3], 0, 0, 0, 0};
        const unsigned sgn = (q_ >= 2) ? 0x80808080u : 0u;
        const unsigned lo0 = 0x48444038u, lo1 = 0x504E4C4Au, hi0 = 0x54535251u, hi1 = 0x58575655u;
        const unsigned w0 = ((q_ & 1) ? hi0 : lo0) | sgn, w1 = ((q_ & 1) ? hi1 : lo1) | sgn;
        v8i_ bb = (v8i_){(int)w0 + z, (int)w1, (int)w0, (int)w1, (int)w0, (int)w1, (int)w0, (int)w1};
        pg8::f32x4 c = (pg8::f32x4){0.f, 0.f, 0.f, 0.f};
        c = __builtin_amdgcn_mfma_scale_f32_16x16x128_f8f6f4(a, bb, c, 4, 0, 0, 127 + z, 0, 127 + z);
        if (blockIdx.x == 0 && threadIdx.x == 0) { const float v = c[0]; float code = (v != v) ? 2.0f : (fabsf(v) > 1.0e6f) ? 3.0f : (fminf(fmaxf(v, -28.0f), 100.0f) * 0.25f + 12.0f); args.out[0] += DBG_SCALE * code; }
    }
#endif

}

extern "C" void kernel_launch(void* const* d_in, const int* in_sizes, int n_in, void* d_out, int out_size, void* d_ws, size_t ws_size, hipStream_t stream) {
    static int grid = 0;
    if (grid == 0) {
        if (n_in != 19 || in_sizes[0] != T * D || out_size != T * D || ws_size < WS_END) { fprintf(stderr, "kernel_launch: unexpected shapes (n_in %d, in0 %d, out %d, ws %zu < %zu); nothing launched\n", n_in, n_in > 0 ? in_sizes[0] : -1, out_size, ws_size, (size_t)WS_END); grid = -1; return; }
        int dev = 0, cus = 0, per_cu = 0;
        if (hipGetDevice(&dev) != hipSuccess || hipDeviceGetAttribute(&cus, hipDeviceAttributeMultiprocessorCount, dev) != hipSuccess) { grid = -1; return; }
        if (hipFuncSetAttribute((const void*)fwd_megakernel, hipFuncAttributeMaxDynamicSharedMemorySize, LDS_BYTES) != hipSuccess) { fprintf(stderr, "kernel_launch: hipFuncSetAttribute failed\n"); grid = -1; return; }
        if (hipOccupancyMaxActiveBlocksPerMultiprocessor(&per_cu, (const void*)fwd_megakernel, NTHR, LDS_BYTES) != hipSuccess || per_cu < 1) { fprintf(stderr, "kernel_launch: occupancy query says %d blocks per CU; nothing launched\n", per_cu); (void)hipGetLastError(); grid = -1; return; }
        grid = 256; while (grid > cus) grid >>= 1;
        if (grid < 8) { fprintf(stderr, "kernel_launch: only %d CUs; nothing launched\n", cus); grid = -1; return; }
    }
    if (grid < 0) return;
    if (hipMemsetAsync((char*)d_ws + WS_CTL, 0, CTL_ZERO_BYTES, stream) != hipSuccess) { fprintf(stderr, "kernel_launch: memset failed\n"); return; }
    Args a{};
    const float** ap = (const float**)&a;
    for (int i = 0; i < 19; ++i) ap[i] = (const float*)d_in[i];
    a.out = (float*)d_out; a.ws = (unsigned char*)d_ws;
    void* kargs[] = {&a};
    hipError_t e = hipLaunchCooperativeKernel((const void*)fwd_megakernel, dim3(grid), dim3(NTHR), kargs, LDS_BYTES, stream);
    if (e != hipSuccess) fprintf(stderr, "kernel_launch: cooperative launch failed: %s (grid %d)\n", hipGetErrorString(e), grid);
}
```

```cpp
#define BR_I8 1
#define Z_I8 1
#define GATE_I8 1
#define GATE_FP8 1
#define MIN_FP8 1
#define ZP_FP8 1
#define X1_BF16 1
#define QN_DSA 1
#define ADA_SPREAD 1
#define QUANT2 1
#define EIDX16 1
#include <hip/hip_runtime.h>
#include <hip/hip_bf16.h>
#include <cstdio>
#include <cstdint>
__device__ __forceinline__ int lane_now() { int l; asm volatile("v_mbcnt_lo_u32_b32 %0, -1, 0\n\tv_mbcnt_hi_u32_b32 %0, -1, %0" : "=v"(l)); return l; }
__device__ __forceinline__ int opaque_tid_w(int wave_s) { int t = wave_s * 64 + lane_now(); asm volatile("" : "+v"(t)); return t; }
namespace pg8 {
#define PG8_LAS __attribute__((address_space(3)))
typedef unsigned short bf16_t;
typedef short bf16x8 __attribute__((ext_vector_type(8)));
typedef float f32x4 __attribute__((ext_vector_type(4)));
typedef unsigned u32x4 __attribute__((ext_vector_type(4)));
typedef int i32x4 __attribute__((ext_vector_type(4)));
constexpr int BM = 256, BK = 64, HALF = 128, HTB = HALF * BK * 2  , STAGE_BYTES = 8 * HTB, NXCD = 8, WGM = 8;

__host__ __device__ __forceinline__ int lds_byte(int r, int c) { const int st = (r >> 4) * 2 + (c >> 5), rr = r & 15, cc = c & 31, ob = rr * 64 + cc * 2; return st * 1024 + (ob ^ (((ob >> 9) & 1) << 5)); }
__host__ __device__ __forceinline__ void stage_rc(int b, int& R, int& C) { const int st = b / 1024, sb = b % 1024, swz = sb ^ (((sb >> 9) & 1) << 5); R = (st >> 1) * 16 + swz / 64; C = (st & 1) * 32 + (swz % 64) / 2; }
__host__ __device__ __forceinline__ int perm32(int rho) { const int n = rho >> 4, i = rho & 15; return 8 * (i >> 2) + 4 * n + (i & 3); }

struct Unit { int pm, pn; };
struct Gemm { const bf16_t* A; const bf16_t* Bt; int M, N, K; };

struct StaticOrder {
    int nM, nN, nwg, G, c;
    __host__ __device__ void init(int M, int N, int G_, int c_) { nM = M / BM; nN = N / BM; nwg = nM * nN; G = G_; c = c_; }
    __host__ __device__ bool next(int i, Unit& u) const {
        const long L = (long)i * G + c; if (L >= nwg) return false;
        int wgid = (int)L; { const int q = nwg / NXCD, r = nwg % NXCD, xcd = wgid % NXCD, off = wgid / NXCD; wgid = (xcd < r ? xcd * (q + 1) : r * (q + 1) + (xcd - r) * q) + off; }
        const int nig = WGM * nN, gid = wgid / nig, fm = gid * WGM, gsz = (nM - fm) < WGM ? (nM - fm) : WGM;
        u.pm = fm + ((wgid % nig) % gsz); u.pn = (wgid % nig) / gsz; return true;
    }
    __device__ __forceinline__ void a_ready(const Unit&) const {}
    __device__ __forceinline__ void done(const Unit&) const {}
};

__device__ __forceinline__ unsigned cvt_pk_bf16(float lo, float hi) { unsigned r; asm volatile("v_cvt_pk_bf16_f32 %0, %1, %2" : "=v"(r) : "v"(lo), "v"(hi)); return r; }
typedef float f32x2 __attribute__((ext_vector_type(2)));
__device__ __forceinline__ f32x2 gelu_pk(f32x2 v) {
    const f32x2 av = __builtin_elementwise_abs(v), d = av * 0.2316418882f + 1.0f;
    f32x2 t; t.x = __builtin_amdgcn_rcpf(d.x); t.y = __builtin_amdgcn_rcpf(d.y);
    f32x2 q = t * 0.5307027145f + (-0.7265760135f); q = q * t + 0.7107068705f; q = q * t + (-0.142248368f); q = q * t + 0.127414796f; q = q * t;
    const f32x2 s = (v * v) * (-0.72134752044f);
    f32x2 e; e.x = __builtin_amdgcn_exp2f(s.x); e.y = __builtin_amdgcn_exp2f(s.y);
    const f32x2 m = v * (q * e), r = v - m;
    f32x2 o; o.x = v.x < 0.f ? m.x : r.x; o.y = v.y < 0.f ? m.y : r.y; return o;
}

template <int ACT  > struct EpiBf16 {
    static constexpr bool PERM = true, AFTER_DRAIN = false; static_assert(ACT == 0 || ACT == 1, "EpiBf16: ACT is 0 (none) or 1 (gelu_pk)");
    bf16_t* O; int ldc; const float* bias; int split_cols; size_t split_stride; float scale0;
    __device__ __forceinline__ void operator()(const f32x4 (&acc)[2][2][4][2], const Unit& u, int wr, int wc, int fr, int fq) const {
        const int row0 = u.pm * BM + wr * 64 + fr; int colt = u.pn * BM; bf16_t* base = O;
        float sc = 1.f; if (split_cols) { const int t = colt / split_cols; base += (size_t)t * split_stride; colt -= t * split_cols; if (t == 0) sc = scale0; }
        const int col0 = colt + wc * 32 + 8 * fq, bcol0 = u.pn * BM + wc * 32 + 8 * fq;
        f32x4 bv[2][2];
#pragma unroll
        for (int bj = 0; bj < 2; ++bj)
#pragma unroll
            for (int n = 0; n < 2; ++n) bv[bj][n] = bias ? *(const f32x4*)(bias + bcol0 + bj * HALF + 4 * n) : (f32x4){0.f, 0.f, 0.f, 0.f};
#pragma unroll
        for (int ai = 0; ai < 2; ++ai)
#pragma unroll
            for (int m = 0; m < 4; ++m) { bf16_t* rowp = base + (size_t)(row0 + ai * HALF + m * 16) * ldc + col0;
#pragma unroll
                for (int bj = 0; bj < 2; ++bj) { f32x4 v0 = acc[ai][bj][m][0] + bv[bj][0], v1 = acc[ai][bj][m][1] + bv[bj][1];
                    if (ACT == 1) { f32x2 a = gelu_pk((f32x2){v0[0], v0[1]}), b = gelu_pk((f32x2){v0[2], v0[3]}), c = gelu_pk((f32x2){v1[0], v1[1]}), d = gelu_pk((f32x2){v1[2], v1[3]});
                        v0 = (f32x4){a.x, a.y, b.x, b.y}; v1 = (f32x4){c.x, c.y, d.x, d.y}; }
                    v0 = v0 * sc; v1 = v1 * sc; u32x4 w; w.x = cvt_pk_bf16(v0[0], v0[1]); w.y = cvt_pk_bf16(v0[2], v0[3]); w.z = cvt_pk_bf16(v1[0], v1[1]); w.w = cvt_pk_bf16(v1[2], v1[3]);
                    *(u32x4*)(rowp + bj * HALF) = w; } }
    }
};
template <class Epi, class Sched, bool ALIGN_EPI = false, bool SP2 = false, bool I8 = false>
__device__ __forceinline__ void gemm_phase(PG8_LAS unsigned char* lds, const Gemm g, const Sched& S, const Epi& E, const int tid) {
    const int wid = __builtin_amdgcn_readfirstlane(tid >> 6), lane = tid & 63, wr = wid >> 2, wc = wid & 3, fr = lane & 15, fq = lane >> 4;
    const int K = g.K, nt = K / BK;
    unsigned voffA[2], voffB[2];
#pragma unroll
    for (int i = 0; i < 2; ++i) { int R, C; stage_rc(tid * 16 + i * 8192, R, C); const int Rb = Epi::PERM ? ((R & ~31) + perm32(R & 31)) : R;
        voffA[i] = (unsigned)(R * K + C) * 2u; voffB[i] = (unsigned)(Rb * K + C) * 2u; }
    const size_t kstep = (size_t)(BK * 2);
    const size_t hstep = (size_t)HALF * K * 2;
    const size_t tstep = 2 * hstep;
    const unsigned ldsw = (unsigned)wid * 1024u;
    const int aoff = lds_byte(wr * 64 + fr, fq * 8), boff = lds_byte(wc * 32 + fr, fq * 8);
#define PG8_SA(b, h) (((b) * 2 + (h)) * HTB)
#define PG8_SB(b, h) ((4 + (b) * 2 + (h)) * HTB)
#define PG8_STAGE(bufoff, gbase, voff) do { _Pragma("unroll") for (int _i = 0; _i < 2; ++_i) \
        __builtin_amdgcn_global_load_lds((const unsigned*)((const char*)(gbase) + (voff)[_i]), (PG8_LAS unsigned*)(lds + (bufoff) + ldsw + _i * 8192), 16, 0, 0); } while (0)
#define PG8_LDA(dst, b, h) do { _Pragma("unroll") for (int m = 0; m < 4; ++m) _Pragma("unroll") for (int k = 0; k < 2; ++k) dst[m][k] = *(const PG8_LAS bf16x8*)(lds + PG8_SA(b, h) + aoff + m * 2048 + k * 1024); } while (0)
#define PG8_LDB(dst, b, h) do { _Pragma("unroll") for (int n = 0; n < 2; ++n) _Pragma("unroll") for (int k = 0; k < 2; ++k) dst[n][k] = *(const PG8_LAS bf16x8*)(lds + PG8_SB(b, h) + boff + n * 2048 + k * 1024); } while (0)
#define PG8_MMA(ai, bj, At, Bt) do { __builtin_amdgcn_s_setprio(1); _Pragma("unroll") for (int m = 0; m < 4; ++m) _Pragma("unroll") for (int n = 0; n < 2; ++n) _Pragma("unroll") for (int k = 0; k < 2; ++k) { \
        if constexpr (I8) acc[ai][bj][m][n] = __builtin_bit_cast(f32x4, __builtin_amdgcn_mfma_i32_16x16x64_i8(__builtin_bit_cast(i32x4, Bt[n][k]), __builtin_bit_cast(i32x4, At[m][k]), __builtin_bit_cast(i32x4, acc[ai][bj][m][n]), 0, 0, 0)); \
        else acc[ai][bj][m][n] = __builtin_amdgcn_mfma_f32_16x16x32_bf16(Bt[n][k], At[m][k], acc[ai][bj][m][n], 0, 0, 0); } __builtin_amdgcn_s_setprio(0); } while (0)
#define PG8_WAIT_V(n) asm volatile("s_waitcnt vmcnt(" #n ")" ::: "memory")
#define PG8_WAIT_L(n) asm volatile("s_waitcnt lgkmcnt(" #n ")" ::: "memory")
#define PG8_BAR __builtin_amdgcn_s_barrier()
#define PG8_SCHED __builtin_amdgcn_sched_barrier(0)
    Unit cur, nxt; int ui = 0;
    if (!S.next(0, cur)) return;
    f32x4 acc[2][2][4][2];
#pragma unroll
    for (int a = 0; a < 2; ++a)
#pragma unroll
        for (int b = 0; b < 2; ++b)
#pragma unroll
            for (int m = 0; m < 4; ++m)
#pragma unroll
                for (int n = 0; n < 2; ++n) acc[a][b][m][n] = (f32x4){0.f, 0.f, 0.f, 0.f};
    bf16x8 At[4][2], B0[2][2], B1[2][2];
    const char* cA = (const char*)g.A + (size_t)cur.pm * tstep; const char* cB = (const char*)g.Bt + (size_t)cur.pn * tstep;
    S.a_ready(cur);
    if constexpr (SP2) {
        PG8_STAGE(PG8_SB(0, 0), cB, voffB); PG8_STAGE(PG8_SB(0, 1), cB + hstep, voffB); PG8_STAGE(PG8_SA(0, 0), cA, voffA); PG8_STAGE(PG8_SA(0, 1), cA + hstep, voffA);
        if (wr == 1) PG8_BAR;
        PG8_WAIT_V(2); PG8_BAR;
        PG8_STAGE(PG8_SB(1, 0), cB + kstep, voffB); PG8_STAGE(PG8_SA(1, 0), cA + kstep, voffA); PG8_STAGE(PG8_SB(1, 1), cB + hstep + kstep, voffB);
        PG8_WAIT_V(6); PG8_BAR;
    } else {
        PG8_STAGE(PG8_SB(0, 0), cB, voffB); PG8_STAGE(PG8_SA(0, 0), cA, voffA); PG8_STAGE(PG8_SB(0, 1), cB + hstep, voffB); PG8_STAGE(PG8_SA(0, 1), cA + hstep, voffA);
        if (wr == 1) PG8_BAR;
        PG8_WAIT_V(4); PG8_BAR;
        PG8_STAGE(PG8_SB(1, 0), cB + kstep, voffB); PG8_STAGE(PG8_SA(1, 0), cA + kstep, voffA); PG8_STAGE(PG8_SB(1, 1), cB + hstep + kstep, voffB);
        PG8_WAIT_V(6); PG8_BAR;
    }
    for (;;) {
        const bool has_next = S.next(ui + 1, nxt);
        const char* nA = has_next ? (const char*)g.A + (size_t)nxt.pm * tstep : cA; const char* nB = has_next ? (const char*)g.Bt + (size_t)nxt.pn * tstep : cB;
        for (int t = 0; t < nt; t += 2) {
            const bool last = (t == nt - 2);
            const char* a1 = cA + (size_t)(t + 1) * kstep;
            const char* a2 = last ? nA : cA + (size_t)(t + 2) * kstep; const char* b2 = last ? nB : cB + (size_t)(t + 2) * kstep;
            const char* a3 = a2 + kstep; const char* b3 = b2 + kstep;
            if (last && has_next) S.a_ready(nxt);
            if constexpr (SP2) {
            PG8_LDB(B0, 0, 0); PG8_LDB(B1, 0, 1); PG8_SCHED; PG8_LDA(At, 0, 0); PG8_STAGE(PG8_SA(1, 1), a1 + hstep, voffA);
            PG8_WAIT_V(8); PG8_WAIT_L(0); PG8_BAR; PG8_MMA(0, 0, At, B0); PG8_MMA(0, 1, At, B1); PG8_BAR; PG8_SCHED;
            PG8_LDA(At, 0, 1); PG8_STAGE(PG8_SB(0, 0), b2, voffB); PG8_STAGE(PG8_SB(0, 1), b2 + hstep, voffB); PG8_STAGE(PG8_SA(0, 0), a2, voffA);
            PG8_WAIT_V(8); PG8_WAIT_L(0); PG8_BAR; PG8_MMA(1, 0, At, B0); PG8_MMA(1, 1, At, B1); PG8_BAR; PG8_SCHED;
            PG8_LDB(B0, 1, 0); PG8_LDB(B1, 1, 1); PG8_SCHED; PG8_LDA(At, 1, 0); PG8_STAGE(PG8_SA(0, 1), a2 + hstep, voffA);
            PG8_WAIT_V(8); PG8_WAIT_L(0); PG8_BAR; PG8_MMA(0, 0, At, B0); PG8_MMA(0, 1, At, B1); PG8_BAR; PG8_SCHED;
            PG8_LDA(At, 1, 1); PG8_STAGE(PG8_SB(1, 0), b3, voffB); PG8_STAGE(PG8_SB(1, 1), b3 + hstep, voffB); PG8_STAGE(PG8_SA(1, 0), a3, voffA);
            PG8_WAIT_V(8); PG8_WAIT_L(0); PG8_BAR; PG8_MMA(1, 0, At, B0); PG8_MMA(1, 1, At, B1); PG8_BAR; PG8_SCHED;
            } else {
            PG8_LDB(B0, 0, 0); PG8_SCHED; PG8_LDA(At, 0, 0); PG8_STAGE(PG8_SA(1, 1), a1 + hstep, voffA);
            PG8_WAIT_L(8); PG8_BAR; PG8_WAIT_L(0); PG8_MMA(0, 0, At, B0); PG8_BAR; PG8_SCHED;
            PG8_LDB(B1, 0, 1); PG8_STAGE(PG8_SB(0, 0), b2, voffB);
            PG8_BAR; PG8_WAIT_L(0); PG8_MMA(0, 1, At, B1); PG8_BAR;
            PG8_LDA(At, 0, 1); PG8_STAGE(PG8_SA(0, 0), a2, voffA);
            PG8_BAR; PG8_WAIT_L(0); PG8_MMA(1, 0, At, B0); PG8_BAR; PG8_SCHED;
            PG8_STAGE(PG8_SB(0, 1), b2 + hstep, voffB);
            PG8_WAIT_V(6); PG8_BAR; PG8_MMA(1, 1, At, B1); PG8_BAR;
            PG8_LDB(B0, 1, 0); PG8_SCHED; PG8_LDA(At, 1, 0); PG8_STAGE(PG8_SA(0, 1), a2 + hstep, voffA);
            PG8_WAIT_L(8); PG8_BAR; PG8_WAIT_L(0); PG8_MMA(0, 0, At, B0); PG8_BAR; PG8_SCHED;
            PG8_LDB(B1, 1, 1); PG8_STAGE(PG8_SB(1, 0), b3, voffB);
            PG8_BAR; PG8_WAIT_L(0); PG8_MMA(0, 1, At, B1); PG8_BAR;
            PG8_LDA(At, 1, 1); PG8_STAGE(PG8_SA(1, 0), a3, voffA);
            PG8_BAR; PG8_WAIT_L(0); PG8_MMA(1, 0, At, B0); PG8_BAR; PG8_SCHED;
            PG8_STAGE(PG8_SB(1, 1), b3 + hstep, voffB);
            PG8_WAIT_V(6); PG8_BAR; PG8_MMA(1, 1, At, B1); PG8_BAR;
            }
        }
        if constexpr (ALIGN_EPI) { if (wr == 0) PG8_BAR; }
        if constexpr (!Epi::AFTER_DRAIN) { E(acc, cur, wr, wc, fr, fq); S.done(cur); }
        if (!has_next) break;
#pragma unroll
        for (int a = 0; a < 2; ++a)
#pragma unroll
            for (int b = 0; b < 2; ++b)
#pragma unroll
                for (int m = 0; m < 4; ++m)
#pragma unroll
                    for (int n = 0; n < 2; ++n) acc[a][b][m][n] = (f32x4){0.f, 0.f, 0.f, 0.f};
        cur = nxt; cA = nA; cB = nB; ++ui;
        if constexpr (ALIGN_EPI) { if (wr == 1) PG8_BAR; }
    }
    PG8_WAIT_V(0);
    if constexpr (!ALIGN_EPI) { if (wr == 0) PG8_BAR; }
    PG8_BAR;
    if constexpr (Epi::AFTER_DRAIN) { E.fused(acc, cur, wr, wc, fr, fq, lds, wid, lane); S.done(cur); }
#undef PG8_SA
#undef PG8_SB
#undef PG8_STAGE
#undef PG8_LDA
#undef PG8_LDB
#undef PG8_MMA
#undef PG8_WAIT_V
#undef PG8_WAIT_L
#undef PG8_BAR
#undef PG8_SCHED
}
}

#define GAS __attribute__((address_space(1)))
#define LAS __attribute__((address_space(3)))
typedef unsigned short bf16;
typedef unsigned v4u __attribute__((ext_vector_type(4)));
typedef unsigned v2u __attribute__((ext_vector_type(2)));
typedef float f32x4 __attribute__((ext_vector_type(4)));
typedef float f32x16 __attribute__((ext_vector_type(16)));
typedef short bf16x8 __attribute__((ext_vector_type(8)));
typedef __bf16 bf16x2_t __attribute__((ext_vector_type(2)));

constexpr int NWAVES = 8, NTHR = 512;
constexpr int NB = 32, SEQ = 2048, T = NB * SEQ, D = 1024, ZW = 3584, INW = 3524;
constexpr int ZC_Q = 0, ZC_K = 512, ZC_V = 576, ZC_IK = 640, ZC_IW = 704, ZC_IQ = 768, ZC_ZP = 1024, ZC_GA = 1536, ZC_GP = 2560;
constexpr float EPS = 1e-6f;
constexpr float QSCALE = 0.125f * 1.4426950408889634f;

constexpr size_t MiB = 1u << 20;
constexpr size_t WS_CTL = 0, CTL_ZERO_BYTES = 65536;
constexpr size_t WS_ADA = 1 * MiB, WS_IW = 2 * MiB, WS_SK = 3 * MiB, WS_WGRP = 4 * MiB, WS_WUA = 5 * MiB, WS_WUP = 6 * MiB, WS_WOUT = 7 * MiB, WS_WPQ = 9 * MiB, WS_WIN = 11 * MiB;
constexpr size_t WS_IKX = 18 * MiB, WS_KX = 26 * MiB, WS_VX = 34 * MiB;
constexpr size_t WS_U = 64 * MiB, WS_V = 96 * MiB, WS_Z = 128 * MiB, WS_H = 576 * MiB, WS_POOLED = 576 * MiB, WS_PM = 640 * MiB;
constexpr size_t WS_ATT = 704 * MiB, WS_PQ = 704 * MiB, WS_MIN = 832 * MiB, WS_EIDX = 832 * MiB, WS_EGATE = 864 * MiB, WS_END = 960 * MiB;
constexpr int CW_BAR = 4096;
constexpr size_t WS_SU = 512 * 1024, WS_SV = 576 * 1024, WS_SH2 = 640 * 1024;
constexpr size_t WS_H8 = 704 * MiB;
#ifdef Z_I8
constexpr size_t WS_WG8 = 44 * MiB, WS_CS8 = 48 * MiB, WS_S1 = 49 * MiB;
#else
constexpr size_t WS_WG8 = 44 * MiB, WS_CS8 = 46 * MiB, WS_S1 = 47 * MiB;
#endif
constexpr size_t WS_W58 = 122 * MiB, WS_W78 = 122 * MiB + 512 * 1024, WS_CS5 = 123 * MiB, WS_CS7 = 123 * MiB + 8192, WS_SPL = 124 * MiB, WS_SAT = 125 * MiB;
constexpr size_t WS_X1 = 128 * MiB;
constexpr size_t WS_H2HI = 384 * MiB, WS_H2LO = 416 * MiB;
constexpr size_t WS_H2F8 = 384 * MiB;

constexpr int RING_BYTES = 131072, LDS_BYTES = 163840, LDSCTL_OFF = LDS_BYTES - 1024, MISC_OFF = LDSCTL_OFF + 320;

__device__ __forceinline__ unsigned f2bf(float f) { unsigned u = __builtin_bit_cast(unsigned, f); return (u + 0x7fffu + ((u >> 16) & 1u)) >> 16; }
__device__ __forceinline__ unsigned pk2(float lo, float hi) { typedef float f32x2_ __attribute__((ext_vector_type(2))); typedef __bf16 bf16x2_ __attribute__((ext_vector_type(2))); const f32x2_ v = {lo, hi}; return __builtin_bit_cast(unsigned, __builtin_convertvector(v, bf16x2_)); }
__device__ __forceinline__ float bflo(unsigned w) { return __builtin_bit_cast(float, w << 16); }
__device__ __forceinline__ float bfhi(unsigned w) { return __builtin_bit_cast(float, w & 0xffff0000u); }
__device__ __forceinline__ float bf2f(bf16 h) { return __builtin_bit_cast(float, (unsigned)h << 16); }
#define LDS_WAIT() asm volatile("s_waitcnt lgkmcnt(0)" ::: "memory")
#define VM_WAIT() asm volatile("s_waitcnt vmcnt(0)" ::: "memory")

#define XB_TMO      128
#define XB_XCNT(j)  (256  + 64 * (j))
#define XB_XSUB(j)  (1280 + 64 * (j))
#define XB_XGEN(j)  (2304 + 64 * (j))
#define XB_TOP      3328
#define XB_TOPGEN   3392
#define XCD_BAR_WORDS 3456
#define XB_SPIN_CAP (1u << 26)

__device__ __forceinline__ unsigned xb_ld(unsigned* p)              { return __hip_atomic_load(p, __ATOMIC_RELAXED, __HIP_MEMORY_SCOPE_AGENT); }
__device__ __forceinline__ unsigned xb_add(unsigned* p, unsigned v) { return __hip_atomic_fetch_add(p, v, __ATOMIC_RELAXED, __HIP_MEMORY_SCOPE_AGENT); }
__device__ __forceinline__ unsigned xb_xcc_id() { return (unsigned)__builtin_amdgcn_s_getreg((3 << 11) | 20) & 0xFu; }
#define XB_SPIN(cond, bar) do { unsigned _sp = 0; while (cond) { __builtin_amdgcn_s_sleep(1); \
    if ((++_sp & 255u) == 0u) { if (xb_ld(&(bar)[XB_TMO])) break; if (_sp > XB_SPIN_CAP) { atomicAdd(&(bar)[XB_TMO], 1u); break; } } } } while (0)

struct XcdBarrier {
    unsigned* bar; unsigned x;
    unsigned w0;
    volatile LAS unsigned* st;
};

__device__ __forceinline__ XcdBarrier xcd_barrier_post(unsigned* bar, volatile LAS unsigned* st, int wave_s) {
    XcdBarrier b; b.bar = bar; b.x = xb_xcc_id(); b.st = st; b.w0 = (wave_s == 0) ? 1u : 0u;
    if (b.w0 && lane_now() == 0) (void)xb_add(&bar[XB_XCNT(b.x)], 1u);
    return b;
}
__device__ __forceinline__ void xcd_barrier_complete(unsigned* bar, unsigned x, unsigned& nloc, unsigned& nx) {
    const unsigned G = gridDim.x * gridDim.y * gridDim.z;
    unsigned sum, cnt, mine, sp = 0u;
    for (;;) {
        sum = 0u; cnt = 0u; mine = 0u;
#pragma unroll
        for (unsigned j = 0; j < 16; ++j) { const unsigned c = xb_ld(&bar[XB_XCNT(j)]); sum += c; cnt += (c > 0u) ? 1u : 0u; mine = (j == x) ? c : mine; }
        if (sum == G) break;
        __builtin_amdgcn_s_sleep(1);
        if ((++sp & 255u) == 0u) { if (xb_ld(&bar[XB_TMO])) break; if (sp > XB_SPIN_CAP) { atomicAdd(&bar[XB_TMO], 1u); break; } }
    }
    nloc = mine > 0u ? mine : 1u; nx = cnt > 0u ? cnt : 1u;
}

__device__ __forceinline__ void xcd_barrier(const XcdBarrier& b) {
    asm volatile("s_waitcnt vmcnt(0)" ::: "memory");
    __syncthreads();
    if (b.w0 && lane_now() == 0) {
        unsigned* bar = b.bar;
        __builtin_amdgcn_s_waitcnt(0);
        unsigned nloc = b.st[0], nx = b.st[1];
        if (nloc == 0u) { xcd_barrier_complete(bar, b.x, nloc, nx); b.st[0] = nloc; b.st[1] = nx; }
        const unsigned old = xb_add(&bar[XB_XSUB(b.x)], 1u);
        const unsigned gen = old / nloc;
        if (old + 1u == (gen + 1u) * nloc) {
            __builtin_amdgcn_fence(__ATOMIC_RELEASE, "agent");
            asm volatile("s_waitcnt vmcnt(0)" ::: "memory");
            const unsigned og = xb_add(&bar[XB_TOP], 1u);
            const unsigned tg = og / nx;
            if (og + 1u == (tg + 1u) * nx) xb_add(&bar[XB_TOPGEN], 1u);
            else XB_SPIN(xb_ld(&bar[XB_TOPGEN]) == tg, bar);
            __builtin_amdgcn_fence(__ATOMIC_ACQUIRE, "agent");
            xb_add(&bar[XB_XGEN(b.x)], 1u);
            asm volatile("s_waitcnt vmcnt(0)" ::: "memory");
        } else {
            XB_SPIN(xb_ld(&bar[XB_XGEN(b.x)]) == gen, bar);
            __builtin_amdgcn_fence(__ATOMIC_ACQUIRE, "agent");
            asm volatile("s_waitcnt vmcnt(0)" ::: "memory");
        }
    }
    __syncthreads();
}


struct Args {
    const float *x, *c, *w_ada, *b_ada, *g1, *w_in, *g_q, *g_k, *g_ik, *w_grp, *s_pool, *w_ua, *w_up, *w_out, *g2, *w_pq, *sk, *pu, *pv;
    float* out; unsigned char* ws;
};

struct Frame {
    LAS unsigned char* lds;
    int tid, lane, wave, vcu, G, gw, NGW;
};

__device__ __forceinline__ float wave_sum(float v) {
#pragma unroll
    for (int o = 1; o < 64; o <<= 1) v += __shfl_xor(v, o);
    return v;
}
__device__ __forceinline__ float xhalf_max(float m) { auto rr = __builtin_amdgcn_permlane32_swap(__float_as_uint(m), __float_as_uint(m), false, false); return fmaxf(__uint_as_float(rr[0]), __uint_as_float(rr[1])); }
__device__ __forceinline__ float xhalf_sum(float m) { auto rr = __builtin_amdgcn_permlane32_swap(__float_as_uint(m), __float_as_uint(m), false, false); return __uint_as_float(rr[0]) + __uint_as_float(rr[1]); }
__device__ __forceinline__ unsigned ordf(float f) { unsigned b = __float_as_uint(f); return b ^ ((b >> 31) ? 0xFFFFFFFFu : 0x80000000u); }
__device__ __forceinline__ float unordf(unsigned u) { unsigned b = u ^ ((u >> 31) ? 0x80000000u : 0xFFFFFFFFu); return __uint_as_float(b); }

__device__ __forceinline__ void transpose_item(const float* W, int ldw, int src_k0, int src_col0, int valid, bf16* WT, int ldwt, int dst_row0, int dst_k0, LAS float* scr, int lane) {
#pragma unroll 8
    for (int i = 0; i < 32; ++i) { const int kk = 2 * i + (lane >> 5), n = lane & 31; scr[kk * 33 + n] = (n < valid) ? W[(size_t)(src_k0 + kk) * ldw + src_col0 + n] : 0.f; }
    LDS_WAIT(); asm volatile("" ::: "memory");
    const int c = lane & 7;
#pragma unroll
    for (int j = 0; j < 4; ++j) { const int n = (lane >> 3) + 8 * j; const LAS float* s = scr + (8 * c) * 33 + n;
        v4u o; o.x = pk2(s[0 * 33], s[1 * 33]); o.y = pk2(s[2 * 33], s[3 * 33]); o.z = pk2(s[4 * 33], s[5 * 33]); o.w = pk2(s[6 * 33], s[7 * 33]);
        *(GAS v4u*)(WT + (size_t)(dst_row0 + n) * ldwt + dst_k0 + 8 * c) = o; }
    LDS_WAIT(); asm volatile("" ::: "memory");
}
__device__ __forceinline__ void zcol_src(int nb, int& src, int& valid) {
    const int n0 = nb * 32; valid = 32;
    if (n0 < 640) src = n0;
    else if (n0 < 704) src = 896 + (n0 - 640);
    else if (n0 < 736) { src = 960; valid = 4; }
    else if (n0 < 768) { src = 0; valid = 0; }
    else if (n0 < 1024) src = 640 + (n0 - 768);
    else if (n0 < 1536) src = 964 + (n0 - 1024);
    else src = 1476 + (n0 - 1536);
}
__device__ __forceinline__ void cvt_stream(const float* src, bf16* dst, size_t n8, int gtid, int gthreads) {
    for (size_t i = gtid; i < n8; i += gthreads) {
        const f32x4 a = ((const GAS f32x4*)src)[2 * i], b = ((const GAS f32x4*)src)[2 * i + 1];
        v4u o; o.x = pk2(a.x, a.y); o.y = pk2(a.z, a.w); o.z = pk2(b.x, b.y); o.w = pk2(b.z, b.w);
        ((GAS v4u*)dst)[i] = o;
    }
}
__device__ __forceinline__ void p0_prologue(Frame& F, const Args& A) {
    unsigned char* ws = A.ws;
    float* ADA = (float*)(ws + WS_ADA);
#ifdef ADA_SPREAD
    if (F.vcu * NWAVES < 1536) {
        LAS float* cT = (LAS float*)F.lds;
        LAS float* part = (LAS float*)(F.lds + 131072);
        for (int idx = F.tid; idx < NB * D; idx += NTHR) cT[(idx & (D - 1)) * NB + (idx >> 10)] = A.c[idx];
        __syncthreads();
      for (int item = F.gw; item < 1536; item += F.NGW) {
        const int task = item >> 2, quarter = item & 3;
        {
            const int col = task * 16 + (F.lane & 15), ks = F.lane >> 4;
            float acc[NB];
#pragma unroll
            for (int b = 0; b < NB; ++b) acc[b] = 0.f;
#pragma unroll 4
            for (int i = 0; i < 64; ++i) {
                const int k = quarter * 256 + 4 * i + ks;
                const float w = A.w_ada[(size_t)k * 6144 + col];
                const LAS f32x4* cr = (const LAS f32x4*)(cT + k * NB);
#pragma unroll
                for (int b4 = 0; b4 < 8; ++b4) { const f32x4 cv = cr[b4]; acc[4 * b4] = fmaf(cv.x, w, acc[4 * b4]); acc[4 * b4 + 1] = fmaf(cv.y, w, acc[4 * b4 + 1]); acc[4 * b4 + 2] = fmaf(cv.z, w, acc[4 * b4 + 2]); acc[4 * b4 + 3] = fmaf(cv.w, w, acc[4 * b4 + 3]); }
            }
#pragma unroll
            for (int b = 0; b < NB; ++b) { float v = acc[b]; v += __shfl_xor(v, 16); v += __shfl_xor(v, 32); acc[b] = v; }
            if (ks == 0) {
                LAS f32x4* pp = (LAS f32x4*)(part + (F.wave * 16 + (F.lane & 15)) * NB);
#pragma unroll
                for (int b4 = 0; b4 < 8; ++b4) pp[b4] = (f32x4){acc[4 * b4], acc[4 * b4 + 1], acc[4 * b4 + 2], acc[4 * b4 + 3]};
            }
        }
        __syncthreads();
        if (quarter == 0) {
#pragma unroll
            for (int j = 0; j < 8; ++j) {
                const int o = F.lane * 8 + j, cc = o >> 5, bb = o & 31;
                const float v = part[((F.wave + 0) * 16 + cc) * NB + bb] + part[((F.wave + 1) * 16 + cc) * NB + bb] + part[((F.wave + 2) * 16 + cc) * NB + bb] + part[((F.wave + 3) * 16 + cc) * NB + bb];
                ADA[bb * 6144 + task * 16 + cc] = v + A.b_ada[task * 16 + cc];
            }
        }
        __syncthreads();
      }
    }
#else
    if (F.vcu * NWAVES < 384) {
        LAS float* cT = (LAS float*)F.lds;
        for (int idx = F.tid; idx < NB * D; idx += NTHR) cT[(idx & (D - 1)) * NB + (idx >> 10)] = A.c[idx];
        __syncthreads();
        for (int task = F.gw; task < 384; task += F.NGW) {
            const int col = task * 16 + (F.lane & 15), ks = F.lane >> 4;
            float acc[NB];
#pragma unroll
            for (int b = 0; b < NB; ++b) acc[b] = 0.f;
#pragma unroll 4
            for (int i = 0; i < 256; ++i) {
                const int k = 4 * i + ks;
                const float w = A.w_ada[(size_t)k * 6144 + col];
                const LAS f32x4* cr = (const LAS f32x4*)(cT + k * NB);
#pragma unroll
                for (int b4 = 0; b4 < 8; ++b4) { const f32x4 cv = cr[b4]; acc[4 * b4] = fmaf(cv.x, w, acc[4 * b4]); acc[4 * b4 + 1] = fmaf(cv.y, w, acc[4 * b4 + 1]); acc[4 * b4 + 2] = fmaf(cv.z, w, acc[4 * b4 + 2]); acc[4 * b4 + 3] = fmaf(cv.w, w, acc[4 * b4 + 3]); }
            }
#pragma unroll
            for (int b = 0; b < NB; ++b) { float v = acc[b]; v += __shfl_xor(v, 16); v += __shfl_xor(v, 32); acc[b] = v; }
            if (ks == 0) {
                const float bb = A.b_ada[col];
#pragma unroll
                for (int b = 0; b < NB; ++b) ADA[b * 6144 + col] = acc[b] + bb;
            }
        }
        __syncthreads();
    }
#endif
    LAS float* scr = (LAS float*)(F.lds + F.wave * 16384);
    bf16* WIN = (bf16*)(ws + WS_WIN); bf16* WUA = (bf16*)(ws + WS_WUA); bf16* WUP = (bf16*)(ws + WS_WUP); bf16* WOUT = (bf16*)(ws + WS_WOUT); bf16* WPQ = (bf16*)(ws + WS_WPQ); bf16* WGRP = (bf16*)(ws + WS_WGRP);
    constexpr int I_IN = 16 * 112, I_UA = 8 * 32, I_UP = 8 * 32, I_OUT = 16 * 32, I_PQ = 16 * 32;
    constexpr int NITEMS = I_IN + I_UA + I_UP + I_OUT + I_PQ;
    for (int it = F.gw; it < NITEMS; it += F.NGW) {
        int r = it;
        if (r < I_IN) { const int kb = r / 112, nb = r % 112; int src, valid; zcol_src(nb, src, valid); transpose_item(A.w_in, INW, kb * 64, src, valid, WIN, 1024, nb * 32, kb * 64, scr, F.lane); continue; } r -= I_IN;
        if (r < I_UA) { const int kb = r / 32, nb = r % 32; transpose_item(A.w_ua, 1024, kb * 64, nb * 32, 32, WUA, 512, nb * 32, kb * 64, scr, F.lane); continue; } r -= I_UA;
        if (r < I_UP) { continue; } r -= I_UP;
        if (r < I_OUT) { const int kb = r / 32, nb = r % 32; transpose_item(A.w_out, 1024, kb * 64, nb * 32, 32, WOUT, 1024, nb * 32, kb * 64, scr, F.lane); continue; } r -= I_OUT;
        if (r < I_PQ) { const int kb = r / 32, nb = r % 32; transpose_item(A.w_pq, 1024, kb * 64, nb * 32, 32, WPQ, 1024, nb * 32, kb * 64, scr, F.lane); continue; } r -= I_PQ;
        (void)WGRP;
    }
    const int gtid = F.gw * 64 + F.lane, gthreads = F.NGW * 64;
    for (int it = F.gw; it < 512 * 4; it += F.NGW) {
        const int k = it >> 2, n = (it & 3) * 256 + F.lane, g = k >> 7;
        const float* wg = A.w_grp + (size_t)k * 128; const float* sp = A.s_pool + g * 128; const float* wu = A.w_up + (size_t)g * 128 * 1024 + n;
        float a0 = 0.f, a1 = 0.f, a2 = 0.f, a3 = 0.f;
#pragma unroll 8
        for (int d = 0; d < 128; ++d) { const float ws_ = wg[d] * sp[d]; const float* wr = wu + (size_t)d * 1024;
            a0 = fmaf(ws_, wr[0], a0); a1 = fmaf(ws_, wr[64], a1); a2 = fmaf(ws_, wr[128], a2); a3 = fmaf(ws_, wr[192], a3); }
        WUP[(size_t)n * 512 + k] = (bf16)f2bf(a0); WUP[(size_t)(n + 64) * 512 + k] = (bf16)f2bf(a1); WUP[(size_t)(n + 128) * 512 + k] = (bf16)f2bf(a2); WUP[(size_t)(n + 192) * 512 + k] = (bf16)f2bf(a3);
    }
    cvt_stream(A.sk, (bf16*)(ws + WS_SK), (size_t)16 * 128 * 64 / 8, gtid, gthreads);
#ifdef QUANT2
#ifndef QUANT_R
#define QUANT_R 2
#endif
    for (int row = F.gw; row < 2 * 16384; row += QUANT_R * F.NGW) {
        f32x4 av[QUANT_R][4]; float m[QUANT_R];
#pragma unroll
        for (int q = 0; q < QUANT_R; ++q) { int rq = row + q * F.NGW; rq = rq < 2 * 16384 ? rq : row; const bool isv = rq >= 16384; const int r = isv ? rq - 16384 : rq; const float* src = (isv ? A.pv : A.pu) + (size_t)r * 1024 + 16 * F.lane;
#pragma unroll
            for (int j = 0; j < 4; ++j) av[q][j] = *(const GAS f32x4*)(src + 4 * j); }
#pragma unroll
        for (int q = 0; q < QUANT_R; ++q) { float t = 0.f;
#pragma unroll
            for (int j = 0; j < 4; ++j) t = fmaxf(t, fmaxf(fmaxf(fabsf(av[q][j].x), fabsf(av[q][j].y)), fmaxf(fabsf(av[q][j].z), fabsf(av[q][j].w))));
            m[q] = t; }
#pragma unroll
        for (int o = 1; o < 64; o <<= 1) {
#pragma unroll
            for (int q = 0; q < QUANT_R; ++q) m[q] = fmaxf(m[q], __shfl_xor(m[q], o)); }
#pragma unroll
        for (int q = 0; q < QUANT_R; ++q) {
            int rq = row + q * F.NGW; rq = rq < 2 * 16384 ? rq : row; const bool isv = rq >= 16384; const int r = isv ? rq - 16384 : rq;
            const float sc = m[q] > 0.f ? (isv ? 6.0f / m[q] : 10.0f / m[q]) : 1.0f;
            unsigned w[2] = {0u, 0u};
#pragma unroll
            for (int j = 0; j < 4; ++j)
#pragma unroll
                for (int k = 0; k < 4; ++k) {
                    const float x = av[q][j][k], a = fabsf(x) * sc;
                    const unsigned c = (a >= 0.25f) + (a >= 0.75f) + (a >= 1.25f) + (a >= 1.75f) + (a >= 2.5f) + (a >= 3.5f) + (a >= 5.0f);
                    unsigned nib = c | (x < 0.f ? 8u : 0u);
                    if (!isv) { int qi = (int)rintf(x * sc); qi = qi < -8 ? -8 : (qi > 7 ? 7 : qi); nib = (unsigned)qi & 15u; }
                    const int el = 4 * j + k;
                    w[el >> 3] |= nib << (4 * (el & 7));
                }
            *(GAS v2u*)(ws + (isv ? WS_V : WS_U) + (size_t)(F.lane >> 4) * (16384 * 128) + (size_t)r * 128 + 8 * (F.lane & 15)) = (v2u){w[0], w[1]};
            if (F.lane == 0) ((float*)(ws + (isv ? WS_SV : WS_SU)))[r] = m[q] > 0.f ? (isv ? m[q] * (1.0f / 6.0f) : m[q] * 0.1f) : 1.0f;
        }
    }
}
#else
    for (int row = F.gw; row < 2 * 16384; row += F.NGW) {
        const bool isv = row >= 16384; const int r = isv ? row - 16384 : row;
        const float* src = (isv ? A.pv : A.pu) + (size_t)r * 1024 + 16 * F.lane;
        f32x4 av[4];
#pragma unroll
        for (int j = 0; j < 4; ++j) av[j] = *(const GAS f32x4*)(src + 4 * j);
        float m = 0.f;
#pragma unroll
        for (int j = 0; j < 4; ++j) m = fmaxf(m, fmaxf(fmaxf(fabsf(av[j].x), fabsf(av[j].y)), fmaxf(fabsf(av[j].z), fabsf(av[j].w))));
#pragma unroll
        for (int o = 1; o < 64; o <<= 1) m = fmaxf(m, __shfl_xor(m, o));
        const float sc = m > 0.f ? (isv ? 6.0f / m : 10.0f / m) : 1.0f;
        unsigned w[2] = {0u, 0u};
#pragma unroll
        for (int j = 0; j < 4; ++j)
#pragma unroll
            for (int k = 0; k < 4; ++k) {
                const float x = av[j][k], a = fabsf(x) * sc;
                const unsigned c = (a >= 0.25f) + (a >= 0.75f) + (a >= 1.25f) + (a >= 1.75f) + (a >= 2.5f) + (a >= 3.5f) + (a >= 5.0f);
                unsigned nib = c | (x < 0.f ? 8u : 0u);
                if (!isv) { int qi = (int)rintf(x * sc); qi = qi < -8 ? -8 : (qi > 7 ? 7 : qi); nib = (unsigned)qi & 15u; }
                const int el = 4 * j + k;
#if defined(U4_SWAP) && !defined(OLD_GATHER)
                w[el >> 3] |= nib << (4 * (isv ? (el & 7) : ((el & 7) ^ 1)));
#else
                w[el >> 3] |= nib << (4 * (el & 7));
#endif
            }
#ifdef OLD_GATHER
        *(GAS v2u*)(ws + (isv ? WS_V : WS_U) + (size_t)r * 512 + 8 * F.lane) = (v2u){w[0], w[1]};
#else
        *(GAS v2u*)(ws + (isv ? WS_V : WS_U) + (size_t)(F.lane >> 4) * (16384 * 128) + (size_t)r * 128 + 8 * (F.lane & 15)) = (v2u){w[0], w[1]};
#endif
        if (F.lane == 0) ((float*)(ws + (isv ? WS_SV : WS_SU)))[r] = m > 0.f ? (isv ? m * (1.0f / 6.0f) : m * 0.1f) : 1.0f;
    }
}
#endif

__device__ __forceinline__ void norm_rows(Frame& F, const float* X, const float* g, const float* ADA, int shift_off, int scale_off, bf16* O, unsigned char* O8, float* S8, const bf16* XB = nullptr, unsigned char* H8 = nullptr, float* S1 = nullptr) {
    const int rpw = T / F.NGW, m_begin = F.gw * rpw, b = m_begin >> 11;
    f32x4 cg[4], sh[4];
#pragma unroll
    for (int j = 0; j < 4; ++j) { const int col = 4 * F.lane + 256 * j;
        const f32x4 gg = *(const GAS f32x4*)(g + col), sc = *(const GAS f32x4*)(ADA + b * 6144 + scale_off + col);
        cg[j] = gg * (sc + 1.0f); sh[j] = *(const GAS f32x4*)(ADA + b * 6144 + shift_off + col); }
    for (int m0 = m_begin; m0 < m_begin + rpw; m0 += 4) {
        f32x4 v[4][4]; float s[4];
#pragma unroll
        for (int r = 0; r < 4; ++r) {
            if (XB) {
                const GAS v2u* ar = (const GAS v2u*)(XB + (size_t)(m0 + r) * D) + F.lane;
#pragma unroll
                for (int j = 0; j < 4; ++j) { const v2u a = ar[64 * j]; v[r][j] = (f32x4){__uint_as_float(a.x << 16), __uint_as_float(a.x & 0xffff0000u), __uint_as_float(a.y << 16), __uint_as_float(a.y & 0xffff0000u)}; }
            } else {
                const GAS f32x4* xr = (const GAS f32x4*)(X + (size_t)(m0 + r) * D) + F.lane;
#pragma unroll
                for (int j = 0; j < 4; ++j) v[r][j] = xr[64 * j];
            } }
#pragma unroll
        for (int r = 0; r < 4; ++r) { float t = 0.f;
#pragma unroll
            for (int j = 0; j < 4; ++j) t += (v[r][j].x * v[r][j].x + v[r][j].y * v[r][j].y) + (v[r][j].z * v[r][j].z + v[r][j].w * v[r][j].w);
            s[r] = t; }
#pragma unroll
        for (int o = 1; o < 64; o <<= 1) {
#pragma unroll
            for (int r = 0; r < 4; ++r) s[r] += __shfl_xor(s[r], o);
        }
#pragma unroll
        for (int r = 0; r < 4; ++r) {
            const float rstd = 1.0f / sqrtf(s[r] * (1.f / D) + EPS);
            GAS unsigned long long* o8 = (GAS unsigned long long*)(O + (size_t)(m0 + r) * D) + F.lane;
#pragma unroll
            for (int j = 0; j < 4; ++j) { const f32x4 y = (v[r][j] * rstd) * cg[j] + sh[j]; if (O) o8[64 * j] = (unsigned long long)pk2(y.x, y.y) | ((unsigned long long)pk2(y.z, y.w) << 32); v[r][j] = y; }
        }
        if (H8) {
            float am[4];
#pragma unroll
            for (int r = 0; r < 4; ++r) { float t = 0.f;
#pragma unroll
                for (int j = 0; j < 4; ++j) t = fmaxf(t, fmaxf(fmaxf(fabsf(v[r][j].x), fabsf(v[r][j].y)), fmaxf(fabsf(v[r][j].z), fabsf(v[r][j].w))));
                am[r] = t; }
#pragma unroll
            for (int o = 1; o < 64; o <<= 1) {
#pragma unroll
                for (int r = 0; r < 4; ++r) am[r] = fmaxf(am[r], __shfl_xor(am[r], o));
            }
#pragma unroll
            for (int r = 0; r < 4; ++r) {
                const float q = am[r] > 0.f ? 127.0f / am[r] : 1.0f;
                GAS unsigned* hb = (GAS unsigned*)(H8 + (size_t)(m0 + r) * D) + F.lane;
#pragma unroll
                for (int j = 0; j < 4; ++j) {
                    const int x0 = (int)rintf(v[r][j].x * q), x1 = (int)rintf(v[r][j].y * q), x2 = (int)rintf(v[r][j].z * q), x3 = (int)rintf(v[r][j].w * q);
                    hb[64 * j] = ((unsigned)x0 & 255u) | (((unsigned)x1 & 255u) << 8) | (((unsigned)x2 & 255u) << 16) | (((unsigned)x3 & 255u) << 24);
                }
                if (F.lane == 0) S1[m0 + r] = am[r] > 0.f ? am[r] * (1.0f / 127.0f) : 1.0f;
            }
        }
        if (O8) {
            float am[4];
#pragma unroll
            for (int r = 0; r < 4; ++r) { float t = 0.f;
#pragma unroll
                for (int j = 0; j < 4; ++j) t = fmaxf(t, fmaxf(fmaxf(fabsf(v[r][j].x), fabsf(v[r][j].y)), fmaxf(fabsf(v[r][j].z), fabsf(v[r][j].w))));
                am[r] = t; }
#pragma unroll
            for (int o = 1; o < 64; o <<= 1) {
#pragma unroll
                for (int r = 0; r < 4; ++r) am[r] = fmaxf(am[r], __shfl_xor(am[r], o));
            }
#pragma unroll
            for (int r = 0; r < 4; ++r) {
                const float q = am[r] > 0.f ? 119.0f / am[r] : 1.0f;
                GAS unsigned* hi = (GAS unsigned*)(O8 + (size_t)(m0 + r) * 512); GAS unsigned* lo = (GAS unsigned*)(O8 + (WS_H2LO - WS_H2HI) + (size_t)(m0 + r) * 512);
#pragma unroll
                for (int j = 0; j < 4; ++j) {
                    unsigned h16 = 0u, l16 = 0u;
#pragma unroll
                    for (int k = 0; k < 4; ++k) { const int x = (int)rintf(v[r][j][k] * q); const int l4 = ((x + 8) & 15) - 8; const int h4 = (x - l4) >> 4; h16 |= ((unsigned)h4 & 15u) << (4 * k); l16 |= ((unsigned)l4 & 15u) << (4 * k); }
                    const unsigned ph = (unsigned)__shfl_xor((int)h16, 1), pl = (unsigned)__shfl_xor((int)l16, 1);
                    if (!(F.lane & 1)) { hi[32 * j + (F.lane >> 1)] = h16 | (ph << 16); lo[32 * j + (F.lane >> 1)] = l16 | (pl << 16); }
                }
                if (F.lane == 0) S8[m0 + r] = am[r] > 0.f ? am[r] * (1.0f / 119.0f) : 1.0f;
            }
        }
    }
}

__device__ __forceinline__ void quant_rows512(Frame& F, const bf16* SRC, unsigned char* DST, float* CS, int nrows) {
    for (int n = F.gw; n < nrows; n += F.NGW) {
        const v4u a = *(const GAS v4u*)(SRC + (size_t)n * 512 + 8 * F.lane);
        const float f[8] = {bflo(a.x), bfhi(a.x), bflo(a.y), bfhi(a.y), bflo(a.z), bfhi(a.z), bflo(a.w), bfhi(a.w)};
        float m = 0.f;
#pragma unroll
        for (int i = 0; i < 8; ++i) m = fmaxf(m, fabsf(f[i]));
#pragma unroll
        for (int o = 1; o < 64; o <<= 1) m = fmaxf(m, __shfl_xor(m, o));
        const float q = m > 0.f ? 127.0f / m : 1.0f;
        unsigned w[2] = {0u, 0u};
#pragma unroll
        for (int i = 0; i < 8; ++i) w[i >> 2] |= ((unsigned)(int)rintf(f[i] * q) & 255u) << (8 * (i & 3));
        *(GAS v2u*)(DST + (size_t)n * 512 + 8 * F.lane) = (v2u){w[0], w[1]};
        if (F.lane == 0) CS[n] = m > 0.f ? m * (1.0f / 127.0f) : 1.0f;
    }
}
__device__ __forceinline__ void quant_gate_weights(Frame& F, unsigned char* ws) {
    const bf16* WIN = (const bf16*)(ws + WS_WIN); unsigned char* WG8 = ws + WS_WG8; float* CS8 = (float*)(ws + WS_CS8);
#ifdef Z_I8
    constexpr int QW_ROWS = ZW, QW_FIRST = 0;
#else
    constexpr int QW_ROWS = 2048, QW_FIRST = 1536;
#endif
    for (int n = F.gw; n < QW_ROWS; n += F.NGW) {
        const v4u a = *(const GAS v4u*)(WIN + (size_t)(QW_FIRST + n) * 1024 + 16 * F.lane), c = *(const GAS v4u*)(WIN + (size_t)(QW_FIRST + n) * 1024 + 16 * F.lane + 8);
        const float f[16] = {bflo(a.x), bfhi(a.x), bflo(a.y), bfhi(a.y), bflo(a.z), bfhi(a.z), bflo(a.w), bfhi(a.w), bflo(c.x), bfhi(c.x), bflo(c.y), bfhi(c.y), bflo(c.z), bfhi(c.z), bflo(c.w), bfhi(c.w)};
        float m = 0.f;
#pragma unroll
        for (int i = 0; i < 16; ++i) m = fmaxf(m, fabsf(f[i]));
#pragma unroll
        for (int o = 1; o < 64; o <<= 1) m = fmaxf(m, __shfl_xor(m, o));
        const float q = m > 0.f ? 127.0f / m : 1.0f;
        unsigned w[4] = {0u, 0u, 0u, 0u};
#pragma unroll
        for (int i = 0; i < 16; ++i) w[i >> 2] |= ((unsigned)(int)rintf(f[i] * q) & 255u) << (8 * (i & 3));
        *(GAS v4u*)(WG8 + (size_t)n * 1024 + 16 * F.lane) = (v4u){w[0], w[1], w[2], w[3]};
        if (F.lane == 0) CS8[n] = m > 0.f ? m * (1.0f / 127.0f) : 1.0f;
    }
#ifdef BR_I8
    quant_rows512(F, (const bf16*)(ws + WS_WUP), ws + WS_W58, (float*)(ws + WS_CS5), 1024);
    quant_rows512(F, (const bf16*)(ws + WS_WUA), ws + WS_W78, (float*)(ws + WS_CS7), 1024);
#endif
}

namespace pg8 {
__device__ __forceinline__ float sigm(float v) { return __builtin_amdgcn_rcpf(1.0f + __builtin_amdgcn_exp2f(-1.4426950408889634f * v)); }
template <int MODE, bool I8IN = false> struct EpiB {
    static constexpr bool PERM = true, AFTER_DRAIN = false;
    bf16_t* O; int ldc; int sig_from; const float* colscale; const bf16_t* G; int ldg; int gcol0; int zp8_from; const float* rs8; const float* cs8;
    __device__ __forceinline__ void operator()(const f32x4 (&acc)[2][2][4][2], const Unit& u, int wr, int wc, int fr, int fq) const {
        const int row0 = u.pm * BM + wr * 64 + fr, col0 = u.pn * BM + wc * 32 + 8 * fq;
        const bool sg = (MODE == 0) && (u.pn >= sig_from);
        f32x4 cs[2][2];
        if (MODE == 1) {
#pragma unroll
            for (int bj = 0; bj < 2; ++bj)
#pragma unroll
                for (int n = 0; n < 2; ++n) cs[bj][n] = *(const f32x4*)(colscale + col0 + bj * HALF + 4 * n);
        }
#pragma unroll
        for (int ai = 0; ai < 2; ++ai)
#pragma unroll
            for (int m = 0; m < 4; ++m) { const size_t row = (size_t)(row0 + ai * HALF + m * 16); bf16_t* rowp = O + row * ldc + col0;
#pragma unroll
                for (int bj = 0; bj < 2; ++bj) { f32x4 v0 = acc[ai][bj][m][0], v1 = acc[ai][bj][m][1];
                    if (I8IN) { const float r8 = rs8[row]; const i32x4 a0 = __builtin_bit_cast(i32x4, v0), a1 = __builtin_bit_cast(i32x4, v1);
                        const f32x4 c80 = *(const f32x4*)(cs8 + col0 + bj * HALF), c81 = *(const f32x4*)(cs8 + col0 + bj * HALF + 4);
                        v0 = (f32x4){(float)a0[0], (float)a0[1], (float)a0[2], (float)a0[3]} * c80 * r8; v1 = (f32x4){(float)a1[0], (float)a1[1], (float)a1[2], (float)a1[3]} * c81 * r8; }
                    if (MODE == 0) { if (sg) { v0 = (f32x4){sigm(v0[0]), sigm(v0[1]), sigm(v0[2]), sigm(v0[3])}; v1 = (f32x4){sigm(v1[0]), sigm(v1[1]), sigm(v1[2]), sigm(v1[3])}; } }
                    if (MODE == 1) { v0 = v0 * cs[bj][0]; v1 = v1 * cs[bj][1]; }
#ifdef GATE_FP8
                    if (MODE == 2 || MODE == 3) {
                        typedef float f32x2g __attribute__((ext_vector_type(2)));
                        const unsigned long long g8 = *(const unsigned long long*)((const unsigned char*)G + row * (size_t)(ldg * 2) + 3072 + (gcol0 - 1536 + col0 + bj * HALF));
                        const unsigned glo = (unsigned)g8, ghi = (unsigned)(g8 >> 32);
                        const f32x2g a0 = __builtin_amdgcn_cvt_pk_f32_fp8(glo, false), a1 = __builtin_amdgcn_cvt_pk_f32_fp8(glo, true), a2 = __builtin_amdgcn_cvt_pk_f32_fp8(ghi, false), a3 = __builtin_amdgcn_cvt_pk_f32_fp8(ghi, true);
                        v0 = v0 * (f32x4){a0.x, a0.y, a1.x, a1.y}; v1 = v1 * (f32x4){a2.x, a2.y, a3.x, a3.y};
                    }
#else
                    if (MODE == 2 || MODE == 3) {
                        const u32x4 gw = *(const u32x4*)(G + row * ldg + gcol0 + col0 + bj * HALF);
                        v0 = v0 * (f32x4){__builtin_bit_cast(float, gw.x << 16), __builtin_bit_cast(float, gw.x & 0xffff0000u), __builtin_bit_cast(float, gw.y << 16), __builtin_bit_cast(float, gw.y & 0xffff0000u)};
                        v1 = v1 * (f32x4){__builtin_bit_cast(float, gw.z << 16), __builtin_bit_cast(float, gw.z & 0xffff0000u), __builtin_bit_cast(float, gw.w << 16), __builtin_bit_cast(float, gw.w & 0xffff0000u)};
                    }
#endif
#ifdef MIN_FP8
                    if (MODE == 3) {
                        typedef float f32x2g __attribute__((ext_vector_type(2)));
                        const unsigned long long o8 = *(const unsigned long long*)((const unsigned char*)G + row * (size_t)(ldg * 2) + 5120 + (col0 + bj * HALF));
                        const unsigned olo = (unsigned)o8, ohi = (unsigned)(o8 >> 32);
                        const f32x2g a0 = __builtin_amdgcn_cvt_pk_f32_fp8(olo, false), a1 = __builtin_amdgcn_cvt_pk_f32_fp8(olo, true), a2 = __builtin_amdgcn_cvt_pk_f32_fp8(ohi, false), a3 = __builtin_amdgcn_cvt_pk_f32_fp8(ohi, true);
                        v0 = v0 + (f32x4){a0.x, a0.y, a1.x, a1.y}; v1 = v1 + (f32x4){a2.x, a2.y, a3.x, a3.y};
                    }
                    if (MODE == 2) {
                        int lo = 0, hi = 0;
                        lo = __builtin_amdgcn_cvt_pk_fp8_f32(v0[0], v0[1], lo, false); lo = __builtin_amdgcn_cvt_pk_fp8_f32(v0[2], v0[3], lo, true);
                        hi = __builtin_amdgcn_cvt_pk_fp8_f32(v1[0], v1[1], hi, false); hi = __builtin_amdgcn_cvt_pk_fp8_f32(v1[2], v1[3], hi, true);
                        *(unsigned long long*)((unsigned char*)G + row * (size_t)(ldg * 2) + 5120 + (col0 + bj * HALF)) = (unsigned long long)(unsigned)lo | ((unsigned long long)(unsigned)hi << 32);
                        continue;
                    }
#else
                    if (MODE == 3) {
                        const u32x4 ow = *(const u32x4*)(rowp + bj * HALF);
                        v0 = v0 + (f32x4){__builtin_bit_cast(float, ow.x << 16), __builtin_bit_cast(float, ow.x & 0xffff0000u), __builtin_bit_cast(float, ow.y << 16), __builtin_bit_cast(float, ow.y & 0xffff0000u)};
                        v1 = v1 + (f32x4){__builtin_bit_cast(float, ow.z << 16), __builtin_bit_cast(float, ow.z & 0xffff0000u), __builtin_bit_cast(float, ow.w << 16), __builtin_bit_cast(float, ow.w & 0xffff0000u)};
                    }
#endif
#ifdef ZP_FP8
                    if (MODE == 0 && zp8_from > 0 && u.pn >= zp8_from && u.pn < sig_from) {
                        int lo = 0, hi = 0;
                        lo = __builtin_amdgcn_cvt_pk_fp8_f32(v0[0], v0[1], lo, false); lo = __builtin_amdgcn_cvt_pk_fp8_f32(v0[2], v0[3], lo, true);
                        hi = __builtin_amdgcn_cvt_pk_fp8_f32(v1[0], v1[1], hi, false); hi = __builtin_amdgcn_cvt_pk_fp8_f32(v1[2], v1[3], hi, true);
                        *(unsigned long long*)((unsigned char*)O + row * (size_t)(ldc * 2) + 6144 + (col0 - 256 * zp8_from + bj * HALF)) = (unsigned long long)(unsigned)lo | ((unsigned long long)(unsigned)hi << 32);
                        continue;
                    }
#endif
#ifdef GATE_FP8
                    if (MODE == 0 && sg) {
                        int lo = 0, hi = 0;
                        lo = __builtin_amdgcn_cvt_pk_fp8_f32(v0[0], v0[1], lo, false); lo = __builtin_amdgcn_cvt_pk_fp8_f32(v0[2], v0[3], lo, true);
                        hi = __builtin_amdgcn_cvt_pk_fp8_f32(v1[0], v1[1], hi, false); hi = __builtin_amdgcn_cvt_pk_fp8_f32(v1[2], v1[3], hi, true);
                        *(unsigned long long*)((unsigned char*)O + row * (size_t)(ldc * 2) + 3072 + (col0 - 1536 + bj * HALF)) = (unsigned long long)(unsigned)lo | ((unsigned long long)(unsigned)hi << 32);
                        continue;
                    }
#endif
                    u32x4 w; w.x = cvt_pk_bf16(v0[0], v0[1]); w.y = cvt_pk_bf16(v0[2], v0[3]); w.z = cvt_pk_bf16(v1[0], v1[1]); w.w = cvt_pk_bf16(v1[2], v1[3]);
                    *(u32x4*)(rowp + bj * HALF) = w; } }
    }
};
struct EpiRes {
    static constexpr bool PERM = false, AFTER_DRAIN = false;
    const float* X; float* C; const float* gate;
    __device__ __forceinline__ void operator()(const f32x4 (&acc)[2][2][4][2], const Unit& u, int wr, int wc, int fr, int fq) const {
        const int row0 = u.pm * BM + wr * 64 + fr, col0 = u.pn * BM + wc * 32 + 4 * fq;
        const int b = (u.pm * BM) >> 11;
        f32x4 gv[2][2];
#pragma unroll
        for (int bj = 0; bj < 2; ++bj)
#pragma unroll
            for (int n = 0; n < 2; ++n) gv[bj][n] = *(const f32x4*)(gate + b * 6144 + col0 + bj * HALF + n * 16);
#pragma unroll
        for (int ai = 0; ai < 2; ++ai)
#pragma unroll
            for (int m = 0; m < 4; ++m) { const size_t off = (size_t)(row0 + ai * HALF + m * 16) * 1024 + col0;
#pragma unroll
                for (int bj = 0; bj < 2; ++bj)
#pragma unroll
                    for (int n = 0; n < 2; ++n) { const f32x4 xv = *(const f32x4*)(X + off + bj * HALF + n * 16); *(f32x4*)(C + off + bj * HALF + n * 16) = xv + gv[bj][n] * acc[ai][bj][m][n]; } }
    }
};
struct EpiX1 {
    static constexpr bool PERM = true, AFTER_DRAIN = false;
    const float* X; bf16_t* O; const float* gate;
    __device__ __forceinline__ void operator()(const f32x4 (&acc)[2][2][4][2], const Unit& u, int wr, int wc, int fr, int fq) const {
        const int row0 = u.pm * BM + wr * 64 + fr, col0 = u.pn * BM + wc * 32 + 8 * fq;
        const int b = (u.pm * BM) >> 11;
        f32x4 gv[2][2];
#pragma unroll
        for (int bj = 0; bj < 2; ++bj)
#pragma unroll
            for (int n = 0; n < 2; ++n) gv[bj][n] = *(const f32x4*)(gate + b * 6144 + col0 + bj * HALF + 4 * n);
#pragma unroll
        for (int ai = 0; ai < 2; ++ai)
#pragma unroll
            for (int m = 0; m < 4; ++m) { const size_t off = (size_t)(row0 + ai * HALF + m * 16) * 1024 + col0;
#pragma unroll
                for (int bj = 0; bj < 2; ++bj) {
                    const f32x4 v0 = *(const f32x4*)(X + off + bj * HALF) + gv[bj][0] * acc[ai][bj][m][0], v1 = *(const f32x4*)(X + off + bj * HALF + 4) + gv[bj][1] * acc[ai][bj][m][1];
                    u32x4 w; w.x = cvt_pk_bf16(v0[0], v0[1]); w.y = cvt_pk_bf16(v0[2], v0[3]); w.z = cvt_pk_bf16(v1[0], v1[1]); w.w = cvt_pk_bf16(v1[2], v1[3]);
                    *(u32x4*)(O + off + bj * HALF) = w; } }
    }
};
struct EpiGate8 {
    static constexpr bool PERM = true, AFTER_DRAIN = false;
    unsigned char* Zb; int zpitch; const float* rs; const float* cs;
    __device__ __forceinline__ void operator()(const f32x4 (&acc)[2][2][4][2], const Unit& u, int wr, int wc, int fr, int fq) const {
        const int row0 = u.pm * BM + wr * 64 + fr, col0 = u.pn * BM + wc * 32 + 8 * fq;
        f32x4 cv[2][2];
#pragma unroll
        for (int bj = 0; bj < 2; ++bj)
#pragma unroll
            for (int n = 0; n < 2; ++n) cv[bj][n] = *(const f32x4*)(cs + col0 + bj * HALF + 4 * n);
#pragma unroll
        for (int ai = 0; ai < 2; ++ai)
#pragma unroll
            for (int m = 0; m < 4; ++m) { const size_t row = (size_t)(row0 + ai * HALF + m * 16); const float r = rs[row];
#pragma unroll
                for (int bj = 0; bj < 2; ++bj) {
                    const i32x4 a0 = __builtin_bit_cast(i32x4, acc[ai][bj][m][0]), a1 = __builtin_bit_cast(i32x4, acc[ai][bj][m][1]);
                    const f32x4 v0 = (f32x4){sigm((float)a0[0] * r * cv[bj][0][0]), sigm((float)a0[1] * r * cv[bj][0][1]), sigm((float)a0[2] * r * cv[bj][0][2]), sigm((float)a0[3] * r * cv[bj][0][3])};
                    const f32x4 v1 = (f32x4){sigm((float)a1[0] * r * cv[bj][1][0]), sigm((float)a1[1] * r * cv[bj][1][1]), sigm((float)a1[2] * r * cv[bj][1][2]), sigm((float)a1[3] * r * cv[bj][1][3])};
                    int lo = 0, hi = 0;
                    lo = __builtin_amdgcn_cvt_pk_fp8_f32(v0[0], v0[1], lo, false); lo = __builtin_amdgcn_cvt_pk_fp8_f32(v0[2], v0[3], lo, true);
                    hi = __builtin_amdgcn_cvt_pk_fp8_f32(v1[0], v1[1], hi, false); hi = __builtin_amdgcn_cvt_pk_fp8_f32(v1[2], v1[3], hi, true);
                    *(unsigned long long*)(Zb + row * (size_t)zpitch + 3072 + (col0 + bj * HALF)) = (unsigned long long)(unsigned)lo | ((unsigned long long)(unsigned)hi << 32);
                } }
    }
};
struct EpiZ8 {
    static constexpr bool PERM = true, AFTER_DRAIN = false;
    unsigned char* Zb; int zpitch; const float* rs; const float* cs;
    __device__ __forceinline__ void operator()(const f32x4 (&acc)[2][2][4][2], const Unit& u, int wr, int wc, int fr, int fq) const {
        const int row0 = u.pm * BM + wr * 64 + fr, col0 = u.pn * BM + wc * 32 + 8 * fq;
#pragma unroll
        for (int ai = 0; ai < 2; ++ai)
#pragma unroll
            for (int m = 0; m < 4; ++m) { const size_t row = (size_t)(row0 + ai * HALF + m * 16); const float r = rs[row];
#pragma unroll
                for (int bj = 0; bj < 2; ++bj) {
                    const i32x4 a0 = __builtin_bit_cast(i32x4, acc[ai][bj][m][0]), a1 = __builtin_bit_cast(i32x4, acc[ai][bj][m][1]);
                    const f32x4 c0 = *(const f32x4*)(cs + col0 + bj * HALF), c1 = *(const f32x4*)(cs + col0 + bj * HALF + 4);
                    f32x4 v0 = (f32x4){(float)a0[0], (float)a0[1], (float)a0[2], (float)a0[3]} * c0 * r, v1 = (f32x4){(float)a1[0], (float)a1[1], (float)a1[2], (float)a1[3]} * c1 * r;
                    if (u.pn < 4) {
                        u32x4 w; w.x = cvt_pk_bf16(v0[0], v0[1]); w.y = cvt_pk_bf16(v0[2], v0[3]); w.z = cvt_pk_bf16(v1[0], v1[1]); w.w = cvt_pk_bf16(v1[2], v1[3]);
                        *(u32x4*)(Zb + row * (size_t)zpitch + (size_t)(col0 + bj * HALF) * 2) = w;
                    } else {
                        if (u.pn >= 6) { v0 = (f32x4){sigm(v0[0]), sigm(v0[1]), sigm(v0[2]), sigm(v0[3])}; v1 = (f32x4){sigm(v1[0]), sigm(v1[1]), sigm(v1[2]), sigm(v1[3])}; }
                        int lo = 0, hi = 0;
                        lo = __builtin_amdgcn_cvt_pk_fp8_f32(v0[0], v0[1], lo, false); lo = __builtin_amdgcn_cvt_pk_fp8_f32(v0[2], v0[3], lo, true);
                        hi = __builtin_amdgcn_cvt_pk_fp8_f32(v1[0], v1[1], hi, false); hi = __builtin_amdgcn_cvt_pk_fp8_f32(v1[2], v1[3], hi, true);
                        const int boff = (u.pn >= 6) ? 3072 + (col0 - 1536 + bj * HALF) : 6144 + (col0 - 1024 + bj * HALF);
                        *(unsigned long long*)(Zb + row * (size_t)zpitch + boff) = (unsigned long long)(unsigned)lo | ((unsigned long long)(unsigned)hi << 32);
                    }
                } }
    }
};
}

__device__ __forceinline__ void p3_fixup(Frame& F, const Args& A) {
    unsigned char* ws = A.ws;
    bf16* Z = (bf16*)(ws + WS_Z); bf16* IKX = (bf16*)(ws + WS_IKX); bf16* KX = (bf16*)(ws + WS_KX); bf16* VX = (bf16*)(ws + WS_VX); float* IW = (float*)(ws + WS_IW); bf16* POOLED = (bf16*)(ws + WS_POOLED);
    const int lane = F.lane;
    const int rpw = T / F.NGW, m_begin = F.gw * rpw;
    for (int m0 = m_begin; m0 < m_begin + rpw; m0 += 2) {
        const int g = lane >> 4, w = 2 << g;
#ifdef ZP_FP8
        typedef float f32x2z __attribute__((ext_vector_type(2)));
        float sum[2][8], self[2][8]; int cnt[2];
#pragma unroll
        for (int r = 0; r < 2; ++r) {
            const int m = m0 + r, s = m & (SEQ - 1);
            const int lo = (s + 1 - w) > 0 ? (s + 1 - w) : 0; cnt[r] = s + 1 - lo;
            const unsigned char* zp8 = (const unsigned char*)Z + (size_t)m * (ZW * 2) + 6144 + 8 * lane;
#pragma unroll
            for (int j = 0; j < 8; ++j) { sum[r][j] = 0.f; self[r][j] = 0.f; }
#pragma unroll
            for (int i = 0; i < 16; ++i) {
                if (i < cnt[r]) { const v2u q = *(const GAS v2u*)(zp8 - (size_t)i * (ZW * 2));
                    const f32x2z a0 = __builtin_amdgcn_cvt_pk_f32_fp8(q.x, false), a1 = __builtin_amdgcn_cvt_pk_f32_fp8(q.x, true), a2 = __builtin_amdgcn_cvt_pk_f32_fp8(q.y, false), a3 = __builtin_amdgcn_cvt_pk_f32_fp8(q.y, true);
                    const float fv[8] = {a0.x, a0.y, a1.x, a1.y, a2.x, a2.y, a3.x, a3.y};
#pragma unroll
                    for (int j = 0; j < 8; ++j) { sum[r][j] += fv[j]; if (i == 0) self[r][j] = fv[j]; } }
            }
        }
#pragma unroll
        for (int r = 0; r < 2; ++r) {
            const float inv = 1.0f / (float)cnt[r];
#ifdef BR_I8
            float pv[8]; float am = 0.f;
#pragma unroll
            for (int j = 0; j < 8; ++j) { pv[j] = sum[r][j] * inv - self[r][j]; am = fmaxf(am, fabsf(pv[j])); }
#pragma unroll
            for (int o = 1; o < 64; o <<= 1) am = fmaxf(am, __shfl_xor(am, o));
            const float q8 = am > 0.f ? 127.0f / am : 1.0f;
            unsigned wlo = 0u, whi = 0u;
#pragma unroll
            for (int j = 0; j < 4; ++j) { wlo |= ((unsigned)(int)rintf(pv[j] * q8) & 255u) << (8 * j); whi |= ((unsigned)(int)rintf(pv[4 + j] * q8) & 255u) << (8 * j); }
            *(GAS v2u*)((unsigned char*)POOLED + (size_t)(m0 + r) * 512 + 8 * lane) = (v2u){wlo, whi};
            if (lane == 0) ((float*)(ws + WS_SPL))[m0 + r] = am > 0.f ? am * (1.0f / 127.0f) : 1.0f;
#else
            v4u o; o.x = pk2(sum[r][0] * inv - self[r][0], sum[r][1] * inv - self[r][1]); o.y = pk2(sum[r][2] * inv - self[r][2], sum[r][3] * inv - self[r][3]);
            o.z = pk2(sum[r][4] * inv - self[r][4], sum[r][5] * inv - self[r][5]); o.w = pk2(sum[r][6] * inv - self[r][6], sum[r][7] * inv - self[r][7]);
            *(GAS v4u*)(POOLED + (size_t)(m0 + r) * 512 + 8 * lane) = o;
#endif
        }
    }
#else
        float sum[2][8]; v4u self[2]; int cnt[2];
#pragma unroll
        for (int r = 0; r < 2; ++r) {
            const int m = m0 + r, s = m & (SEQ - 1);
            const int lo = (s + 1 - w) > 0 ? (s + 1 - w) : 0; cnt[r] = s + 1 - lo;
            const bf16* zp = Z + (size_t)m * ZW + ZC_ZP + 8 * lane;
#pragma unroll
            for (int j = 0; j < 8; ++j) sum[r][j] = 0.f;
            self[r] = (v4u){0u, 0u, 0u, 0u};
#pragma unroll
            for (int i = 0; i < 16; ++i) {
                if (i < cnt[r]) { const v4u q = *(const GAS v4u*)(zp - (size_t)i * ZW); if (i == 0) self[r] = q;
                    sum[r][0] += bflo(q.x); sum[r][1] += bfhi(q.x); sum[r][2] += bflo(q.y); sum[r][3] += bfhi(q.y); sum[r][4] += bflo(q.z); sum[r][5] += bfhi(q.z); sum[r][6] += bflo(q.w); sum[r][7] += bfhi(q.w); }
            }
        }
#pragma unroll
        for (int r = 0; r < 2; ++r) {
            const float inv = 1.0f / (float)cnt[r];
            v4u o; o.x = pk2(sum[r][0] * inv - bflo(self[r].x), sum[r][1] * inv - bfhi(self[r].x)); o.y = pk2(sum[r][2] * inv - bflo(self[r].y), sum[r][3] * inv - bfhi(self[r].y));
            o.z = pk2(sum[r][4] * inv - bflo(self[r].z), sum[r][5] * inv - bfhi(self[r].z)); o.w = pk2(sum[r][6] * inv - bflo(self[r].w), sum[r][7] * inv - bfhi(self[r].w));
            *(GAS v4u*)(POOLED + (size_t)(m0 + r) * 512 + 8 * lane) = o;
        }
    }
#endif
    for (int tile = F.gw; tile < T / 32; tile += F.NGW) {
        const bf16* vsrc = Z + (size_t)tile * 32 * ZW + ZC_V;
        bf16* vdst = VX + (size_t)tile * 2048;
#pragma unroll
        for (int i = 0; i < 4; ++i) {
            const int pi = lane + 64 * i, h = pi & 1, d = (pi >> 1) & 31, s = (pi >> 6) & 1, rt = pi >> 7;
            unsigned e[8];
#pragma unroll
            for (int j = 0; j < 8; ++j) { const int key = 16 * s + 8 * (j >> 2) + 4 * h + (j & 3); e[j] = vsrc[(size_t)key * ZW + d + 32 * rt]; }
            v4u o; o.x = e[0] | (e[1] << 16); o.y = e[2] | (e[3] << 16); o.z = e[4] | (e[5] << 16); o.w = e[6] | (e[7] << 16);
            *(GAS v4u*)(vdst + pi * 8) = o;
        }
    }
    float gqv[8];
#pragma unroll
    for (int j = 0; j < 8; ++j) gqv[j] = A.g_q[8 * (lane & 7) + j];
    const float gkv = A.g_k[lane], gikv = A.g_ik[lane];
    for (int m0 = m_begin; m0 < m_begin + rpw; m0 += 4) {
        v4u qr[4]; float kv[4], ikv[4], iwr[4];
#pragma unroll
        for (int r = 0; r < 4; ++r) { bf16* zr = Z + (size_t)(m0 + r) * ZW;
#ifndef QN_DSA
            qr[r] = *(GAS v4u*)(zr + 8 * lane);
#endif
            kv[r] = bf2f(zr[ZC_K + lane]); ikv[r] = bf2f(zr[ZC_IK + lane]); iwr[r] = bf2f(zr[ZC_IW + (lane & 3)]); }
        float sk[4], sik[4];
#pragma unroll
        for (int r = 0; r < 4; ++r) { sk[r] = kv[r] * kv[r]; sik[r] = ikv[r] * ikv[r]; }
#pragma unroll
        for (int o = 1; o < 64; o <<= 1) {
#pragma unroll
            for (int r = 0; r < 4; ++r) { sk[r] += __shfl_xor(sk[r], o); sik[r] += __shfl_xor(sik[r], o); }
        }
#pragma unroll
        for (int r = 0; r < 4; ++r) {
            const int m = m0 + r, b = m >> 11, s = m & (SEQ - 1);
            bf16* zr = Z + (size_t)m * ZW;
#ifndef QN_DSA
            float q[8] = {bflo(qr[r].x), bfhi(qr[r].x), bflo(qr[r].y), bfhi(qr[r].y), bflo(qr[r].z), bfhi(qr[r].z), bflo(qr[r].w), bfhi(qr[r].w)};
            float ss = 0.f;
#pragma unroll
            for (int j = 0; j < 8; ++j) ss += q[j] * q[j];
            ss += __shfl_xor(ss, 1); ss += __shfl_xor(ss, 2); ss += __shfl_xor(ss, 4);
            const float rstd = QSCALE / sqrtf(ss * (1.f / 64.f) + EPS);
#pragma unroll
            for (int j = 0; j < 8; ++j) q[j] = q[j] * rstd * gqv[j];
            v4u o; o.x = pk2(q[0], q[1]); o.y = pk2(q[2], q[3]); o.z = pk2(q[4], q[5]); o.w = pk2(q[6], q[7]);
            *(GAS v4u*)(zr + 8 * lane) = o;
#else
            (void)zr; (void)gqv;
#endif
            const float rk = 1.0f / sqrtf(sk[r] * (1.f / 64.f) + EPS), rik = 0.125f / sqrtf(sik[r] * (1.f / 64.f) + EPS);
            const size_t xo = ((((size_t)b * 64 + (s >> 5)) * 4 + (lane >> 4)) * 32 + (s & 31)) * 16 + (lane & 15);
            KX[xo] = (bf16)f2bf(kv[r] * rk * gkv);
            IKX[xo] = (bf16)f2bf(ikv[r] * rik * gikv);
            if (lane < 4) IW[(size_t)m * 4 + lane] = 0.5f * iwr[r];
        }
    }
}


__device__ __forceinline__ void p4_naive(Frame& F, const Args& A) {
    const bf16* POOLED = (const bf16*)(A.ws + WS_POOLED); bf16* PM = (bf16*)(A.ws + WS_PM);
    const int lane = F.lane, g = lane >> 4, d0 = 8 * (lane & 15);
    for (int m = F.gw; m < T; m += F.NGW) {
        float acc[8];
#pragma unroll
        for (int j = 0; j < 8; ++j) acc[j] = 0.f;
        for (int c = 0; c < 128; ++c) {
            const float p = bf2f(POOLED[(size_t)m * 512 + g * 128 + c]);
            const float* w = A.w_grp + ((size_t)g * 128 + c) * 128 + d0;
#pragma unroll
            for (int j = 0; j < 8; ++j) acc[j] = fmaf(p, w[j], acc[j]);
        }
        const float* sp = A.s_pool + g * 128 + d0;
        v4u o; o.x = pk2(acc[0] * sp[0], acc[1] * sp[1]); o.y = pk2(acc[2] * sp[2], acc[3] * sp[3]); o.z = pk2(acc[4] * sp[4], acc[5] * sp[5]); o.w = pk2(acc[6] * sp[6], acc[7] * sp[7]);
        *(GAS v4u*)(PM + (size_t)m * 512 + 8 * lane) = o;
    }
}


__device__ __forceinline__ void dbg_pool_check(Frame& F, const Args& A) {
    if (blockIdx.x != 0) return;
    unsigned char* ws = A.ws;
    const bf16* Z = (const bf16*)(ws + WS_Z); const bf16* POOLED = (const bf16*)(ws + WS_POOLED); const bf16* PM = (const bf16*)(ws + WS_PM); const bf16* MIN = (const bf16*)(ws + WS_MIN); const bf16* WUP = (const bf16*)(ws + WS_WUP);
    unsigned* flag = (unsigned*)(ws + WS_CTL) + 64;
    const int t = F.tid;
    const int r = (int)(((long long)t * 2579 + 17) % T), c = (t * 131 + 5) % 1024;
    unsigned f = 0u;
    { const int k = (t * 7) % 512; if (WUP[(size_t)c * 512 + k] != (bf16)f2bf(A.w_up[(size_t)k * 1024 + c])) f |= 8u; }
    const int n = c % 512, g = n >> 7, w = 2 << g, s = r & (SEQ - 1);
    { const int lo = (s + 1 - w) > 0 ? (s + 1 - w) : 0, cnt = s + 1 - lo; float sum = 0.f;
      for (int i = 0; i < cnt; ++i) sum += bf2f(Z[(size_t)(r - i) * ZW + ZC_ZP + n]);
      const float e = sum / (float)cnt - bf2f(Z[(size_t)r * ZW + ZC_ZP + n]), got = bf2f(POOLED[(size_t)r * 512 + n]);
      if (fabsf(got - e) > 0.02f * fabsf(e) + 0.02f) f |= 1u; }
    { float acc = 0.f; for (int cc = 0; cc < 128; ++cc) acc += bf2f(POOLED[(size_t)r * 512 + g * 128 + cc]) * A.w_grp[((size_t)g * 128 + cc) * 128 + (n & 127)];
      const float e = acc * A.s_pool[n], got = bf2f(PM[(size_t)r * 512 + n]);
      if (fabsf(got - e) > 0.02f * fabsf(e) + 0.02f) f |= 2u; }
    { float acc = 0.f; for (int k = 0; k < 512; ++k) acc += bf2f(PM[(size_t)r * 512 + k]) * A.w_up[(size_t)k * 1024 + c];
      const float e = acc * bf2f(Z[(size_t)r * ZW + ZC_GP + c]), got = bf2f(MIN[(size_t)r * 1024 + c]);
      if (fabsf(got - e) > 0.02f * fabsf(e) + 0.02f) f |= 4u; }
    if (f) atomicOr(flag, f);
}
__device__ __forceinline__ void dbg_min_check(Frame& F, const Args& A) {
    if (blockIdx.x != 0) return;
    unsigned char* ws = A.ws;
    const bf16* Z = (const bf16*)(ws + WS_Z); const bf16* PM = (const bf16*)(ws + WS_PM); const bf16* MIN = (const bf16*)(ws + WS_MIN); const bf16* ATT = (const bf16*)(ws + WS_ATT);
    unsigned* flag = (unsigned*)(ws + WS_CTL) + 64;
    const int t = F.tid;
    const int r = (int)(((long long)t * 2579 + 17) % T), c = (t * 131 + 5) % 1024;
    float a1 = 0.f, a2 = 0.f;
    for (int k = 0; k < 512; ++k) { a1 += bf2f(PM[(size_t)r * 512 + k]) * A.w_up[(size_t)k * 1024 + c]; a2 += bf2f(ATT[(size_t)r * 512 + k]) * A.w_ua[(size_t)k * 1024 + c]; }
    const float e = a1 * bf2f(Z[(size_t)r * ZW + ZC_GP + c]) + a2 * bf2f(Z[(size_t)r * ZW + ZC_GA + c]), got = bf2f(MIN[(size_t)r * 1024 + c]);
    if (fabsf(got - e) > 0.03f * fabsf(e) + 0.03f) atomicOr(flag, 32u);
}
__device__ __forceinline__ void dbg_report(const Args& A) {
    if (blockIdx.x == 0 && threadIdx.x == 0) {
        const unsigned f = *((volatile unsigned*)(A.ws + WS_CTL) + 64);
        float add = 0.f; if (f & 1u) add += 1e4f; if (f & 2u) add += 1e5f; if (f & 4u) add += 1e6f; if (f & 8u) add += 1e7f; if (f & 16u) add += 3e3f; if (f & 32u) add += 1e8f;
        A.out[0] += add;
    }
}

constexpr int DSA_HS = 288;
constexpr int DSA_HIST = 0, DSA_STG = 73728, DSA_STGB = 32768, DSA_MASK = DSA_STG + 65536, DSA_PRE = DSA_MASK + 16384, DSA_KREM = DSA_PRE + 256;
static_assert(64 * DSA_HS * 4 <= DSA_STG, "DSA histogram rows");
static_assert(DSA_KREM + 256 <= LDSCTL_OFF, "DSA LDS map");

__device__ __forceinline__ unsigned umax(unsigned a, unsigned b) { return a > b ? a : b; }
__device__ __forceinline__ unsigned umin(unsigned a, unsigned b) { return a < b ? a : b; }
#define GLDS16(gsrc, ldst) __builtin_amdgcn_global_load_lds((const unsigned*)(gsrc), (LAS unsigned*)(ldst), 16, 0, 0)
__device__ __forceinline__ void idx_scores(const LAS unsigned char* ikt, const bf16x8 (&aiq)[4], const f32x4 (&iwv)[4], int lane, unsigned (&u)[4]) {
    f32x16 acc;
#pragma unroll
    for (int r = 0; r < 16; ++r) acc[r] = 0.f;
    const LAS unsigned char* p = ikt + (lane & 31) * 32 + (lane >> 5) * 16;
#pragma unroll
    for (int ks = 0; ks < 4; ++ks) { const bf16x8 bik = *(const LAS bf16x8*)(p + ks * 1024); acc = __builtin_amdgcn_mfma_f32_32x32x16_bf16(aiq[ks], bik, acc, 0, 0, 0); }
#pragma unroll
    for (int j = 0; j < 4; ++j) {
        float s = fmaxf(acc[4 * j + 0], 0.f) * iwv[j][0];
        s = __builtin_fmaf(fmaxf(acc[4 * j + 1], 0.f), iwv[j][1], s);
        s = __builtin_fmaf(fmaxf(acc[4 * j + 2], 0.f), iwv[j][2], s);
        s = __builtin_fmaf(fmaxf(acc[4 * j + 3], 0.f), iwv[j][3], s);
        u[j] = (s == 0.f) ? 0x80000000u : ordf(s);
    }
}

__device__ __forceinline__ bool hist_scan(LAS unsigned* HIST, LAS unsigned* PRE, LAS unsigned* KREM, int wave, int lane) {
    bool exact = true;
    for (int i = 0; i < 8; ++i) {
        const int q = 8 * wave + i;
        const v4u c4 = *(const LAS v4u*)(HIST + q * DSA_HS + 252 - 4 * lane);
        const unsigned c0 = c4.w, c1 = c4.z, c2 = c4.y, c3 = c4.x, ssum = c0 + c1 + c2 + c3;
        unsigned incl = ssum;
#pragma unroll
        for (int o = 1; o < 64; o <<= 1) { const unsigned t = __shfl_up(incl, o); if (lane >= o) incl += t; }
        const unsigned k = KREM[q], pold = PRE[q];
        const unsigned long long bal = __ballot(incl >= k);
        const int L = bal ? (__ffsll((long long)bal) - 1) : 63;
        unsigned a = __shfl(incl - ssum, L);
        const unsigned d0 = __shfl(c0, L), d1 = __shfl(c1, L), d2 = __shfl(c2, L), d3 = __shfl(c3, L);
        int bin; unsigned dsel;
        if (a + d0 >= k) { bin = 255 - 4 * L; dsel = d0; }
        else { a += d0; if (a + d1 >= k) { bin = 254 - 4 * L; dsel = d1; } else { a += d1; if (a + d2 >= k) { bin = 253 - 4 * L; dsel = d2; } else { a += d2; bin = 252 - 4 * L; dsel = d3; } } }
        const unsigned pnew = (pold << 8) | (unsigned)bin;
        exact = exact && (dsel == k - a) && (pnew != 0u);
        if (lane == 0) { PRE[q] = pnew; KREM[q] = k - a; }
    }
    return __builtin_amdgcn_readfirstlane((int)exact) != 0;
}

template <int VAR> __device__ __forceinline__ void dsa_attend(const bf16* Z, const unsigned char* KX, const unsigned char* VX, bf16* ATT, LAS unsigned char* STG, LAS unsigned* MASKW,
                                                          int tq, size_t kblk0, int nsteps, int c, int lane, int wave, int tid, const float* GQ, float* SATp) {
        const int half = lane >> 5, l31 = lane & 31;
#ifdef NO_PRIO_DSA
        if (wave >> 2) __builtin_amdgcn_s_setprio(2);
#endif
        bf16x8 bq[2][4];
#pragma unroll
        for (int ct = 0; ct < 2; ++ct) { const bf16* qp = Z + (size_t)(tq + 4 * ct + (l31 >> 3)) * ZW + ZC_Q + (l31 & 7) * 64 + half * 8;
#pragma unroll
            for (int ks = 0; ks < 4; ++ks) bq[ct][ks] = *(const GAS bf16x8*)(qp + 16 * ks); }
#ifdef QN_DSA
#pragma unroll
        for (int ct = 0; ct < 2; ++ct) {
            float qf[4][8]; float ss = 0.f;
#pragma unroll
            for (int ks = 0; ks < 4; ++ks) { const v4u w = __builtin_bit_cast(v4u, bq[ct][ks]);
                qf[ks][0] = bflo(w.x); qf[ks][1] = bfhi(w.x); qf[ks][2] = bflo(w.y); qf[ks][3] = bfhi(w.y); qf[ks][4] = bflo(w.z); qf[ks][5] = bfhi(w.z); qf[ks][6] = bflo(w.w); qf[ks][7] = bfhi(w.w);
#pragma unroll
                for (int jj = 0; jj < 8; ++jj) ss += qf[ks][jj] * qf[ks][jj]; }
            ss = xhalf_sum(ss);
            const float rstd = QSCALE / sqrtf(ss * (1.f / 64.f) + EPS);
#pragma unroll
            for (int ks = 0; ks < 4; ++ks) { const f32x4 g0 = *(const GAS f32x4*)(GQ + 16 * ks + 8 * half), g1 = *(const GAS f32x4*)(GQ + 16 * ks + 8 * half + 4);
                v4u o; o.x = pk2(qf[ks][0] * rstd * g0.x, qf[ks][1] * rstd * g0.y); o.y = pk2(qf[ks][2] * rstd * g0.z, qf[ks][3] * rstd * g0.w);
                o.z = pk2(qf[ks][4] * rstd * g1.x, qf[ks][5] * rstd * g1.y); o.w = pk2(qf[ks][6] * rstd * g1.z, qf[ks][7] * rstd * g1.w);
                bq[ct][ks] = __builtin_bit_cast(bf16x8, o); }
        }
#endif
        f32x16 O[2][2];
#pragma unroll
        for (int ct = 0; ct < 2; ++ct)
#pragma unroll
            for (int rt = 0; rt < 2; ++rt)
#pragma unroll
                for (int r = 0; r < 16; ++r) O[ct][rt][r] = 0.f;
        float m_run[2] = {-1e30f, -1e30f}, l_run[2] = {0.f, 0.f};
        const int qsel = (lane >> 3) & 3;
        const bool all_on = (c < 4);
#ifdef ATT_BIG8
        constexpr int AB = 4; LAS unsigned char* const ABASE = STG - DSA_STG; constexpr int ABUFB = 65536;
        __syncthreads();
#else
#ifndef ATT_AB
#define ATT_AB 2
#endif
        constexpr int AB = ATT_AB; LAS unsigned char* const ABASE = STG; constexpr int ABUFB = DSA_STGB;
#endif
        constexpr int AVOFF = AB * 8192;
        const int nbig2 = (nsteps + AB - 1) / AB;
        { const int ns0 = nsteps < AB ? nsteps : AB;
#pragma unroll
          for (int k = 0; k < AB; ++k) if (k < ns0) { GLDS16(KX + kblk0 + (size_t)k * 8192 + (size_t)tid * 16, ABASE + k * 8192 + wave * 1024); GLDS16(VX + kblk0 + (size_t)k * 8192 + (size_t)tid * 16, ABASE + AVOFF + k * 8192 + wave * 1024); } }
        __syncthreads();
        for (int bs = 0; bs < nbig2; ++bs) {
            const int nsub = (nsteps - AB * bs) < AB ? (nsteps - AB * bs) : AB;
            const int nnext = (bs + 1 < nbig2) ? ((nsteps - AB * (bs + 1)) < AB ? (nsteps - AB * (bs + 1)) : AB) : 0;
#pragma unroll
            for (int k = 0; k < AB; ++k) if (VAR != 5 && k < nnext) { const size_t o = kblk0 + (size_t)(AB * (bs + 1) + k) * 8192 + (size_t)tid * 16; LAS unsigned char* nb = ABASE + ((bs + 1) & 1) * ABUFB + k * 8192 + wave * 1024; GLDS16(KX + o, nb); GLDS16(VX + o, nb + AVOFF); }
            const LAS unsigned char* buf = ABASE + (bs & 1) * ABUFB;
#pragma unroll 1
            for (int tl = 0; tl < 2 * nsub; ++tl) {
                const LAS unsigned char* kp = buf + (VAR == 4 ? 0 : tl) * 4096 + l31 * 32 + half * 16;
                bf16x8 kf[4];
#pragma unroll
                for (int ks = 0; ks < 4; ++ks) kf[ks] = *(const LAS bf16x8*)(kp + ks * 1024);
                const LAS unsigned char* vp = buf + AVOFF + (VAR == 4 ? 0 : tl) * 4096 + l31 * 32 + half * 16;
                bf16x8 vf[2][2];
#pragma unroll
                for (int rt = 0; rt < 2; ++rt)
#pragma unroll
                    for (int s = 0; s < 2; ++s) vf[rt][s] = *(const LAS bf16x8*)(vp + (rt * 2 + s) * 1024);
#ifdef ATT_S2
                f32x16 sacc2[2];
#pragma unroll
                for (int ct = 0; ct < 2; ++ct) {
#pragma unroll
                    for (int r = 0; r < 16; ++r) sacc2[ct][r] = 0.f;
#pragma unroll
                    for (int ks = 0; ks < 4; ++ks) sacc2[ct] = __builtin_amdgcn_mfma_f32_32x32x16_bf16(kf[ks], bq[ct][ks], sacc2[ct], 0, 0, 0);
                }
#endif
#pragma unroll
                for (int ct = 0; ct < 2; ++ct) {
#ifdef ATT_S2
                    const f32x16 sacc = sacc2[ct];
#else
                    f32x16 sacc;
#pragma unroll
                    for (int r = 0; r < 16; ++r) sacc[r] = 0.f;
#pragma unroll
                    for (int ks = 0; ks < (VAR == 2 ? 1 : 4); ++ks) sacc = __builtin_amdgcn_mfma_f32_32x32x16_bf16(kf[ks], bq[ct][ks], sacc, 0, 0, 0);
#endif
                    const unsigned Wq = all_on ? 0xFFFFFFFFu : MASKW[(8 * wave + 4 * ct + qsel) * 64 + 2 * AB * bs + tl];
                    const unsigned Wh = Wq >> (4 * half);
                    float mx = fmaxf(fmaxf(sacc[0], sacc[1]), sacc[2]);
#pragma unroll
                    for (int r = 3; r < 15; r += 2) mx = fmaxf(fmaxf(mx, sacc[r]), sacc[r + 1]);
                    mx = fmaxf(mx, sacc[15]);
                    mx = xhalf_max(mx);
                    const float m_new = fmaxf(m_run[ct], mx);
                    const float alpha = __builtin_amdgcn_exp2f(m_run[ct] - m_new);
                    m_run[ct] = m_new;
                    unsigned pw[8]; float psum = 0.f;
#pragma unroll
                    for (int i = 0; i < 8; ++i) {
                        const int r0 = 2 * i, b0 = (r0 & 3) + 8 * (r0 >> 2);
                        const unsigned k0 = (unsigned)__builtin_amdgcn_sbfe((int)Wh, b0, 1), k1 = (unsigned)__builtin_amdgcn_sbfe((int)Wh, b0 + 1, 1);
                        const unsigned keep = __builtin_amdgcn_perm(k1, k0, 0x05040100u);
                        const unsigned pk = (VAR == 1 ? pk2(sacc[r0] - m_new, sacc[r0 + 1] - m_new) : pk2(__builtin_amdgcn_exp2f(sacc[r0] - m_new), __builtin_amdgcn_exp2f(sacc[r0 + 1] - m_new))) & keep;
                        pw[i] = pk;
                        psum = __builtin_amdgcn_fdot2_f32_bf16(__builtin_bit_cast(bf16x2_t, pk), __builtin_bit_cast(bf16x2_t, 0x3F803F80u), psum, false);
                    }
                    l_run[ct] = l_run[ct] * alpha + psum;
                    if (__any(alpha != 1.0f)) {
#pragma unroll
                        for (int rt = 0; rt < 2; ++rt)
#pragma unroll
                            for (int r = 0; r < 16; ++r) O[ct][rt][r] *= alpha;
                    }
                    bf16x8 pb[2];
#pragma unroll
                    for (int s = 0; s < 2; ++s) pb[s] = __builtin_bit_cast(bf16x8, (v4u){pw[4 * s], pw[4 * s + 1], pw[4 * s + 2], pw[4 * s + 3]});
#pragma unroll
                    for (int rt = 0; rt < (VAR == 3 ? 1 : 2); ++rt)
#pragma unroll
                        for (int s = 0; s < (VAR == 3 ? 1 : 2); ++s) O[ct][rt] = __builtin_amdgcn_mfma_f32_32x32x16_bf16(vf[rt][s], pb[s], O[ct][rt], 0, 0, 0);
                }
            }
            if (VAR != 5) __syncthreads();
        }
        if (VAR == 5) __syncthreads();
#pragma unroll
        for (int ct = 0; ct < 2; ++ct) {
            const float inv = 1.0f / xhalf_sum(l_run[ct]);
#ifdef BR_I8
            float am = 0.f;
#pragma unroll
            for (int rt = 0; rt < 2; ++rt)
#pragma unroll
                for (int r = 0; r < 16; ++r) am = fmaxf(am, fabsf(O[ct][rt][r]));
            am *= inv;
            am = fmaxf(am, __shfl_xor(am, 1)); am = fmaxf(am, __shfl_xor(am, 2)); am = fmaxf(am, __shfl_xor(am, 4)); am = xhalf_max(am);
            const float q8 = am > 0.f ? 127.0f * inv / am : 1.0f;
            unsigned char* op8 = (unsigned char*)ATT + (size_t)(tq + 4 * ct + (l31 >> 3)) * 512 + (l31 & 7) * 64 + 4 * half;
#pragma unroll
            for (int rt = 0; rt < 2; ++rt)
#pragma unroll
                for (int g = 0; g < 4; ++g) {
                    const unsigned w = ((unsigned)(int)rintf(O[ct][rt][4 * g] * q8) & 255u) | (((unsigned)(int)rintf(O[ct][rt][4 * g + 1] * q8) & 255u) << 8) | (((unsigned)(int)rintf(O[ct][rt][4 * g + 2] * q8) & 255u) << 16) | (((unsigned)(int)rintf(O[ct][rt][4 * g + 3] * q8) & 255u) << 24);
                    *(GAS unsigned*)(op8 + 32 * rt + 8 * g) = w;
                }
            if ((l31 & 7) == 0 && half == 0) SATp[tq + 4 * ct + (l31 >> 3)] = am > 0.f ? am * (1.0f / 127.0f) : 1.0f;
#else
            bf16* op = ATT + (size_t)(tq + 4 * ct + (l31 >> 3)) * 512 + (l31 & 7) * 64 + 4 * half;
#pragma unroll
            for (int rt = 0; rt < 2; ++rt)
#pragma unroll
                for (int g = 0; g < 4; ++g) {
                    v2u w; w.x = pk2(O[ct][rt][4 * g] * inv, O[ct][rt][4 * g + 1] * inv); w.y = pk2(O[ct][rt][4 * g + 2] * inv, O[ct][rt][4 * g + 3] * inv);
                    *(GAS v2u*)(op + 32 * rt + 8 * g) = w;
                }
#endif
        }
#ifdef NO_PRIO_DSA
        __builtin_amdgcn_s_setprio(0);
#endif
}

__device__ __forceinline__ void dsa_phase(Frame& F, const Args& A) {
    unsigned char* ws = A.ws;
    const bf16* Z = (const bf16*)(ws + WS_Z); const unsigned char* IKX = ws + WS_IKX; const unsigned char* KX = ws + WS_KX; const unsigned char* VX = ws + WS_VX;
    const float* IW = (const float*)(ws + WS_IW); bf16* ATT = (bf16*)(ws + WS_ATT);
    const int lane = F.lane, wave = F.wave, tid = F.tid, half = lane >> 5, l31 = lane & 31;
    LAS unsigned* HIST = (LAS unsigned*)(F.lds + DSA_HIST);
    LAS unsigned* PRE = (LAS unsigned*)(F.lds + DSA_PRE);
    LAS unsigned* KREM = (LAS unsigned*)(F.lds + DSA_KREM);
    LAS unsigned* MASKW = (LAS unsigned*)(F.lds + DSA_MASK);
    LAS unsigned char* STG = F.lds + DSA_STG;

    for (int P = F.vcu; P < 512; P += F.G) {
      for (int side = 0; side < 2; ++side) {
        const int b = P >> 4, c = side ? 31 - (P & 15) : (P & 15);
        const int nsteps = c + 1;
        const int tq = b * SEQ + 64 * c + 8 * wave;
        const size_t kblk0 = (size_t)b * 64 * 4096;
#ifndef DSA_REP_SEL
#define DSA_REP_SEL 1
#endif
#ifndef DSA_REP_ATT
#define DSA_REP_ATT 1
#endif
        for (int rs_ = 0; rs_ < DSA_REP_SEL; ++rs_)
        if (c >= 4) {
            const int v_ = F.vcu;
            const size_t scb = v_ < 128 ? WS_PM + (size_t)v_ * (512 * 1024) : v_ < 172 ? 42 * MiB + (size_t)(v_ - 128) * (512 * 1024) : v_ < 220 ? 72 * MiB + (size_t)(v_ - 172) * (512 * 1024) : 104 * MiB + (size_t)(v_ - 220) * (512 * 1024);
            unsigned* SC = (unsigned*)(ws + scb) + (size_t)(wave * 64 + lane) * 4;
            if (lane < 8) { PRE[8 * wave + lane] = 0u; KREM[8 * wave + lane] = 256u; }
#ifndef DSA_REP_P0
#define DSA_REP_P0 1
#endif
            for (int rp0_ = 0; rp0_ < DSA_REP_P0; ++rp0_) {
#pragma unroll
            for (int i = 0; i < 8; ++i) *(LAS v4u*)(HIST + (wave * 8 + i) * DSA_HS + lane * 4) = (v4u){0u, 0u, 0u, 0u};
            {
                bf16x8 aiq[4];
                { const bf16* zq = Z + (size_t)(tq + (l31 >> 2)) * ZW + ZC_IQ + (l31 & 3) * 64 + half * 8;
#pragma unroll
                  for (int ks = 0; ks < 4; ++ks) aiq[ks] = *(const GAS bf16x8*)(zq + 16 * ks); }
                f32x4 iwv[4];
#pragma unroll
                for (int j = 0; j < 4; ++j) iwv[j] = *(const GAS f32x4*)(IW + (size_t)(tq + 2 * j + half) * 4);
                const int nbig = (nsteps + 3) >> 2;
                { const int ns0 = nsteps < 4 ? nsteps : 4;
#pragma unroll
                  for (int k = 0; k < 4; ++k) if (k < ns0) GLDS16(IKX + kblk0 + (size_t)k * 8192 + (size_t)tid * 16, STG + k * 8192 + wave * 1024); }
                __syncthreads();
                unsigned WB = 0u; unsigned long long pkc[4] = {0ull, 0ull, 0ull, 0ull};
                for (int bs = 0; bs < nbig; ++bs) {
                    const int nsub = (nsteps - 4 * bs) < 4 ? (nsteps - 4 * bs) : 4;
                    const int nnext = (bs + 1 < nbig) ? ((nsteps - 4 * (bs + 1)) < 4 ? (nsteps - 4 * (bs + 1)) : 4) : 0;
#pragma unroll
                    for (int k = 0; k < 4; ++k) if (k < nnext) GLDS16(IKX + kblk0 + (size_t)(4 * (bs + 1) + k) * 8192 + (size_t)tid * 16, STG + ((bs + 1) & 1) * DSA_STGB + k * 8192 + wave * 1024);
                    const LAS unsigned char* buf = STG + (bs & 1) * DSA_STGB;
                    for (int sb = 0; sb < nsub; ++sb) {
                        unsigned uu[2][4];
                        idx_scores(buf + sb * 8192, aiq, iwv, lane, uu[0]);
                        idx_scores(buf + sb * 8192 + 4096, aiq, iwv, lane, uu[1]);
                        if (bs == 0 && sb == 0) {
                            unsigned fm = 0u;
#pragma unroll
                            for (int t2 = 0; t2 < 2; ++t2)
#pragma unroll
                                for (int j = 0; j < 4; ++j) { const unsigned u = uu[t2][j]; fm = umax(fm, umax(u >> 24, (~u) >> 24)); }
#pragma unroll
                            for (int o = 1; o < 64; o <<= 1) fm = umax(fm, (unsigned)__shfl_xor((int)fm, o));
                            WB = (unsigned)__builtin_amdgcn_readfirstlane((int)fm) - 3u;
                        }
#pragma unroll
                        for (int t2 = 0; t2 < 2; ++t2) {
                            const int tile = 8 * bs + 2 * sb + t2;
                            *(GAS v4u*)(SC + (size_t)tile * 2048) = (v4u){uu[t2][0], uu[t2][1], uu[t2][2], uu[t2][3]};
#pragma unroll
                            for (int j = 0; j < 4; ++j) {
                                const unsigned u = uu[t2][j], bin = u >> 24, nb = (~u) >> 24, slot = umax(bin, nb) - WB;
                                if (slot < 4u) pkc[j] += 1ull << (8u * slot + ((nb >> 7) << 5));
                                else __hip_atomic_fetch_add(HIST + (8 * wave + 2 * j + half) * DSA_HS + bin, 1u, __ATOMIC_RELAXED, __HIP_MEMORY_SCOPE_WORKGROUP);
                            }
                        }
                    }
                    __syncthreads();
                }
#pragma unroll
                for (int j = 0; j < 4; ++j) {
                    const unsigned lo = (unsigned)pkc[j], hi = (unsigned)(pkc[j] >> 32);
                    unsigned f[4] = {lo & 0x00FF00FFu, (lo >> 8) & 0x00FF00FFu, hi & 0x00FF00FFu, (hi >> 8) & 0x00FF00FFu};
#pragma unroll
                    for (int o = 1; o < 32; o <<= 1)
#pragma unroll
                        for (int i = 0; i < 4; ++i) f[i] += (unsigned)__shfl_xor((int)f[i], o);
                    const unsigned sc8[8] = {f[0] & 0xFFFFu, f[1] & 0xFFFFu, f[0] >> 16, f[1] >> 16, f[2] & 0xFFFFu, f[3] & 0xFFFFu, f[2] >> 16, f[3] >> 16};
                    unsigned mine = 0u;
#pragma unroll
                    for (int s8 = 0; s8 < 8; ++s8) mine = (l31 == s8) ? sc8[s8] : mine;
                    const unsigned fbv = WB + (unsigned)(l31 & 3), bin = (l31 & 4) ? (255u - fbv) : fbv;
                    if (l31 < 8 && mine != 0u) __hip_atomic_fetch_add(HIST + (8 * wave + 2 * j + half) * DSA_HS + (bin & 255u), mine, __ATOMIC_RELAXED, __HIP_MEMORY_SCOPE_WORKGROUP);
                }
            }
            }
            bool exact = hist_scan(HIST, PRE, KREM, wave, lane);
            for (int pass = 1; pass < 5; ++pass) {
                if (pass < 4 && exact) {
                    if (lane < 8) { const int q = 8 * wave + lane; PRE[q] = (PRE[q] << (8 * (4 - pass))) - 1u; KREM[q] = 0u; }
                    pass = 4;
                }
                unsigned pre[4], krem[4], eqrun[4];
#pragma unroll
                for (int j = 0; j < 4; ++j) { pre[j] = PRE[8 * wave + 2 * j + half]; krem[j] = KREM[8 * wave + 2 * j + half]; eqrun[j] = 0u; }
                if (pass < 4) {
#pragma unroll
                    for (int i = 0; i < 8; ++i) *(LAS v4u*)(HIST + (wave * 8 + i) * DSA_HS + lane * 4) = (v4u){0u, 0u, 0u, 0u};
                }
                const int sh_hi = 32 - 8 * pass, sh_lo = 24 - 8 * pass;
                const unsigned lmask = (1u << l31) - 1u;
                {
                    const int ntiles = 2 * nsteps;
                    v4u nx[4];
#pragma unroll
                    for (int k = 0; k < 4; ++k) { nx[k] = (v4u){0u, 0u, 0u, 0u}; if (k < ntiles) nx[k] = *(const GAS v4u*)(SC + (size_t)k * 2048); }
                    for (int t0 = 0; t0 < ntiles; t0 += 4) {
                        v4u cur[4];
#pragma unroll
                        for (int k = 0; k < 4; ++k) { cur[k] = nx[k]; if (t0 + 4 + k < ntiles) nx[k] = *(const GAS v4u*)(SC + (size_t)(t0 + 4 + k) * 2048); }
#pragma unroll
                        for (int k = 0; k < 4; ++k) {
                            const int tile = t0 + k;
                            if (tile < ntiles) {
                                const unsigned u4[4] = {cur[k].x, cur[k].y, cur[k].z, cur[k].w};
                                if (pass < 4) {
#pragma unroll
                                    for (int j = 0; j < 4; ++j) {
                                        const unsigned u = u4[j];
                                        if ((u >> sh_hi) == pre[j]) __hip_atomic_fetch_add(HIST + (8 * wave + 2 * j + half) * DSA_HS + ((u >> sh_lo) & 255u), 1u, __ATOMIC_RELAXED, __HIP_MEMORY_SCOPE_WORKGROUP);
                                    }
                                } else {
#pragma unroll
                                    for (int j = 0; j < 4; ++j) {
                                        const unsigned u = u4[j];
                                        const bool e = (u == pre[j]);
                                        const unsigned long long em = __ballot(e);
                                        const unsigned mine = half ? (unsigned)(em >> 32) : (unsigned)em;
                                        const unsigned rank = eqrun[j] + __popc(mine & lmask);
                                        eqrun[j] += __popc(mine);
                                        const bool sel = (u > pre[j]) || (e && rank < krem[j]);
                                        const unsigned long long sm = __ballot(sel);
                                        if (lane == 0) { MASKW[(8 * wave + 2 * j) * 64 + tile] = (unsigned)sm; MASKW[(8 * wave + 2 * j + 1) * 64 + tile] = (unsigned)(sm >> 32); }
                                    }
                                }
                            }
                        }
                    }
                }
                if (pass < 4) exact = hist_scan(HIST, PRE, KREM, wave, lane);
            }
#ifdef DBG_SEL
            for (int i = 0; i < 8; ++i) {
                unsigned v = (lane < 2 * nsteps) ? (unsigned)__popc(MASKW[(8 * wave + i) * 64 + lane]) : 0u;
#pragma unroll
                for (int o = 1; o < 64; o <<= 1) v += (unsigned)__shfl_xor((int)v, o);
                if (lane == 0 && v != 256u) atomicOr((unsigned*)(ws + WS_CTL) + 64, 1u);
            }
#endif
        }

#if DSA_REP_ATT == 2
        dsa_attend<ATT_VARIANT>(Z, KX, VX, ATT, STG, MASKW, tq, kblk0, nsteps, c, lane, wave, tid, A.g_q, (float*)(ws + WS_SAT));
#endif
        dsa_attend<0>(Z, KX, VX, ATT, STG, MASKW, tq, kblk0, nsteps, c, lane, wave, tid, A.g_q, (float*)(ws + WS_SAT));
      }
    }
}

template <int BASE, int N> __device__ __forceinline__ void sort16(float (&v)[N]) {
    constexpr int NCE = 60;
    constexpr unsigned char CI[NCE] = {0,1,2,3,4,5,7,9, 0,1,2,3,6,8,10,11, 0,2,4,6,7,10,12,14, 0,1,4,5,6,8,12,13, 1,3,4,5,8,9,13, 1,2,5,7,9,11, 2,3,9,11, 3,6,7,10, 3,5,7,9,11, 6,8};
    constexpr unsigned char CJ[NCE] = {13,12,15,14,8,6,11,10, 5,7,9,4,13,14,15,12, 1,3,5,8,9,11,13,15, 2,3,10,11,7,9,14,15, 2,12,6,7,10,11,14, 4,6,8,10,13,14, 4,6,12,13, 5,8,9,12, 4,6,8,10,12, 7,9};
#pragma unroll
    for (int c = 0; c < NCE; ++c) { const float x = v[BASE + CI[c]], y = v[BASE + CJ[c]]; v[BASE + CI[c]] = fmaxf(x, y); v[BASE + CJ[c]] = fminf(x, y); }
}
template <int A0, int B0, int N> __device__ __forceinline__ void merge16(float (&v)[N]) {
#pragma unroll
    for (int i = 0; i < 16; ++i) v[A0 + i] = fmaxf(v[A0 + i], v[B0 + 15 - i]);
#pragma unroll
    for (int j = 8; j > 0; j >>= 1)
#pragma unroll
        for (int i = 0; i < 16; ++i) { const int l = i ^ j; if (l > i) { const float x = v[A0 + i], y = v[A0 + l]; v[A0 + i] = fmaxf(x, y); v[A0 + l] = fminf(x, y); } }
}
__device__ __forceinline__ void top16_of64(float (&v)[64]) {
    sort16<0, 64>(v); sort16<16, 64>(v); sort16<32, 64>(v); sort16<48, 64>(v);
    merge16<0, 16, 64>(v); merge16<32, 48, 64>(v); merge16<0, 32, 64>(v);
}
__device__ __forceinline__ void peer_half(const bf16x8 (&bqf)[4], const LAS unsigned char* skl, int p, int lane, float (&lst)[16]) {
    const int half = lane >> 5, l31 = lane & 31;
    float v[64];
    const LAS unsigned char* ap = skl + p * 16384 + l31 * 32 + half * 16;
#pragma unroll
    for (int rt = 0; rt < 4; ++rt) {
        f32x16 acc;
#pragma unroll
        for (int r = 0; r < 16; ++r) acc[r] = 0.f;
#pragma unroll
        for (int ks = 0; ks < 4; ++ks) { const bf16x8 af = *(const LAS bf16x8*)(ap + (rt * 4 + ks) * 1024); acc = __builtin_amdgcn_mfma_f32_32x32x16_bf16(af, bqf[ks], acc, 0, 0, 0); }
#pragma unroll
        for (int r = 0; r < 16; ++r) { const unsigned kidx = rt * 32 + (r & 3) + 8 * (r >> 2) + 4 * half; v[rt * 16 + r] = __uint_as_float((__float_as_uint(acc[r]) & ~127u) | (127u - kidx)); }
    }
    top16_of64(v);
    float both[32];
#pragma unroll
    for (int i = 0; i < 16; ++i) { both[i] = v[i]; both[16 + i] = __shfl_xor(v[i], 32); }
    merge16<0, 16, 32>(both);
#pragma unroll
    for (int i = 0; i < 16; ++i) lst[i] = both[i];
}
__device__ __forceinline__ void peer_route(Frame& F, const Args& A) {
    unsigned char* ws = A.ws;
    const bf16* PQ = (const bf16*)(ws + WS_PQ); const bf16* SK = (const bf16*)(ws + WS_SK); int* EIDX = (int*)(ws + WS_EIDX); float* EGATE = (float*)(ws + WS_EGATE);
    const int lane = F.lane;
    LAS unsigned* KL = (LAS unsigned*)(F.lds + F.wave * 8192);
    LAS unsigned char* SKL = F.lds + 65536;
    for (int hp = 0; hp < 4; ++hp) {
        __syncthreads();
#pragma unroll
        for (int i = 0; i < 8; ++i) {
            const int ch = F.tid + 512 * i, c8 = ch & 7, key = (ch >> 3) & 127, p = (ch >> 10) & 1, hh = ch >> 11;
            const v4u r = *(const GAS v4u*)(SK + ((size_t)((2 * hp + hh) * 2 + p) * 128 + key) * 64 + 8 * c8);
            *(LAS v4u*)(SKL + hh * 32768 + ((p * 4 + (key >> 5)) * 4 + (c8 >> 1)) * 1024 + (key & 31) * 32 + (c8 & 1) * 16) = r;
        }
        __syncthreads();
      for (int tt = F.gw * (T / 32 / F.NGW); tt < (F.gw + 1) * (T / 32 / F.NGW); ++tt) {
        const int token = tt * 32 + (lane & 31);
        float l0[16], l1[16];
        {
            const bool hi = lane >= 32;
            const bf16* qa = PQ + (size_t)token * 1024 + (2 * hp) * 128 + (lane >> 5) * 8; const bf16* qb = qa + 128;
            bf16x8 bq[4]; float t[16];
#pragma unroll
            for (int ks = 0; ks < 4; ++ks) bq[ks] = *(const GAS bf16x8*)(qa + 16 * ks);
            peer_half(bq, SKL, 0, lane, l0);
#pragma unroll
            for (int ks = 0; ks < 4; ++ks) bq[ks] = *(const GAS bf16x8*)(qb + 16 * ks);
            peer_half(bq, SKL + 32768, 0, lane, t);
#pragma unroll
            for (int i = 0; i < 16; ++i) l0[i] = hi ? t[i] : l0[i];
#pragma unroll
            for (int ks = 0; ks < 4; ++ks) bq[ks] = *(const GAS bf16x8*)(qa + 64 + 16 * ks);
            peer_half(bq, SKL, 1, lane, l1);
#pragma unroll
            for (int ks = 0; ks < 4; ++ks) bq[ks] = *(const GAS bf16x8*)(qb + 64 + 16 * ks);
            peer_half(bq, SKL + 32768, 1, lane, t);
#pragma unroll
            for (int i = 0; i < 16; ++i) l1[i] = hi ? t[i] : l1[i];
        }
        const int h = 2 * hp + (lane >> 5);
        float s0[16], s1[16];
#pragma unroll
        for (int i = 0; i < 16; ++i) { const unsigned b0 = __float_as_uint(l0[i]), b1 = __float_as_uint(l1[i]); s0[i] = __uint_as_float(b0 & ~127u); s1[i] = __uint_as_float(b1 & ~127u); KL[i * 64 + lane] = 127u - (b0 & 127u); KL[(16 + i) * 64 + lane] = 127u - (b1 & 127u); }
        float cs[64]; int nc = 0;
#pragma unroll
        for (int r = 0; r < 64; ++r) cs[r] = -3.0e38f;
#pragma unroll
        for (int i = 0; i < 16; ++i)
#pragma unroll
            for (int j = 0; j < 16; ++j)
                if ((i + 1) * (j + 1) <= 16) { cs[nc] = __uint_as_float((__float_as_uint(s0[i] + s1[j]) & ~255u) | (255u - (unsigned)(i * 16 + j))); ++nc; }
        top16_of64(cs);
        float ev[16]; unsigned be[16]; float sum = 0.f; const float mx = __uint_as_float(__float_as_uint(cs[0]) & ~255u);
#pragma unroll
        for (int i = 0; i < 16; ++i) {
            const unsigned cb = __float_as_uint(cs[i]); ev[i] = __expf(__uint_as_float(cb & ~255u) - mx); sum += ev[i];
            const unsigned fi = 255u - (cb & 255u);
            be[i] = KL[(fi >> 4) * 64 + lane] * 128u + KL[(16 + (fi & 15u)) * 64 + lane];
        }
        const float inv = 1.0f / sum;
        {
            int* ep = EIDX + (size_t)token * 128 + h * 16; float* gp = EGATE + (size_t)token * 128 + h * 16;
#pragma unroll
            for (int i = 0; i < 4; ++i) {
#ifndef EIDX16
                *(GAS v4u*)(ep + 4 * i) = (v4u){be[4 * i], be[4 * i + 1], be[4 * i + 2], be[4 * i + 3]};
#endif
                *(GAS f32x4*)(gp + 4 * i) = (f32x4){ev[4 * i] * inv, ev[4 * i + 1] * inv, ev[4 * i + 2] * inv, ev[4 * i + 3] * inv};
            }
#ifdef EIDX16
            {
                GAS v4u* e16 = (GAS v4u*)((unsigned short*)EIDX + (size_t)token * 128 + h * 16);
                e16[0] = (v4u){(unsigned)be[0] | ((unsigned)be[1] << 16), (unsigned)be[2] | ((unsigned)be[3] << 16), (unsigned)be[4] | ((unsigned)be[5] << 16), (unsigned)be[6] | ((unsigned)be[7] << 16)};
                e16[1] = (v4u){(unsigned)be[8] | ((unsigned)be[9] << 16), (unsigned)be[10] | ((unsigned)be[11] << 16), (unsigned)be[12] | ((unsigned)be[13] << 16), (unsigned)be[14] | ((unsigned)be[15] << 16)};
            }
#endif
        }
        LDS_WAIT(); asm volatile("" ::: "memory");
      }
    }
}

__device__ __forceinline__ float dot2bf(unsigned w, unsigned x, float acc) { return __builtin_amdgcn_fdot2_f32_bf16(__builtin_bit_cast(bf16x2_t, w), __builtin_bit_cast(bf16x2_t, x), acc, false); }
__device__ __forceinline__ float dot8(v4u a, v4u b, float acc) {
    const unsigned a0 = a.x, a1 = a.y, a2 = a.z, a3 = a.w, b0 = b.x, b1 = b.y, b2 = b.z, b3 = b.w;
    return dot2bf(a3, b3, dot2bf(a2, b2, dot2bf(a1, b1, dot2bf(a0, b0, acc))));
}
__device__ __forceinline__ float dot8f4(unsigned q, v4u h, float acc) {
    const unsigned h0 = h.x, h1 = h.y, h2 = h.z, h3 = h.w;
    acc = __builtin_amdgcn_fdot2_f32_bf16(__builtin_amdgcn_cvt_scalef32_pk_bf16_fp4(q, 1.0f, 0), __builtin_bit_cast(bf16x2_t, h0), acc, false);
    acc = __builtin_amdgcn_fdot2_f32_bf16(__builtin_amdgcn_cvt_scalef32_pk_bf16_fp4(q, 1.0f, 1), __builtin_bit_cast(bf16x2_t, h1), acc, false);
    acc = __builtin_amdgcn_fdot2_f32_bf16(__builtin_amdgcn_cvt_scalef32_pk_bf16_fp4(q, 1.0f, 2), __builtin_bit_cast(bf16x2_t, h2), acc, false);
    acc = __builtin_amdgcn_fdot2_f32_bf16(__builtin_amdgcn_cvt_scalef32_pk_bf16_fp4(q, 1.0f, 3), __builtin_bit_cast(bf16x2_t, h3), acc, false);
    return acc;
}
typedef float f32x2v __attribute__((ext_vector_type(2)));
__device__ __forceinline__ void peer_gather(Frame& F, const Args& A, const bool dummy) {
    unsigned char* ws = A.ws;
    const bf16* H2 = (const bf16*)(ws + WS_H); const unsigned char* U4 = ws + WS_U; const unsigned char* V4 = ws + WS_V;
    const float* SU = (const float*)(ws + WS_SU); const float* SV = (const float*)(ws + WS_SV);
    const int* EIDX = (const int*)(ws + WS_EIDX); const float* EGATE = (const float*)(ws + WS_EGATE); const float* ADA = (const float*)(ws + WS_ADA);
    const int lane = F.lane, grp = lane >> 3, i8 = lane & 7;
    LAS unsigned* WSM = (LAS unsigned*)(F.lds + F.wave * 1024);
    for (int n = F.gw; n < T; n += F.NGW) {
        const int b = n >> 11;
        v4u hh[4][4];
        { const bf16* hp = H2 + (size_t)n * 1024 + 32 * i8;
#pragma unroll
          for (int t = 0; t < 4; ++t)
#pragma unroll
              for (int k = 0; k < 4; ++k) hh[t][k] = *(const GAS v4u*)(hp + 256 * t + 8 * k); }
#pragma unroll 4
        for (int bb = 0; bb < 16; ++bb) {
            const int slot = bb * 8 + grp;
            const int eid = EIDX[(size_t)n * 128 + slot]; const float gt = EGATE[(size_t)n * 128 + slot];
            const unsigned char* up = U4 + (size_t)eid * 512 + 16 * i8;
            v4u q[4];
#pragma unroll
            for (int t = 0; t < 4; ++t) q[t] = *(const GAS v4u*)(up + 128 * t);
            const float su = SU[eid], sv = SV[eid];
            float d0 = 0.f, d1 = 0.f;
#pragma unroll
            for (int t = 0; t < 4; ++t) {
                const unsigned q0 = q[t].x, q1 = q[t].y, q2 = q[t].z, q3 = q[t].w;
                d0 = dot8f4(q0, hh[t][0], d0); d1 = dot8f4(q1, hh[t][1], d1); d0 = dot8f4(q2, hh[t][2], d0); d1 = dot8f4(q3, hh[t][3], d1);
            }
#ifdef GATHER_DUP_U
            { float e0 = 0.f, e1 = 0.f;
#pragma unroll
              for (int t = 0; t < 4; ++t) { const unsigned q0 = q[t].x ^ 0x88888888u, q1 = q[t].y ^ 0x88888888u, q2 = q[t].z ^ 0x88888888u, q3 = q[t].w ^ 0x88888888u;
                e0 = dot8f4(q0, hh[t][0], e0); e1 = dot8f4(q1, hh[t][1], e1); e0 = dot8f4(q2, hh[t][2], e0); e1 = dot8f4(q3, hh[t][3], e1); }
              d0 = 0.5f * (d0 - e0); d1 = 0.5f * (d1 - e1); }
#endif
            float dot = d0 + d1;
            dot += __shfl_xor(dot, 1); dot += __shfl_xor(dot, 2); dot += __shfl_xor(dot, 4);
            dot *= su;
            const float act = 0.5f * dot * (1.0f + erff(dot * 0.70710678118654752f));
            if (i8 == 0) { WSM[2 * slot] = (unsigned)eid; WSM[2 * slot + 1] = __float_as_uint(gt * act * sv); }
        }
        LDS_WAIT(); asm volatile("" ::: "memory");
        f32x2v acc[8];
#pragma unroll
        for (int j = 0; j < 8; ++j) acc[j] = (f32x2v){0.f, 0.f};
#pragma unroll 2
        for (int e0 = 0; e0 < 128; e0 += 16) {
            v2u vv[16]; float ww[16];
#pragma unroll
            for (int j = 0; j < 16; ++j) {
                const v2u ew = *(const LAS v2u*)(WSM + 2 * (e0 + j));
                const int eid = __builtin_amdgcn_readfirstlane((int)ew.x); ww[j] = __uint_as_float(__builtin_amdgcn_readfirstlane((int)ew.y));
                vv[j] = *(const GAS v2u*)(V4 + (size_t)eid * 512 + 8 * lane);
            }
#pragma unroll
            for (int j = 0; j < 16; ++j) {
                const unsigned v0 = vv[j].x, v1 = vv[j].y; const f32x2v w2 = (f32x2v){ww[j], ww[j]};
                acc[0] += w2 * __builtin_amdgcn_cvt_scalef32_pk_f32_fp4(v0, 1.0f, 0); acc[1] += w2 * __builtin_amdgcn_cvt_scalef32_pk_f32_fp4(v0, 1.0f, 1);
                acc[2] += w2 * __builtin_amdgcn_cvt_scalef32_pk_f32_fp4(v0, 1.0f, 2); acc[3] += w2 * __builtin_amdgcn_cvt_scalef32_pk_f32_fp4(v0, 1.0f, 3);
                acc[4] += w2 * __builtin_amdgcn_cvt_scalef32_pk_f32_fp4(v1, 1.0f, 0); acc[5] += w2 * __builtin_amdgcn_cvt_scalef32_pk_f32_fp4(v1, 1.0f, 1);
                acc[6] += w2 * __builtin_amdgcn_cvt_scalef32_pk_f32_fp4(v1, 1.0f, 2); acc[7] += w2 * __builtin_amdgcn_cvt_scalef32_pk_f32_fp4(v1, 1.0f, 3);
            }
        }
        LDS_WAIT(); asm volatile("" ::: "memory");
        const float* ip = A.out + (size_t)n * 1024 + 16 * lane; float* op = dummy ? (float*)(ws + WS_Z) + (size_t)n * 1024 + 16 * lane : A.out + (size_t)n * 1024 + 16 * lane; const float* g2p = ADA + b * 6144 + 5 * 1024 + 16 * lane;
#pragma unroll
        for (int q4 = 0; q4 < 4; ++q4) {
            const f32x4 xv = *(const GAS f32x4*)(ip + 4 * q4), gv = *(const GAS f32x4*)(g2p + 4 * q4);
            const f32x4 av = (f32x4){acc[2 * q4].x, acc[2 * q4].y, acc[2 * q4 + 1].x, acc[2 * q4 + 1].y};
            *(GAS f32x4*)(op + 4 * q4) = xv + gv * av;
        }
    }
}


constexpr int CW_Q1 = 8192, CW_Q3 = 8192 + 8 * 64;
__device__ __forceinline__ float quad_sum(float v) {
    v += __builtin_bit_cast(float, __builtin_amdgcn_update_dpp(0, __builtin_bit_cast(int, v), 0xB1, 0xF, 0xF, true));
    v += __builtin_bit_cast(float, __builtin_amdgcn_update_dpp(0, __builtin_bit_cast(int, v), 0x4E, 0xF, 0xF, true));
    return v;
}
__device__ __forceinline__ int next_item(Frame& F, unsigned* q) {
    LAS int* sh = (LAS int*)(F.lds);
    if (F.tid == 0) sh[0] = (int)__hip_atomic_fetch_add(q, 1u, __ATOMIC_RELAXED, __HIP_MEMORY_SCOPE_AGENT);
    __syncthreads(); const int it = sh[0]; __syncthreads();
    return it;
}
__device__ __forceinline__ void peer_g1(Frame& F, const Args& A) {
    unsigned char* ws = A.ws;
    const bf16* H2 = (const bf16*)(ws + WS_H); const unsigned char* U4 = ws + WS_U; const int* EIDX = (const int*)(ws + WS_EIDX); float* PD = (float*)(ws + WS_Z);
    unsigned* Q = (unsigned*)(ws + WS_CTL) + CW_Q1;
    const int lane = F.lane, tk = lane >> 3, c4 = lane & 7;
    const int s0 = (int)(xb_xcc_id() & 3u);
    for (int so = 0; so < 4; ++so) {
        const int s = (s0 + so) & 3;
        for (;;) {
            const int item = next_item(F, Q + 64 * s);
            if (item >= T / 128) break;
          for (int sub = 0; sub < 2; ++sub) {
            const int n = item * 128 + F.wave * 16 + sub * 8 + tk;
            v4u h2s[4];
            { const bf16* hp = H2 + (size_t)n * 1024 + 256 * s + 32 * c4;
#pragma unroll
              for (int k = 0; k < 4; ++k) h2s[k] = *(const GAS v4u*)(hp + 8 * k); }
            const unsigned char* ub = U4 + (size_t)s * (16384 * 128) + 16 * c4;
            float* pd = PD + ((size_t)s * T + n) * 128;
            const int* ep = EIDX + (size_t)n * 128;
            v4u idb[2], idc[2], rows[8], rnx[8];
            { const v4u i0 = *(const GAS v4u*)(ep), i1 = *(const GAS v4u*)(ep + 4); idb[0] = *(const GAS v4u*)(ep + 8); idb[1] = *(const GAS v4u*)(ep + 12);
              const unsigned a0 = i0.x, a1 = i0.y, a2 = i0.z, a3 = i0.w, a4 = i1.x, a5 = i1.y, a6 = i1.z, a7 = i1.w;
              rows[0] = *(const GAS v4u*)(ub + (size_t)a0 * 128); rows[1] = *(const GAS v4u*)(ub + (size_t)a1 * 128); rows[2] = *(const GAS v4u*)(ub + (size_t)a2 * 128); rows[3] = *(const GAS v4u*)(ub + (size_t)a3 * 128);
              rows[4] = *(const GAS v4u*)(ub + (size_t)a4 * 128); rows[5] = *(const GAS v4u*)(ub + (size_t)a5 * 128); rows[6] = *(const GAS v4u*)(ub + (size_t)a6 * 128); rows[7] = *(const GAS v4u*)(ub + (size_t)a7 * 128); }
            for (int g = 0; g < 16; ++g) {
                if (g + 2 < 16) { idc[0] = *(const GAS v4u*)(ep + 8 * (g + 2)); idc[1] = *(const GAS v4u*)(ep + 8 * (g + 2) + 4); }
                if (g + 1 < 16) {
                    const unsigned a0 = idb[0].x, a1 = idb[0].y, a2 = idb[0].z, a3 = idb[0].w, a4 = idb[1].x, a5 = idb[1].y, a6 = idb[1].z, a7 = idb[1].w;
                    rnx[0] = *(const GAS v4u*)(ub + (size_t)a0 * 128); rnx[1] = *(const GAS v4u*)(ub + (size_t)a1 * 128); rnx[2] = *(const GAS v4u*)(ub + (size_t)a2 * 128); rnx[3] = *(const GAS v4u*)(ub + (size_t)a3 * 128);
                    rnx[4] = *(const GAS v4u*)(ub + (size_t)a4 * 128); rnx[5] = *(const GAS v4u*)(ub + (size_t)a5 * 128); rnx[6] = *(const GAS v4u*)(ub + (size_t)a6 * 128); rnx[7] = *(const GAS v4u*)(ub + (size_t)a7 * 128);
                }
                float p[8];
#pragma unroll
                for (int k = 0; k < 8; ++k) { const unsigned x0 = rows[k].x, x1 = rows[k].y, x2 = rows[k].z, x3 = rows[k].w; float pp = quad_sum(dot8f4(x3, h2s[3], dot8f4(x2, h2s[2], dot8f4(x1, h2s[1], dot8f4(x0, h2s[0], 0.f))))); pp += __shfl_xor(pp, 4); p[k] = pp; }
                if (c4 == 0) { *(GAS f32x4*)(pd + 8 * g) = (f32x4){p[0], p[1], p[2], p[3]}; *(GAS f32x4*)(pd + 8 * g + 4) = (f32x4){p[4], p[5], p[6], p[7]}; }
#pragma unroll
                for (int k = 0; k < 8; ++k) rows[k] = rnx[k];
                idb[0] = idc[0]; idb[1] = idc[1];
            }
          }
        }
    }
}
__device__ __forceinline__ void peer_g2(Frame& F, const Args& A) {
    unsigned char* ws = A.ws;
    const int* EIDX = (const int*)(ws + WS_EIDX); float* EGATE = (float*)(ws + WS_EGATE); const float* PD = (const float*)(ws + WS_Z);
    const float* SU = (const float*)(ws + WS_SU); const float* SV = (const float*)(ws + WS_SV); const float* SH2 = (const float*)(ws + WS_SH2);
    const size_t gtid = (size_t)F.gw * 64 + F.lane, gthreads = (size_t)F.NGW * 64;
    for (size_t idx = gtid; idx < (size_t)T * 128; idx += gthreads) {
        float d = 0.f;
#pragma unroll
        for (int s = 0; s < 4; ++s) d += PD[(size_t)s * T * 128 + idx];
        const int eid = EIDX[idx];
        d *= SU[eid];
        const float act = 0.5f * d * (1.0f + erff(d * 0.70710678118654752f));
        EGATE[idx] = EGATE[idx] * act * SV[eid];
    }
}
__device__ __forceinline__ void peer_g3(Frame& F, const Args& A) {
    unsigned char* ws = A.ws;
    const unsigned char* V4 = ws + WS_V; const int* EIDX = (const int*)(ws + WS_EIDX); const float* W = (const float*)(ws + WS_EGATE); const float* ADA = (const float*)(ws + WS_ADA);
    unsigned* Q = (unsigned*)(ws + WS_CTL) + CW_Q3;
    const int lane = F.lane, tk = lane >> 3, c4 = lane & 7;
#ifdef G3_DUPLOAD
    const size_t zoff = (size_t)*((volatile unsigned*)(ws + WS_CTL) + 80);
#endif
    const int s0 = (int)(xb_xcc_id() & 3u);
    for (int so = 0; so < 4; ++so) {
        const int s = (s0 + so) & 3;
        for (;;) {
            const int item = next_item(F, Q + 64 * s);
            if (item >= T / 128) break;
          for (int sub = 0; sub < 2; ++sub) {
            const int n = item * 128 + F.wave * 16 + sub * 8 + tk;
            const unsigned char* vb = V4 + (size_t)s * (16384 * 128) + 16 * c4;
            f32x2v acc[16];
#pragma unroll
            for (int j = 0; j < 16; ++j) acc[j] = (f32x2v){0.f, 0.f};
            const int* ep = EIDX + (size_t)n * 128; const float* wp = W + (size_t)n * 128;
            v4u idb[2], idc[2], rows[8], rnx[8]; f32x4 wc[2], wb[2], wn[2];
            { const v4u i0 = *(const GAS v4u*)(ep), i1 = *(const GAS v4u*)(ep + 4); idb[0] = *(const GAS v4u*)(ep + 8); idb[1] = *(const GAS v4u*)(ep + 12);
              wc[0] = *(const GAS f32x4*)(wp); wc[1] = *(const GAS f32x4*)(wp + 4); wb[0] = *(const GAS f32x4*)(wp + 8); wb[1] = *(const GAS f32x4*)(wp + 12);
              const unsigned a0 = i0.x, a1 = i0.y, a2 = i0.z, a3 = i0.w, a4 = i1.x, a5 = i1.y, a6 = i1.z, a7 = i1.w;
              rows[0] = *(const GAS v4u*)(vb + (size_t)a0 * 128); rows[1] = *(const GAS v4u*)(vb + (size_t)a1 * 128); rows[2] = *(const GAS v4u*)(vb + (size_t)a2 * 128); rows[3] = *(const GAS v4u*)(vb + (size_t)a3 * 128);
              rows[4] = *(const GAS v4u*)(vb + (size_t)a4 * 128); rows[5] = *(const GAS v4u*)(vb + (size_t)a5 * 128); rows[6] = *(const GAS v4u*)(vb + (size_t)a6 * 128); rows[7] = *(const GAS v4u*)(vb + (size_t)a7 * 128); }
            for (int g = 0; g < 16; ++g) {
                if (g + 2 < 16) { idc[0] = *(const GAS v4u*)(ep + 8 * (g + 2)); idc[1] = *(const GAS v4u*)(ep + 8 * (g + 2) + 4); wn[0] = *(const GAS f32x4*)(wp + 8 * (g + 2)); wn[1] = *(const GAS f32x4*)(wp + 8 * (g + 2) + 4); }
                if (g + 1 < 16) {
                    const unsigned a0 = idb[0].x, a1 = idb[0].y, a2 = idb[0].z, a3 = idb[0].w, a4 = idb[1].x, a5 = idb[1].y, a6 = idb[1].z, a7 = idb[1].w;
                    rnx[0] = *(const GAS v4u*)(vb + (size_t)a0 * 128); rnx[1] = *(const GAS v4u*)(vb + (size_t)a1 * 128); rnx[2] = *(const GAS v4u*)(vb + (size_t)a2 * 128); rnx[3] = *(const GAS v4u*)(vb + (size_t)a3 * 128);
                    rnx[4] = *(const GAS v4u*)(vb + (size_t)a4 * 128); rnx[5] = *(const GAS v4u*)(vb + (size_t)a5 * 128); rnx[6] = *(const GAS v4u*)(vb + (size_t)a6 * 128); rnx[7] = *(const GAS v4u*)(vb + (size_t)a7 * 128);
                }
#ifdef G3_DUPLOAD
                v4u r2[8];
                if (g + 1 < 16) {
                    const unsigned a0 = idb[0].x, a1 = idb[0].y, a2 = idb[0].z, a3 = idb[0].w, a4 = idb[1].x, a5 = idb[1].y, a6 = idb[1].z, a7 = idb[1].w;
                    r2[0] = *(const GAS v4u*)(vb + zoff + (size_t)a0 * 128); r2[1] = *(const GAS v4u*)(vb + zoff + (size_t)a1 * 128); r2[2] = *(const GAS v4u*)(vb + zoff + (size_t)a2 * 128); r2[3] = *(const GAS v4u*)(vb + zoff + (size_t)a3 * 128);
                    r2[4] = *(const GAS v4u*)(vb + zoff + (size_t)a4 * 128); r2[5] = *(const GAS v4u*)(vb + zoff + (size_t)a5 * 128); r2[6] = *(const GAS v4u*)(vb + zoff + (size_t)a6 * 128); r2[7] = *(const GAS v4u*)(vb + zoff + (size_t)a7 * 128);
#pragma unroll
                    for (int k = 0; k < 8; ++k) { rnx[k].y = r2[k].y; rnx[k].w = r2[k].w; }
                }
#endif
#pragma unroll
                for (int k = 0; k < 8; ++k) {
                    const float wk = wc[k >> 2][k & 3]; const f32x2v w2 = (f32x2v){wk, wk};
                    const unsigned x0 = rows[k].x, x1 = rows[k].y, x2 = rows[k].z, x3 = rows[k].w;
                    acc[0] += w2 * __builtin_amdgcn_cvt_scalef32_pk_f32_fp4(x0, 1.0f, 0); acc[1] += w2 * __builtin_amdgcn_cvt_scalef32_pk_f32_fp4(x0, 1.0f, 1);
                    acc[2] += w2 * __builtin_amdgcn_cvt_scalef32_pk_f32_fp4(x0, 1.0f, 2); acc[3] += w2 * __builtin_amdgcn_cvt_scalef32_pk_f32_fp4(x0, 1.0f, 3);
                    acc[4] += w2 * __builtin_amdgcn_cvt_scalef32_pk_f32_fp4(x1, 1.0f, 0); acc[5] += w2 * __builtin_amdgcn_cvt_scalef32_pk_f32_fp4(x1, 1.0f, 1);
                    acc[6] += w2 * __builtin_amdgcn_cvt_scalef32_pk_f32_fp4(x1, 1.0f, 2); acc[7] += w2 * __builtin_amdgcn_cvt_scalef32_pk_f32_fp4(x1, 1.0f, 3);
                    acc[8] += w2 * __builtin_amdgcn_cvt_scalef32_pk_f32_fp4(x2, 1.0f, 0); acc[9] += w2 * __builtin_amdgcn_cvt_scalef32_pk_f32_fp4(x2, 1.0f, 1);
                    acc[10] += w2 * __builtin_amdgcn_cvt_scalef32_pk_f32_fp4(x2, 1.0f, 2); acc[11] += w2 * __builtin_amdgcn_cvt_scalef32_pk_f32_fp4(x2, 1.0f, 3);
                    acc[12] += w2 * __builtin_amdgcn_cvt_scalef32_pk_f32_fp4(x3, 1.0f, 0); acc[13] += w2 * __builtin_amdgcn_cvt_scalef32_pk_f32_fp4(x3, 1.0f, 1);
                    acc[14] += w2 * __builtin_amdgcn_cvt_scalef32_pk_f32_fp4(x3, 1.0f, 2); acc[15] += w2 * __builtin_amdgcn_cvt_scalef32_pk_f32_fp4(x3, 1.0f, 3);
                }
#pragma unroll
                for (int k = 0; k < 8; ++k) rows[k] = rnx[k];
                idb[0] = idc[0]; idb[1] = idc[1]; wc[0] = wb[0]; wc[1] = wb[1]; wb[0] = wn[0]; wb[1] = wn[1];
            }
            float* op = A.out + (size_t)n * 1024 + 256 * s + 32 * c4; const float* g2p = ADA + (n >> 11) * 6144 + 5 * 1024 + 256 * s + 32 * c4;
#pragma unroll
            for (int q4 = 0; q4 < 8; ++q4) {
                const f32x4 xv = *(const GAS f32x4*)(op + 4 * q4), gv = *(const GAS f32x4*)(g2p + 4 * q4);
                const f32x4 av = (f32x4){acc[2 * q4].x, acc[2 * q4].y, acc[2 * q4 + 1].x, acc[2 * q4 + 1].y};
                *(GAS f32x4*)(op + 4 * q4) = xv + gv * av;
            }
          }
        }
    }
}


__device__ __forceinline__ void peer_local(Frame& F, const Args& A, const XcdBarrier& xb) {
    unsigned char* ws = A.ws;
    const bf16* H2 = (const bf16*)(ws + WS_H); const unsigned char* U4 = ws + WS_U; const unsigned char* V4 = ws + WS_V;
    const int* EIDX = (const int*)(ws + WS_EIDX); const float* EGATE = (const float*)(ws + WS_EGATE); const float* ADA = (const float*)(ws + WS_ADA);
    const float* SU = (const float*)(ws + WS_SU); const float* SV = (const float*)(ws + WS_SV); const float* SH2 = (const float*)(ws + WS_SH2);
    const int lane = F.lane, tk = lane >> 3, c4 = lane & 7;
    const int tpw = T / F.NGW;
    LAS float* PDL = (LAS float*)F.lds + (size_t)F.wave * tpw * 128;
    const int nbase = F.gw * tpw;
    for (int i = lane; i < tpw * 128; i += 64) PDL[i] = 0.f;
    LDS_WAIT(); asm volatile("" ::: "memory");
    const unsigned char* HHI = ws + WS_H2HI; const unsigned char* HLO = ws + WS_H2LO;
    for (int s = 0; s < 4; ++s) {
#ifdef SLICE_BAR
        if (s) xcd_barrier(xb);
#endif
        const unsigned char* ub = U4 + (size_t)s * (16384 * 128) + 16 * c4;
        for (int sub = 0; sub < tpw; sub += 8) {
            const int n = nbase + sub + tk;
            const v4u hh = *(const GAS v4u*)(HHI + (size_t)n * 512 + 128 * s + 16 * c4), hl = *(const GAS v4u*)(HLO + (size_t)n * 512 + 128 * s + 16 * c4);
            const int h0 = (int)hh.x, h1 = (int)hh.y, h2_ = (int)hh.z, h3 = (int)hh.w, l0 = (int)hl.x, l1 = (int)hl.y, l2 = (int)hl.z, l3 = (int)hl.w;
            LAS float* pd = PDL + (sub + tk) * 128;
            const int* ep = EIDX + (size_t)n * 128;
            v4u idb[2], idc[2], rows[8], rnx[8];
#ifdef EIDX16
            const unsigned short* ep16 = (const unsigned short*)EIDX + (size_t)n * 128;
            { const v4u i0 = *(const GAS v4u*)(ep16); idb[0] = *(const GAS v4u*)(ep16 + 8); idb[1] = idb[0]; (void)ep;
              const unsigned a0 = i0.x & 0xFFFFu, a1 = i0.x >> 16, a2 = i0.y & 0xFFFFu, a3 = i0.y >> 16, a4 = i0.z & 0xFFFFu, a5 = i0.z >> 16, a6 = i0.w & 0xFFFFu, a7 = i0.w >> 16;
#else
            { const v4u i0 = *(const GAS v4u*)(ep), i1 = *(const GAS v4u*)(ep + 4); idb[0] = *(const GAS v4u*)(ep + 8); idb[1] = *(const GAS v4u*)(ep + 12);
              const unsigned a0 = i0.x, a1 = i0.y, a2 = i0.z, a3 = i0.w, a4 = i1.x, a5 = i1.y, a6 = i1.z, a7 = i1.w;
#endif
              rows[0] = *(const GAS v4u*)(ub + (size_t)a0 * 128); rows[1] = *(const GAS v4u*)(ub + (size_t)a1 * 128); rows[2] = *(const GAS v4u*)(ub + (size_t)a2 * 128); rows[3] = *(const GAS v4u*)(ub + (size_t)a3 * 128);
              rows[4] = *(const GAS v4u*)(ub + (size_t)a4 * 128); rows[5] = *(const GAS v4u*)(ub + (size_t)a5 * 128); rows[6] = *(const GAS v4u*)(ub + (size_t)a6 * 128); rows[7] = *(const GAS v4u*)(ub + (size_t)a7 * 128); }
            for (int g = 0; g < 16; ++g) {
#ifdef EIDX16
                if (g + 2 < 16) { idc[0] = *(const GAS v4u*)(ep16 + 8 * (g + 2)); idc[1] = idc[0]; }
                if (g + 1 < 16) {
                    const unsigned a0 = idb[0].x & 0xFFFFu, a1 = idb[0].x >> 16, a2 = idb[0].y & 0xFFFFu, a3 = idb[0].y >> 16, a4 = idb[0].z & 0xFFFFu, a5 = idb[0].z >> 16, a6 = idb[0].w & 0xFFFFu, a7 = idb[0].w >> 16;
#else
                if (g + 2 < 16) { idc[0] = *(const GAS v4u*)(ep + 8 * (g + 2)); idc[1] = *(const GAS v4u*)(ep + 8 * (g + 2) + 4); }
                if (g + 1 < 16) {
                    const unsigned a0 = idb[0].x, a1 = idb[0].y, a2 = idb[0].z, a3 = idb[0].w, a4 = idb[1].x, a5 = idb[1].y, a6 = idb[1].z, a7 = idb[1].w;
#endif
                    rnx[0] = *(const GAS v4u*)(ub + (size_t)a0 * 128); rnx[1] = *(const GAS v4u*)(ub + (size_t)a1 * 128); rnx[2] = *(const GAS v4u*)(ub + (size_t)a2 * 128); rnx[3] = *(const GAS v4u*)(ub + (size_t)a3 * 128);
                    rnx[4] = *(const GAS v4u*)(ub + (size_t)a4 * 128); rnx[5] = *(const GAS v4u*)(ub + (size_t)a5 * 128); rnx[6] = *(const GAS v4u*)(ub + (size_t)a6 * 128); rnx[7] = *(const GAS v4u*)(ub + (size_t)a7 * 128);
                }
                float p[8];
#pragma unroll
                for (int k = 0; k < 8; ++k) {
                    const int x0 = (int)rows[k].x, x1 = (int)rows[k].y, x2 = (int)rows[k].z, x3 = (int)rows[k].w;
                    const int ah = __builtin_amdgcn_sdot8(x3, h3, __builtin_amdgcn_sdot8(x2, h2_, __builtin_amdgcn_sdot8(x1, h1, __builtin_amdgcn_sdot8(x0, h0, 0, false), false), false), false);
                    const int al = __builtin_amdgcn_sdot8(x3, l3, __builtin_amdgcn_sdot8(x2, l2, __builtin_amdgcn_sdot8(x1, l1, __builtin_amdgcn_sdot8(x0, l0, 0, false), false), false), false);
                    int t = 16 * ah + al;
                    t += __builtin_amdgcn_update_dpp(0, t, 0xB1, 0xF, 0xF, true); t += __builtin_amdgcn_update_dpp(0, t, 0x4E, 0xF, 0xF, true); t += __shfl_xor(t, 4);
                    p[k] = (float)t;
                }
                if (c4 == 0) {
                    const f32x4 o0 = *(const LAS f32x4*)(pd + 8 * g), o1 = *(const LAS f32x4*)(pd + 8 * g + 4);
                    *(LAS f32x4*)(pd + 8 * g) = o0 + (f32x4){p[0], p[1], p[2], p[3]}; *(LAS f32x4*)(pd + 8 * g + 4) = o1 + (f32x4){p[4], p[5], p[6], p[7]};
                }
#pragma unroll
                for (int k = 0; k < 8; ++k) rows[k] = rnx[k];
                idb[0] = idc[0]; idb[1] = idc[1];
            }
        }
    }
    LDS_WAIT(); asm volatile("" ::: "memory");
    for (int i = lane; i < tpw * 128; i += 64) {
        const size_t gi = (size_t)nbase * 128 + i;
#ifdef EIDX16
        const int eid = ((const unsigned short*)EIDX)[gi];
#else
        const int eid = EIDX[gi];
#endif
        const float d = PDL[i] * SU[eid] * SH2[nbase + (i >> 7)];
        const float act = 0.5f * d * (1.0f + erff(d * 0.70710678118654752f));
        PDL[i] = EGATE[gi] * act * SV[eid];
    }
    LDS_WAIT(); asm volatile("" ::: "memory");
    for (int s = 0; s < 4; ++s) {
#ifdef SLICE_BAR
        xcd_barrier(xb);
#endif
        const unsigned char* vb = V4 + (size_t)s * (16384 * 128) + 16 * c4;
        for (int sub = 0; sub < tpw; sub += 8) {
            const int n = nbase + sub + tk;
            const LAS float* wl = PDL + (sub + tk) * 128;
            f32x2v acc[16];
#pragma unroll
            for (int j = 0; j < 16; ++j) acc[j] = (f32x2v){0.f, 0.f};
#ifdef P12_PREF
            f32x4 xpre[8];
            { const float* op0 = A.out + (size_t)n * 1024 + 256 * s + 32 * c4;
#pragma unroll
              for (int q4 = 0; q4 < 8; ++q4) xpre[q4] = *(const GAS f32x4*)(op0 + 4 * q4); }
#endif
            const int* ep = EIDX + (size_t)n * 128;
            v4u idb[2], idc[2], rows[8], rnx[8];
#ifdef EIDX16
            const unsigned short* ep16 = (const unsigned short*)EIDX + (size_t)n * 128;
            { const v4u i0 = *(const GAS v4u*)(ep16); idb[0] = *(const GAS v4u*)(ep16 + 8); idb[1] = idb[0]; (void)ep;
              const unsigned a0 = i0.x & 0xFFFFu, a1 = i0.x >> 16, a2 = i0.y & 0xFFFFu, a3 = i0.y >> 16, a4 = i0.z & 0xFFFFu, a5 = i0.z >> 16, a6 = i0.w & 0xFFFFu, a7 = i0.w >> 16;
#else
            { const v4u i0 = *(const GAS v4u*)(ep), i1 = *(const GAS v4u*)(ep + 4); idb[0] = *(const GAS v4u*)(ep + 8); idb[1] = *(const GAS v4u*)(ep + 12);
              const unsigned a0 = i0.x, a1 = i0.y, a2 = i0.z, a3 = i0.w, a4 = i1.x, a5 = i1.y, a6 = i1.z, a7 = i1.w;
#endif
              rows[0] = *(const GAS v4u*)(vb + (size_t)a0 * 128); rows[1] = *(const GAS v4u*)(vb + (size_t)a1 * 128); rows[2] = *(const GAS v4u*)(vb + (size_t)a2 * 128); rows[3] = *(const GAS v4u*)(vb + (size_t)a3 * 128);
              rows[4] = *(const GAS v4u*)(vb + (size_t)a4 * 128); rows[5] = *(const GAS v4u*)(vb + (size_t)a5 * 128); rows[6] = *(const GAS v4u*)(vb + (size_t)a6 * 128); rows[7] = *(const GAS v4u*)(vb + (size_t)a7 * 128); }
            for (int g = 0; g < 16; ++g) {
#ifdef EIDX16
                if (g + 2 < 16) { idc[0] = *(const GAS v4u*)(ep16 + 8 * (g + 2)); idc[1] = idc[0]; }
                if (g + 1 < 16) {
                    const unsigned a0 = idb[0].x & 0xFFFFu, a1 = idb[0].x >> 16, a2 = idb[0].y & 0xFFFFu, a3 = idb[0].y >> 16, a4 = idb[0].z & 0xFFFFu, a5 = idb[0].z >> 16, a6 = idb[0].w & 0xFFFFu, a7 = idb[0].w >> 16;
#else
                if (g + 2 < 16) { idc[0] = *(const GAS v4u*)(ep + 8 * (g + 2)); idc[1] = *(const GAS v4u*)(ep + 8 * (g + 2) + 4); }
                if (g + 1 < 16) {
                    const unsigned a0 = idb[0].x, a1 = idb[0].y, a2 = idb[0].z, a3 = idb[0].w, a4 = idb[1].x, a5 = idb[1].y, a6 = idb[1].z, a7 = idb[1].w;
#endif
                    rnx[0] = *(const GAS v4u*)(vb + (size_t)a0 * 128); rnx[1] = *(const GAS v4u*)(vb + (size_t)a1 * 128); rnx[2] = *(const GAS v4u*)(vb + (size_t)a2 * 128); rnx[3] = *(const GAS v4u*)(vb + (size_t)a3 * 128);
                    rnx[4] = *(const GAS v4u*)(vb + (size_t)a4 * 128); rnx[5] = *(const GAS v4u*)(vb + (size_t)a5 * 128); rnx[6] = *(const GAS v4u*)(vb + (size_t)a6 * 128); rnx[7] = *(const GAS v4u*)(vb + (size_t)a7 * 128);
                }
                const f32x4 w0 = *(const LAS f32x4*)(wl + 8 * g), w1 = *(const LAS f32x4*)(wl + 8 * g + 4);
#pragma unroll
                for (int k = 0; k < 8; ++k) {
                    const float wk = (k < 4) ? w0[k & 3] : w1[k & 3]; const f32x2v w2 = (f32x2v){wk, wk};
                    const unsigned x0 = rows[k].x, x1 = rows[k].y, x2 = rows[k].z, x3 = rows[k].w;
                    acc[0] += w2 * __builtin_amdgcn_cvt_scalef32_pk_f32_fp4(x0, 1.0f, 0); acc[1] += w2 * __builtin_amdgcn_cvt_scalef32_pk_f32_fp4(x0, 1.0f, 1);
                    acc[2] += w2 * __builtin_amdgcn_cvt_scalef32_pk_f32_fp4(x0, 1.0f, 2); acc[3] += w2 * __builtin_amdgcn_cvt_scalef32_pk_f32_fp4(x0, 1.0f, 3);
                    acc[4] += w2 * __builtin_amdgcn_cvt_scalef32_pk_f32_fp4(x1, 1.0f, 0); acc[5] += w2 * __builtin_amdgcn_cvt_scalef32_pk_f32_fp4(x1, 1.0f, 1);
                    acc[6] += w2 * __builtin_amdgcn_cvt_scalef32_pk_f32_fp4(x1, 1.0f, 2); acc[7] += w2 * __builtin_amdgcn_cvt_scalef32_pk_f32_fp4(x1, 1.0f, 3);
                    acc[8] += w2 * __builtin_amdgcn_cvt_scalef32_pk_f32_fp4(x2, 1.0f, 0); acc[9] += w2 * __builtin_amdgcn_cvt_scalef32_pk_f32_fp4(x2, 1.0f, 1);
                    acc[10] += w2 * __builtin_amdgcn_cvt_scalef32_pk_f32_fp4(x2, 1.0f, 2); acc[11] += w2 * __builtin_amdgcn_cvt_scalef32_pk_f32_fp4(x2, 1.0f, 3);
                    acc[12] += w2 * __builtin_amdgcn_cvt_scalef32_pk_f32_fp4(x3, 1.0f, 0); acc[13] += w2 * __builtin_amdgcn_cvt_scalef32_pk_f32_fp4(x3, 1.0f, 1);
                    acc[14] += w2 * __builtin_amdgcn_cvt_scalef32_pk_f32_fp4(x3, 1.0f, 2); acc[15] += w2 * __builtin_amdgcn_cvt_scalef32_pk_f32_fp4(x3, 1.0f, 3);
                }
#pragma unroll
                for (int k = 0; k < 8; ++k) rows[k] = rnx[k];
                idb[0] = idc[0]; idb[1] = idc[1];
            }
            float* op = A.out + (size_t)n * 1024 + 256 * s + 32 * c4; const float* g2p = ADA + (n >> 11) * 6144 + 5 * 1024 + 256 * s + 32 * c4;
#pragma unroll
            for (int q4 = 0; q4 < 8; ++q4) {
#if defined(X1_BF16)
#ifdef P12_NT
                const f32x4 gv = *(const GAS f32x4*)(g2p + 4 * q4); const v2u a_ = __builtin_nontemporal_load((const GAS v2u*)((const bf16*)(ws + WS_X1) + (size_t)n * 1024 + 256 * s + 32 * c4 + 4 * q4));
#else
                const f32x4 gv = *(const GAS f32x4*)(g2p + 4 * q4); const v2u a_ = *(const GAS v2u*)((const bf16*)(ws + WS_X1) + (size_t)n * 1024 + 256 * s + 32 * c4 + 4 * q4);
#endif
                const f32x4 xv = (f32x4){__uint_as_float(a_.x << 16), __uint_as_float(a_.x & 0xffff0000u), __uint_as_float(a_.y << 16), __uint_as_float(a_.y & 0xffff0000u)};
#elif defined(P12_PREF)
                const f32x4 xv = xpre[q4], gv = *(const GAS f32x4*)(g2p + 4 * q4);
#else
                const f32x4 xv = *(const GAS f32x4*)(op + 4 * q4), gv = *(const GAS f32x4*)(g2p + 4 * q4);
#endif
                const f32x4 av = (f32x4){acc[2 * q4].x, acc[2 * q4].y, acc[2 * q4 + 1].x, acc[2 * q4 + 1].y};
#ifdef P12_NT
                __builtin_nontemporal_store(xv + gv * av, (GAS f32x4*)(op + 4 * q4));
#else
                *(GAS f32x4*)(op + 4 * q4) = xv + gv * av;
#endif
            }
        }
    }
}

__device__ __forceinline__ void dbg_peer_check1(Frame& F, const Args& A) {
    if (blockIdx.x != 0) return;
    unsigned char* ws = A.ws;
    const bf16* H2 = (const bf16*)(ws + WS_H); const bf16* PQ = (const bf16*)(ws + WS_PQ); const bf16* SK = (const bf16*)(ws + WS_SK);
    const int* EIDX = (const int*)(ws + WS_EIDX); const float* EGATE = (const float*)(ws + WS_EGATE); float* DBG = (float*)(ws + 48 * MiB);
    unsigned* flag = (unsigned*)(ws + WS_CTL) + 64;
    const int t = F.tid;
    const int r = (int)(((long long)t * 2579 + 17) % T), c = (t * 131 + 5) % 1024;
    unsigned f = 0u;
    { float acc = 0.f; for (int k = 0; k < 1024; ++k) acc += bf2f(H2[(size_t)r * 1024 + k]) * A.w_pq[(size_t)k * 1024 + c];
      const float got = bf2f(PQ[(size_t)r * 1024 + c]); if (fabsf(got - acc) > 0.02f * fabsf(acc) + 0.02f) f |= 1u; }
    { const int h = t & 7; float s[2][128];
      float* sc = DBG + 4096 + (size_t)t * 256;
      for (int p = 0; p < 2; ++p) for (int k = 0; k < 128; ++k) { float acc = 0.f; for (int d = 0; d < 64; ++d) acc += bf2f(PQ[(size_t)r * 1024 + h * 128 + p * 64 + d]) * bf2f(SK[((size_t)(h * 2 + p) * 128 + k) * 64 + d]); sc[p * 128 + k] = acc; }
      (void)s;
      float t0v[16], t1v[16];
      for (int p = 0; p < 2; ++p) { float last = 3.0e38f; int lasti = -1; for (int i = 0; i < 16; ++i) { float best = -3.0e38f; int bi = -1; for (int k = 0; k < 128; ++k) { const float v = sc[p * 128 + k]; if ((v < last || (v == last && k > lasti)) && v > best) { best = v; bi = k; } } last = best; lasti = bi; if (p == 0) t0v[i] = best; else t1v[i] = best; } }
      float last = 3.0e38f; int cnt_ge = 0; float kth = 0.f;
      for (int it = 0; it < 16; ++it) { float best = -3.0e38f; for (int i = 0; i < 16; ++i) for (int j = 0; j < 16; ++j) { const float v = t0v[i] + t1v[j]; if (v < last && v > best) best = v; } last = best; kth = best; }
      (void)cnt_ge;
      float gs = 0.f; int badn = 0;
      for (int i = 0; i < 16; ++i) { const int e = EIDX[(size_t)r * 128 + h * 16 + i]; const float g = EGATE[(size_t)r * 128 + h * 16 + i]; gs += g;
          if (e < 0 || e >= 16384) { badn += 100; continue; }
          const float sm = sc[e >> 7] + sc[128 + (e & 127)]; if (sm < kth - 0.02f * fabsf(kth) - 0.02f) ++badn; }
      if (badn > 1) f |= 2u;
      if (fabsf(gs - 1.0f) > 0.01f) f |= 4u; }
    { float acc = 0.f;
      for (int e = 0; e < 128; ++e) { const int id = EIDX[(size_t)r * 128 + e]; const float g = EGATE[(size_t)r * 128 + e]; if (id < 0 || id >= 16384) continue;
          float d = 0.f; for (int k = 0; k < 1024; ++k) d += bf2f(H2[(size_t)r * 1024 + k]) * A.pu[(size_t)id * 1024 + k];
          const float act = 0.5f * d * (1.0f + erff(d * 0.70710678f)); acc += g * act * A.pv[(size_t)id * 1024 + c]; }
      DBG[t] = acc; DBG[512 + t] = A.out[(size_t)r * 1024 + c]; }
    if (f) atomicOr(flag, f);
}
__device__ __forceinline__ void dbg_peer_check2(Frame& F, const Args& A) {
    if (blockIdx.x != 0) return;
    unsigned char* ws = A.ws; const float* DBG = (const float*)(ws + 48 * MiB); const float* ADA = (const float*)(ws + WS_ADA);
    unsigned* flag = (unsigned*)(ws + WS_CTL) + 64;
    const int t = F.tid;
    const int r = (int)(((long long)t * 2579 + 17) % T), c = (t * 131 + 5) % 1024;
    const float e = DBG[512 + t] + ADA[(r >> 11) * 6144 + 5120 + c] * DBG[t], got = A.out[(size_t)r * 1024 + c];
    if (fabsf(got - e) > 0.03f * fabsf(DBG[t]) + 0.02f) atomicOr(flag, 8u);
}

__device__ __forceinline__ Args fresh_args() {
    const __attribute__((address_space(4))) Args* p = (const __attribute__((address_space(4))) Args*)__builtin_amdgcn_kernarg_segment_ptr();
    asm volatile("" : "+s"(p));
    return *(const Args*)p;
}
__global__ void __launch_bounds__(NTHR, 2) fwd_megakernel(Args args_byval) {
    extern __shared__ __attribute__((aligned(16))) unsigned char lds_raw[];
#define MAKE_FRAME() Frame F; F.lds = (LAS unsigned char*)lds_raw; F.tid = opaque_tid_w(wave_s); F.lane = F.tid & 63; F.wave = __builtin_amdgcn_readfirstlane(F.tid >> 6); \
    F.G = gridDim.x; { const int bx_ = blockIdx.x; F.vcu = (F.G % 8 == 0) ? (bx_ % 8) * (F.G / 8) + bx_ / 8 : bx_; } F.gw = F.vcu * NWAVES + F.wave; F.NGW = F.G * NWAVES;
    const int wave_s = __builtin_amdgcn_readfirstlane((int)(threadIdx.x >> 6));
    LAS unsigned char* const lds0 = (LAS unsigned char*)lds_raw;
    for (int u = threadIdx.x; u < (LDS_BYTES - LDSCTL_OFF) / 4; u += NTHR) ((LAS unsigned*)(lds0 + LDSCTL_OFF))[u] = 0u;
    __syncthreads();
    XcdBarrier bar = xcd_barrier_post((unsigned*)(fresh_args().ws + WS_CTL) + CW_BAR, (volatile LAS unsigned*)(lds0 + MISC_OFF) + 8, wave_s);
#define GRID_BAR() xcd_barrier(bar)
    const int bx = (int)blockIdx.x;

    using pg8::Gemm; using pg8::StaticOrder; using pg8::EpiB; using pg8::EpiRes; using pg8::EpiX1; using pg8::EpiGate8; using pg8::EpiZ8;
#ifndef REP_P0
#define REP_P0 1
#endif
    for (int rep_ = 0; rep_ < REP_P0; ++rep_) {

#ifndef NO_PH_P0
    { const Args args = fresh_args(); MAKE_FRAME(); p0_prologue(F, args); }
#endif
    GRID_BAR();
    }

#ifndef REP_P1
#define REP_P1 1
#endif
    for (int rep_ = 0; rep_ < REP_P1; ++rep_) {

#ifndef NO_PH_NORM
#if defined(Z_I8)
    { const Args args = fresh_args(); MAKE_FRAME(); norm_rows(F, args.x, args.g1, ((const float*)(args.ws + WS_ADA)), 0, 1024, nullptr, nullptr, nullptr, nullptr, args.ws + WS_H8, (float*)(args.ws + WS_S1));
      quant_gate_weights(F, args.ws); }
#elif defined(GATE_I8)
    { const Args args = fresh_args(); MAKE_FRAME(); norm_rows(F, args.x, args.g1, ((const float*)(args.ws + WS_ADA)), 0, 1024, ((bf16*)(args.ws + WS_H)), nullptr, nullptr, nullptr, args.ws + WS_H8, (float*)(args.ws + WS_S1));
      quant_gate_weights(F, args.ws); }
#else
    { const Args args = fresh_args(); MAKE_FRAME(); norm_rows(F, args.x, args.g1, ((const float*)(args.ws + WS_ADA)), 0, 1024, ((bf16*)(args.ws + WS_H)), nullptr, nullptr); }
#endif
#endif
    GRID_BAR();
    }

#ifdef EXTRA_BARS
    for (int xb_ = 0; xb_ < EXTRA_BARS; ++xb_) GRID_BAR();
#endif
#ifndef REP_P2
#define REP_P2 1
#endif
    for (int rep_ = 0; rep_ < REP_P2; ++rep_) {
#ifndef NO_PH_GEMM
#if defined(Z_I8)
    { const Args args = fresh_args(); MAKE_FRAME(); Gemm g{((bf16*)(args.ws + WS_H8)), ((bf16*)(args.ws + WS_WG8)), T, ZW, 512}; StaticOrder S; S.init(T, ZW, F.G, bx); EpiZ8 E{args.ws + WS_Z, ZW * 2, (const float*)(args.ws + WS_S1), (const float*)(args.ws + WS_CS8)};
      pg8::gemm_phase<EpiZ8, StaticOrder, false, true, true>(F.lds, g, S, E, F.tid); }
#elif defined(GATE_I8)
    { const Args args = fresh_args(); MAKE_FRAME(); Gemm g{((bf16*)(args.ws + WS_H)), ((bf16*)(args.ws + WS_WIN)), T, 1536, 1024}; StaticOrder S; S.init(T, 1536, F.G, bx); EpiB<0> E{((bf16*)(args.ws + WS_Z)), ZW, 6, nullptr, nullptr, 0, 0, 4};
      pg8::gemm_phase<EpiB<0>, StaticOrder, false, true>(F.lds, g, S, E, F.tid); }
    { const Args args = fresh_args(); MAKE_FRAME(); Gemm g{((bf16*)(args.ws + WS_H8)), ((bf16*)(args.ws + WS_WG8)), T, 2048, 512}; StaticOrder S; S.init(T, 2048, F.G, bx); EpiGate8 E{args.ws + WS_Z, ZW * 2, (const float*)(args.ws + WS_S1), (const float*)(args.ws + WS_CS8)};
      pg8::gemm_phase<EpiGate8, StaticOrder, false, true, true>(F.lds, g, S, E, F.tid); }
#else
    { const Args args = fresh_args(); MAKE_FRAME(); Gemm g{((bf16*)(args.ws + WS_H)), ((bf16*)(args.ws + WS_WIN)), T, ZW, 1024}; StaticOrder S; S.init(T, ZW, F.G, bx); EpiB<0> E{((bf16*)(args.ws + WS_Z)), ZW, 6, nullptr, nullptr, 0, 0, 4};
      pg8::gemm_phase<EpiB<0>, StaticOrder, false, true>(F.lds, g, S, E, F.tid); }
#endif
#endif
    GRID_BAR();
    }


#ifndef NO_PH_P3
    { const Args args = fresh_args(); MAKE_FRAME();
#ifdef PRIO_P3
      if (F.wave >> 2) __builtin_amdgcn_s_setprio(2);
#endif
      p3_fixup(F, args);
#ifdef PRIO_P3
      __builtin_amdgcn_s_setprio(0);
#endif
     }
#endif
    GRID_BAR();
#ifndef NO_PH_GEMM
    { const Args args = fresh_args(); MAKE_FRAME();
#ifdef BR_I8
      Gemm g{((bf16*)(args.ws + WS_POOLED)), ((bf16*)(args.ws + WS_W58)), T, 1024, 256};
#else
      Gemm g{((bf16*)(args.ws + WS_POOLED)), ((bf16*)(args.ws + WS_WUP)), T, 1024, 512};
#endif
      StaticOrder S; S.init(T, 1024, F.G, bx);
#ifdef P5_NOGATE
      EpiB<0> E{((bf16*)(args.ws + WS_MIN)), 1024, 1000, nullptr, nullptr, 0, 0};
      pg8::gemm_phase<EpiB<0>, StaticOrder, false, true>(F.lds, g, S, E, F.tid); }
#else
#ifdef BR_I8
      EpiB<2, true> E{((bf16*)(args.ws + WS_MIN)), 1024, 0, nullptr, ((bf16*)(args.ws + WS_Z)), ZW, ZC_GP, 0, (const float*)(args.ws + WS_SPL), (const float*)(args.ws + WS_CS5)};
      pg8::gemm_phase<EpiB<2, true>, StaticOrder, true, true, true>(F.lds, g, S, E, F.tid); }
#else
      EpiB<2> E{((bf16*)(args.ws + WS_MIN)), 1024, 0, nullptr, ((bf16*)(args.ws + WS_Z)), ZW, ZC_GP};
      pg8::gemm_phase<EpiB<2>, StaticOrder, true, true>(F.lds, g, S, E, F.tid); }
#endif
#endif
#endif
#ifdef DBG_POOL
    GRID_BAR();
    { const Args args = fresh_args(); MAKE_FRAME(); dbg_pool_check(F, args); }
#endif
#ifdef P5P6_BAR
    GRID_BAR();
#endif
#ifndef REP_DSA
#define REP_DSA 1
#endif
    for (int rep_ = 0; rep_ < REP_DSA; ++rep_) {

#ifndef NO_PH_DSA
    { const Args args = fresh_args(); MAKE_FRAME();
#ifndef NO_PRIO_DSA
      if (F.wave >> 2) __builtin_amdgcn_s_setprio(2);
#endif
      dsa_phase(F, args);
#ifndef NO_PRIO_DSA
      __builtin_amdgcn_s_setprio(0);
#endif
     }
#endif
    GRID_BAR();
    }

#if !defined(NO_PH_GEMM) && !defined(NO_P7)
#ifdef BR_I8
    { const Args args = fresh_args(); MAKE_FRAME(); Gemm g{((bf16*)(args.ws + WS_ATT)), ((bf16*)(args.ws + WS_W78)), T, 1024, 256}; StaticOrder S; S.init(T, 1024, F.G, bx);
      EpiB<3, true> E{((bf16*)(args.ws + WS_MIN)), 1024, 0, nullptr, ((bf16*)(args.ws + WS_Z)), ZW, ZC_GA, 0, (const float*)(args.ws + WS_SAT), (const float*)(args.ws + WS_CS7)};
      pg8::gemm_phase<EpiB<3, true>, StaticOrder, true, true, true>(F.lds, g, S, E, F.tid); }
#else
    { const Args args = fresh_args(); MAKE_FRAME(); Gemm g{((bf16*)(args.ws + WS_ATT)), ((bf16*)(args.ws + WS_WUA)), T, 1024, 512}; StaticOrder S; S.init(T, 1024, F.G, bx); EpiB<3> E{((bf16*)(args.ws + WS_MIN)), 1024, 0, nullptr, ((bf16*)(args.ws + WS_Z)), ZW, ZC_GA};
      pg8::gemm_phase<EpiB<3>, StaticOrder, true, true>(F.lds, g, S, E, F.tid); }
#endif
#endif
    GRID_BAR();
#ifdef DBG_POOL
    { const Args args = fresh_args(); MAKE_FRAME(); dbg_min_check(F, args); }
    GRID_BAR();
#endif
#ifndef REP_P8
#define REP_P8 1
#endif
    for (int rep_ = 0; rep_ < REP_P8; ++rep_) {
#ifndef NO_PH_GEMM
    { const Args args = fresh_args(); MAKE_FRAME(); Gemm g{((bf16*)(args.ws + WS_MIN)), ((bf16*)(args.ws + WS_WOUT)), T, 1024, 1024}; StaticOrder S; S.init(T, 1024, F.G, bx);
#ifdef X1_BF16
      EpiX1 E{args.x, ((bf16*)(args.ws + WS_X1)), ((const float*)(args.ws + WS_ADA)) + 2048};
      pg8::gemm_phase<EpiX1, StaticOrder, true, true>(F.lds, g, S, E, F.tid); }
#else
      EpiRes E{args.x, args.out, ((const float*)(args.ws + WS_ADA)) + 2048};
      pg8::gemm_phase<EpiRes, StaticOrder, true, true>(F.lds, g, S, E, F.tid); }
#endif
#endif
    GRID_BAR();
    }

#ifndef REP_P9
#define REP_P9 1
#endif
    for (int rep_ = 0; rep_ < REP_P9; ++rep_) {

#ifndef NO_PH_NORM
    { const Args args = fresh_args(); MAKE_FRAME();
#ifdef X1_BF16
      norm_rows(F, nullptr, args.g2, ((const float*)(args.ws + WS_ADA)), 3072, 4096, ((bf16*)(args.ws + WS_H)), args.ws + WS_H2HI, (float*)(args.ws + WS_SH2), (const bf16*)(args.ws + WS_X1)); }
#else
      norm_rows(F, args.out, args.g2, ((const float*)(args.ws + WS_ADA)), 3072, 4096, ((bf16*)(args.ws + WS_H)), args.ws + WS_H2HI, (float*)(args.ws + WS_SH2)); }
#endif
#endif
    GRID_BAR();
    }

#ifndef REP_P10
#define REP_P10 1
#endif
    for (int rep_ = 0; rep_ < REP_P10; ++rep_) {
#ifndef NO_PH_GEMM
    { const Args args = fresh_args(); MAKE_FRAME(); Gemm g{((bf16*)(args.ws + WS_H)), ((bf16*)(args.ws + WS_WPQ)), T, 1024, 1024}; StaticOrder S; S.init(T, 1024, F.G, bx); EpiB<0> E{((bf16*)(args.ws + WS_PQ)), 1024, 1000, nullptr, nullptr, 0, 0};
      pg8::gemm_phase<EpiB<0>, StaticOrder, false, true>(F.lds, g, S, E, F.tid); }
#endif
    GRID_BAR();
    }

#ifndef REP_P11
#define REP_P11 1
#endif
    for (int rep_ = 0; rep_ < REP_P11; ++rep_) {

#ifndef NO_PH_ROUTE
    { const Args args = fresh_args(); MAKE_FRAME();
#ifdef PRIO_ROUTE
      if (F.wave >> 2) __builtin_amdgcn_s_setprio(2);
#endif
      peer_route(F, args);
#ifdef PRIO_ROUTE
      __builtin_amdgcn_s_setprio(0);
#endif
     }
#endif
#ifdef PEER_QUEUED
    GRID_BAR();
#else
    VM_WAIT();
    __builtin_amdgcn_fence(__ATOMIC_ACQUIRE, "agent"); VM_WAIT();
    __syncthreads();
#endif
#ifdef DBG_PEER
    { const Args args = fresh_args(); MAKE_FRAME(); dbg_peer_check1(F, args); }
    GRID_BAR();
#endif
    }

#ifndef REP_GATHER
#define REP_GATHER 1
#endif
    for (int rep_ = 1; rep_ < REP_GATHER; ++rep_) { { const Args args = fresh_args(); MAKE_FRAME(); peer_gather(F, args, true); } GRID_BAR(); }

#ifdef OLD_GATHER
    { const Args args = fresh_args(); MAKE_FRAME(); peer_gather(F, args, false); }
#else
#ifdef PEER_QUEUED
    { const Args args = fresh_args(); MAKE_FRAME(); peer_g1(F, args); } GRID_BAR();
    { const Args args = fresh_args(); MAKE_FRAME(); peer_g2(F, args); } GRID_BAR();
    { const Args args = fresh_args(); MAKE_FRAME(); peer_g3(F, args); }
#else
    { const Args args = fresh_args(); MAKE_FRAME();
#ifdef PRIO_LOCAL
      if (F.wave >> 2) __builtin_amdgcn_s_setprio(2);
#endif
      peer_local(F, args, bar);
#ifdef PRIO_LOCAL
      __builtin_amdgcn_s_setprio(0);
#endif
     }
#endif
#endif

#ifdef DBG_PEER
    GRID_BAR();
    { const Args args = fresh_args(); MAKE_FRAME(); dbg_peer_check2(F, args); }
#endif
#if defined(DBG_POOL) || defined(DBG_PEER) || defined(DBG_SEL)
    GRID_BAR();
    { const Args args = fresh_args(); dbg_report(args); }
#endif
#ifdef DBG_FP4
    GRID_BAR();
    if (blockIdx.x == 0 && threadIdx.x == 0) {
        const Args args = fresh_args();
        volatile unsigned* src = (volatile unsigned*)(args.ws + WS_CTL) + 80;
        const unsigned x = 0x00007521u + *src; const float one = 1.0f + (float)*src, three = 3.0f + (float)*src;
        typedef float f32x2q __attribute__((ext_vector_type(2)));
        const f32x2q f0 = __builtin_amdgcn_cvt_scalef32_pk_f32_fp4(x, one, 0), f1 = __builtin_amdgcn_cvt_scalef32_pk_f32_fp4(x, one, 1), f3 = __builtin_amdgcn_cvt_scalef32_pk_f32_fp4(x, three, 0);
        const unsigned b0 = __builtin_bit_cast(unsigned, __builtin_amdgcn_cvt_scalef32_pk_bf16_fp4(x, one, 0));
        const bool A = (f0.x == 0.5f && f0.y == 1.0f && f1.x == 3.0f && f1.y == 6.0f && b0 == 0x3F803F00u);
        const bool Bf = (f3.x == 1.5f && f3.y == 3.0f), Cf = (f3.x == 1.0f && f3.y == 2.0f);
        const int code = (A ? 1 : 0) + (Bf ? 2 : 0) + (Cf ? 4 : 0);
        args.out[0] += 1000.0f * (float)(1 + code);
    }
#endif
#ifndef DBG_SCALE
#define DBG_SCALE 1000.0f
#endif
#ifdef DBG_MFMA8
    GRID_BAR();
    {
        const Args args = fresh_args();
        volatile unsigned* src = (volatile unsigned*)(args.ws + WS_CTL) + 80;
        const int z = (int)*src;
        const int lane_ = threadIdx.x & 63;
        typedef int v8i_ __attribute__((ext_vector_type(8)));
        v8i_ a = (v8i_){0x22222222 + z, 0x22222222, 0x22222222, 0x22222222, 0, 0, 0, 0};
        v8i_ bb = (v8i_){0x38383838 + z, 0x38383838, 0x38383838, 0x38383838, 0x38383838, 0x38383838, 0x38383838, 0x38383838};
#if DBG_MFMA8 == 2
        a = (v8i_){(lane_ < 32) ? (0x00200000 + z) : z, 0, 0, 0, 0, 0, 0, 0};
        { const unsigned sgn = (lane_ >= 32) ? 0x80808080u : 0u;
          const unsigned w0 = 0x48444038u | sgn, w1 = 0x504E4C4Au | sgn, w2 = 0x54535251u | sgn, w3 = 0x58575655u | sgn;
          bb = (v8i_){(int)w0 + z, (int)w1, (int)w2, (int)w3, (int)w0, (int)w1, (int)w2, (int)w3}; }
#endif
        f32x16 c;
#pragma unroll
        for (int i = 0; i < 16; ++i) c[i] = 0.f;
#if DBG_MFMA8 == 3
        a = bb;
        c = __builtin_amdgcn_mfma_scale_f32_32x32x64_f8f6f4(a, bb, c, 0, 0, 0, 127 + z, 0, 127 + z);
#else
        c = __builtin_amdgcn_mfma_scale_f32_32x32x64_f8f6f4(a, bb, c, 4, 0, 0, 127 + z, 0, 127 + z);
#endif
        if (blockIdx.x == 0 && threadIdx.x == 0) { const float v = c[0]; float code = (v != v) ? 2.0f : (fabsf(v) > 1.0e6f) ? 3.0f : (fminf(fmaxf(v, -28.0f), 100.0f) * 0.25f + 12.0f); args.out[0] += DBG_SCALE * code; }
    }
#endif
#ifdef DBG_MFMA16
    GRID_BAR();
    {
        const Args args = fresh_args();
        volatile unsigned* src = (volatile unsigned*)(args.ws + WS_CTL) + 80;
        const int z = (int)*src;
        const int lane_ = threadIdx.x & 63, q_ = lane_ >> 4;
        typedef int v8i_ __attribute__((ext_vector_type(8)));
        constexpr int PQ = DBG_MFMA16 / 100, PJ = DBG_MFMA16 % 100;
        unsigned aw[4] = {0u, 0u, 0u, 0u};
        if (q_ == PQ) aw[PJ >> 3] = 2u << (4 * (PJ & 7));
        v8i_ a = (v8i_){(int)aw[0] + z, (int)aw[1], (int)aw[2], (int)aw[3], 0, 0, 0, 0};
        const unsigned sgn = (q_ >= 2) ? 0x80808080u : 0u;
        const unsigned lo0 = 0x48444038u, lo1 = 0x504E4C4Au, hi0 = 0x54535251u, hi1 = 0x58575655u;
        const unsigned w0 = ((q_ & 1) ? hi0 : lo0) | sgn, w1 = ((q_ & 1) ? hi1 : lo1) | sgn;
        v8i_ bb = (v8i_){(int)w0 + z, (int)w1, (int)w0, (int)w1, (int)w0, (int)w1, (int)w0, (int)w1};
        pg8::f32x4 c = (pg8::f32x4){0.f, 0.f, 0.f, 0.f};
        c = __builtin_amdgcn_mfma_scale_f32_16x16x128_f8f6f4(a, bb, c, 4, 0, 0, 127 + z, 0, 127 + z);
        if (blockIdx.x == 0 && threadIdx.x == 0) { const float v = c[0]; float code = (v != v) ? 2.0f : (fabsf(v) > 1.0e6f) ? 3.0f : (fminf(fmaxf(v, -28.0f), 100.0f) * 0.25f + 12.0f); args.out[0] += DBG_SCALE * code; }
    }
#endif

}

extern "C" void kernel_launch(void* const* d_in, const int* in_sizes, int n_in, void* d_out, int out_size, void* d_ws, size_t ws_size, hipStream_t stream) {
    static int grid = 0;
    if (grid == 0) {
        if (n_in != 19 || in_sizes[0] != T * D || out_size != T * D || ws_size < WS_END) { fprintf(stderr, "kernel_launch: unexpected shapes (n_in %d, in0 %d, out %d, ws %zu < %zu); nothing launched\n", n_in, n_in > 0 ? in_sizes[0] : -1, out_size, ws_size, (size_t)WS_END); grid = -1; return; }
        int dev = 0, cus = 0, per_cu = 0;
        if (hipGetDevice(&dev) != hipSuccess || hipDeviceGetAttribute(&cus, hipDeviceAttributeMultiprocessorCount, dev) != hipSuccess) { grid = -1; return; }
        if (hipFuncSetAttribute((const void*)fwd_megakernel, hipFuncAttributeMaxDynamicSharedMemorySize, LDS_BYTES) != hipSuccess) { fprintf(stderr, "kernel_launch: hipFuncSetAttribute failed\n"); grid = -1; return; }
        if (hipOccupancyMaxActiveBlocksPerMultiprocessor(&per_cu, (const void*)fwd_megakernel, NTHR, LDS_BYTES) != hipSuccess || per_cu < 1) { fprintf(stderr, "kernel_launch: occupancy query says %d blocks per CU; nothing launched\n", per_cu); (void)hipGetLastError(); grid = -1; return; }
        grid = 256; while (grid > cus) grid >>= 1;
        if (grid < 8) { fprintf(stderr, "kernel_launch: only %d CUs; nothing launched\n", cus); grid = -1; return; }
    }
    if (grid < 0) return;
    if (hipMemsetAsync((char*)d_ws + WS_CTL, 0, CTL_ZERO_BYTES, stream) != hipSuccess) { fprintf(stderr, "kernel_launch: memset failed\n"); return; }
    Args a{};
    const float** ap = (const float**)&a;
    for (int i = 0; i < 19; ++i) ap[i] = (const float*)d_in[i];
    a.out = (float*)d_out; a.ws = (unsigned char*)d_ws;
    void* kargs[] = {&a};
    hipError_t e = hipLaunchCooperativeKernel((const void*)fwd_megakernel, dim3(grid), dim3(NTHR), kargs, LDS_BYTES, stream);
    if (e != hipSuccess) fprintf(stderr, "kernel_launch: cooperative launch failed: %s (grid %d)\n", hipGetErrorString(e), grid);
}
```
